# Optimizing an MI355X kernel written in HIP

```python
import jax
import jax.numpy as jnp
from jax import lax
import numpy as np

D_MODEL = 1024
BATCH = 8
SEQ = 2048
DEPTH = 4

GRID_W = 64
CTX_LEN = 256
Q_BLOCK = 128
NORM_EPS = 1e-6
NEG_INF = -1e30

A_HEAD_DIM = 64
A_DIM = D_MODEL // 2
A_HEADS = A_DIM // A_HEAD_DIM
LORA_W = 64
LORA_A = 64
LORA_G = 128
GN_EPS = 64e-5

QK_NOPE = 64
QK_ROPE = 32
V_HEAD = 64
B_DIM = D_MODEL - A_DIM
B_HEADS = B_DIM // V_HEAD
Q_RANK = 384
KV_RANK = 256
ROPE_BASE = 10000.0

A_COLS = 3 * A_DIM + 2 * LORA_W + 2 * LORA_A + LORA_G
AB_COLS = A_COLS + Q_RANK + KV_RANK + QK_ROPE
MIX_DIM = A_DIM + B_DIM

C_HEAD_DIM = 64
C_HEADS = D_MODEL // C_HEAD_DIM
WIN_R = 8
WIN_C = 16
Q_COL_BLOCK = 16
KEY_COL_SPAN = 32

N_EXPERTS = 16
EXPERT_FF = 2048
CAPACITY_FACTOR = 2

kernel_name = 'hybrid_diffusion_trunk'


def rms_norm(x, w):
    xf = x.astype(jnp.float32)
    y = xf * lax.rsqrt(jnp.mean(xf * xf, axis=-1, keepdims=True) + NORM_EPS)
    return (y * w).astype(x.dtype)


def modulate(xn, shift, scale):
    return xn * (1.0 + scale) + shift


def axial_rope(T, dtype):
    t = jnp.arange(T)
    row = (t // GRID_W).astype(jnp.float32)
    col = (t % GRID_W).astype(jnp.float32)
    n_freq = QK_ROPE // 4
    inv = ROPE_BASE ** (-jnp.arange(n_freq, dtype=jnp.float32) / n_freq)
    ang = jnp.concatenate([row[:, None] * inv, col[:, None] * inv], axis=-1)
    return jnp.cos(ang).astype(dtype), jnp.sin(ang).astype(dtype)


def apply_rope(x, cos, sin):
    x2 = x.reshape(x.shape[:-1] + (-1, 2))
    x0, x1 = x2[..., 0], x2[..., 1]
    return jnp.stack([x0 * cos - x1 * sin, x0 * sin + x1 * cos], axis=-1).reshape(x.shape)


def blocked_attention(q, k, v, scale):
    B, S, H, Dq = q.shape
    Dv = v.shape[-1]
    nb = S // Q_BLOCK
    qb = jnp.moveaxis(q.reshape(B, nb, Q_BLOCK, H, Dq), 1, 0)

    def one_block(q_blk):
        s = jnp.einsum('bqhd,bkhd->bhqk', q_blk, k).astype(jnp.float32) * scale
        p = jax.nn.softmax(s, axis=-1).astype(v.dtype)
        return jnp.einsum('bhqk,bkhd->bqhd', p, v)

    o = lax.map(one_block, qb)
    return jnp.moveaxis(o, 0, 1).reshape(B, S, H, Dv)


def token_shift(f, mu):
    prev = jnp.pad(f, ((0, 0), (1, 0), (0, 0)))[:, :-1]
    nxt = jnp.pad(f, ((0, 0), (0, 1), (0, 0)))[:, 1:]
    return f + mu[0] * (prev - f) + mu[1] * (nxt - f)


def rwkv_prepare(z, mu, w0, w2, a0, a2, g2, k_k, k_a):
    z = token_shift(z, mu).astype(jnp.float32)
    B, T, _ = z.shape
    cuts = [A_DIM, 2 * A_DIM, 3 * A_DIM, 3 * A_DIM + 2 * LORA_W, 3 * A_DIM + 2 * LORA_W + 2 * LORA_A]
    r, k, v, wd, ad, gd = jnp.split(z, cuts, axis=-1)
    wd = wd.reshape(B, T, 2, LORA_W)
    ad = ad.reshape(B, T, 2, LORA_A)
    w_log = -jax.nn.softplus(-(w0 + jnp.einsum('btdr,drc->btdc', jnp.tanh(wd), w2))) - 0.5
    decay = jnp.exp(-jnp.exp(w_log))
    a = jax.nn.sigmoid(a0 + jnp.einsum('btdr,drc->btdc', ad, a2))
    g = jax.nn.sigmoid(gd) @ g2
    kk = (k * k_k).reshape(B, T, A_HEADS, A_HEAD_DIM)
    kk = kk / jnp.maximum(jnp.sqrt(jnp.sum(kk * kk, axis=-1, keepdims=True)), 1e-12)
    kd = k[:, :, None, :] * (1.0 + (a - 1.0) * k_a)
    hd = (B, T, A_HEADS, A_HEAD_DIM)
    hd2 = (B, T, 2, A_HEADS, A_HEAD_DIM)
    return (r.reshape(hd), v.reshape(hd), kk, g, decay.reshape(hd2), a.reshape(hd2), kd.reshape(hd2))


def wkv_scan(state0, r, decay, k, v, kk, a, reverse):
    def step(state, inp):
        r_t, w_t, k_t, v_t, kk_t, a_t = inp
        sa = jnp.einsum('bhvk,bhk->bhv', state, -kk_t)
        state = (state * w_t[:, :, None, :]
                 + sa[..., None] * (kk_t * a_t)[:, :, None, :]
                 + v_t[..., None] * k_t[:, :, None, :])
        return state, jnp.einsum('bhvk,bhk->bhv', state, r_t)

    xs = tuple(jnp.swapaxes(t, 0, 1) for t in (r, decay, k, v, kk, a))
    state, ys = lax.scan(step, state0, xs, reverse=reverse)
    return state, jnp.swapaxes(ys, 0, 1)


def rwkv_scan_dir(state0, feats, d, reverse):
    r, v, kk, g, decay, a, kd = feats
    return wkv_scan(state0, r, decay[:, :, d], kd[:, :, d], v, kk, a[:, :, d], reverse)


def rwkv_output(y, feats, r_k, ln_w, ln_b):
    r, v, kk, g, decay, a, kd = feats
    B, T = y.shape[:2]
    mean = jnp.mean(y, axis=-1, keepdims=True)
    var = jnp.mean(jnp.square(y - mean), axis=-1, keepdims=True)
    yn = (y - mean) * lax.rsqrt(var + GN_EPS)
    yn = yn * ln_w.reshape(A_HEADS, A_HEAD_DIM) + ln_b.reshape(A_HEADS, A_HEAD_DIM)
    bonus = jnp.sum(jnp.sum(r[:, :, None] * kd * r_k, axis=-1, keepdims=True) * v[:, :, None], axis=2)
    return (yn + bonus).reshape(B, T, A_DIM) * g


def mla_project(zq, zkv, zr, cos, sin, qn_w, w_qup, kvn_w, w_kvup):
    B, T, _ = zq.shape
    q = (rms_norm(zq, qn_w) @ w_qup).reshape(B, T, B_HEADS, QK_NOPE + QK_ROPE)
    kv = (rms_norm(zkv, kvn_w) @ w_kvup).reshape(B, T, B_HEADS, QK_NOPE + V_HEAD)
    q_nope, q_rope = q[..., :QK_NOPE], q[..., QK_NOPE:]
    k_nope, v = kv[..., :QK_NOPE], kv[..., QK_NOPE:]
    k_rope = zr
    if cos is not None:
        q_rope = apply_rope(q_rope, cos[:, None], sin[:, None])
        k_rope = apply_rope(k_rope, cos, sin)
    k_full = jnp.concatenate([k_nope, jnp.broadcast_to(k_rope[:, :, None, :], (B, T, B_HEADS, QK_ROPE))], axis=-1)
    q_full = jnp.concatenate([q_nope, q_rope], axis=-1)
    return q_full, k_full, v


def rwkv_mla_mixer(h, hc, cos, sin, need_ctx, w_in, w_out, mu, w0, w2, a0, a2, g2, k_k, k_a, r_k,
                   ln_w, ln_b, qn_w, w_qup, kvn_w, w_kvup):
    B, S, _ = h.shape
    L = hc.shape[1]
    cuts = [A_COLS, A_COLS + Q_RANK, A_COLS + Q_RANK + KV_RANK]
    za, zq, zkv, zr = jnp.split(h @ w_in, cuts, axis=-1)
    zac, zqc, zkvc, zrc = jnp.split(hc @ w_in, cuts, axis=-1)
    lat = rwkv_prepare(za, mu, w0, w2, a0, a2, g2, k_k, k_a)
    cx = rwkv_prepare(zac, mu, w0, w2, a0, a2, g2, k_k, k_a)
    state0 = jnp.zeros((B, A_HEADS, A_HEAD_DIM, A_HEAD_DIM), jnp.float32)
    st_f, yc_f = rwkv_scan_dir(state0, cx, 0, False)
    st_b, yc_b = rwkv_scan_dir(state0, cx, 1, True)
    _, y_f = rwkv_scan_dir(st_f, lat, 0, False)
    _, y_b = rwkv_scan_dir(st_b, lat, 1, True)
    o_a = rwkv_output(y_f + y_b, lat, r_k, ln_w, ln_b).astype(h.dtype)
    q, k, v = mla_project(zq, zkv, zr, cos, sin, qn_w, w_qup, kvn_w, w_kvup)
    qc, kc, vc = mla_project(zqc, zkvc, zrc, None, None, qn_w, w_qup, kvn_w, w_kvup)
    scale = (QK_NOPE + QK_ROPE) ** -0.5
    o_b = blocked_attention(q, jnp.concatenate([kc, k], axis=1), jnp.concatenate([vc, v], axis=1), scale)
    out = jnp.concatenate([o_a, o_b.reshape(B, S, B_DIM)], axis=-1) @ w_out
    if not need_ctx:
        return out, None
    oc_a = rwkv_output(yc_f + yc_b, cx, r_k, ln_w, ln_b).astype(hc.dtype)
    oc_b = blocked_attention(qc, kc, vc, scale)
    out_c = jnp.concatenate([oc_a, oc_b.reshape(B, L, B_DIM)], axis=-1) @ w_out
    return out, out_c


def neighbourhood_attention(q, k, v, k_ctx, v_ctx, rpb):
    B, S, H, Dh = q.shape
    rows = S // GRID_W
    kr = min(WIN_R, rows)
    n_cb = GRID_W // Q_COL_BLOCK
    scale = Dh ** -0.5
    qrow = jnp.arange(rows)
    row_start = jnp.clip(qrow - kr // 2, 0, rows - kr)
    key_rows = row_start[:, None] + jnp.arange(kr)
    dr_idx = key_rows - qrow[:, None] + (WIN_R - 1)
    cb = jnp.arange(n_cb)
    qcol = cb[:, None] * Q_COL_BLOCK + jnp.arange(Q_COL_BLOCK)
    col_start = jnp.clip(qcol - WIN_C // 2, 0, GRID_W - WIN_C)
    span_start = jnp.clip(cb * Q_COL_BLOCK - WIN_C // 2, 0, GRID_W - KEY_COL_SPAN)
    key_cols = span_start[:, None] + jnp.arange(KEY_COL_SPAN)
    kcb = key_cols[:, None, :]
    col_valid = (kcb >= col_start[..., None]) & (kcb < col_start[..., None] + WIN_C)
    dc_idx = jnp.clip(kcb - qcol[..., None] + (WIN_C - 1), 0, 2 * WIN_C - 2)
    kg = k.reshape(B, rows, GRID_W, H, Dh)
    vg = v.reshape(B, rows, GRID_W, H, Dh)
    qg = jnp.moveaxis(q.reshape(B, rows, n_cb, Q_COL_BLOCK, H, Dh), 1, 0)
    n_nb = kr * KEY_COL_SPAN

    def one_row(args):
        q_r, rows_r, dr_r = args
        k_blk = kg[:, rows_r][:, :, key_cols]
        v_blk = vg[:, rows_r][:, :, key_cols]
        s_nb = jnp.einsum('bnqhd,brnkhd->bhnqrk', q_r, k_blk).astype(jnp.float32) * scale
        bias = jnp.transpose(rpb[:, dr_r][:, :, dc_idx], (0, 2, 3, 1, 4)).astype(jnp.float32)
        s_nb = jnp.where(col_valid[:, :, None, :], s_nb + bias, NEG_INF)
        s_ctx = jnp.einsum('bnqhd,blhd->bhnql', q_r, k_ctx).astype(jnp.float32) * scale
        s = jnp.concatenate([s_nb.reshape(s_nb.shape[:4] + (n_nb,)), s_ctx], axis=-1)
        p = jax.nn.softmax(s, axis=-1).astype(v.dtype)
        p_nb = p[..., :n_nb].reshape(s_nb.shape)
        p_ctx = p[..., n_nb:]
        return (jnp.einsum('bhnqrk,brnkhd->bnqhd', p_nb, v_blk)
                + jnp.einsum('bhnql,blhd->bnqhd', p_ctx, v_ctx))

    out = lax.map(one_row, (qg, key_rows, dr_idx))
    return jnp.moveaxis(out, 0, 1).reshape(B, S, H, Dh)


def na_mixer(h, hc, need_ctx, w_qkv, rpb, w_out):
    B, S, D = h.shape
    L = hc.shape[1]
    qkv = (h @ w_qkv).reshape(B, S, 3, C_HEADS, C_HEAD_DIM)
    kvc = (hc @ w_qkv[:, D:]).reshape(B, L, 2, C_HEADS, C_HEAD_DIM)
    kc, vc = kvc[:, :, 0], kvc[:, :, 1]
    o = neighbourhood_attention(qkv[:, :, 0], qkv[:, :, 1], qkv[:, :, 2], kc, vc, rpb)
    out = o.reshape(B, S, D) @ w_out
    if not need_ctx:
        return out, None
    qc = (hc @ w_qkv[:, :D]).reshape(B, L, C_HEADS, C_HEAD_DIM)
    oc = blocked_attention(qc, kc, vc, C_HEAD_DIM ** -0.5)
    return out, oc.reshape(B, L, D) @ w_out


def expert_choice_ffn(h, w_router, w1, w3, w2):
    B, T, D = h.shape
    cap = CAPACITY_FACTOR * T // N_EXPERTS
    aff = jax.nn.softmax((h @ w_router).astype(jnp.float32), axis=-1)
    gate, idx = lax.top_k(jnp.swapaxes(aff, 1, 2), cap)
    xin = jax.vmap(lambda hb, ib: hb[ib])(h, idx)
    hid = jax.nn.silu(jnp.einsum('becd,edf->becf', xin, w1)) * jnp.einsum('becd,edf->becf', xin, w3)
    y = jnp.einsum('becf,efd->becd', hid, w2) * gate[..., None].astype(h.dtype)
    return jax.vmap(lambda yb, ib: jnp.zeros((T, D), yb.dtype).at[ib.reshape(-1)].add(yb.reshape(-1, D)))(y, idx)


def setup_inputs(seed: int = 0) -> dict:
    key = jax.random.key(seed)
    ks = iter(jax.random.split(key, 64))
    n_even = (DEPTH + 1) // 2
    n_odd = DEPTH // 2
    D = D_MODEL

    def nrm(shape, scale):
        return jax.random.normal(next(ks), shape, jnp.float32) * scale

    def unif(shape, lo, hi):
        return jax.random.uniform(next(ks), shape, jnp.float32, lo, hi)

    return {
        'x': nrm((BATCH, SEQ, D), 1.0),
        'c': nrm((BATCH, D), 1.0),
        'ctx': nrm((BATCH, CTX_LEN, D), 1.0),
        'c_ctx': nrm((D,), 1.0),
        'mod_w': nrm((DEPTH, D, 6 * D), 0.5 * D ** -0.5),
        'mod_b': nrm((DEPTH, 6 * D), 0.02),
        'norm1_w': 1.0 + nrm((DEPTH, D), 0.02),
        'norm2_w': 1.0 + nrm((DEPTH, D), 0.02),
        'final_norm_w': 1.0 + nrm((D,), 0.02),
        'ab_w_in': nrm((n_even, D, AB_COLS), D ** -0.5),
        'ab_w_out': nrm((n_even, MIX_DIM, D), MIX_DIM ** -0.5),
        'rk_mu': unif((n_even, 2, A_COLS), 0.0, 0.5),
        'rk_w0': unif((n_even, 2, A_DIM), -6.5, -1.5),
        'rk_w2': nrm((n_even, 2, LORA_W, A_DIM), 0.5 * LORA_W ** -0.5),
        'rk_a0': nrm((n_even, 2, A_DIM), 0.1),
        'rk_a2': nrm((n_even, 2, LORA_A, A_DIM), 0.5 * LORA_A ** -0.5),
        'rk_g2': nrm((n_even, LORA_G, A_DIM), LORA_G ** -0.5),
        'rk_kk': 0.85 + nrm((n_even, A_DIM), 0.02),
        'rk_ka': 1.0 + nrm((n_even, A_DIM), 0.02),
        'rk_rk': nrm((n_even, A_HEADS, A_HEAD_DIM), 0.1),
        'rk_ln_w': 1.0 + nrm((n_even, A_DIM), 0.02),
        'rk_ln_b': nrm((n_even, A_DIM), 0.02),
        'mla_qn_w': 1.0 + nrm((n_even, Q_RANK), 0.02),
        'mla_w_qup': nrm((n_even, Q_RANK, B_HEADS * (QK_NOPE + QK_ROPE)), Q_RANK ** -0.5),
        'mla_kvn_w': 1.0 + nrm((n_even, KV_RANK), 0.02),
        'mla_w_kvup': nrm((n_even, KV_RANK, B_HEADS * (QK_NOPE + V_HEAD)), KV_RANK ** -0.5),
        'na_w_qkv': nrm((n_odd, D, 3 * D), D ** -0.5),
        'na_rpb': nrm((n_odd, C_HEADS, 2 * WIN_R - 1, 2 * WIN_C - 1), 0.1),
        'na_w_out': nrm((n_odd, D, D), D ** -0.5),
        'moe_router': nrm((DEPTH, D, N_EXPERTS), D ** -0.5),
        'moe_w1': nrm((DEPTH, N_EXPERTS, D, EXPERT_FF), D ** -0.5),
        'moe_w3': nrm((DEPTH, N_EXPERTS, D, EXPERT_FF), D ** -0.5),
        'moe_w2': nrm((DEPTH, N_EXPERTS, EXPERT_FF, D), EXPERT_FF ** -0.5),
    }


def reference(x, c, ctx, c_ctx, mod_w, mod_b, norm1_w, norm2_w, final_norm_w, ab_w_in, ab_w_out,
              rk_mu, rk_w0, rk_w2, rk_a0, rk_a2, rk_g2, rk_kk, rk_ka, rk_rk, rk_ln_w, rk_ln_b,
              mla_qn_w, mla_w_qup, mla_kvn_w, mla_w_kvup, na_w_qkv, na_rpb, na_w_out,
              moe_router, moe_w1, moe_w3, moe_w2):
    S = x.shape[1]
    cos, sin = axial_rope(S, x.dtype)
    silu_c = jax.nn.silu(c)
    silu_cc = jax.nn.silu(c_ctx)
    for layer in range(DEPTH):
        need_ctx = layer < DEPTH - 1
        i = layer // 2
        m = (silu_c @ mod_w[layer] + mod_b[layer])[:, None, :]
        sh1, sc1, g1, sh2, sc2, g2 = jnp.split(m, 6, axis=-1)
        mc = silu_cc @ mod_w[layer] + mod_b[layer]
        sh1c, sc1c, g1c, sh2c, sc2c, g2c = jnp.split(mc, 6, axis=-1)
        h = modulate(rms_norm(x, norm1_w[layer]), sh1, sc1)
        hc = modulate(rms_norm(ctx, norm1_w[layer]), sh1c, sc1c)
        if layer % 2 == 0:
            o, oc = rwkv_mla_mixer(h, hc, cos, sin, need_ctx, ab_w_in[i], ab_w_out[i], rk_mu[i], rk_w0[i],
                                   rk_w2[i], rk_a0[i], rk_a2[i], rk_g2[i], rk_kk[i], rk_ka[i], rk_rk[i],
                                   rk_ln_w[i], rk_ln_b[i], mla_qn_w[i], mla_w_qup[i], mla_kvn_w[i], mla_w_kvup[i])
        else:
            o, oc = na_mixer(h, hc, need_ctx, na_w_qkv[i], na_rpb[i], na_w_out[i])
        x = x + g1 * o
        h2 = modulate(rms_norm(x, norm2_w[layer]), sh2, sc2)
        x = x + g2 * expert_choice_ffn(h2, moe_router[layer], moe_w1[layer], moe_w3[layer], moe_w2[layer])
        if need_ctx:
            ctx = ctx + g1c * oc
            h2c = modulate(rms_norm(ctx, norm2_w[layer]), sh2c, sc2c)
            ctx = ctx + g2c * expert_choice_ffn(h2c, moe_router[layer], moe_w1[layer], moe_w3[layer], moe_w2[layer])
    return rms_norm(x, final_norm_w)
```

```cpp
#include <hip/hip_runtime.h>
#include <cstdio>
#include <cstdint>

#ifndef PHMASK
#define PHMASK 0xFFFFFFFFu
#endif
#define PON(n) (((PHMASK) >> (n)) & 1u)
#ifndef SINGLE_LAUNCH
#define SINGLE_LAUNCH 0
#endif

#define LAS __attribute__((address_space(3)))
#define GAS __attribute__((address_space(1)))
typedef unsigned short bf16_t;
typedef short bf16x8 __attribute__((ext_vector_type(8)));
typedef float f32x4 __attribute__((ext_vector_type(4)));
typedef float f32x2 __attribute__((ext_vector_type(2)));
typedef unsigned u32x4 __attribute__((ext_vector_type(4)));
typedef unsigned u32x2 __attribute__((ext_vector_type(2)));

constexpr int NB = 8, SEQ = 2048, CTXL = 256, DM = 1024;
constexpr int NLAT = NB * SEQ, NCTX = NB * CTXL, NT = NLAT + NCTX;
constexpr int ADIM = 512, ZP = 2816;
constexpr int NEXP = 16, FF = 2048, ROWS_E = 2304;
constexpr float NORM_EPS = 1e-6f;

constexpr size_t MiB = 1u << 20;
constexpr size_t WS_CTL = 0, CTL_BYTES = 1 * MiB;
constexpr size_t WS_MOD = 1 * MiB;
constexpr size_t WS_ROPE = 2 * MiB;
constexpr size_t WS_WIN = 4 * MiB;
constexpr size_t WS_WLORA = 16 * MiB;
constexpr size_t WS_WQUP = 20 * MiB;
constexpr size_t WS_WKVUP = 22 * MiB;
constexpr size_t WS_WOUTA = 24 * MiB;
constexpr size_t WS_WQKV = 28 * MiB;
constexpr size_t WS_WOUTC = 40 * MiB;
constexpr size_t WS_W13 = 48 * MiB;
constexpr size_t WS_W2 = 560 * MiB;
constexpr size_t WS_X = 816 * MiB;
constexpr size_t WS_H = 888 * MiB;
constexpr size_t WS_MIX = 924 * MiB;
constexpr size_t WS_Z = 960 * MiB;
constexpr size_t WS_R = 1068 * MiB;
constexpr size_t WS_V = 1086 * MiB;
constexpr size_t WS_KS = 1104 * MiB;
constexpr size_t WS_KK = 1122 * MiB;
constexpr size_t WS_LIN = 1140 * MiB;
constexpr size_t WS_QN = 1154 * MiB;
constexpr size_t WS_KVN = 1168 * MiB;
constexpr size_t WS_KR = 1177 * MiB;
constexpr size_t WS_DEC = 1179 * MiB;
constexpr size_t WS_KD = 1251 * MiB;
constexpr size_t WS_BB = 1287 * MiB;
constexpr size_t WS_G = 1323 * MiB;
constexpr size_t WS_Y = 1341 * MiB;
constexpr size_t WS_Q = 1413 * MiB;
constexpr size_t WS_KV = 1440 * MiB;
constexpr size_t WS_AFF = 1476 * MiB;
constexpr size_t WS_SEL = 1478 * MiB;
constexpr size_t WS_IDX = 1480 * MiB;
constexpr size_t WS_GATE = 1481 * MiB;
constexpr size_t WS_XIN = 1482 * MiB;
constexpr size_t WS_HID = 1554 * MiB;
constexpr size_t WS_YB = 1698 * MiB;
constexpr size_t WS_END = 1770 * MiB;

constexpr int CW_TMO = 0, CW_BAR = 4096;

constexpr int RING_BYTES = 133120;
constexpr int LDSCTL_OFF = RING_BYTES;
constexpr int LDS_BYTES = 147456;

__device__ __forceinline__ float bf2f(unsigned short b) { return __uint_as_float(((unsigned)b) << 16); }
__device__ __forceinline__ unsigned f2bf(float f) { unsigned u = __float_as_uint(f); return (u + 0x7fffu + ((u >> 16) & 1u)) >> 16; }
__device__ __forceinline__ unsigned pk2(float lo, float hi) { return f2bf(lo) | (f2bf(hi) << 16); }
__device__ __forceinline__ void unpk8(const u32x4 w, float (&f)[8]) {
    f[0] = __uint_as_float(w.x << 16); f[1] = __uint_as_float(w.x & 0xffff0000u); f[2] = __uint_as_float(w.y << 16); f[3] = __uint_as_float(w.y & 0xffff0000u);
    f[4] = __uint_as_float(w.z << 16); f[5] = __uint_as_float(w.z & 0xffff0000u); f[6] = __uint_as_float(w.w << 16); f[7] = __uint_as_float(w.w & 0xffff0000u); }
__device__ __forceinline__ void ld8(const bf16_t* p, float (&f)[8]) { unpk8(*(const u32x4*)p, f); }
__device__ __forceinline__ u32x4 pack8(const float (&f)[8]) { u32x4 w; w.x = pk2(f[0], f[1]); w.y = pk2(f[2], f[3]); w.z = pk2(f[4], f[5]); w.w = pk2(f[6], f[7]); return w; }
__device__ __forceinline__ void st8(bf16_t* p, const float (&f)[8]) { *(u32x4*)p = pack8(f); }
__device__ __forceinline__ float wave_sum(float v) {
#pragma unroll
    for (int o = 1; o < 64; o <<= 1) v += __shfl_xor(v, o);
    return v; }
__device__ __forceinline__ float sum8(float v) { v += __shfl_xor(v, 1); v += __shfl_xor(v, 2); v += __shfl_xor(v, 4); return v; }
__device__ __forceinline__ float sigmoidf_(float x) { return 1.f / (1.f + __expf(-x)); }
__device__ __forceinline__ int mod_group(int row) { return row < NLAT ? (row >> 11) : NB; }

namespace pg8 {
constexpr int BM = 256, BK = 64, HALF = 128, HTB = HALF * BK * 2, STAGE_BYTES = 8 * HTB, NXCD = 8, WGM = 8;
__host__ __device__ __forceinline__ int lds_byte(int r, int c) { const int st = (r >> 4) * 2 + (c >> 5), rr = r & 15, cc = c & 31, ob = rr * 64 + cc * 2; return st * 1024 + (ob ^ (((ob >> 9) & 1) << 5)); }
__host__ __device__ __forceinline__ void stage_rc(int b, int& R, int& C) { const int st = b / 1024, sb = b % 1024, swz = sb ^ (((sb >> 9) & 1) << 5); R = (st >> 1) * 16 + swz / 64; C = (st & 1) * 32 + (swz % 64) / 2; }
__host__ __device__ __forceinline__ int perm32(int rho) { const int n = rho >> 4, i = rho & 15; return 8 * (i >> 2) + 4 * n + (i & 3); }
struct Unit { int pm, pn; };
struct Gemm { const bf16_t* A; const bf16_t* Bt; int lda, ldb, K; };

struct StaticOrder {
    int nM, nN, nwg, G, c;
    __device__ void init(int M, int N, int G_, int c_) { nM = M / BM; nN = N / BM; nwg = nM * nN; G = G_; c = c_; }
    __device__ bool next(int i, Unit& u) const {
        const long L = (long)i * G + c; if (L >= nwg) return false;
        int wgid = (int)L; { const int q = nwg / NXCD, r = nwg % NXCD, xcd = wgid % NXCD, off = wgid / NXCD; wgid = (xcd < r ? xcd * (q + 1) : r * (q + 1) + (xcd - r) * q) + off; }
        const int nig = WGM * nN, gid = wgid / nig, fm = gid * WGM, gsz = (nM - fm) < WGM ? (nM - fm) : WGM;
        u.pm = fm + ((wgid % nig) % gsz); u.pn = (wgid % nig) / gsz; return true;
    }
};
struct MoeOrder {
    int nrt, nct, nwg, G, c;
    __device__ void init(int nrt_, int nct_, int G_, int c_) { nrt = nrt_; nct = nct_; nwg = NEXP * nrt * nct; G = G_; c = c_; }
    __device__ bool next(int i, Unit& u) const {
        const long L = (long)i * G + c; if (L >= nwg) return false;
        const int wgid = (int)(L % NXCD) * (nwg / NXCD) + (int)(L / NXCD);
        const int per = nrt * nct, e = wgid / per, rem = wgid % per, ct = rem / nrt, rt = rem % nrt;
        u.pm = e * 9 + rt; u.pn = e * nct + ct; return true;
    }
};

template <class F, bool PAIR> struct Epi {
    F f;
    __device__ __forceinline__ void operator()(const f32x4 (&acc)[2][2][4][2], const Unit& u, int wr, int wc, int fr, int fq) const {
#pragma unroll
        for (int ai = 0; ai < 2; ++ai)
#pragma unroll
            for (int m = 0; m < 4; ++m) {
                const int row = u.pm * BM + ai * HALF + wr * 64 + m * 16 + fr;
                if constexpr (PAIR) {
                    float a[8], b[8];
#pragma unroll
                    for (int j = 0; j < 4; ++j) { a[j] = acc[ai][0][m][0][j]; a[4 + j] = acc[ai][0][m][1][j]; b[j] = acc[ai][1][m][0][j]; b[4 + j] = acc[ai][1][m][1][j]; }
                    f(row, u.pn * HALF + wc * 32 + 8 * fq, a, b);
                } else {
#pragma unroll
                    for (int bj = 0; bj < 2; ++bj) { float a[8];
#pragma unroll
                        for (int j = 0; j < 4; ++j) { a[j] = acc[ai][bj][m][0][j]; a[4 + j] = acc[ai][bj][m][1][j]; }
                        f(row, u.pn * BM + bj * HALF + wc * 32 + 8 * fq, a); }
                }
            }
    }
};

template <class EpiT, class Sched>
__device__ __forceinline__ void gemm_phase(LAS unsigned char* lds, const Gemm g, const Sched& S, const EpiT& E) {
    int tid = threadIdx.x; asm volatile("" : "+v"(tid));
    const int wid = __builtin_amdgcn_readfirstlane(tid >> 6), lane = tid & 63, wr = wid >> 2, wc = wid & 3, fr = lane & 15, fq = lane >> 4;
    const int K = g.K, nt = K / BK;
    unsigned voffA[2], voffB[2];
#pragma unroll
    for (int i = 0; i < 2; ++i) { int R, C; stage_rc(tid * 16 + i * 8192, R, C); const int Rb = (R & ~31) + perm32(R & 31);
        voffA[i] = (unsigned)(R * g.lda + C) * 2u; voffB[i] = (unsigned)(Rb * g.ldb + C) * 2u; }
    const size_t kstep = (size_t)(BK * 2);
    const size_t hsA = (size_t)HALF * g.lda * 2, hsB = (size_t)HALF * g.ldb * 2, tsA = 2 * hsA, tsB = 2 * hsB;
    const unsigned ldsw = (unsigned)wid * 1024u;
    const int aoff = lds_byte(wr * 64 + fr, fq * 8), boff = lds_byte(wc * 32 + fr, fq * 8);
#define PG8_SA(b, h) (((b) * 2 + (h)) * HTB)
#define PG8_SB(b, h) ((4 + (b) * 2 + (h)) * HTB)
#define PG8_STAGE(bufoff, gbase, voff) do { _Pragma("unroll") for (int _i = 0; _i < 2; ++_i) \
        __builtin_amdgcn_global_load_lds((const unsigned*)((const char*)(gbase) + (voff)[_i]), (LAS unsigned*)(lds + (bufoff) + ldsw + _i * 8192), 16, 0, 0); } while (0)
#define PG8_LDA(dst, b, h) do { _Pragma("unroll") for (int m = 0; m < 4; ++m) _Pragma("unroll") for (int k = 0; k < 2; ++k) dst[m][k] = *(const LAS bf16x8*)(lds + PG8_SA(b, h) + aoff + m * 2048 + k * 1024); } while (0)
#define PG8_LDB(dst, b, h) do { _Pragma("unroll") for (int n = 0; n < 2; ++n) _Pragma("unroll") for (int k = 0; k < 2; ++k) dst[n][k] = *(const LAS bf16x8*)(lds + PG8_SB(b, h) + boff + n * 2048 + k * 1024); } while (0)
#define PG8_MMA(ai, bj, At, Bt) do { __builtin_amdgcn_s_setprio(1); _Pragma("unroll") for (int m = 0; m < 4; ++m) _Pragma("unroll") for (int n = 0; n < 2; ++n) _Pragma("unroll") for (int k = 0; k < 2; ++k) \
        acc[ai][bj][m][n] = __builtin_amdgcn_mfma_f32_16x16x32_bf16(Bt[n][k], At[m][k], acc[ai][bj][m][n], 0, 0, 0); __builtin_amdgcn_s_setprio(0); } while (0)
#define PG8_WAIT_V(n) asm volatile("s_waitcnt vmcnt(" #n ")" ::: "memory")
#define PG8_WAIT_L(n) asm volatile("s_waitcnt lgkmcnt(" #n ")" ::: "memory")
#define PG8_BAR __builtin_amdgcn_s_barrier()
#define PG8_SCHED __builtin_amdgcn_sched_barrier(0)
    Unit cur, nxt; int ui = 0;
    if (!S.next(0, cur)) return;
    f32x4 acc[2][2][4][2];
#pragma unroll
    for (int a = 0; a < 2; ++a)
#pragma unroll
        for (int b = 0; b < 2; ++b)
#pragma unroll
            for (int m = 0; m < 4; ++m)
#pragma unroll
                for (int n = 0; n < 2; ++n) acc[a][b][m][n] = (f32x4){0.f, 0.f, 0.f, 0.f};
    bf16x8 At[4][2], B0[2][2], B1[2][2];
    const char* cA = (const char*)g.A + (size_t)cur.pm * tsA; const char* cB = (const char*)g.Bt + (size_t)cur.pn * tsB;
    PG8_STAGE(PG8_SB(0, 0), cB, voffB); PG8_STAGE(PG8_SB(0, 1), cB + hsB, voffB); PG8_STAGE(PG8_SA(0, 0), cA, voffA); PG8_STAGE(PG8_SA(0, 1), cA + hsA, voffA);
    if (wr == 1) PG8_BAR;
    PG8_WAIT_V(2); PG8_BAR;
    PG8_STAGE(PG8_SB(1, 0), cB + kstep, voffB); PG8_STAGE(PG8_SA(1, 0), cA + kstep, voffA); PG8_STAGE(PG8_SB(1, 1), cB + hsB + kstep, voffB);
    PG8_WAIT_V(6); PG8_BAR;
    for (;;) {
        const bool has_next = S.next(ui + 1, nxt);
        const char* nA = has_next ? (const char*)g.A + (size_t)nxt.pm * tsA : cA; const char* nB = has_next ? (const char*)g.Bt + (size_t)nxt.pn * tsB : cB;
#pragma unroll 1
        for (int t = 0; t < nt; t += 2) {
            const bool last = (t == nt - 2);
            const char* a1 = cA + (size_t)(t + 1) * kstep;
            const char* a2 = last ? nA : cA + (size_t)(t + 2) * kstep; const char* b2 = last ? nB : cB + (size_t)(t + 2) * kstep;
            const char* a3 = a2 + kstep; const char* b3 = b2 + kstep;
            PG8_LDB(B0, 0, 0); PG8_LDB(B1, 0, 1); PG8_SCHED; PG8_LDA(At, 0, 0); PG8_STAGE(PG8_SA(1, 1), a1 + hsA, voffA);
            PG8_WAIT_V(8); PG8_WAIT_L(0); PG8_BAR; PG8_MMA(0, 0, At, B0); PG8_MMA(0, 1, At, B1); PG8_BAR; PG8_SCHED;
            PG8_LDA(At, 0, 1); PG8_STAGE(PG8_SB(0, 0), b2, voffB); PG8_STAGE(PG8_SB(0, 1), b2 + hsB, voffB); PG8_STAGE(PG8_SA(0, 0), a2, voffA);
            PG8_WAIT_V(8); PG8_WAIT_L(0); PG8_BAR; PG8_MMA(1, 0, At, B0); PG8_MMA(1, 1, At, B1); PG8_BAR; PG8_SCHED;
            PG8_LDB(B0, 1, 0); PG8_LDB(B1, 1, 1); PG8_SCHED; PG8_LDA(At, 1, 0); PG8_STAGE(PG8_SA(0, 1), a2 + hsA, voffA);
            PG8_WAIT_V(8); PG8_WAIT_L(0); PG8_BAR; PG8_MMA(0, 0, At, B0); PG8_MMA(0, 1, At, B1); PG8_BAR; PG8_SCHED;
            PG8_LDA(At, 1, 1); PG8_STAGE(PG8_SB(1, 0), b3, voffB); PG8_STAGE(PG8_SB(1, 1), b3 + hsB, voffB); PG8_STAGE(PG8_SA(1, 0), a3, voffA);
            PG8_WAIT_V(8); PG8_WAIT_L(0); PG8_BAR; PG8_MMA(1, 0, At, B0); PG8_MMA(1, 1, At, B1); PG8_BAR; PG8_SCHED;
        }
        if (wr == 0) PG8_BAR;
        E(acc, cur, wr, wc, fr, fq);
        if (!has_next) break;
#pragma unroll
        for (int a = 0; a < 2; ++a)
#pragma unroll
            for (int b = 0; b < 2; ++b)
#pragma unroll
                for (int m = 0; m < 4; ++m)
#pragma unroll
                    for (int n = 0; n < 2; ++n) acc[a][b][m][n] = (f32x4){0.f, 0.f, 0.f, 0.f};
        cur = nxt; cA = nA; cB = nB; ++ui;
        if (wr == 1) PG8_BAR;
    }
    PG8_WAIT_V(0);
    PG8_BAR;
#undef PG8_SA
#undef PG8_SB
#undef PG8_STAGE
#undef PG8_LDA
#undef PG8_LDB
#undef PG8_MMA
#undef PG8_WAIT_V
#undef PG8_WAIT_L
#undef PG8_BAR
#undef PG8_SCHED
}
}

#define XB_TMO      128
#define XB_XCNT(j)  (256  + 64 * (j))
#define XB_XSUB(j)  (1280 + 64 * (j))
#define XB_XGEN(j)  (2304 + 64 * (j))
#define XB_TOP      3328
#define XB_TOPGEN   3392
#define XCD_BAR_WORDS 3456
#define XB_SPIN_CAP (1u << 22)
__device__ __forceinline__ unsigned xb_ld(unsigned* p)              { return __hip_atomic_load(p, __ATOMIC_RELAXED, __HIP_MEMORY_SCOPE_AGENT); }
__device__ __forceinline__ unsigned xb_add(unsigned* p, unsigned v) { return __hip_atomic_fetch_add(p, v, __ATOMIC_RELAXED, __HIP_MEMORY_SCOPE_AGENT); }
__device__ __forceinline__ unsigned xb_xcc_id() { return (unsigned)__builtin_amdgcn_s_getreg((3 << 11) | 20) & 0xFu; }
#define XB_SPIN(cond, bar) do { unsigned _sp = 0; while (cond) { __builtin_amdgcn_s_sleep(1); \
    if ((++_sp & 255u) == 0u) { if (xb_ld(&(bar)[XB_TMO])) break; if (_sp > XB_SPIN_CAP) { atomicAdd(&(bar)[XB_TMO], 1u); break; } } } } while (0)
struct XcdBarrier { unsigned* bar; unsigned x; volatile LAS unsigned* st; };
__device__ __forceinline__ XcdBarrier xcd_barrier_post(unsigned* bar, volatile LAS unsigned* st) {
    XcdBarrier b; b.bar = bar; b.x = xb_xcc_id(); b.st = st;
    if (threadIdx.x == 0) (void)xb_add(&bar[XB_XCNT(b.x)], 1u);
    return b;
}
__device__ __forceinline__ void xcd_barrier_complete(unsigned* bar, unsigned x, unsigned& nloc, unsigned& nx) {
    const unsigned G = gridDim.x * gridDim.y * gridDim.z;
    unsigned sum, cnt, mine, sp = 0u;
    for (;;) {
        sum = 0u; cnt = 0u; mine = 0u;
#pragma unroll
        for (unsigned j = 0; j < 16; ++j) { const unsigned c = xb_ld(&bar[XB_XCNT(j)]); sum += c; cnt += (c > 0u) ? 1u : 0u; mine = (j == x) ? c : mine; }
        if (sum == G) break;
        __builtin_amdgcn_s_sleep(1);
        if ((++sp & 255u) == 0u) { if (xb_ld(&bar[XB_TMO])) break; if (sp > XB_SPIN_CAP) { atomicAdd(&bar[XB_TMO], 1u); break; } }
    }
    nloc = mine > 0u ? mine : 1u; nx = cnt > 0u ? cnt : 1u;
}
__device__ __forceinline__ void xcd_barrier(const XcdBarrier& b) {
    asm volatile("s_waitcnt vmcnt(0)" ::: "memory");
    __syncthreads();
    if (threadIdx.x == 0) {
        unsigned* bar = b.bar;
        __builtin_amdgcn_s_waitcnt(0);
        unsigned nloc = b.st[0], nx = b.st[1];
        if (nloc == 0u) { xcd_barrier_complete(bar, b.x, nloc, nx); b.st[0] = nloc; b.st[1] = nx; }
        const unsigned old = xb_add(&bar[XB_XSUB(b.x)], 1u);
        const unsigned gen = old / nloc;
        if (old + 1u == (gen + 1u) * nloc) {
            __builtin_amdgcn_fence(__ATOMIC_RELEASE, "agent");
            asm volatile("s_waitcnt vmcnt(0)" ::: "memory");
            const unsigned og = xb_add(&bar[XB_TOP], 1u);
            const unsigned tg = og / nx;
            if (og + 1u == (tg + 1u) * nx) xb_add(&bar[XB_TOPGEN], 1u);
            else XB_SPIN(xb_ld(&bar[XB_TOPGEN]) == tg, bar);
            __builtin_amdgcn_fence(__ATOMIC_ACQUIRE, "agent");
            xb_add(&bar[XB_XGEN(b.x)], 1u);
            asm volatile("s_waitcnt vmcnt(0)" ::: "memory");
        } else {
            XB_SPIN(xb_ld(&bar[XB_XGEN(b.x)]) == gen, bar);
            __builtin_amdgcn_fence(__ATOMIC_ACQUIRE, "agent");
            asm volatile("s_waitcnt vmcnt(0)" ::: "memory");
        }
    }
    __syncthreads();
}

struct Args { const float* in[33]; float* out; unsigned char* ws; int ph_lo, ph_hi; };
struct Ctx {
    const Args& A; float* out; unsigned char* ws;
    LAS unsigned char* lds; int tid, lane, wave, G, bid, gw, ngw;
};
#define WSP(T, off) ((T*)(C.ws + (off)))
__device__ __forceinline__ Ctx relaunder(const Ctx& C0) {
    int tid = C0.tid; unsigned char* ws = C0.ws; LAS unsigned char* lds = C0.lds;
    asm volatile("" : "+v"(tid), "+s"(ws));
    const int wave = __builtin_amdgcn_readfirstlane(tid >> 6);
    return Ctx{C0.A, C0.out, ws, lds, tid, tid & 63, wave, C0.G, C0.bid, C0.bid * 8 + wave, C0.G * 8};
}
__device__ __forceinline__ const float* modp(const Ctx& C, int layer, int mg, int chunk) { return WSP(const float, WS_MOD) + ((size_t)(layer * 9 + mg) * 6 + chunk) * 1024; }

__device__ __forceinline__ void tr_item(const float* src, int ld_src, int nvalid, int k0, int n0, bf16_t* dst, int ld_dst, int drow0, int dk0, LAS float* scr, int lane) {
    {
        const int n = (lane & 15) * 4; const bool ok = (n0 + n) < nvalid;
#pragma unroll 4
        for (int i = 0; i < 16; ++i) { const int k = 4 * i + (lane >> 4);
            f32x4 v = (f32x4){0.f, 0.f, 0.f, 0.f};
            if (ok) v = *(const f32x4*)(src + (size_t)(k0 + k) * ld_src + n0 + n);
            LAS float* s = scr + k * 65 + n; s[0] = v.x; s[1] = v.y; s[2] = v.z; s[3] = v.w; }
    }
    asm volatile("s_waitcnt lgkmcnt(0)" ::: "memory");
    const int c = lane & 7;
#pragma unroll
    for (int jj = 0; jj < 8; ++jj) { const int nl = (lane >> 3) + 8 * jj; const LAS float* s = scr + (8 * c) * 65 + nl;
        u32x4 o; o.x = pk2(s[0 * 65], s[1 * 65]); o.y = pk2(s[2 * 65], s[3 * 65]); o.z = pk2(s[4 * 65], s[5 * 65]); o.w = pk2(s[6 * 65], s[7 * 65]);
        if (n0 + nl < nvalid) *(u32x4*)(dst + (size_t)(drow0 + nl) * ld_dst + dk0 + 8 * c) = o; }
    asm volatile("s_waitcnt lgkmcnt(0)" ::: "memory");
}
constexpr int CV_SMALL = 2120, CV_MOE = 4 * 16 * 3 * 512;
__device__ __forceinline__ void p0_convert(const Ctx& C) {
    LAS float* scr = (LAS float*)(C.lds + C.wave * 16640);
    for (int it = C.gw; it < 2 * CV_SMALL + CV_MOE; it += C.ngw) {
        const float* src; int ld_src, nvalid, k0, n0, ld_dst, drow0, dk0; bf16_t* dst;
        if (it < 2 * CV_SMALL) {
            const int i = it / CV_SMALL; int r = it % CV_SMALL;
            if (r < 656) { src = C.A.in[9] + (size_t)i * 1024 * 2592; ld_src = 2592; nvalid = 2592; k0 = (r / 41) * 64; n0 = (r % 41) * 64; dst = WSP(bf16_t, WS_WIN) + (size_t)i * ZP * 1024; ld_dst = 1024; drow0 = n0; dk0 = k0; }
            else if ((r -= 656) < 16) { const int d = r >> 3; src = C.A.in[13] + (size_t)(i * 2 + d) * 64 * 512; ld_src = 512; nvalid = 512; k0 = 0; n0 = (r & 7) * 64; dst = WSP(bf16_t, WS_WLORA) + (size_t)i * 2560 * 384; ld_dst = 384; drow0 = d * 512 + n0; dk0 = d * 64; }
            else if ((r -= 16) < 16) { const int d = r >> 3; src = C.A.in[15] + (size_t)(i * 2 + d) * 64 * 512; ld_src = 512; nvalid = 512; k0 = 0; n0 = (r & 7) * 64; dst = WSP(bf16_t, WS_WLORA) + (size_t)i * 2560 * 384; ld_dst = 384; drow0 = 1024 + d * 512 + n0; dk0 = 128 + d * 64; }
            else if ((r -= 16) < 16) { src = C.A.in[16] + (size_t)i * 128 * 512; ld_src = 512; nvalid = 512; k0 = (r >> 3) * 64; n0 = (r & 7) * 64; dst = WSP(bf16_t, WS_WLORA) + (size_t)i * 2560 * 384; ld_dst = 384; drow0 = 2048 + n0; dk0 = 256 + k0; }
            else if ((r -= 16) < 72) { src = C.A.in[23] + (size_t)i * 384 * 768; ld_src = 768; nvalid = 768; k0 = (r / 12) * 64; n0 = (r % 12) * 64; dst = WSP(bf16_t, WS_WQUP) + (size_t)i * 768 * 384; ld_dst = 384; drow0 = n0; dk0 = k0; }
            else if ((r -= 72) < 64) { src = C.A.in[25] + (size_t)i * 256 * 1024; ld_src = 1024; nvalid = 1024; k0 = (r / 16) * 64; n0 = (r % 16) * 64; dst = WSP(bf16_t, WS_WKVUP) + (size_t)i * 1024 * 256; ld_dst = 256; drow0 = n0; dk0 = k0; }
            else if ((r -= 64) < 256) { src = C.A.in[10] + (size_t)i * 1024 * 1024; ld_src = 1024; nvalid = 1024; k0 = (r / 16) * 64; n0 = (r % 16) * 64; dst = WSP(bf16_t, WS_WOUTA) + (size_t)i * 1024 * 1024; ld_dst = 1024; drow0 = n0; dk0 = k0; }
            else if ((r -= 256) < 768) { src = C.A.in[26] + (size_t)i * 1024 * 3072; ld_src = 3072; nvalid = 3072; k0 = (r / 48) * 64; n0 = (r % 48) * 64; dst = WSP(bf16_t, WS_WQKV) + (size_t)i * 3072 * 1024; ld_dst = 1024; drow0 = n0; dk0 = k0; }
            else { r -= 768; src = C.A.in[28] + (size_t)i * 1024 * 1024; ld_src = 1024; nvalid = 1024; k0 = (r / 16) * 64; n0 = (r % 16) * 64; dst = WSP(bf16_t, WS_WOUTC) + (size_t)i * 1024 * 1024; ld_dst = 1024; drow0 = n0; dk0 = k0; }
        } else {
            const int m = it - 2 * CV_SMALL, le = m / 1536, r = m % 1536, which = r / 512, q = r % 512;
            if (which < 2) { src = C.A.in[which == 0 ? 30 : 31] + (size_t)le * 1024 * 2048; ld_src = 2048; nvalid = 2048; k0 = (q / 32) * 64; n0 = (q % 32) * 64;
                dst = WSP(bf16_t, WS_W13) + (size_t)le * 4096 * 1024; ld_dst = 1024; drow0 = (n0 >> 7) * 256 + which * 128 + (n0 & 127); dk0 = k0; }
            else { src = C.A.in[32] + (size_t)le * 2048 * 1024; ld_src = 1024; nvalid = 1024; k0 = (q / 16) * 64; n0 = (q % 16) * 64;
                dst = WSP(bf16_t, WS_W2) + (size_t)le * 1024 * 2048; ld_dst = 2048; drow0 = n0; dk0 = k0; }
        }
        tr_item(src, ld_src, nvalid, k0, n0, dst, ld_dst, drow0, dk0, scr, C.lane);
    }
    const u32x4 z4 = (u32x4){0u, 0u, 0u, 0u};
    const int gt = C.bid * 512 + C.tid, ngt = C.G * 512;
    for (int idx = gt; idx < 2 * 224 * 128; idx += ngt) { const int i = idx / (224 * 128), r = (idx / 128) % 224, ch = idx % 128;
        *(u32x4*)(WSP(bf16_t, WS_WIN) + ((size_t)i * ZP + 2592 + r) * 1024 + ch * 8) = z4; }
    for (int idx = gt; idx < 2 * 2560 * 48; idx += ngt) { const int i = idx / (2560 * 48), r = (idx / 48) % 2560, ch = idx % 48, seg = r >> 9;
        const int lo = seg < 4 ? seg * 8 : 32, hi = seg < 4 ? seg * 8 + 8 : 48;
        if (ch < lo || ch >= hi) *(u32x4*)(WSP(bf16_t, WS_WLORA) + ((size_t)i * 2560 + r) * 384 + ch * 8) = z4; }
    for (int idx = gt; idx < 2048 * 16; idx += ngt) { const int t = idx >> 4, i = idx & 15; const float pos = (float)(i < 8 ? (t >> 6) : (t & 63));
        const float inv = powf(10000.0f, -(float)(i & 7) / 8.0f); const float ang = pos * inv;
        WSP(float, WS_ROPE)[idx * 2] = cosf(ang); WSP(float, WS_ROPE)[idx * 2 + 1] = sinf(ang); }
}
__device__ __forceinline__ void p0_mod(const Ctx& C) {
    LAS float* sc = (LAS float*)C.lds;
    LAS float* part = (LAS float*)(C.lds + 36864);
    __syncthreads();
    for (int idx = C.tid; idx < 9 * 1024; idx += 512) { const int r = idx >> 10, k = idx & 1023; const float cv = r < 8 ? C.A.in[1][r * 1024 + k] : C.A.in[3][k]; sc[idx] = cv / (1.f + __expf(-cv)); }
    __syncthreads();
    for (int unit = C.bid; unit < 192; unit += C.G) {
        const int l = unit / 48, jb = unit % 48, jj = C.tid & 127, kc = C.tid >> 7;
        const float* w = C.A.in[4] + ((size_t)l * 1024 + kc * 256) * 6144 + jb * 128 + jj;
        float acc[9];
#pragma unroll
        for (int r = 0; r < 9; ++r) acc[r] = 0.f;
#pragma unroll 4
        for (int k = 0; k < 256; ++k) { const float wv = w[(size_t)k * 6144];
#pragma unroll
            for (int r = 0; r < 9; ++r) acc[r] += sc[r * 1024 + kc * 256 + k] * wv; }
#pragma unroll
        for (int r = 0; r < 9; ++r) part[(kc * 9 + r) * 128 + jj] = acc[r];
        __syncthreads();
        for (int idx = C.tid; idx < 9 * 128; idx += 512) { const int r = idx >> 7, j2 = idx & 127;
            const float s = part[(0 * 9 + r) * 128 + j2] + part[(1 * 9 + r) * 128 + j2] + part[(2 * 9 + r) * 128 + j2] + part[(3 * 9 + r) * 128 + j2] + C.A.in[5][l * 6144 + jb * 128 + j2];
            WSP(float, WS_MOD)[(size_t)(l * 9 + r) * 6144 + jb * 128 + j2] = s; }
        __syncthreads();
    }
}

__device__ __forceinline__ void row_load(const float* p, int lane, f32x4 (&v)[4]) {
#pragma unroll
    for (int j = 0; j < 4; ++j) v[j] = *(const f32x4*)(p + (lane + 64 * j) * 4); }
__device__ __forceinline__ void row_store(float* p, int lane, const f32x4 (&v)[4]) {
#pragma unroll
    for (int j = 0; j < 4; ++j) *(f32x4*)(p + (lane + 64 * j) * 4) = v[j]; }
__device__ __forceinline__ float row_rstd(const f32x4 (&v)[4]) {
    float s = 0.f;
#pragma unroll
    for (int j = 0; j < 4; ++j) s += (v[j].x * v[j].x + v[j].y * v[j].y) + (v[j].z * v[j].z + v[j].w * v[j].w);
    return rsqrtf(wave_sum(s) * (1.f / 1024.f) + NORM_EPS); }
__device__ __forceinline__ void row_modulate(const f32x4 (&v)[4], float rstd, const float* nw, const float* sh, const float* sc, int lane, f32x4 (&h)[4]) {
#pragma unroll
    for (int j = 0; j < 4; ++j) { const int c = (lane + 64 * j) * 4; const f32x4 w = *(const f32x4*)(nw + c), s1 = *(const f32x4*)(sc + c), s0 = *(const f32x4*)(sh + c);
        h[j] = (v[j] * rstd * w) * (s1 + 1.0f) + s0; } }
__device__ __forceinline__ void row_store_bf16(bf16_t* p, int lane, const f32x4 (&h)[4]) {
#pragma unroll
    for (int j = 0; j < 4; ++j) { u32x2 w; w.x = pk2(h[j].x, h[j].y); w.y = pk2(h[j].z, h[j].w); *(u32x2*)(p + (lane + 64 * j) * 4) = w; } }

__device__ __forceinline__ void p1_init(const Ctx& C) {
    for (int row = C.gw; row < NT; row += C.ngw) {
        const float* src = row < NLAT ? C.A.in[0] + (size_t)row * DM : C.A.in[2] + (size_t)(row - NLAT) * DM;
        f32x4 v[4], h[4]; row_load(src, C.lane, v); row_store(WSP(float, WS_X) + (size_t)row * DM, C.lane, v);
        const int mg = mod_group(row); const float rstd = row_rstd(v);
        row_modulate(v, rstd, C.A.in[6], modp(C, 0, mg, 0), modp(C, 0, mg, 1), C.lane, h);
        row_store_bf16(WSP(bf16_t, WS_H) + (size_t)row * DM, C.lane, h);
    }
}

__device__ __forceinline__ void a2_prepare(const Ctx& C, int i) {
    const bf16_t* Z = WSP(const bf16_t, WS_Z);
    const float* mu = C.A.in[11] + (size_t)i * 2 * 1920;
    const int lane = C.lane;
    for (int row = C.gw; row < NT; row += C.ngw) {
        const bool isctx = row >= NLAT; const int t = isctx ? ((row - NLAT) & 255) : (row & 2047), T = isctx ? 256 : 2048;
        const bf16_t* z = Z + (size_t)row * ZP; const bool hp = t > 0, hn = t < T - 1;
        float r8[8], k8[8], v8[8];
#pragma unroll
        for (int seg = 0; seg < 3; ++seg) {
            const int c0 = seg * 512 + lane * 8; float zc[8], zp[8], zn[8], m0[8], m1[8];
            ld8(z + c0, zc);
            if (hp) ld8(z - ZP + c0, zp); else { for (int j = 0; j < 8; ++j) zp[j] = 0.f; }
            if (hn) ld8(z + ZP + c0, zn); else { for (int j = 0; j < 8; ++j) zn[j] = 0.f; }
            *(f32x4*)&m0[0] = *(const f32x4*)(mu + c0); *(f32x4*)&m0[4] = *(const f32x4*)(mu + c0 + 4);
            *(f32x4*)&m1[0] = *(const f32x4*)(mu + 1920 + c0); *(f32x4*)&m1[4] = *(const f32x4*)(mu + 1920 + c0 + 4);
#pragma unroll
            for (int j = 0; j < 8; ++j) { const float o = zc[j] + m0[j] * (zp[j] - zc[j]) + m1[j] * (zn[j] - zc[j]); if (seg == 0) r8[j] = o; else if (seg == 1) k8[j] = o; else v8[j] = o; }
        }
        st8(WSP(bf16_t, WS_R) + (size_t)row * ADIM + lane * 8, r8);
        st8(WSP(bf16_t, WS_KS) + (size_t)row * ADIM + lane * 8, k8);
        st8(WSP(bf16_t, WS_V) + (size_t)row * ADIM + lane * 8, v8);
        { float kk[8], ss = 0.f; const float* kkw = C.A.in[17] + i * ADIM + lane * 8;
#pragma unroll
            for (int j = 0; j < 8; ++j) { kk[j] = k8[j] * kkw[j]; ss += kk[j] * kk[j]; }
            ss = sum8(ss); const float inv = 1.f / fmaxf(sqrtf(ss), 1e-12f);
#pragma unroll
            for (int j = 0; j < 8; ++j) kk[j] *= inv;
            st8(WSP(bf16_t, WS_KK) + (size_t)row * ADIM + lane * 8, kk); }
#pragma unroll
        for (int seg = 0; seg < 3; ++seg) {
            const int c0 = 1536 + seg * 128 + lane * 2; const unsigned wc_ = *(const unsigned*)(z + c0);
            const unsigned wp_ = hp ? *(const unsigned*)(z - ZP + c0) : 0u, wn_ = hn ? *(const unsigned*)(z + ZP + c0) : 0u;
            float o[2];
#pragma unroll
            for (int j = 0; j < 2; ++j) { const float zc = j ? __uint_as_float(wc_ & 0xffff0000u) : __uint_as_float(wc_ << 16), zp = j ? __uint_as_float(wp_ & 0xffff0000u) : __uint_as_float(wp_ << 16),
                                                      zn = j ? __uint_as_float(wn_ & 0xffff0000u) : __uint_as_float(wn_ << 16);
                const float s = zc + mu[c0 + j] * (zp - zc) + mu[1920 + c0 + j] * (zn - zc);
                o[j] = seg == 0 ? tanhf(s) : (seg == 1 ? s : sigmoidf_(s)); }
            *(unsigned*)(WSP(bf16_t, WS_LIN) + (size_t)row * 384 + seg * 128 + lane * 2) = pk2(o[0], o[1]);
        }
        { float q[6], ss = 0.f;
#pragma unroll
            for (int j = 0; j < 3; ++j) { const unsigned w = *(const unsigned*)(z + 1920 + j * 128 + lane * 2); q[2 * j] = __uint_as_float(w << 16); q[2 * j + 1] = __uint_as_float(w & 0xffff0000u); ss += q[2 * j] * q[2 * j] + q[2 * j + 1] * q[2 * j + 1]; }
            const float rstd = rsqrtf(wave_sum(ss) * (1.f / 384.f) + NORM_EPS); const float* nw = C.A.in[22] + i * 384;
#pragma unroll
            for (int j = 0; j < 3; ++j) { const int c = j * 128 + lane * 2; *(unsigned*)(WSP(bf16_t, WS_QN) + (size_t)row * 384 + c) = pk2(q[2 * j] * rstd * nw[c], q[2 * j + 1] * rstd * nw[c + 1]); } }
        { const u32x2 w = *(const u32x2*)(z + 2304 + lane * 4); float q[4] = {__uint_as_float(w.x << 16), __uint_as_float(w.x & 0xffff0000u), __uint_as_float(w.y << 16), __uint_as_float(w.y & 0xffff0000u)};
            const float ss = q[0] * q[0] + q[1] * q[1] + q[2] * q[2] + q[3] * q[3];
            const float rstd = rsqrtf(wave_sum(ss) * (1.f / 256.f) + NORM_EPS); const float* nw = C.A.in[24] + i * 256 + lane * 4;
            u32x2 o; o.x = pk2(q[0] * rstd * nw[0], q[1] * rstd * nw[1]); o.y = pk2(q[2] * rstd * nw[2], q[3] * rstd * nw[3]);
            *(u32x2*)(WSP(bf16_t, WS_KVN) + (size_t)row * 256 + lane * 4) = o; }
        if (lane < 16) { const unsigned w = *(const unsigned*)(z + 2560 + lane * 2); float x0 = __uint_as_float(w << 16), x1 = __uint_as_float(w & 0xffff0000u);
            if (!isctx) { const float cs = WSP(const float, WS_ROPE)[(t * 16 + lane) * 2], sn = WSP(const float, WS_ROPE)[(t * 16 + lane) * 2 + 1]; const float o0 = x0 * cs - x1 * sn, o1 = x0 * sn + x1 * cs; x0 = o0; x1 = o1; }
            *(unsigned*)(WSP(bf16_t, WS_KR) + (size_t)row * 32 + lane * 2) = pk2(x0, x1); }
    }
}

struct FStoreBf16 { bf16_t* O; int ldo; float scale; int scale_cols;
    __device__ __forceinline__ void operator()(int row, int col, const float (&v)[8]) const { float o[8]; const float s = col < scale_cols ? scale : 1.f;
#pragma unroll
        for (int j = 0; j < 8; ++j) o[j] = v[j] * s;
        st8(O + (size_t)row * ldo + col, o); } };
struct FLora { const float* w0; const float* a0; const float* ka; const bf16_t* KS; const bf16_t* KK; float* DEC; bf16_t* KD; bf16_t* BB; bf16_t* G;
    __device__ __forceinline__ void operator()(int row, int col, const float (&v)[8]) const {
        const int seg = col >> 9, c = col & 511;
        if (seg < 2) { float o[8];
#pragma unroll
            for (int j = 0; j < 8; ++j) { const float x = w0[seg * 512 + c + j] + v[j]; const float sp = fmaxf(-x, 0.f) + __logf(1.f + __expf(-fabsf(x)));
                o[j] = __expf(-__expf(-sp - 0.5f)); }
            float* d = DEC + ((size_t)seg * NT + row) * ADIM + c; *(f32x4*)d = *(const f32x4*)&o[0]; *(f32x4*)(d + 4) = *(const f32x4*)&o[4];
        } else if (seg < 4) { const int d_ = seg - 2; float k[8], kk[8], kd[8], bb[8]; ld8(KS + (size_t)row * ADIM + c, k); ld8(KK + (size_t)row * ADIM + c, kk);
#pragma unroll
            for (int j = 0; j < 8; ++j) { const float a = sigmoidf_(a0[d_ * 512 + c + j] + v[j]); kd[j] = k[j] * (1.f + (a - 1.f) * ka[c + j]); bb[j] = kk[j] * a; }
            st8(KD + ((size_t)d_ * NT + row) * ADIM + c, kd); st8(BB + ((size_t)d_ * NT + row) * ADIM + c, bb);
        } else st8(G + (size_t)row * ADIM + c, v);
    } };
struct FQup { bf16_t* Q; const float* rope; float scale;
    __device__ __forceinline__ void operator()(int row, int col, const float (&v)[8]) const {
        const int d = col % 96; float o[8];
#pragma unroll
        for (int j = 0; j < 8; ++j) o[j] = v[j] * scale;
        if (d >= 64 && row < NLAT) { const int t = row & 2047, p0 = (d - 64) >> 1;
#pragma unroll
            for (int p = 0; p < 4; ++p) { const float cs = rope[(t * 16 + p0 + p) * 2], sn = rope[(t * 16 + p0 + p) * 2 + 1]; const float x0 = o[2 * p], x1 = o[2 * p + 1]; o[2 * p] = x0 * cs - x1 * sn; o[2 * p + 1] = x0 * sn + x1 * cs; } }
        st8(Q + (size_t)row * 768 + col, o);
    } };
struct FResid { float* X; const float* mod; int layer;
    __device__ __forceinline__ void operator()(int row, int col, const float (&v)[8]) const {
        const float* g = mod + ((size_t)(layer * 9 + mod_group(row)) * 6 + 2) * 1024 + col; float* x = X + (size_t)row * DM + col;
        f32x4 x0 = *(const f32x4*)x, x1 = *(const f32x4*)(x + 4); const f32x4 g0 = *(const f32x4*)g, g1 = *(const f32x4*)(g + 4);
        x0 += g0 * (f32x4){v[0], v[1], v[2], v[3]}; x1 += g1 * (f32x4){v[4], v[5], v[6], v[7]};
        *(f32x4*)x = x0; *(f32x4*)(x + 4) = x1;
    } };
struct FSwiglu { bf16_t* HID;
    __device__ __forceinline__ void operator()(int row, int col, const float (&a)[8], const float (&b)[8]) const { float o[8];
#pragma unroll
        for (int j = 0; j < 8; ++j) o[j] = a[j] / (1.f + __expf(-a[j])) * b[j];
        st8(HID + (size_t)row * FF + (col & (FF - 1)), o); } };
struct FGate { bf16_t* YB; const float* gate;
    __device__ __forceinline__ void operator()(int row, int col, const float (&v)[8]) const { const float g = gate[row]; float o[8];
#pragma unroll
        for (int j = 0; j < 8; ++j) o[j] = v[j] * g;
        st8(YB + (size_t)row * DM + (col & (DM - 1)), o); } };

constexpr int SC_TC = 32;
__device__ __forceinline__ void a4_scan(const Ctx& C) {
    LAS float* L = (LAS float*)C.lds;
    const int tid = C.tid, rowi = tid >> 3, j = tid & 7;
    const int ls_ld = tid >> 4, c4 = (tid & 15) * 4;
    for (int unit = C.bid; unit < 128; unit += C.G) {
        const int b = unit >> 4, h = (unit >> 1) & 7, dir = unit & 1;
        const float* DEC = WSP(const float, WS_DEC) + (size_t)dir * NT * ADIM + h * 64;
        const bf16_t* KD = WSP(const bf16_t, WS_KD) + (size_t)dir * NT * ADIM + h * 64;
        const bf16_t* BB = WSP(const bf16_t, WS_BB) + (size_t)dir * NT * ADIM + h * 64;
        const bf16_t* KK = WSP(const bf16_t, WS_KK) + h * 64; const bf16_t* R = WSP(const bf16_t, WS_R) + h * 64; const bf16_t* V = WSP(const bf16_t, WS_V) + h * 64;
        float* Y = WSP(float, WS_Y) + (size_t)dir * NT * ADIM + h * 64;
        auto row_of = [&](int s) -> int { return s < 256 ? NLAT + b * 256 + (dir ? 255 - s : s) : b * 2048 + (dir ? 2047 - (s - 256) : (s - 256)); };
        f32x4 pw; u32x2 pkd, pbb, pkk, pr, pv;
        auto gload = [&](int chunk) { const size_t o = (size_t)row_of(chunk * SC_TC + ls_ld) * ADIM + c4;
            pw = *(const f32x4*)(DEC + o); pkd = *(const u32x2*)(KD + o); pbb = *(const u32x2*)(BB + o); pkk = *(const u32x2*)(KK + o); pr = *(const u32x2*)(R + o); pv = *(const u32x2*)(V + o); };
        auto lwrite = [&](int buf) { LAS float* Bf = L + buf * 12288 + ls_ld * 64 + c4;
            *(LAS f32x4*)(Bf) = pw;
            *(LAS f32x4*)(Bf + 2048) = (f32x4){__uint_as_float(pkd.x << 16), __uint_as_float(pkd.x & 0xffff0000u), __uint_as_float(pkd.y << 16), __uint_as_float(pkd.y & 0xffff0000u)};
            *(LAS f32x4*)(Bf + 4096) = (f32x4){__uint_as_float(pbb.x << 16), __uint_as_float(pbb.x & 0xffff0000u), __uint_as_float(pbb.y << 16), __uint_as_float(pbb.y & 0xffff0000u)};
            *(LAS f32x4*)(Bf + 6144) = (f32x4){__uint_as_float(pkk.x << 16), __uint_as_float(pkk.x & 0xffff0000u), __uint_as_float(pkk.y << 16), __uint_as_float(pkk.y & 0xffff0000u)};
            *(LAS f32x4*)(Bf + 8192) = (f32x4){__uint_as_float(pr.x << 16), __uint_as_float(pr.x & 0xffff0000u), __uint_as_float(pr.y << 16), __uint_as_float(pr.y & 0xffff0000u)};
            *(LAS f32x4*)(Bf + 10240) = (f32x4){__uint_as_float(pv.x << 16), __uint_as_float(pv.x & 0xffff0000u), __uint_as_float(pv.y << 16), __uint_as_float(pv.y & 0xffff0000u)}; };
        float S[8];
#pragma unroll
        for (int q = 0; q < 8; ++q) S[q] = 0.f;
        __syncthreads();
        gload(0); lwrite(0);
        __syncthreads();
        constexpr int NCH = 2304 / SC_TC;
        for (int ch = 0; ch < NCH; ++ch) {
            if (ch + 1 < NCH) gload(ch + 1);
            const LAS float* Bf = L + (ch & 1) * 12288 + j * 8;
#pragma unroll 4
            for (int ls = 0; ls < SC_TC; ++ls) {
                const LAS float* p = Bf + ls * 64;
                const f32x4 w0 = *(const LAS f32x4*)(p), w1 = *(const LAS f32x4*)(p + 4);
                const f32x4 d0 = *(const LAS f32x4*)(p + 2048), d1 = *(const LAS f32x4*)(p + 2052);
                const f32x4 b0 = *(const LAS f32x4*)(p + 4096), b1 = *(const LAS f32x4*)(p + 4100);
                const f32x4 k0 = *(const LAS f32x4*)(p + 6144), k1 = *(const LAS f32x4*)(p + 6148);
                const f32x4 r0 = *(const LAS f32x4*)(p + 8192), r1 = *(const LAS f32x4*)(p + 8196);
                const float vv = L[(ch & 1) * 12288 + 10240 + ls * 64 + rowi];
                float sa = (S[0] * k0.x + S[1] * k0.y) + (S[2] * k0.z + S[3] * k0.w) + (S[4] * k1.x + S[5] * k1.y) + (S[6] * k1.z + S[7] * k1.w);
                sa = -sum8(sa);
                S[0] = S[0] * w0.x + sa * b0.x + vv * d0.x; S[1] = S[1] * w0.y + sa * b0.y + vv * d0.y; S[2] = S[2] * w0.z + sa * b0.z + vv * d0.z; S[3] = S[3] * w0.w + sa * b0.w + vv * d0.w;
                S[4] = S[4] * w1.x + sa * b1.x + vv * d1.x; S[5] = S[5] * w1.y + sa * b1.y + vv * d1.y; S[6] = S[6] * w1.z + sa * b1.z + vv * d1.z; S[7] = S[7] * w1.w + sa * b1.w + vv * d1.w;
                float y = (S[0] * r0.x + S[1] * r0.y) + (S[2] * r0.z + S[3] * r0.w) + (S[4] * r1.x + S[5] * r1.y) + (S[6] * r1.z + S[7] * r1.w);
                y = sum8(y);
                if (j == 0) Y[(size_t)row_of(ch * SC_TC + ls) * ADIM + rowi] = y;
            }
            if (ch + 1 < NCH) lwrite((ch + 1) & 1);
            __syncthreads();
        }
    }
}

__device__ __forceinline__ void a4_mla_naive(const Ctx& C) {
    LAS float* Kt = (LAS float*)C.lds;
    LAS float* Vt = Kt + 32 * 96;
    const bf16_t* Q = WSP(const bf16_t, WS_Q); const bf16_t* KV = WSP(const bf16_t, WS_KV); const bf16_t* KR = WSP(const bf16_t, WS_KR); bf16_t* MIX = WSP(bf16_t, WS_MIX);
    const int tid = C.tid;
    for (int unit = C.bid; unit < 320; unit += C.G) {
        int b, h, qrow, nkeys; bool active = true;
        if (unit < 256) { b = unit >> 5; h = (unit >> 2) & 7; qrow = b * 2048 + (unit & 3) * 512 + tid; nkeys = 2304; }
        else { const int u = unit - 256; b = u >> 3; h = u & 7; qrow = NLAT + b * 256 + (tid & 255); nkeys = 256; active = tid < 256; }
        float q[96], acc[64], m = -1e30f, l = 0.f;
#pragma unroll
        for (int d8 = 0; d8 < 12; ++d8) { float t8[8]; ld8(Q + (size_t)qrow * 768 + h * 96 + d8 * 8, t8);
#pragma unroll
            for (int jj = 0; jj < 8; ++jj) q[d8 * 8 + jj] = t8[jj]; }
#pragma unroll
        for (int d = 0; d < 64; ++d) acc[d] = 0.f;
        for (int kt = 0; kt < nkeys; kt += 32) {
            __syncthreads();
            for (int idx = tid; idx < 32 * 48; idx += 512) { const int key = idx / 48, dp = idx % 48, kj = kt + key; const int krow = kj < 256 ? NLAT + b * 256 + kj : b * 2048 + (kj - 256);
                const unsigned w = dp < 32 ? *(const unsigned*)(KV + (size_t)krow * 1024 + h * 128 + dp * 2) : *(const unsigned*)(KR + (size_t)krow * 32 + (dp - 32) * 2);
                Kt[key * 96 + dp * 2] = __uint_as_float(w << 16); Kt[key * 96 + dp * 2 + 1] = __uint_as_float(w & 0xffff0000u); }
            for (int idx = tid; idx < 32 * 32; idx += 512) { const int key = idx >> 5, dp = idx & 31, kj = kt + key; const int krow = kj < 256 ? NLAT + b * 256 + kj : b * 2048 + (kj - 256);
                const unsigned w = *(const unsigned*)(KV + (size_t)krow * 1024 + h * 128 + 64 + dp * 2);
                Vt[key * 64 + dp * 2] = __uint_as_float(w << 16); Vt[key * 64 + dp * 2 + 1] = __uint_as_float(w & 0xffff0000u); }
            __syncthreads();
            for (int key = 0; key < 32; ++key) {
                float s = 0.f;
#pragma unroll
                for (int d4 = 0; d4 < 24; ++d4) { const f32x4 kv = *(const LAS f32x4*)(Kt + key * 96 + d4 * 4); s += q[d4 * 4] * kv.x + q[d4 * 4 + 1] * kv.y + q[d4 * 4 + 2] * kv.z + q[d4 * 4 + 3] * kv.w; }
                const float mn = fmaxf(m, s), corr = __expf(m - mn), p = __expf(s - mn); m = mn; l = l * corr + p;
#pragma unroll
                for (int d4 = 0; d4 < 16; ++d4) { const f32x4 vv = *(const LAS f32x4*)(Vt + key * 64 + d4 * 4);
                    acc[d4 * 4] = acc[d4 * 4] * corr + p * vv.x; acc[d4 * 4 + 1] = acc[d4 * 4 + 1] * corr + p * vv.y; acc[d4 * 4 + 2] = acc[d4 * 4 + 2] * corr + p * vv.z; acc[d4 * 4 + 3] = acc[d4 * 4 + 3] * corr + p * vv.w; }
            }
        }
        if (active) { const float il = 1.f / l;
#pragma unroll
            for (int d8 = 0; d8 < 8; ++d8) { float o[8];
#pragma unroll
                for (int jj = 0; jj < 8; ++jj) o[jj] = acc[d8 * 8 + jj] * il;
                st8(MIX + (size_t)qrow * DM + 512 + h * 64 + d8 * 8, o); } }
    }
    __syncthreads();
}

__device__ __forceinline__ void a5_output(const Ctx& C, int i) {
    const int lane = C.lane, c0 = lane * 8;
    const float* rk = C.A.in[19] + i * ADIM + c0; const float* lnw = C.A.in[20] + i * ADIM + c0; const float* lnb = C.A.in[21] + i * ADIM + c0;
    for (int row = C.gw; row < NT; row += C.ngw) {
        const float* yf = WSP(const float, WS_Y) + (size_t)row * ADIM + c0; const float* yb = yf + (size_t)NT * ADIM;
        float y[8]; { const f32x4 a0 = *(const f32x4*)yf, a1 = *(const f32x4*)(yf + 4), b0 = *(const f32x4*)yb, b1 = *(const f32x4*)(yb + 4);
            y[0] = a0.x + b0.x; y[1] = a0.y + b0.y; y[2] = a0.z + b0.z; y[3] = a0.w + b0.w; y[4] = a1.x + b1.x; y[5] = a1.y + b1.y; y[6] = a1.z + b1.z; y[7] = a1.w + b1.w; }
        float s = 0.f;
#pragma unroll
        for (int j = 0; j < 8; ++j) s += y[j];
        const float mean = sum8(s) * (1.f / 64.f); float q = 0.f;
#pragma unroll
        for (int j = 0; j < 8; ++j) { const float d = y[j] - mean; q += d * d; }
        const float rstd = rsqrtf(sum8(q) * (1.f / 64.f) + 64e-5f);
        float r[8], v[8], g[8], kd0[8], kd1[8];
        ld8(WSP(const bf16_t, WS_R) + (size_t)row * ADIM + c0, r); ld8(WSP(const bf16_t, WS_V) + (size_t)row * ADIM + c0, v); ld8(WSP(const bf16_t, WS_G) + (size_t)row * ADIM + c0, g);
        ld8(WSP(const bf16_t, WS_KD) + (size_t)row * ADIM + c0, kd0); ld8(WSP(const bf16_t, WS_KD) + ((size_t)NT + row) * ADIM + c0, kd1);
        float bs = 0.f;
#pragma unroll
        for (int j = 0; j < 8; ++j) bs += r[j] * (kd0[j] + kd1[j]) * rk[j];
        bs = sum8(bs);
        float o[8];
#pragma unroll
        for (int j = 0; j < 8; ++j) o[j] = ((y[j] - mean) * rstd * lnw[j] + lnb[j] + bs * v[j]) * g[j];
        st8(WSP(bf16_t, WS_MIX) + (size_t)row * DM + c0, o);
    }
}

__device__ __forceinline__ void b2_na_naive(const Ctx& C, int i, bool need_ctx) {
    const bf16_t* QKV = WSP(const bf16_t, WS_Z); bf16_t* MIX = WSP(bf16_t, WS_MIX);
    const float* rpb = C.A.in[27] + (size_t)i * 16 * 15 * 31;
    const int nq = need_ctx ? NT : NLAT;
    const int nblk = nq / 512;
    for (int unit = C.bid; unit < nblk * 16; unit += C.G) {
        const int h = unit & 15, qrow = (unit >> 4) * 512 + C.tid;
        float q[64], acc[64], m = -1e30f, l = 0.f;
#pragma unroll
        for (int d8 = 0; d8 < 8; ++d8) { float t8[8]; ld8(QKV + (size_t)qrow * 3072 + h * 64 + d8 * 8, t8);
#pragma unroll
            for (int jj = 0; jj < 8; ++jj) q[d8 * 8 + jj] = t8[jj]; }
#pragma unroll
        for (int d = 0; d < 64; ++d) acc[d] = 0.f;
        const bool isctx = qrow >= NLAT; const int b = isctx ? (qrow - NLAT) >> 8 : qrow >> 11;
        int qr = 0, qc = 0, rs = 0, cs = 0, nwin = 0;
        if (!isctx) { const int t = qrow & 2047; qr = t >> 6; qc = t & 63; rs = min(max(qr - 4, 0), 24); cs = min(max(qc - 8, 0), 48); nwin = 128; }
        const int nk = nwin + 256;
        for (int kj = 0; kj < nk; ++kj) {
            int krow; float bias = 0.f;
            if (kj < nwin) { const int kr = rs + (kj >> 4), kc = cs + (kj & 15); krow = b * 2048 + kr * 64 + kc; bias = rpb[(h * 15 + (kr - qr + 7)) * 31 + (kc - qc + 15)]; }
            else krow = NLAT + b * 256 + (kj - nwin);
            const bf16_t* kp = QKV + (size_t)krow * 3072 + 1024 + h * 64; const bf16_t* vp = kp + 1024;
            float s = 0.f;
#pragma unroll
            for (int d8 = 0; d8 < 8; ++d8) { float t8[8]; ld8(kp + d8 * 8, t8);
#pragma unroll
                for (int jj = 0; jj < 8; ++jj) s += q[d8 * 8 + jj] * t8[jj]; }
            s += bias;
            const float mn = fmaxf(m, s), corr = __expf(m - mn), p = __expf(s - mn); m = mn; l = l * corr + p;
#pragma unroll
            for (int d8 = 0; d8 < 8; ++d8) { float t8[8]; ld8(vp + d8 * 8, t8);
#pragma unroll
                for (int jj = 0; jj < 8; ++jj) acc[d8 * 8 + jj] = acc[d8 * 8 + jj] * corr + p * t8[jj]; }
        }
        const float il = 1.f / l;
#pragma unroll
        for (int d8 = 0; d8 < 8; ++d8) { float o[8];
#pragma unroll
            for (int jj = 0; jj < 8; ++jj) o[jj] = acc[d8 * 8 + jj] * il;
            st8(MIX + (size_t)qrow * DM + h * 64 + d8 * 8, o); }
    }
}

__device__ __forceinline__ void c2_router(const Ctx& C, int layer, int nrows) {
    const float* rw = C.A.in[29] + (size_t)layer * DM * NEXP; const int lane = C.lane;
    for (int row = C.gw; row < nrows; row += C.ngw) {
        f32x4 v[4], h[4]; row_load(WSP(const float, WS_X) + (size_t)row * DM, lane, v);
        const int mg = mod_group(row); const float rstd = row_rstd(v);
        row_modulate(v, rstd, C.A.in[7] + layer * DM, modp(C, layer, mg, 3), modp(C, layer, mg, 4), lane, h);
        row_store_bf16(WSP(bf16_t, WS_H) + (size_t)row * DM, lane, h);
        float lg[16];
#pragma unroll
        for (int e = 0; e < 16; ++e) lg[e] = 0.f;
#pragma unroll
        for (int j = 0; j < 4; ++j)
#pragma unroll
            for (int q = 0; q < 4; ++q) { const float hv = h[j][q]; const float* wr_ = rw + (size_t)((lane + 64 * j) * 4 + q) * NEXP;
#pragma unroll
                for (int e4 = 0; e4 < 4; ++e4) { const f32x4 w = *(const f32x4*)(wr_ + e4 * 4); lg[e4 * 4] += hv * w.x; lg[e4 * 4 + 1] += hv * w.y; lg[e4 * 4 + 2] += hv * w.z; lg[e4 * 4 + 3] += hv * w.w; } }
#pragma unroll
        for (int e = 0; e < 16; ++e) lg[e] = wave_sum(lg[e]);
        float mx = lg[0];
#pragma unroll
        for (int e = 1; e < 16; ++e) mx = fmaxf(mx, lg[e]);
        float den = 0.f;
#pragma unroll
        for (int e = 0; e < 16; ++e) { lg[e] = __expf(lg[e] - mx); den += lg[e]; }
        const float inv = 1.f / den;
        if (lane < 16) { float a = 0.f;
#pragma unroll
            for (int e = 0; e < 16; ++e) a = (lane == e) ? lg[e] * inv : a;
            float* AFF = WSP(float, WS_AFF);
            if (row < NLAT) AFF[((size_t)(row >> 11) * 16 + lane) * 2048 + (row & 2047)] = a;
            else { const int r2 = row - NLAT; AFF[(size_t)NB * 16 * 2048 + ((size_t)(r2 >> 8) * 16 + lane) * 256 + (r2 & 255)] = a; } }
    }
}

__device__ __forceinline__ void c3_topk(const Ctx& C, bool need_ctx) {
    LAS float* vals = (LAS float*)C.lds;
    LAS int* list = (LAS int*)(C.lds + 8192);
    LAS int* cnt = (LAS int*)(C.lds + 8192 + 4096);
    const int nunits = 512 + (need_ctx ? 128 : 0), tid = C.tid;
    for (int unit = C.bid; unit < nunits; unit += C.G) {
        int b, e, part, n, cap; bool lat = unit < 512;
        if (lat) { b = unit >> 6; e = (unit >> 2) & 15; part = unit & 3; n = 2048; cap = 256; } else { const int u = unit - 512; b = u >> 4; e = u & 15; part = 0; n = 256; cap = 32; }
        const float* src = lat ? WSP(const float, WS_AFF) + ((size_t)b * 16 + e) * 2048 : WSP(const float, WS_AFF) + (size_t)NB * 16 * 2048 + ((size_t)b * 16 + e) * 256;
        __syncthreads();
        for (int idx = tid; idx < n; idx += 512) vals[idx] = src[idx];
        if (tid == 0) cnt[0] = 0;
        __syncthreads();
        const int iel = part * 512 + tid; const bool act = iel < n;
        const float a = vals[act ? iel : 0]; int rank = 0;
        for (int j4 = 0; j4 < n; j4 += 4) { const f32x4 o = *(const LAS f32x4*)(vals + j4);
            rank += (o.x > a || (o.x == a && j4 < iel)) ? 1 : 0; rank += (o.y > a || (o.y == a && j4 + 1 < iel)) ? 1 : 0;
            rank += (o.z > a || (o.z == a && j4 + 2 < iel)) ? 1 : 0; rank += (o.w > a || (o.w == a && j4 + 3 < iel)) ? 1 : 0; }
        if (act) { const int trow = lat ? b * 2048 + iel : NLAT + b * 256 + iel; int grow = -1;
            if (rank < cap) { grow = e * ROWS_E + (lat ? b * 256 + rank : 2048 + b * 32 + rank);
                WSP(int, WS_IDX)[grow] = trow; WSP(float, WS_GATE)[grow] = a;
                const int slot = atomicAdd((int*)cnt, 1); list[slot * 2] = trow; list[slot * 2 + 1] = grow; }
            WSP(int, WS_SEL)[(size_t)trow * 16 + e] = grow; }
        __syncthreads();
        const int nsel = cnt[0];
        for (int s = C.wave; s < nsel; s += 8) { const int trow = list[s * 2], grow = list[s * 2 + 1];
            const u32x4* sp = (const u32x4*)(WSP(const bf16_t, WS_H) + (size_t)trow * DM); u32x4* dp = (u32x4*)(WSP(bf16_t, WS_XIN) + (size_t)grow * DM);
            dp[C.lane] = sp[C.lane]; dp[C.lane + 64] = sp[C.lane + 64]; }
    }
    __syncthreads();
}

__device__ __forceinline__ void c6_combine(const Ctx& C, int layer, int nrows) {
    const int lane = C.lane;
    for (int row = C.gw; row < nrows; row += C.ngw) {
        f32x4 v[4], a[4]; row_load(WSP(const float, WS_X) + (size_t)row * DM, lane, v);
#pragma unroll
        for (int j = 0; j < 4; ++j) a[j] = (f32x4){0.f, 0.f, 0.f, 0.f};
        const int* sel = WSP(const int, WS_SEL) + (size_t)row * 16;
        for (int e = 0; e < 16; ++e) { const int g = __builtin_amdgcn_readfirstlane(sel[e]);
            if (g >= 0) { const bf16_t* y = WSP(const bf16_t, WS_YB) + (size_t)g * DM;
#pragma unroll
                for (int j = 0; j < 4; ++j) { const u32x2 w = *(const u32x2*)(y + (lane + 64 * j) * 4);
                    a[j] += (f32x4){__uint_as_float(w.x << 16), __uint_as_float(w.x & 0xffff0000u), __uint_as_float(w.y << 16), __uint_as_float(w.y & 0xffff0000u)}; } } }
        const int mg = mod_group(row); const float* g2 = modp(C, layer, mg, 5);
#pragma unroll
        for (int j = 0; j < 4; ++j) v[j] += *(const f32x4*)(g2 + (lane + 64 * j) * 4) * a[j];
        const float rstd = row_rstd(v);
        if (layer < 3) { row_store(WSP(float, WS_X) + (size_t)row * DM, lane, v);
            f32x4 h[4]; row_modulate(v, rstd, C.A.in[6] + (layer + 1) * DM, modp(C, layer + 1, mg, 0), modp(C, layer + 1, mg, 1), lane, h);
            row_store_bf16(WSP(bf16_t, WS_H) + (size_t)row * DM, lane, h);
        } else {
#pragma unroll
            for (int j = 0; j < 4; ++j) { const int c = (lane + 64 * j) * 4; *(f32x4*)(C.out + (size_t)row * DM + c) = v[j] * rstd * *(const f32x4*)(C.A.in[8] + c); }
        }
    }
}

constexpr int N_PHASE_IDS = 2 + 12 * 4;
__host__ __device__ inline bool phase_exists(int p) { if (p < 2) return true; const int l = (p - 2) / 12, k = (p - 2) % 12; if (k == 11) return false; if (l & 1) return !(k >= 2 && k <= 4); return true; }

__global__ void __launch_bounds__(512, 2) fwd(Args args) {
    extern __shared__ __attribute__((aligned(16))) unsigned char lds_raw[];
    const int tid_ = threadIdx.x, wave_ = __builtin_amdgcn_readfirstlane(tid_ >> 6);
    const Ctx C0{args, args.out, args.ws, (LAS unsigned char*)lds_raw, tid_, tid_ & 63, wave_, (int)gridDim.x, (int)blockIdx.x, (int)blockIdx.x * 8 + wave_, (int)gridDim.x * 8};
    volatile LAS unsigned* MISC = (volatile LAS unsigned*)(C0.lds + LDSCTL_OFF);
    if (C0.tid < 128) MISC[C0.tid] = 0u;
    __syncthreads();
    const int lo = args.ph_lo, hi = args.ph_hi;
    XcdBarrier bar; bar.bar = (unsigned*)(C0.ws + WS_CTL) + CW_BAR; bar.x = 0; bar.st = nullptr;
    if (hi - lo > 1) bar = xcd_barrier_post((unsigned*)(C0.ws + WS_CTL) + CW_BAR, MISC + 8);
#define RUN(p) (lo <= (p) && (p) < hi)
#define SEAM(p) do { if (hi > (p) + 1) xcd_barrier(bar); } while (0)
    LAS unsigned char* ring = C0.lds;

    if (RUN(0)) { const Ctx C = relaunder(C0); if (PON(0)) { p0_convert(C); p0_mod(C); } SEAM(0); }
    if (RUN(1)) { const Ctx C = relaunder(C0); if (PON(1)) p1_init(C); SEAM(1); }

    for (int layer = 0; layer < 4; ++layer) {
        const int base = 2 + 12 * layer, i = layer >> 1;
        const bool need_ctx = layer < 3;
        if (!(layer & 1)) {
            if (RUN(base + 0)) { const Ctx C = relaunder(C0);
                pg8::Gemm g{WSP(const bf16_t, WS_H), WSP(const bf16_t, WS_WIN) + (size_t)i * ZP * 1024, 1024, 1024, 1024}; pg8::StaticOrder S; S.init(NT, ZP, C.G, C.bid);
                pg8::Epi<FStoreBf16, false> E{{WSP(bf16_t, WS_Z), ZP, 1.f, 0}};
                if (PON(2)) pg8::gemm_phase(ring, g, S, E); SEAM(base + 0); }
            if (RUN(base + 1)) { const Ctx C = relaunder(C0); if (PON(3)) a2_prepare(C, i); SEAM(base + 1); }
            if (RUN(base + 2)) { const Ctx C = relaunder(C0);
                { pg8::Gemm g{WSP(const bf16_t, WS_LIN), WSP(const bf16_t, WS_WLORA) + (size_t)i * 2560 * 384, 384, 384, 384}; pg8::StaticOrder S; S.init(NT, 2560, C.G, C.bid);
                  pg8::Epi<FLora, false> E{{C.A.in[12] + i * 1024, C.A.in[14] + i * 1024, C.A.in[18] + i * 512, WSP(const bf16_t, WS_KS), WSP(const bf16_t, WS_KK), WSP(float, WS_DEC), WSP(bf16_t, WS_KD), WSP(bf16_t, WS_BB), WSP(bf16_t, WS_G)}};
                  if (PON(4)) pg8::gemm_phase(ring, g, S, E); }
                { pg8::Gemm g{WSP(const bf16_t, WS_QN), WSP(const bf16_t, WS_WQUP) + (size_t)i * 768 * 384, 384, 384, 384}; pg8::StaticOrder S; S.init(NT, 768, C.G, C.bid);
                  pg8::Epi<FQup, false> E{{WSP(bf16_t, WS_Q), WSP(const float, WS_ROPE), 0.10206207261596577f}};
                  if (PON(16)) pg8::gemm_phase(ring, g, S, E); }
                { pg8::Gemm g{WSP(const bf16_t, WS_KVN), WSP(const bf16_t, WS_WKVUP) + (size_t)i * 1024 * 256, 256, 256, 256}; pg8::StaticOrder S; S.init(NT, 1024, C.G, C.bid);
                  pg8::Epi<FStoreBf16, false> E{{WSP(bf16_t, WS_KV), 1024, 1.f, 0}};
                  if (PON(17)) pg8::gemm_phase(ring, g, S, E); }
                SEAM(base + 2); }
            if (RUN(base + 3)) { const Ctx C = relaunder(C0); if (PON(5)) a4_scan(C); if (PON(6)) a4_mla_naive(C); SEAM(base + 3); }
            if (RUN(base + 4)) { const Ctx C = relaunder(C0); if (PON(7)) a5_output(C, i); SEAM(base + 4); }
        } else {
            if (RUN(base + 0)) { const Ctx C = relaunder(C0);
                pg8::Gemm g{WSP(const bf16_t, WS_H), WSP(const bf16_t, WS_WQKV) + (size_t)i * 3072 * 1024, 1024, 1024, 1024}; pg8::StaticOrder S; S.init(NT, 3072, C.G, C.bid);
                pg8::Epi<FStoreBf16, false> E{{WSP(bf16_t, WS_Z), 3072, 0.125f, 1024}};
                if (PON(8)) pg8::gemm_phase(ring, g, S, E); SEAM(base + 0); }
            if (RUN(base + 1)) { const Ctx C = relaunder(C0); if (PON(9)) b2_na_naive(C, i, need_ctx); SEAM(base + 1); }
        }
        if (RUN(base + 5)) { const Ctx C = relaunder(C0);
            const bf16_t* W = (layer & 1) ? WSP(const bf16_t, WS_WOUTC) + (size_t)i * 1024 * 1024 : WSP(const bf16_t, WS_WOUTA) + (size_t)i * 1024 * 1024;
            pg8::Gemm g{WSP(const bf16_t, WS_MIX), W, 1024, 1024, 1024}; pg8::StaticOrder S; S.init(need_ctx ? NT : NLAT, 1024, C.G, C.bid);
            pg8::Epi<FResid, false> E{{WSP(float, WS_X), WSP(const float, WS_MOD), layer}};
            if (PON(10)) pg8::gemm_phase(ring, g, S, E); SEAM(base + 5); }
        if (RUN(base + 6)) { const Ctx C = relaunder(C0); if (PON(11)) c2_router(C, layer, need_ctx ? NT : NLAT); SEAM(base + 6); }
        if (RUN(base + 7)) { const Ctx C = relaunder(C0); if (PON(12)) c3_topk(C, need_ctx); SEAM(base + 7); }
        if (RUN(base + 8)) { const Ctx C = relaunder(C0);
            pg8::Gemm g{WSP(const bf16_t, WS_XIN), WSP(const bf16_t, WS_W13) + (size_t)layer * 16 * 4096 * 1024, 1024, 1024, 1024}; pg8::MoeOrder S; S.init(need_ctx ? 9 : 8, 16, C.G, C.bid);
            pg8::Epi<FSwiglu, true> E{{WSP(bf16_t, WS_HID)}};
            if (PON(13)) pg8::gemm_phase(ring, g, S, E); SEAM(base + 8); }
        if (RUN(base + 9)) { const Ctx C = relaunder(C0);
            pg8::Gemm g{WSP(const bf16_t, WS_HID), WSP(const bf16_t, WS_W2) + (size_t)layer * 16 * 1024 * 2048, 2048, 2048, 2048}; pg8::MoeOrder S; S.init(need_ctx ? 9 : 8, 4, C.G, C.bid);
            pg8::Epi<FGate, false> E{{WSP(bf16_t, WS_YB), WSP(const float, WS_GATE)}};
            if (PON(14)) pg8::gemm_phase(ring, g, S, E); SEAM(base + 9); }
        if (RUN(base + 10)) { const Ctx C = relaunder(C0); if (PON(15)) c6_combine(C, layer, need_ctx ? NT : NLAT); if (layer < 3) SEAM(base + 10); }
    }
#undef RUN
#undef SEAM
}

extern "C" void kernel_launch(void* const* d_in, const int* in_sizes, int n_in, void* d_out, int out_size, void* d_ws, size_t ws_size, hipStream_t stream) {
    static int grid = 0;
    if (grid == 0) {
        if (n_in != 33 || out_size != NLAT * DM || ws_size < WS_END) { fprintf(stderr, "kernel_launch: unexpected shapes (n_in %d out %d ws %zu need %zu)\n", n_in, out_size, ws_size, (size_t)WS_END); grid = -1; return; }
        int dev = 0, cus = 0, per_cu = 0;
        if (hipGetDevice(&dev) != hipSuccess || hipDeviceGetAttribute(&cus, hipDeviceAttributeMultiprocessorCount, dev) != hipSuccess) { grid = -1; return; }
        if (hipFuncSetAttribute((const void*)fwd, hipFuncAttributeMaxDynamicSharedMemorySize, LDS_BYTES) != hipSuccess) { fprintf(stderr, "kernel_launch: hipFuncSetAttribute failed\n"); grid = -1; return; }
        if (hipOccupancyMaxActiveBlocksPerMultiprocessor(&per_cu, (const void*)fwd, 512, LDS_BYTES) != hipSuccess || per_cu < 1) fprintf(stderr, "kernel_launch: occupancy query says %d\n", per_cu);
        (void)hipGetLastError();
        grid = cus;
    }
    if (grid < 0) return;
    (void)hipMemsetAsync((char*)d_ws + WS_CTL, 0, CTL_BYTES, stream);
    Args a{};
    for (int i = 0; i < 33; ++i) a.in[i] = (const float*)d_in[i];
    a.out = (float*)d_out; a.ws = (unsigned char*)d_ws;
#if SINGLE_LAUNCH
    a.ph_lo = 0; a.ph_hi = N_PHASE_IDS;
    hipLaunchKernelGGL(fwd, dim3(grid), dim3(512), LDS_BYTES, stream, a);
#else
    for (int p = 0; p < N_PHASE_IDS; ++p) { if (!phase_exists(p)) continue; a.ph_lo = p; a.ph_hi = p + 1; hipLaunchKernelGGL(fwd, dim3(grid), dim3(512), LDS_BYTES, stream, a); }
#endif
}
```

```cpp
#include <hip/hip_runtime.h>
#include <cstdio>
#include <cstdint>

#ifndef PHMASK
#define PHMASK 0xFFFFFFFFu
#endif
#define PON(n) (((PHMASK) >> (n)) & 1u)
#ifndef SINGLE_LAUNCH
#define SINGLE_LAUNCH 1
#endif

#define LAS __attribute__((address_space(3)))
#define GAS __attribute__((address_space(1)))
typedef unsigned short bf16_t;
typedef short bf16x8 __attribute__((ext_vector_type(8)));
typedef float f32x4 __attribute__((ext_vector_type(4)));
typedef float f32x2 __attribute__((ext_vector_type(2)));
typedef unsigned u32x4 __attribute__((ext_vector_type(4)));
typedef unsigned u32x2 __attribute__((ext_vector_type(2)));

constexpr int NB = 8, SEQ = 2048, CTXL = 256, DM = 1024;
constexpr int NLAT = NB * SEQ, NCTX = NB * CTXL, NT = NLAT + NCTX;
constexpr int ADIM = 512, ZP = 2816;
constexpr int NEXP = 16, FF = 2048, ROWS_E = 2304;
constexpr float NORM_EPS = 1e-6f;

constexpr size_t MiB = 1u << 20;
constexpr size_t WS_CTL = 0, CTL_BYTES = 1 * MiB;
constexpr size_t WS_MOD = 1 * MiB;
constexpr size_t WS_ROPE = 2 * MiB;
constexpr size_t WS_WIN = 4 * MiB;
constexpr size_t WS_WLORA = 16 * MiB;
constexpr size_t WS_WQUP = 20 * MiB;
constexpr size_t WS_WKVUP = 22 * MiB;
constexpr size_t WS_WOUTA = 24 * MiB;
constexpr size_t WS_WQKV = 28 * MiB;
constexpr size_t WS_WOUTC = 40 * MiB;
constexpr size_t WS_W13 = 48 * MiB;
constexpr size_t WS_W2 = 560 * MiB;
constexpr size_t WS_X = 816 * MiB;
constexpr size_t WS_H = 888 * MiB;
constexpr size_t WS_MIX = 924 * MiB;
constexpr size_t WS_Z = 960 * MiB;
constexpr size_t WS_R = 1068 * MiB;
constexpr size_t WS_V = 1086 * MiB;
constexpr size_t WS_KS = 1104 * MiB;
constexpr size_t WS_KK = 1122 * MiB;
constexpr size_t WS_LIN = 1140 * MiB;
constexpr size_t WS_QN = 1154 * MiB;
constexpr size_t WS_KVN = 1168 * MiB;
constexpr size_t WS_KR = 1177 * MiB;
constexpr size_t WS_DEC = 1179 * MiB;
constexpr size_t WS_KD = 1251 * MiB;
constexpr size_t WS_BB = 1287 * MiB;
constexpr size_t WS_G = 1323 * MiB;
constexpr size_t WS_Y = 1341 * MiB;
constexpr size_t WS_Q = 1413 * MiB;
constexpr size_t WS_KV = 1440 * MiB;
constexpr size_t WS_AFF = 1476 * MiB;
constexpr size_t WS_SEL = 1478 * MiB;
constexpr size_t WS_IDX = 1480 * MiB;
constexpr size_t WS_GATE = 1481 * MiB;
constexpr size_t WS_XIN = 1482 * MiB;
constexpr size_t WS_HID = 1554 * MiB;
constexpr size_t WS_YB = 1698 * MiB;
constexpr size_t WS_END = 1770 * MiB;

constexpr int CW_TMO = 0, CW_BAR = 4096;

constexpr int RING_BYTES = 133120;
constexpr int LDSCTL_OFF = RING_BYTES;
constexpr int LDS_BYTES = 147456;

__device__ __forceinline__ float bf2f(unsigned short b) { return __uint_as_float(((unsigned)b) << 16); }
__device__ __forceinline__ unsigned f2bf(float f) { unsigned u = __float_as_uint(f); return (u + 0x7fffu + ((u >> 16) & 1u)) >> 16; }
__device__ __forceinline__ unsigned pk2(float lo, float hi) { return f2bf(lo) | (f2bf(hi) << 16); }
__device__ __forceinline__ void unpk8(const u32x4 w, float (&f)[8]) {
    f[0] = __uint_as_float(w.x << 16); f[1] = __uint_as_float(w.x & 0xffff0000u); f[2] = __uint_as_float(w.y << 16); f[3] = __uint_as_float(w.y & 0xffff0000u);
    f[4] = __uint_as_float(w.z << 16); f[5] = __uint_as_float(w.z & 0xffff0000u); f[6] = __uint_as_float(w.w << 16); f[7] = __uint_as_float(w.w & 0xffff0000u); }
__device__ __forceinline__ void ld8(const bf16_t* p, float (&f)[8]) { unpk8(*(const u32x4*)p, f); }
__device__ __forceinline__ u32x4 pack8(const float (&f)[8]) { u32x4 w; w.x = pk2(f[0], f[1]); w.y = pk2(f[2], f[3]); w.z = pk2(f[4], f[5]); w.w = pk2(f[6], f[7]); return w; }
__device__ __forceinline__ void st8(bf16_t* p, const float (&f)[8]) { *(u32x4*)p = pack8(f); }
__device__ __forceinline__ float wave_sum(float v) {
#pragma unroll
    for (int o = 1; o < 64; o <<= 1) v += __shfl_xor(v, o);
    return v; }
__device__ __forceinline__ float sum8(float v) { v += __shfl_xor(v, 1); v += __shfl_xor(v, 2); v += __shfl_xor(v, 4); return v; }
__device__ __forceinline__ float sigmoidf_(float x) { return 1.f / (1.f + __expf(-x)); }
__device__ __forceinline__ int mod_group(int row) { return row < NLAT ? (row >> 11) : NB; }

namespace pg8 {
constexpr int BM = 256, BK = 64, HALF = 128, HTB = HALF * BK * 2, STAGE_BYTES = 8 * HTB, NXCD = 8, WGM = 8;
__host__ __device__ __forceinline__ int lds_byte(int r, int c) { const int st = (r >> 4) * 2 + (c >> 5), rr = r & 15, cc = c & 31, ob = rr * 64 + cc * 2; return st * 1024 + (ob ^ (((ob >> 9) & 1) << 5)); }
__host__ __device__ __forceinline__ void stage_rc(int b, int& R, int& C) { const int st = b / 1024, sb = b % 1024, swz = sb ^ (((sb >> 9) & 1) << 5); R = (st >> 1) * 16 + swz / 64; C = (st & 1) * 32 + (swz % 64) / 2; }
__host__ __device__ __forceinline__ int perm32(int rho) { const int n = rho >> 4, i = rho & 15; return 8 * (i >> 2) + 4 * n + (i & 3); }
struct Unit { int pm, pn; };
struct Gemm { const bf16_t* A; const bf16_t* Bt; int lda, ldb, K; };

struct StaticOrder {
    int nM, nN, nwg, G, c;
    __device__ void init(int M, int N, int G_, int c_) { nM = M / BM; nN = N / BM; nwg = nM * nN; G = G_; c = c_; }
    __device__ bool next(int i, Unit& u) const {
        const long L = (long)i * G + c; if (L >= nwg) return false;
        int wgid = (int)L; { const int q = nwg / NXCD, r = nwg % NXCD, xcd = wgid % NXCD, off = wgid / NXCD; wgid = (xcd < r ? xcd * (q + 1) : r * (q + 1) + (xcd - r) * q) + off; }
        const int nig = WGM * nN, gid = wgid / nig, fm = gid * WGM, gsz = (nM - fm) < WGM ? (nM - fm) : WGM;
        u.pm = fm + ((wgid % nig) % gsz); u.pn = (wgid % nig) / gsz; return true;
    }
};
struct MoeOrder {
    int nrt, nct, nwg, G, c;
    __device__ void init(int nrt_, int nct_, int G_, int c_) { nrt = nrt_; nct = nct_; nwg = NEXP * nrt * nct; G = G_; c = c_; }
    __device__ bool next(int i, Unit& u) const {
        const long L = (long)i * G + c; if (L >= nwg) return false;
        const int wgid = (int)(L % NXCD) * (nwg / NXCD) + (int)(L / NXCD);
        const int per = nrt * nct, e = wgid / per, rem = wgid % per, ct = rem / nrt, rt = rem % nrt;
        u.pm = e * 9 + rt; u.pn = e * nct + ct; return true;
    }
};

template <class F, bool PAIR> struct Epi {
    F f;
    __device__ __forceinline__ void operator()(const f32x4 (&acc)[2][2][4][2], const Unit& u, int wr, int wc, int fr, int fq) const {
#pragma unroll
        for (int ai = 0; ai < 2; ++ai)
#pragma unroll
            for (int m = 0; m < 4; ++m) {
                const int row = u.pm * BM + ai * HALF + wr * 64 + m * 16 + fr;
                if constexpr (PAIR) {
                    float a[8], b[8];
#pragma unroll
                    for (int j = 0; j < 4; ++j) { a[j] = acc[ai][0][m][0][j]; a[4 + j] = acc[ai][0][m][1][j]; b[j] = acc[ai][1][m][0][j]; b[4 + j] = acc[ai][1][m][1][j]; }
                    f(row, u.pn * HALF + wc * 32 + 8 * fq, a, b);
                } else {
#pragma unroll
                    for (int bj = 0; bj < 2; ++bj) { float a[8];
#pragma unroll
                        for (int j = 0; j < 4; ++j) { a[j] = acc[ai][bj][m][0][j]; a[4 + j] = acc[ai][bj][m][1][j]; }
                        f(row, u.pn * BM + bj * HALF + wc * 32 + 8 * fq, a); }
                }
            }
    }
};

template <class EpiT, class Sched>
__device__ __forceinline__ void gemm_phase(LAS unsigned char* lds, const Gemm g, const Sched& S, const EpiT& E) {
    int tid = threadIdx.x; asm volatile("" : "+v"(tid));
    const int wid = __builtin_amdgcn_readfirstlane(tid >> 6), lane = tid & 63, wr = wid >> 2, wc = wid & 3, fr = lane & 15, fq = lane >> 4;
    const int K = g.K, nt = K / BK;
    unsigned voffA[2], voffB[2];
#pragma unroll
    for (int i = 0; i < 2; ++i) { int R, C; stage_rc(tid * 16 + i * 8192, R, C); const int Rb = (R & ~31) + perm32(R & 31);
        voffA[i] = (unsigned)(R * g.lda + C) * 2u; voffB[i] = (unsigned)(Rb * g.ldb + C) * 2u; }
    const size_t kstep = (size_t)(BK * 2);
    const size_t hsA = (size_t)HALF * g.lda * 2, hsB = (size_t)HALF * g.ldb * 2, tsA = 2 * hsA, tsB = 2 * hsB;
    const unsigned ldsw = (unsigned)wid * 1024u;
    const int aoff = lds_byte(wr * 64 + fr, fq * 8), boff = lds_byte(wc * 32 + fr, fq * 8);
#define PG8_SA(b, h) (((b) * 2 + (h)) * HTB)
#define PG8_SB(b, h) ((4 + (b) * 2 + (h)) * HTB)
#define PG8_STAGE(bufoff, gbase, voff) do { _Pragma("unroll") for (int _i = 0; _i < 2; ++_i) \
        __builtin_amdgcn_global_load_lds((const unsigned*)((const char*)(gbase) + (voff)[_i]), (LAS unsigned*)(lds + (bufoff) + ldsw + _i * 8192), 16, 0, 0); } while (0)
#define PG8_LDA(dst, b, h) do { _Pragma("unroll") for (int m = 0; m < 4; ++m) _Pragma("unroll") for (int k = 0; k < 2; ++k) dst[m][k] = *(const LAS bf16x8*)(lds + PG8_SA(b, h) + aoff + m * 2048 + k * 1024); } while (0)
#define PG8_LDB(dst, b, h) do { _Pragma("unroll") for (int n = 0; n < 2; ++n) _Pragma("unroll") for (int k = 0; k < 2; ++k) dst[n][k] = *(const LAS bf16x8*)(lds + PG8_SB(b, h) + boff + n * 2048 + k * 1024); } while (0)
#define PG8_MMA(ai, bj, At, Bt) do { __builtin_amdgcn_s_setprio(1); _Pragma("unroll") for (int m = 0; m < 4; ++m) _Pragma("unroll") for (int n = 0; n < 2; ++n) _Pragma("unroll") for (int k = 0; k < 2; ++k) \
        acc[ai][bj][m][n] = __builtin_amdgcn_mfma_f32_16x16x32_bf16(Bt[n][k], At[m][k], acc[ai][bj][m][n], 0, 0, 0); __builtin_amdgcn_s_setprio(0); } while (0)
#define PG8_WAIT_V(n) asm volatile("s_waitcnt vmcnt(" #n ")" ::: "memory")
#define PG8_WAIT_L(n) asm volatile("s_waitcnt lgkmcnt(" #n ")" ::: "memory")
#define PG8_BAR __builtin_amdgcn_s_barrier()
#define PG8_SCHED __builtin_amdgcn_sched_barrier(0)
    Unit cur, nxt; int ui = 0;
    if (!S.next(0, cur)) return;
    f32x4 acc[2][2][4][2];
#pragma unroll
    for (int a = 0; a < 2; ++a)
#pragma unroll
        for (int b = 0; b < 2; ++b)
#pragma unroll
            for (int m = 0; m < 4; ++m)
#pragma unroll
                for (int n = 0; n < 2; ++n) acc[a][b][m][n] = (f32x4){0.f, 0.f, 0.f, 0.f};
    bf16x8 At[4][2], B0[2][2], B1[2][2];
    const char* cA = (const char*)g.A + (size_t)cur.pm * tsA; const char* cB = (const char*)g.Bt + (size_t)cur.pn * tsB;
    PG8_STAGE(PG8_SB(0, 0), cB, voffB); PG8_STAGE(PG8_SB(0, 1), cB + hsB, voffB); PG8_STAGE(PG8_SA(0, 0), cA, voffA); PG8_STAGE(PG8_SA(0, 1), cA + hsA, voffA);
    if (wr == 1) PG8_BAR;
    PG8_WAIT_V(2); PG8_BAR;
    PG8_STAGE(PG8_SB(1, 0), cB + kstep, voffB); PG8_STAGE(PG8_SA(1, 0), cA + kstep, voffA); PG8_STAGE(PG8_SB(1, 1), cB + hsB + kstep, voffB);
    PG8_WAIT_V(6); PG8_BAR;
    for (;;) {
        const bool has_next = S.next(ui + 1, nxt);
        const char* nA = has_next ? (const char*)g.A + (size_t)nxt.pm * tsA : cA; const char* nB = has_next ? (const char*)g.Bt + (size_t)nxt.pn * tsB : cB;
#pragma unroll 1
        for (int t = 0; t < nt; t += 2) {
            const bool last = (t == nt - 2);
            const char* a1 = cA + (size_t)(t + 1) * kstep;
            const char* a2 = last ? nA : cA + (size_t)(t + 2) * kstep; const char* b2 = last ? nB : cB + (size_t)(t + 2) * kstep;
            const char* a3 = a2 + kstep; const char* b3 = b2 + kstep;
            PG8_LDB(B0, 0, 0); PG8_LDB(B1, 0, 1); PG8_SCHED; PG8_LDA(At, 0, 0); PG8_STAGE(PG8_SA(1, 1), a1 + hsA, voffA);
            PG8_WAIT_V(8); PG8_WAIT_L(0); PG8_BAR; PG8_MMA(0, 0, At, B0); PG8_MMA(0, 1, At, B1); PG8_BAR; PG8_SCHED;
            PG8_LDA(At, 0, 1); PG8_STAGE(PG8_SB(0, 0), b2, voffB); PG8_STAGE(PG8_SB(0, 1), b2 + hsB, voffB); PG8_STAGE(PG8_SA(0, 0), a2, voffA);
            PG8_WAIT_V(8); PG8_WAIT_L(0); PG8_BAR; PG8_MMA(1, 0, At, B0); PG8_MMA(1, 1, At, B1); PG8_BAR; PG8_SCHED;
            PG8_LDB(B0, 1, 0); PG8_LDB(B1, 1, 1); PG8_SCHED; PG8_LDA(At, 1, 0); PG8_STAGE(PG8_SA(0, 1), a2 + hsA, voffA);
            PG8_WAIT_V(8); PG8_WAIT_L(0); PG8_BAR; PG8_MMA(0, 0, At, B0); PG8_MMA(0, 1, At, B1); PG8_BAR; PG8_SCHED;
            PG8_LDA(At, 1, 1); PG8_STAGE(PG8_SB(1, 0), b3, voffB); PG8_STAGE(PG8_SB(1, 1), b3 + hsB, voffB); PG8_STAGE(PG8_SA(1, 0), a3, voffA);
            PG8_WAIT_V(8); PG8_WAIT_L(0); PG8_BAR; PG8_MMA(1, 0, At, B0); PG8_MMA(1, 1, At, B1); PG8_BAR; PG8_SCHED;
        }
        if (wr == 0) PG8_BAR;
        E(acc, cur, wr, wc, fr, fq);
        if (!has_next) break;
#pragma unroll
        for (int a = 0; a < 2; ++a)
#pragma unroll
            for (int b = 0; b < 2; ++b)
#pragma unroll
                for (int m = 0; m < 4; ++m)
#pragma unroll
                    for (int n = 0; n < 2; ++n) acc[a][b][m][n] = (f32x4){0.f, 0.f, 0.f, 0.f};
        cur = nxt; cA = nA; cB = nB; ++ui;
        if (wr == 1) PG8_BAR;
    }
    PG8_WAIT_V(0);
    PG8_BAR;
#undef PG8_SA
#undef PG8_SB
#undef PG8_STAGE
#undef PG8_LDA
#undef PG8_LDB
#undef PG8_MMA
#undef PG8_WAIT_V
#undef PG8_WAIT_L
#undef PG8_BAR
#undef PG8_SCHED
}
}

#define XB_TMO      128
#define XB_XCNT(j)  (256  + 64 * (j))
#define XB_XSUB(j)  (1280 + 64 * (j))
#define XB_XGEN(j)  (2304 + 64 * (j))
#define XB_TOP      3328
#define XB_TOPGEN   3392
#define XCD_BAR_WORDS 3456
#define XB_SPIN_CAP (1u << 22)
__device__ __forceinline__ unsigned xb_ld(unsigned* p)              { return __hip_atomic_load(p, __ATOMIC_RELAXED, __HIP_MEMORY_SCOPE_AGENT); }
__device__ __forceinline__ unsigned xb_add(unsigned* p, unsigned v) { return __hip_atomic_fetch_add(p, v, __ATOMIC_RELAXED, __HIP_MEMORY_SCOPE_AGENT); }
__device__ __forceinline__ unsigned xb_xcc_id() { return (unsigned)__builtin_amdgcn_s_getreg((3 << 11) | 20) & 0xFu; }
#define XB_SPIN(cond, bar) do { unsigned _sp = 0; while (cond) { __builtin_amdgcn_s_sleep(1); \
    if ((++_sp & 255u) == 0u) { if (xb_ld(&(bar)[XB_TMO])) break; if (_sp > XB_SPIN_CAP) { atomicAdd(&(bar)[XB_TMO], 1u); break; } } } } while (0)
struct XcdBarrier { unsigned* bar; unsigned x; volatile LAS unsigned* st; };
__device__ __forceinline__ XcdBarrier xcd_barrier_post(unsigned* bar, volatile LAS unsigned* st) {
    XcdBarrier b; b.bar = bar; b.x = xb_xcc_id(); b.st = st;
    if (threadIdx.x == 0) (void)xb_add(&bar[XB_XCNT(b.x)], 1u);
    return b;
}
__device__ __forceinline__ void xcd_barrier_complete(unsigned* bar, unsigned x, unsigned& nloc, unsigned& nx) {
    const unsigned G = gridDim.x * gridDim.y * gridDim.z;
    unsigned sum, cnt, mine, sp = 0u;
    for (;;) {
        sum = 0u; cnt = 0u; mine = 0u;
#pragma unroll
        for (unsigned j = 0; j < 16; ++j) { const unsigned c = xb_ld(&bar[XB_XCNT(j)]); sum += c; cnt += (c > 0u) ? 1u : 0u; mine = (j == x) ? c : mine; }
        if (sum == G) break;
        __builtin_amdgcn_s_sleep(1);
        if ((++sp & 255u) == 0u) { if (xb_ld(&bar[XB_TMO])) break; if (sp > XB_SPIN_CAP) { atomicAdd(&bar[XB_TMO], 1u); break; } }
    }
    nloc = mine > 0u ? mine : 1u; nx = cnt > 0u ? cnt : 1u;
}
__device__ __forceinline__ void xcd_barrier(const XcdBarrier& b) {
    asm volatile("s_waitcnt vmcnt(0)" ::: "memory");
    __syncthreads();
    if (threadIdx.x == 0) {
        unsigned* bar = b.bar;
        __builtin_amdgcn_s_waitcnt(0);
        unsigned nloc = b.st[0], nx = b.st[1];
        if (nloc == 0u) { xcd_barrier_complete(bar, b.x, nloc, nx); b.st[0] = nloc; b.st[1] = nx; }
        const unsigned old = xb_add(&bar[XB_XSUB(b.x)], 1u);
        const unsigned gen = old / nloc;
        if (old + 1u == (gen + 1u) * nloc) {
            __builtin_amdgcn_fence(__ATOMIC_RELEASE, "agent");
            asm volatile("s_waitcnt vmcnt(0)" ::: "memory");
            const unsigned og = xb_add(&bar[XB_TOP], 1u);
            const unsigned tg = og / nx;
            if (og + 1u == (tg + 1u) * nx) xb_add(&bar[XB_TOPGEN], 1u);
            else XB_SPIN(xb_ld(&bar[XB_TOPGEN]) == tg, bar);
            __builtin_amdgcn_fence(__ATOMIC_ACQUIRE, "agent");
            xb_add(&bar[XB_XGEN(b.x)], 1u);
            asm volatile("s_waitcnt vmcnt(0)" ::: "memory");
        } else {
            XB_SPIN(xb_ld(&bar[XB_XGEN(b.x)]) == gen, bar);
            __builtin_amdgcn_fence(__ATOMIC_ACQUIRE, "agent");
            asm volatile("s_waitcnt vmcnt(0)" ::: "memory");
        }
    }
    __syncthreads();
}

struct Args { const float* in[33]; float* out; unsigned char* ws; int ph_lo, ph_hi; };
struct Ctx {
    const Args& A; float* out; unsigned char* ws;
    LAS unsigned char* lds; int tid, lane, wave, G, bid, gw, ngw;
};
#define WSP(T, off) ((T*)(C.ws + (off)))
__device__ __forceinline__ Ctx relaunder(const Ctx& C0) {
    int tid = C0.tid; unsigned char* ws = C0.ws; LAS unsigned char* lds = C0.lds;
    asm volatile("" : "+v"(tid), "+s"(ws));
    const int wave = __builtin_amdgcn_readfirstlane(tid >> 6);
    return Ctx{C0.A, C0.out, ws, lds, tid, tid & 63, wave, C0.G, C0.bid, C0.bid * 8 + wave, C0.G * 8};
}
__device__ __forceinline__ const float* modp(const Ctx& C, int layer, int mg, int chunk) { return WSP(const float, WS_MOD) + ((size_t)(layer * 9 + mg) * 6 + chunk) * 1024; }

__device__ __forceinline__ void tr_item(const float* src, int ld_src, int nvalid, int k0, int n0, bf16_t* dst, int ld_dst, int drow0, int dk0, LAS float* scr, int lane) {
    {
        const int n = (lane & 15) * 4; const bool ok = (n0 + n) < nvalid;
#pragma unroll 4
        for (int i = 0; i < 16; ++i) { const int k = 4 * i + (lane >> 4);
            f32x4 v = (f32x4){0.f, 0.f, 0.f, 0.f};
            if (ok) v = *(const f32x4*)(src + (size_t)(k0 + k) * ld_src + n0 + n);
            LAS float* s = scr + k * 65 + n; s[0] = v.x; s[1] = v.y; s[2] = v.z; s[3] = v.w; }
    }
    asm volatile("s_waitcnt lgkmcnt(0)" ::: "memory");
    const int c = lane & 7;
#pragma unroll
    for (int jj = 0; jj < 8; ++jj) { const int nl = (lane >> 3) + 8 * jj; const LAS float* s = scr + (8 * c) * 65 + nl;
        u32x4 o; o.x = pk2(s[0 * 65], s[1 * 65]); o.y = pk2(s[2 * 65], s[3 * 65]); o.z = pk2(s[4 * 65], s[5 * 65]); o.w = pk2(s[6 * 65], s[7 * 65]);
        if (n0 + nl < nvalid) *(u32x4*)(dst + (size_t)(drow0 + nl) * ld_dst + dk0 + 8 * c) = o; }
    asm volatile("s_waitcnt lgkmcnt(0)" ::: "memory");
}
constexpr int CV_SMALL = 2120, CV_MOE = 4 * 16 * 3 * 512;
__device__ __forceinline__ void p0_convert(const Ctx& C) {
    LAS float* scr = (LAS float*)(C.lds + C.wave * 16640);
    for (int it = C.gw; it < 2 * CV_SMALL + CV_MOE; it += C.ngw) {
        const float* src; int ld_src, nvalid, k0, n0, ld_dst, drow0, dk0; bf16_t* dst;
        if (it < 2 * CV_SMALL) {
            const int i = it / CV_SMALL; int r = it % CV_SMALL;
            if (r < 656) { src = C.A.in[9] + (size_t)i * 1024 * 2592; ld_src = 2592; nvalid = 2592; k0 = (r / 41) * 64; n0 = (r % 41) * 64; dst = WSP(bf16_t, WS_WIN) + (size_t)i * ZP * 1024; ld_dst = 1024; drow0 = n0; dk0 = k0; }
            else if ((r -= 656) < 16) { const int d = r >> 3; src = C.A.in[13] + (size_t)(i * 2 + d) * 64 * 512; ld_src = 512; nvalid = 512; k0 = 0; n0 = (r & 7) * 64; dst = WSP(bf16_t, WS_WLORA) + (size_t)i * 2560 * 384; ld_dst = 384; drow0 = d * 512 + n0; dk0 = d * 64; }
            else if ((r -= 16) < 16) { const int d = r >> 3; src = C.A.in[15] + (size_t)(i * 2 + d) * 64 * 512; ld_src = 512; nvalid = 512; k0 = 0; n0 = (r & 7) * 64; dst = WSP(bf16_t, WS_WLORA) + (size_t)i * 2560 * 384; ld_dst = 384; drow0 = 1024 + d * 512 + n0; dk0 = 128 + d * 64; }
            else if ((r -= 16) < 16) { src = C.A.in[16] + (size_t)i * 128 * 512; ld_src = 512; nvalid = 512; k0 = (r >> 3) * 64; n0 = (r & 7) * 64; dst = WSP(bf16_t, WS_WLORA) + (size_t)i * 2560 * 384; ld_dst = 384; drow0 = 2048 + n0; dk0 = 256 + k0; }
            else if ((r -= 16) < 72) { src = C.A.in[23] + (size_t)i * 384 * 768; ld_src = 768; nvalid = 768; k0 = (r / 12) * 64; n0 = (r % 12) * 64; dst = WSP(bf16_t, WS_WQUP) + (size_t)i * 768 * 384; ld_dst = 384; drow0 = n0; dk0 = k0; }
            else if ((r -= 72) < 64) { src = C.A.in[25] + (size_t)i * 256 * 1024; ld_src = 1024; nvalid = 1024; k0 = (r / 16) * 64; n0 = (r % 16) * 64; dst = WSP(bf16_t, WS_WKVUP) + (size_t)i * 1024 * 256; ld_dst = 256; drow0 = n0; dk0 = k0; }
            else if ((r -= 64) < 256) { src = C.A.in[10] + (size_t)i * 1024 * 1024; ld_src = 1024; nvalid = 1024; k0 = (r / 16) * 64; n0 = (r % 16) * 64; dst = WSP(bf16_t, WS_WOUTA) + (size_t)i * 1024 * 1024; ld_dst = 1024; drow0 = n0; dk0 = k0; }
            else if ((r -= 256) < 768) { src = C.A.in[26] + (size_t)i * 1024 * 3072; ld_src = 3072; nvalid = 3072; k0 = (r / 48) * 64; n0 = (r % 48) * 64; dst = WSP(bf16_t, WS_WQKV) + (size_t)i * 3072 * 1024; ld_dst = 1024; drow0 = n0; dk0 = k0; }
            else { r -= 768; src = C.A.in[28] + (size_t)i * 1024 * 1024; ld_src = 1024; nvalid = 1024; k0 = (r / 16) * 64; n0 = (r % 16) * 64; dst = WSP(bf16_t, WS_WOUTC) + (size_t)i * 1024 * 1024; ld_dst = 1024; drow0 = n0; dk0 = k0; }
        } else {
            const int m = it - 2 * CV_SMALL, le = m / 1536, r = m % 1536, which = r / 512, q = r % 512;
            if (which < 2) { src = C.A.in[which == 0 ? 30 : 31] + (size_t)le * 1024 * 2048; ld_src = 2048; nvalid = 2048; k0 = (q / 32) * 64; n0 = (q % 32) * 64;
                dst = WSP(bf16_t, WS_W13) + (size_t)le * 4096 * 1024; ld_dst = 1024; drow0 = (n0 >> 7) * 256 + which * 128 + (n0 & 127); dk0 = k0; }
            else { src = C.A.in[32] + (size_t)le * 2048 * 1024; ld_src = 1024; nvalid = 1024; k0 = (q / 16) * 64; n0 = (q % 16) * 64;
                dst = WSP(bf16_t, WS_W2) + (size_t)le * 1024 * 2048; ld_dst = 2048; drow0 = n0; dk0 = k0; }
        }
        tr_item(src, ld_src, nvalid, k0, n0, dst, ld_dst, drow0, dk0, scr, C.lane);
    }
    const u32x4 z4 = (u32x4){0u, 0u, 0u, 0u};
    const int gt = C.bid * 512 + C.tid, ngt = C.G * 512;
    for (int idx = gt; idx < 2 * 224 * 128; idx += ngt) { const int i = idx / (224 * 128), r = (idx / 128) % 224, ch = idx % 128;
        *(u32x4*)(WSP(bf16_t, WS_WIN) + ((size_t)i * ZP + 2592 + r) * 1024 + ch * 8) = z4; }
    for (int idx = gt; idx < 2 * 2560 * 48; idx += ngt) { const int i = idx / (2560 * 48), r = (idx / 48) % 2560, ch = idx % 48, seg = r >> 9;
        const int lo = seg < 4 ? seg * 8 : 32, hi = seg < 4 ? seg * 8 + 8 : 48;
        if (ch < lo || ch >= hi) *(u32x4*)(WSP(bf16_t, WS_WLORA) + ((size_t)i * 2560 + r) * 384 + ch * 8) = z4; }
    for (int idx = gt; idx < 2048 * 16; idx += ngt) { const int t = idx >> 4, i = idx & 15; const float pos = (float)(i < 8 ? (t >> 6) : (t & 63));
        const float inv = powf(10000.0f, -(float)(i & 7) / 8.0f); const float ang = pos * inv;
        WSP(float, WS_ROPE)[idx * 2] = cosf(ang); WSP(float, WS_ROPE)[idx * 2 + 1] = sinf(ang); }
}
__device__ __forceinline__ void p0_mod(const Ctx& C) {
    LAS float* sc = (LAS float*)C.lds;
    LAS float* part = (LAS float*)(C.lds + 36864);
    __syncthreads();
    for (int idx = C.tid; idx < 9 * 1024; idx += 512) { const int r = idx >> 10, k = idx & 1023; const float cv = r < 8 ? C.A.in[1][r * 1024 + k] : C.A.in[3][k]; sc[idx] = cv / (1.f + __expf(-cv)); }
    __syncthreads();
    for (int unit = C.bid; unit < 192; unit += C.G) {
        const int l = unit / 48, jb = unit % 48, jj = C.tid & 127, kc = C.tid >> 7;
        const float* w = C.A.in[4] + ((size_t)l * 1024 + kc * 256) * 6144 + jb * 128 + jj;
        float acc[9];
#pragma unroll
        for (int r = 0; r < 9; ++r) acc[r] = 0.f;
#pragma unroll 4
        for (int k = 0; k < 256; ++k) { const float wv = w[(size_t)k * 6144];
#pragma unroll
            for (int r = 0; r < 9; ++r) acc[r] += sc[r * 1024 + kc * 256 + k] * wv; }
#pragma unroll
        for (int r = 0; r < 9; ++r) part[(kc * 9 + r) * 128 + jj] = acc[r];
        __syncthreads();
        for (int idx = C.tid; idx < 9 * 128; idx += 512) { const int r = idx >> 7, j2 = idx & 127;
            const float s = part[(0 * 9 + r) * 128 + j2] + part[(1 * 9 + r) * 128 + j2] + part[(2 * 9 + r) * 128 + j2] + part[(3 * 9 + r) * 128 + j2] + C.A.in[5][l * 6144 + jb * 128 + j2];
            WSP(float, WS_MOD)[(size_t)(l * 9 + r) * 6144 + jb * 128 + j2] = s; }
        __syncthreads();
    }
}

__device__ __forceinline__ void row_load(const float* p, int lane, f32x4 (&v)[4]) {
#pragma unroll
    for (int j = 0; j < 4; ++j) v[j] = *(const f32x4*)(p + (lane + 64 * j) * 4); }
__device__ __forceinline__ void row_store(float* p, int lane, const f32x4 (&v)[4]) {
#pragma unroll
    for (int j = 0; j < 4; ++j) *(f32x4*)(p + (lane + 64 * j) * 4) = v[j]; }
__device__ __forceinline__ float row_rstd(const f32x4 (&v)[4]) {
    float s = 0.f;
#pragma unroll
    for (int j = 0; j < 4; ++j) s += (v[j].x * v[j].x + v[j].y * v[j].y) + (v[j].z * v[j].z + v[j].w * v[j].w);
    return rsqrtf(wave_sum(s) * (1.f / 1024.f) + NORM_EPS); }
__device__ __forceinline__ void row_modulate(const f32x4 (&v)[4], float rstd, const float* nw, const float* sh, const float* sc, int lane, f32x4 (&h)[4]) {
#pragma unroll
    for (int j = 0; j < 4; ++j) { const int c = (lane + 64 * j) * 4; const f32x4 w = *(const f32x4*)(nw + c), s1 = *(const f32x4*)(sc + c), s0 = *(const f32x4*)(sh + c);
        h[j] = (v[j] * rstd * w) * (s1 + 1.0f) + s0; } }
__device__ __forceinline__ void row_store_bf16(bf16_t* p, int lane, const f32x4 (&h)[4]) {
#pragma unroll
    for (int j = 0; j < 4; ++j) { u32x2 w; w.x = pk2(h[j].x, h[j].y); w.y = pk2(h[j].z, h[j].w); *(u32x2*)(p + (lane + 64 * j) * 4) = w; } }

__device__ __forceinline__ void p1_init(const Ctx& C) {
    for (int row = C.gw; row < NT; row += C.ngw) {
        const float* src = row < NLAT ? C.A.in[0] + (size_t)row * DM : C.A.in[2] + (size_t)(row - NLAT) * DM;
        f32x4 v[4], h[4]; row_load(src, C.lane, v); row_store(WSP(float, WS_X) + (size_t)row * DM, C.lane, v);
        const int mg = mod_group(row); const float rstd = row_rstd(v);
        row_modulate(v, rstd, C.A.in[6], modp(C, 0, mg, 0), modp(C, 0, mg, 1), C.lane, h);
        row_store_bf16(WSP(bf16_t, WS_H) + (size_t)row * DM, C.lane, h);
    }
}

__device__ __forceinline__ void a2_prepare(const Ctx& C, int i) {
    const bf16_t* Z = WSP(const bf16_t, WS_Z);
    const float* mu = C.A.in[11] + (size_t)i * 2 * 1920;
    const int lane = C.lane;
    for (int row = C.gw; row < NT; row += C.ngw) {
        const bool isctx = row >= NLAT; const int t = isctx ? ((row - NLAT) & 255) : (row & 2047), T = isctx ? 256 : 2048;
        const bf16_t* z = Z + (size_t)row * ZP; const bool hp = t > 0, hn = t < T - 1;
        float r8[8], k8[8], v8[8];
#pragma unroll
        for (int seg = 0; seg < 3; ++seg) {
            const int c0 = seg * 512 + lane * 8; float zc[8], zp[8], zn[8], m0[8], m1[8];
            ld8(z + c0, zc);
            if (hp) ld8(z - ZP + c0, zp); else { for (int j = 0; j < 8; ++j) zp[j] = 0.f; }
            if (hn) ld8(z + ZP + c0, zn); else { for (int j = 0; j < 8; ++j) zn[j] = 0.f; }
            *(f32x4*)&m0[0] = *(const f32x4*)(mu + c0); *(f32x4*)&m0[4] = *(const f32x4*)(mu + c0 + 4);
            *(f32x4*)&m1[0] = *(const f32x4*)(mu + 1920 + c0); *(f32x4*)&m1[4] = *(const f32x4*)(mu + 1920 + c0 + 4);
#pragma unroll
            for (int j = 0; j < 8; ++j) { const float o = zc[j] + m0[j] * (zp[j] - zc[j]) + m1[j] * (zn[j] - zc[j]); if (seg == 0) r8[j] = o; else if (seg == 1) k8[j] = o; else v8[j] = o; }
        }
        st8(WSP(bf16_t, WS_R) + (size_t)row * ADIM + lane * 8, r8);
        st8(WSP(bf16_t, WS_KS) + (size_t)row * ADIM + lane * 8, k8);
        st8(WSP(bf16_t, WS_V) + (size_t)row * ADIM + lane * 8, v8);
        { float kk[8], ss = 0.f; const float* kkw = C.A.in[17] + i * ADIM + lane * 8;
#pragma unroll
            for (int j = 0; j < 8; ++j) { kk[j] = k8[j] * kkw[j]; ss += kk[j] * kk[j]; }
            ss = sum8(ss); const float inv = 1.f / fmaxf(sqrtf(ss), 1e-12f);
#pragma unroll
            for (int j = 0; j < 8; ++j) kk[j] *= inv;
            st8(WSP(bf16_t, WS_KK) + (size_t)row * ADIM + lane * 8, kk); }
#pragma unroll
        for (int seg = 0; seg < 3; ++seg) {
            const int c0 = 1536 + seg * 128 + lane * 2; const unsigned wc_ = *(const unsigned*)(z + c0);
            const unsigned wp_ = hp ? *(const unsigned*)(z - ZP + c0) : 0u, wn_ = hn ? *(const unsigned*)(z + ZP + c0) : 0u;
            float o[2];
#pragma unroll
            for (int j = 0; j < 2; ++j) { const float zc = j ? __uint_as_float(wc_ & 0xffff0000u) : __uint_as_float(wc_ << 16), zp = j ? __uint_as_float(wp_ & 0xffff0000u) : __uint_as_float(wp_ << 16),
                                                      zn = j ? __uint_as_float(wn_ & 0xffff0000u) : __uint_as_float(wn_ << 16);
                const float s = zc + mu[c0 + j] * (zp - zc) + mu[1920 + c0 + j] * (zn - zc);
                o[j] = seg == 0 ? tanhf(s) : (seg == 1 ? s : sigmoidf_(s)); }
            *(unsigned*)(WSP(bf16_t, WS_LIN) + (size_t)row * 384 + seg * 128 + lane * 2) = pk2(o[0], o[1]);
        }
        { float q[6], ss = 0.f;
#pragma unroll
            for (int j = 0; j < 3; ++j) { const unsigned w = *(const unsigned*)(z + 1920 + j * 128 + lane * 2); q[2 * j] = __uint_as_float(w << 16); q[2 * j + 1] = __uint_as_float(w & 0xffff0000u); ss += q[2 * j] * q[2 * j] + q[2 * j + 1] * q[2 * j + 1]; }
            const float rstd = rsqrtf(wave_sum(ss) * (1.f / 384.f) + NORM_EPS); const float* nw = C.A.in[22] + i * 384;
#pragma unroll
            for (int j = 0; j < 3; ++j) { const int c = j * 128 + lane * 2; *(unsigned*)(WSP(bf16_t, WS_QN) + (size_t)row * 384 + c) = pk2(q[2 * j] * rstd * nw[c], q[2 * j + 1] * rstd * nw[c + 1]); } }
        { const u32x2 w = *(const u32x2*)(z + 2304 + lane * 4); float q[4] = {__uint_as_float(w.x << 16), __uint_as_float(w.x & 0xffff0000u), __uint_as_float(w.y << 16), __uint_as_float(w.y & 0xffff0000u)};
            const float ss = q[0] * q[0] + q[1] * q[1] + q[2] * q[2] + q[3] * q[3];
            const float rstd = rsqrtf(wave_sum(ss) * (1.f / 256.f) + NORM_EPS); const float* nw = C.A.in[24] + i * 256 + lane * 4;
            u32x2 o; o.x = pk2(q[0] * rstd * nw[0], q[1] * rstd * nw[1]); o.y = pk2(q[2] * rstd * nw[2], q[3] * rstd * nw[3]);
            *(u32x2*)(WSP(bf16_t, WS_KVN) + (size_t)row * 256 + lane * 4) = o; }
        if (lane < 16) { const unsigned w = *(const unsigned*)(z + 2560 + lane * 2); float x0 = __uint_as_float(w << 16), x1 = __uint_as_float(w & 0xffff0000u);
            if (!isctx) { const float cs = WSP(const float, WS_ROPE)[(t * 16 + lane) * 2], sn = WSP(const float, WS_ROPE)[(t * 16 + lane) * 2 + 1]; const float o0 = x0 * cs - x1 * sn, o1 = x0 * sn + x1 * cs; x0 = o0; x1 = o1; }
            *(unsigned*)(WSP(bf16_t, WS_KR) + (size_t)row * 32 + lane * 2) = pk2(x0, x1); }
    }
}

struct FStoreBf16 { bf16_t* O; int ldo; float scale; int scale_cols;
    __device__ __forceinline__ void operator()(int row, int col, const float (&v)[8]) const { float o[8]; const float s = col < scale_cols ? scale : 1.f;
#pragma unroll
        for (int j = 0; j < 8; ++j) o[j] = v[j] * s;
        st8(O + (size_t)row * ldo + col, o); } };
struct FLora { const float* w0; const float* a0; const float* ka; const bf16_t* KS; const bf16_t* KK; float* DEC; bf16_t* KD; bf16_t* BB; bf16_t* G;
    __device__ __forceinline__ void operator()(int row, int col, const float (&v)[8]) const {
        const int seg = col >> 9, c = col & 511;
        if (seg < 2) { float o[8];
#pragma unroll
            for (int j = 0; j < 8; ++j) { const float x = w0[seg * 512 + c + j] + v[j]; const float sp = fmaxf(-x, 0.f) + __logf(1.f + __expf(-fabsf(x)));
                o[j] = __expf(-__expf(-sp - 0.5f)); }
            float* d = DEC + ((size_t)seg * NT + row) * ADIM + c; *(f32x4*)d = *(const f32x4*)&o[0]; *(f32x4*)(d + 4) = *(const f32x4*)&o[4];
        } else if (seg < 4) { const int d_ = seg - 2; float k[8], kk[8], kd[8], bb[8]; ld8(KS + (size_t)row * ADIM + c, k); ld8(KK + (size_t)row * ADIM + c, kk);
#pragma unroll
            for (int j = 0; j < 8; ++j) { const float a = sigmoidf_(a0[d_ * 512 + c + j] + v[j]); kd[j] = k[j] * (1.f + (a - 1.f) * ka[c + j]); bb[j] = kk[j] * a; }
            st8(KD + ((size_t)d_ * NT + row) * ADIM + c, kd); st8(BB + ((size_t)d_ * NT + row) * ADIM + c, bb);
        } else st8(G + (size_t)row * ADIM + c, v);
    } };
struct FQup { bf16_t* Q; const float* rope; float scale;
    __device__ __forceinline__ void operator()(int row, int col, const float (&v)[8]) const {
        const int d = col % 96; float o[8];
#pragma unroll
        for (int j = 0; j < 8; ++j) o[j] = v[j] * scale;
        if (d >= 64 && row < NLAT) { const int t = row & 2047, p0 = (d - 64) >> 1;
#pragma unroll
            for (int p = 0; p < 4; ++p) { const float cs = rope[(t * 16 + p0 + p) * 2], sn = rope[(t * 16 + p0 + p) * 2 + 1]; const float x0 = o[2 * p], x1 = o[2 * p + 1]; o[2 * p] = x0 * cs - x1 * sn; o[2 * p + 1] = x0 * sn + x1 * cs; } }
        st8(Q + (size_t)row * 768 + col, o);
    } };
struct FResid { float* X; const float* mod; int layer;
    __device__ __forceinline__ void operator()(int row, int col, const float (&v)[8]) const {
        const float* g = mod + ((size_t)(layer * 9 + mod_group(row)) * 6 + 2) * 1024 + col; float* x = X + (size_t)row * DM + col;
        f32x4 x0 = *(const f32x4*)x, x1 = *(const f32x4*)(x + 4); const f32x4 g0 = *(const f32x4*)g, g1 = *(const f32x4*)(g + 4);
        x0 += g0 * (f32x4){v[0], v[1], v[2], v[3]}; x1 += g1 * (f32x4){v[4], v[5], v[6], v[7]};
        *(f32x4*)x = x0; *(f32x4*)(x + 4) = x1;
    } };
struct FSwiglu { bf16_t* HID;
    __device__ __forceinline__ void operator()(int row, int col, const float (&a)[8], const float (&b)[8]) const { float o[8];
#pragma unroll
        for (int j = 0; j < 8; ++j) o[j] = a[j] / (1.f + __expf(-a[j])) * b[j];
        st8(HID + (size_t)row * FF + (col & (FF - 1)), o); } };
struct FGate { bf16_t* YB; const float* gate;
    __device__ __forceinline__ void operator()(int row, int col, const float (&v)[8]) const { const float g = gate[row]; float o[8];
#pragma unroll
        for (int j = 0; j < 8; ++j) o[j] = v[j] * g;
        st8(YB + (size_t)row * DM + (col & (DM - 1)), o); } };

constexpr int SC_TC = 32;
__device__ __forceinline__ void a4_scan(const Ctx& C) {
    LAS float* L = (LAS float*)C.lds;
    const int tid = C.tid, rowi = tid >> 3, j = tid & 7;
    const int ls_ld = tid >> 4, c4 = (tid & 15) * 4;
    for (int unit = C.bid; unit < 128; unit += C.G) {
        const int b = unit >> 4, h = (unit >> 1) & 7, dir = unit & 1;
        const float* DEC = WSP(const float, WS_DEC) + (size_t)dir * NT * ADIM + h * 64;
        const bf16_t* KD = WSP(const bf16_t, WS_KD) + (size_t)dir * NT * ADIM + h * 64;
        const bf16_t* BB = WSP(const bf16_t, WS_BB) + (size_t)dir * NT * ADIM + h * 64;
        const bf16_t* KK = WSP(const bf16_t, WS_KK) + h * 64; const bf16_t* R = WSP(const bf16_t, WS_R) + h * 64; const bf16_t* V = WSP(const bf16_t, WS_V) + h * 64;
        float* Y = WSP(float, WS_Y) + (size_t)dir * NT * ADIM + h * 64;
        auto row_of = [&](int s) -> int { return s < 256 ? NLAT + b * 256 + (dir ? 255 - s : s) : b * 2048 + (dir ? 2047 - (s - 256) : (s - 256)); };
        f32x4 pw; u32x2 pkd, pbb, pkk, pr, pv;
        auto gload = [&](int chunk) { const size_t o = (size_t)row_of(chunk * SC_TC + ls_ld) * ADIM + c4;
            pw = *(const f32x4*)(DEC + o); pkd = *(const u32x2*)(KD + o); pbb = *(const u32x2*)(BB + o); pkk = *(const u32x2*)(KK + o); pr = *(const u32x2*)(R + o); pv = *(const u32x2*)(V + o); };
        auto lwrite = [&](int buf) { LAS float* Bf = L + buf * 12288 + ls_ld * 64 + c4;
            *(LAS f32x4*)(Bf) = pw;
            *(LAS f32x4*)(Bf + 2048) = (f32x4){__uint_as_float(pkd.x << 16), __uint_as_float(pkd.x & 0xffff0000u), __uint_as_float(pkd.y << 16), __uint_as_float(pkd.y & 0xffff0000u)};
            *(LAS f32x4*)(Bf + 4096) = (f32x4){__uint_as_float(pbb.x << 16), __uint_as_float(pbb.x & 0xffff0000u), __uint_as_float(pbb.y << 16), __uint_as_float(pbb.y & 0xffff0000u)};
            *(LAS f32x4*)(Bf + 6144) = (f32x4){__uint_as_float(pkk.x << 16), __uint_as_float(pkk.x & 0xffff0000u), __uint_as_float(pkk.y << 16), __uint_as_float(pkk.y & 0xffff0000u)};
            *(LAS f32x4*)(Bf + 8192) = (f32x4){__uint_as_float(pr.x << 16), __uint_as_float(pr.x & 0xffff0000u), __uint_as_float(pr.y << 16), __uint_as_float(pr.y & 0xffff0000u)};
            *(LAS f32x4*)(Bf + 10240) = (f32x4){__uint_as_float(pv.x << 16), __uint_as_float(pv.x & 0xffff0000u), __uint_as_float(pv.y << 16), __uint_as_float(pv.y & 0xffff0000u)}; };
        float S[8];
#pragma unroll
        for (int q = 0; q < 8; ++q) S[q] = 0.f;
        __syncthreads();
        gload(0); lwrite(0);
        __syncthreads();
        constexpr int NCH = 2304 / SC_TC;
        for (int ch = 0; ch < NCH; ++ch) {
            if (ch + 1 < NCH) gload(ch + 1);
            const LAS float* Bf = L + (ch & 1) * 12288 + j * 8;
#pragma unroll 4
            for (int ls = 0; ls < SC_TC; ++ls) {
                const LAS float* p = Bf + ls * 64;
                const f32x4 w0 = *(const LAS f32x4*)(p), w1 = *(const LAS f32x4*)(p + 4);
                const f32x4 d0 = *(const LAS f32x4*)(p + 2048), d1 = *(const LAS f32x4*)(p + 2052);
                const f32x4 b0 = *(const LAS f32x4*)(p + 4096), b1 = *(const LAS f32x4*)(p + 4100);
                const f32x4 k0 = *(const LAS f32x4*)(p + 6144), k1 = *(const LAS f32x4*)(p + 6148);
                const f32x4 r0 = *(const LAS f32x4*)(p + 8192), r1 = *(const LAS f32x4*)(p + 8196);
                const float vv = L[(ch & 1) * 12288 + 10240 + ls * 64 + rowi];
                float sa = (S[0] * k0.x + S[1] * k0.y) + (S[2] * k0.z + S[3] * k0.w) + (S[4] * k1.x + S[5] * k1.y) + (S[6] * k1.z + S[7] * k1.w);
                sa = -sum8(sa);
                S[0] = S[0] * w0.x + sa * b0.x + vv * d0.x; S[1] = S[1] * w0.y + sa * b0.y + vv * d0.y; S[2] = S[2] * w0.z + sa * b0.z + vv * d0.z; S[3] = S[3] * w0.w + sa * b0.w + vv * d0.w;
                S[4] = S[4] * w1.x + sa * b1.x + vv * d1.x; S[5] = S[5] * w1.y + sa * b1.y + vv * d1.y; S[6] = S[6] * w1.z + sa * b1.z + vv * d1.z; S[7] = S[7] * w1.w + sa * b1.w + vv * d1.w;
                float y = (S[0] * r0.x + S[1] * r0.y) + (S[2] * r0.z + S[3] * r0.w) + (S[4] * r1.x + S[5] * r1.y) + (S[6] * r1.z + S[7] * r1.w);
                y = sum8(y);
                if (j == 0) Y[(size_t)row_of(ch * SC_TC + ls) * ADIM + rowi] = y;
            }
            if (ch + 1 < NCH) lwrite((ch + 1) & 1);
            __syncthreads();
        }
    }
}

__device__ __forceinline__ void a4_mla_naive(const Ctx& C) {
    LAS float* Kt = (LAS float*)C.lds;
    LAS float* Vt = Kt + 32 * 96;
    const bf16_t* Q = WSP(const bf16_t, WS_Q); const bf16_t* KV = WSP(const bf16_t, WS_KV); const bf16_t* KR = WSP(const bf16_t, WS_KR); bf16_t* MIX = WSP(bf16_t, WS_MIX);
    const int tid = C.tid;
    for (int unit = C.bid; unit < 320; unit += C.G) {
        int b, h, qrow, nkeys; bool active = true;
        if (unit < 256) { b = unit >> 5; h = (unit >> 2) & 7; qrow = b * 2048 + (unit & 3) * 512 + tid; nkeys = 2304; }
        else { const int u = unit - 256; b = u >> 3; h = u & 7; qrow = NLAT + b * 256 + (tid & 255); nkeys = 256; active = tid < 256; }
        float q[96], acc[64], m = -1e30f, l = 0.f;
#pragma unroll
        for (int d8 = 0; d8 < 12; ++d8) { float t8[8]; ld8(Q + (size_t)qrow * 768 + h * 96 + d8 * 8, t8);
#pragma unroll
            for (int jj = 0; jj < 8; ++jj) q[d8 * 8 + jj] = t8[jj]; }
#pragma unroll
        for (int d = 0; d < 64; ++d) acc[d] = 0.f;
        for (int kt = 0; kt < nkeys; kt += 32) {
            __syncthreads();
            for (int idx = tid; idx < 32 * 48; idx += 512) { const int key = idx / 48, dp = idx % 48, kj = kt + key; const int krow = kj < 256 ? NLAT + b * 256 + kj : b * 2048 + (kj - 256);
                const unsigned w = dp < 32 ? *(const unsigned*)(KV + (size_t)krow * 1024 + h * 128 + dp * 2) : *(const unsigned*)(KR + (size_t)krow * 32 + (dp - 32) * 2);
                Kt[key * 96 + dp * 2] = __uint_as_float(w << 16); Kt[key * 96 + dp * 2 + 1] = __uint_as_float(w & 0xffff0000u); }
            for (int idx = tid; idx < 32 * 32; idx += 512) { const int key = idx >> 5, dp = idx & 31, kj = kt + key; const int krow = kj < 256 ? NLAT + b * 256 + kj : b * 2048 + (kj - 256);
                const unsigned w = *(const unsigned*)(KV + (size_t)krow * 1024 + h * 128 + 64 + dp * 2);
                Vt[key * 64 + dp * 2] = __uint_as_float(w << 16); Vt[key * 64 + dp * 2 + 1] = __uint_as_float(w & 0xffff0000u); }
            __syncthreads();
            for (int key = 0; key < 32; ++key) {
                float s = 0.f;
#pragma unroll
                for (int d4 = 0; d4 < 24; ++d4) { const f32x4 kv = *(const LAS f32x4*)(Kt + key * 96 + d4 * 4); s += q[d4 * 4] * kv.x + q[d4 * 4 + 1] * kv.y + q[d4 * 4 + 2] * kv.z + q[d4 * 4 + 3] * kv.w; }
                const float mn = fmaxf(m, s), corr = __expf(m - mn), p = __expf(s - mn); m = mn; l = l * corr + p;
#pragma unroll
                for (int d4 = 0; d4 < 16; ++d4) { const f32x4 vv = *(const LAS f32x4*)(Vt + key * 64 + d4 * 4);
                    acc[d4 * 4] = acc[d4 * 4] * corr + p * vv.x; acc[d4 * 4 + 1] = acc[d4 * 4 + 1] * corr + p * vv.y; acc[d4 * 4 + 2] = acc[d4 * 4 + 2] * corr + p * vv.z; acc[d4 * 4 + 3] = acc[d4 * 4 + 3] * corr + p * vv.w; }
            }
        }
        if (active) { const float il = 1.f / l;
#pragma unroll
            for (int d8 = 0; d8 < 8; ++d8) { float o[8];
#pragma unroll
                for (int jj = 0; jj < 8; ++jj) o[jj] = acc[d8 * 8 + jj] * il;
                st8(MIX + (size_t)qrow * DM + 512 + h * 64 + d8 * 8, o); } }
    }
    __syncthreads();
}

__device__ __forceinline__ void a5_output(const Ctx& C, int i) {
    const int lane = C.lane, c0 = lane * 8;
    const float* rk = C.A.in[19] + i * ADIM + c0; const float* lnw = C.A.in[20] + i * ADIM + c0; const float* lnb = C.A.in[21] + i * ADIM + c0;
    for (int row = C.gw; row < NT; row += C.ngw) {
        const float* yf = WSP(const float, WS_Y) + (size_t)row * ADIM + c0; const float* yb = yf + (size_t)NT * ADIM;
        float y[8]; { const f32x4 a0 = *(const f32x4*)yf, a1 = *(const f32x4*)(yf + 4), b0 = *(const f32x4*)yb, b1 = *(const f32x4*)(yb + 4);
            y[0] = a0.x + b0.x; y[1] = a0.y + b0.y; y[2] = a0.z + b0.z; y[3] = a0.w + b0.w; y[4] = a1.x + b1.x; y[5] = a1.y + b1.y; y[6] = a1.z + b1.z; y[7] = a1.w + b1.w; }
        float s = 0.f;
#pragma unroll
        for (int j = 0; j < 8; ++j) s += y[j];
        const float mean = sum8(s) * (1.f / 64.f); float q = 0.f;
#pragma unroll
        for (int j = 0; j < 8; ++j) { const float d = y[j] - mean; q += d * d; }
        const float rstd = rsqrtf(sum8(q) * (1.f / 64.f) + 64e-5f);
        float r[8], v[8], g[8], kd0[8], kd1[8];
        ld8(WSP(const bf16_t, WS_R) + (size_t)row * ADIM + c0, r); ld8(WSP(const bf16_t, WS_V) + (size_t)row * ADIM + c0, v); ld8(WSP(const bf16_t, WS_G) + (size_t)row * ADIM + c0, g);
        ld8(WSP(const bf16_t, WS_KD) + (size_t)row * ADIM + c0, kd0); ld8(WSP(const bf16_t, WS_KD) + ((size_t)NT + row) * ADIM + c0, kd1);
        float bs = 0.f;
#pragma unroll
        for (int j = 0; j < 8; ++j) bs += r[j] * (kd0[j] + kd1[j]) * rk[j];
        bs = sum8(bs);
        float o[8];
#pragma unroll
        for (int j = 0; j < 8; ++j) o[j] = ((y[j] - mean) * rstd * lnw[j] + lnb[j] + bs * v[j]) * g[j];
        st8(WSP(bf16_t, WS_MIX) + (size_t)row * DM + c0, o);
    }
}

__device__ __forceinline__ void b2_na_naive(const Ctx& C, int i, bool need_ctx) {
    const bf16_t* QKV = WSP(const bf16_t, WS_Z); bf16_t* MIX = WSP(bf16_t, WS_MIX);
    const float* rpb = C.A.in[27] + (size_t)i * 16 * 15 * 31;
    const int nq = need_ctx ? NT : NLAT;
    const int nblk = nq / 512;
    for (int unit = C.bid; unit < nblk * 16; unit += C.G) {
        const int h = unit & 15, qrow = (unit >> 4) * 512 + C.tid;
        float q[64], acc[64], m = -1e30f, l = 0.f;
#pragma unroll
        for (int d8 = 0; d8 < 8; ++d8) { float t8[8]; ld8(QKV + (size_t)qrow * 3072 + h * 64 + d8 * 8, t8);
#pragma unroll
            for (int jj = 0; jj < 8; ++jj) q[d8 * 8 + jj] = t8[jj]; }
#pragma unroll
        for (int d = 0; d < 64; ++d) acc[d] = 0.f;
        const bool isctx = qrow >= NLAT; const int b = isctx ? (qrow - NLAT) >> 8 : qrow >> 11;
        int qr = 0, qc = 0, rs = 0, cs = 0, nwin = 0;
        if (!isctx) { const int t = qrow & 2047; qr = t >> 6; qc = t & 63; rs = min(max(qr - 4, 0), 24); cs = min(max(qc - 8, 0), 48); nwin = 128; }
        const int nk = nwin + 256;
        for (int kj = 0; kj < nk; ++kj) {
            int krow; float bias = 0.f;
            if (kj < nwin) { const int kr = rs + (kj >> 4), kc = cs + (kj & 15); krow = b * 2048 + kr * 64 + kc; bias = rpb[(h * 15 + (kr - qr + 7)) * 31 + (kc - qc + 15)]; }
            else krow = NLAT + b * 256 + (kj - nwin);
            const bf16_t* kp = QKV + (size_t)krow * 3072 + 1024 + h * 64; const bf16_t* vp = kp + 1024;
            float s = 0.f;
#pragma unroll
            for (int d8 = 0; d8 < 8; ++d8) { float t8[8]; ld8(kp + d8 * 8, t8);
#pragma unroll
                for (int jj = 0; jj < 8; ++jj) s += q[d8 * 8 + jj] * t8[jj]; }
            s += bias;
            const float mn = fmaxf(m, s), corr = __expf(m - mn), p = __expf(s - mn); m = mn; l = l * corr + p;
#pragma unroll
            for (int d8 = 0; d8 < 8; ++d8) { float t8[8]; ld8(vp + d8 * 8, t8);
#pragma unroll
                for (int jj = 0; jj < 8; ++jj) acc[d8 * 8 + jj] = acc[d8 * 8 + jj] * corr + p * t8[jj]; }
        }
        const float il = 1.f / l;
#pragma unroll
        for (int d8 = 0; d8 < 8; ++d8) { float o[8];
#pragma unroll
            for (int jj = 0; jj < 8; ++jj) o[jj] = acc[d8 * 8 + jj] * il;
            st8(MIX + (size_t)qrow * DM + h * 64 + d8 * 8, o); }
    }
}

__device__ __forceinline__ void c2_router(const Ctx& C, int layer, int nrows) {
    const float* rw = C.A.in[29] + (size_t)layer * DM * NEXP; const int lane = C.lane;
    for (int row = C.gw; row < nrows; row += C.ngw) {
        f32x4 v[4], h[4]; row_load(WSP(const float, WS_X) + (size_t)row * DM, lane, v);
        const int mg = mod_group(row); const float rstd = row_rstd(v);
        row_modulate(v, rstd, C.A.in[7] + layer * DM, modp(C, layer, mg, 3), modp(C, layer, mg, 4), lane, h);
        row_store_bf16(WSP(bf16_t, WS_H) + (size_t)row * DM, lane, h);
        float lg[16];
#pragma unroll
        for (int e = 0; e < 16; ++e) lg[e] = 0.f;
#pragma unroll
        for (int j = 0; j < 4; ++j)
#pragma unroll
            for (int q = 0; q < 4; ++q) { const float hv = h[j][q]; const float* wr_ = rw + (size_t)((lane + 64 * j) * 4 + q) * NEXP;
#pragma unroll
                for (int e4 = 0; e4 < 4; ++e4) { const f32x4 w = *(const f32x4*)(wr_ + e4 * 4); lg[e4 * 4] += hv * w.x; lg[e4 * 4 + 1] += hv * w.y; lg[e4 * 4 + 2] += hv * w.z; lg[e4 * 4 + 3] += hv * w.w; } }
#pragma unroll
        for (int e = 0; e < 16; ++e) lg[e] = wave_sum(lg[e]);
        float mx = lg[0];
#pragma unroll
        for (int e = 1; e < 16; ++e) mx = fmaxf(mx, lg[e]);
        float den = 0.f;
#pragma unroll
        for (int e = 0; e < 16; ++e) { lg[e] = __expf(lg[e] - mx); den += lg[e]; }
        const float inv = 1.f / den;
        if (lane < 16) { float a = 0.f;
#pragma unroll
            for (int e = 0; e < 16; ++e) a = (lane == e) ? lg[e] * inv : a;
            float* AFF = WSP(float, WS_AFF);
            if (row < NLAT) AFF[((size_t)(row >> 11) * 16 + lane) * 2048 + (row & 2047)] = a;
            else { const int r2 = row - NLAT; AFF[(size_t)NB * 16 * 2048 + ((size_t)(r2 >> 8) * 16 + lane) * 256 + (r2 & 255)] = a; } }
    }
}

__device__ __forceinline__ void c3_topk(const Ctx& C, bool need_ctx) {
    LAS float* vals = (LAS float*)C.lds;
    LAS int* list = (LAS int*)(C.lds + 8192);
    LAS int* cnt = (LAS int*)(C.lds + 8192 + 4096);
    const int nunits = 512 + (need_ctx ? 128 : 0), tid = C.tid;
    for (int unit = C.bid; unit < nunits; unit += C.G) {
        int b, e, part, n, cap; bool lat = unit < 512;
        if (lat) { b = unit >> 6; e = (unit >> 2) & 15; part = unit & 3; n = 2048; cap = 256; } else { const int u = unit - 512; b = u >> 4; e = u & 15; part = 0; n = 256; cap = 32; }
        const float* src = lat ? WSP(const float, WS_AFF) + ((size_t)b * 16 + e) * 2048 : WSP(const float, WS_AFF) + (size_t)NB * 16 * 2048 + ((size_t)b * 16 + e) * 256;
        __syncthreads();
        for (int idx = tid; idx < n; idx += 512) vals[idx] = src[idx];
        if (tid == 0) cnt[0] = 0;
        __syncthreads();
        const int iel = part * 512 + tid; const bool act = iel < n;
        const float a = vals[act ? iel : 0]; int rank = 0;
        for (int j4 = 0; j4 < n; j4 += 4) { const f32x4 o = *(const LAS f32x4*)(vals + j4);
            rank += (o.x > a || (o.x == a && j4 < iel)) ? 1 : 0; rank += (o.y > a || (o.y == a && j4 + 1 < iel)) ? 1 : 0;
            rank += (o.z > a || (o.z == a && j4 + 2 < iel)) ? 1 : 0; rank += (o.w > a || (o.w == a && j4 + 3 < iel)) ? 1 : 0; }
        if (act) { const int trow = lat ? b * 2048 + iel : NLAT + b * 256 + iel; int grow = -1;
            if (rank < cap) { grow = e * ROWS_E + (lat ? b * 256 + rank : 2048 + b * 32 + rank);
                WSP(int, WS_IDX)[grow] = trow; WSP(float, WS_GATE)[grow] = a;
                const int slot = atomicAdd((int*)cnt, 1); list[slot * 2] = trow; list[slot * 2 + 1] = grow; }
            WSP(int, WS_SEL)[(size_t)trow * 16 + e] = grow; }
        __syncthreads();
        const int nsel = cnt[0];
        for (int s = C.wave; s < nsel; s += 8) { const int trow = list[s * 2], grow = list[s * 2 + 1];
            const u32x4* sp = (const u32x4*)(WSP(const bf16_t, WS_H) + (size_t)trow * DM); u32x4* dp = (u32x4*)(WSP(bf16_t, WS_XIN) + (size_t)grow * DM);
            dp[C.lane] = sp[C.lane]; dp[C.lane + 64] = sp[C.lane + 64]; }
    }
    __syncthreads();
}

__device__ __forceinline__ void c6_combine(const Ctx& C, int layer, int nrows) {
    const int lane = C.lane;
    for (int row = C.gw; row < nrows; row += C.ngw) {
        f32x4 v[4], a[4]; row_load(WSP(const float, WS_X) + (size_t)row * DM, lane, v);
#pragma unroll
        for (int j = 0; j < 4; ++j) a[j] = (f32x4){0.f, 0.f, 0.f, 0.f};
        const int* sel = WSP(const int, WS_SEL) + (size_t)row * 16;
        for (int e = 0; e < 16; ++e) { const int g = __builtin_amdgcn_readfirstlane(sel[e]);
            if (g >= 0) { const bf16_t* y = WSP(const bf16_t, WS_YB) + (size_t)g * DM;
#pragma unroll
                for (int j = 0; j < 4; ++j) { const u32x2 w = *(const u32x2*)(y + (lane + 64 * j) * 4);
                    a[j] += (f32x4){__uint_as_float(w.x << 16), __uint_as_float(w.x & 0xffff0000u), __uint_as_float(w.y << 16), __uint_as_float(w.y & 0xffff0000u)}; } } }
        const int mg = mod_group(row); const float* g2 = modp(C, layer, mg, 5);
#pragma unroll
        for (int j = 0; j < 4; ++j) v[j] += *(const f32x4*)(g2 + (lane + 64 * j) * 4) * a[j];
        const float rstd = row_rstd(v);
        if (layer < 3) { row_store(WSP(float, WS_X) + (size_t)row * DM, lane, v);
            f32x4 h[4]; row_modulate(v, rstd, C.A.in[6] + (layer + 1) * DM, modp(C, layer + 1, mg, 0), modp(C, layer + 1, mg, 1), lane, h);
            row_store_bf16(WSP(bf16_t, WS_H) + (size_t)row * DM, lane, h);
        } else {
#pragma unroll
            for (int j = 0; j < 4; ++j) { const int c = (lane + 64 * j) * 4; *(f32x4*)(C.out + (size_t)row * DM + c) = v[j] * rstd * *(const f32x4*)(C.A.in[8] + c); }
        }
    }
}

constexpr int N_PHASE_IDS = 2 + 12 * 4;
__host__ __device__ inline bool phase_exists(int p) { if (p < 2) return true; const int l = (p - 2) / 12, k = (p - 2) % 12; if (k == 11) return false; if (l & 1) return !(k >= 2 && k <= 4); return true; }

__global__ void __launch_bounds__(512, 2) fwd(Args args) {
    extern __shared__ __attribute__((aligned(16))) unsigned char lds_raw[];
    const int tid_ = threadIdx.x, wave_ = __builtin_amdgcn_readfirstlane(tid_ >> 6);
    const Ctx C0{args, args.out, args.ws, (LAS unsigned char*)lds_raw, tid_, tid_ & 63, wave_, (int)gridDim.x, (int)blockIdx.x, (int)blockIdx.x * 8 + wave_, (int)gridDim.x * 8};
    volatile LAS unsigned* MISC = (volatile LAS unsigned*)(C0.lds + LDSCTL_OFF);
    if (C0.tid < 128) MISC[C0.tid] = 0u;
    __syncthreads();
    const int lo = args.ph_lo, hi = args.ph_hi;
    XcdBarrier bar; bar.bar = (unsigned*)(C0.ws + WS_CTL) + CW_BAR; bar.x = 0; bar.st = nullptr;
    if (hi - lo > 1) bar = xcd_barrier_post((unsigned*)(C0.ws + WS_CTL) + CW_BAR, MISC + 8);
#define RUN(p) (lo <= (p) && (p) < hi)
#define SEAM(p) do { if (hi > (p) + 1) xcd_barrier(bar); } while (0)
    LAS unsigned char* ring = C0.lds;

    if (RUN(0)) { const Ctx C = relaunder(C0); if (PON(0)) { p0_convert(C); p0_mod(C); } SEAM(0); }
    if (RUN(1)) { const Ctx C = relaunder(C0); if (PON(1)) p1_init(C); SEAM(1); }

    for (int layer = 0; layer < 4; ++layer) {
        const int base = 2 + 12 * layer, i = layer >> 1;
        const bool need_ctx = layer < 3;
        if (!(layer & 1)) {
            if (RUN(base + 0)) { const Ctx C = relaunder(C0);
                pg8::Gemm g{WSP(const bf16_t, WS_H), WSP(const bf16_t, WS_WIN) + (size_t)i * ZP * 1024, 1024, 1024, 1024}; pg8::StaticOrder S; S.init(NT, ZP, C.G, C.bid);
                pg8::Epi<FStoreBf16, false> E{{WSP(bf16_t, WS_Z), ZP, 1.f, 0}};
                if (PON(2)) pg8::gemm_phase(ring, g, S, E); SEAM(base + 0); }
            if (RUN(base + 1)) { const Ctx C = relaunder(C0); if (PON(3)) a2_prepare(C, i); SEAM(base + 1); }
            if (RUN(base + 2)) { const Ctx C = relaunder(C0);
                { pg8::Gemm g{WSP(const bf16_t, WS_LIN), WSP(const bf16_t, WS_WLORA) + (size_t)i * 2560 * 384, 384, 384, 384}; pg8::StaticOrder S; S.init(NT, 2560, C.G, C.bid);
                  pg8::Epi<FLora, false> E{{C.A.in[12] + i * 1024, C.A.in[14] + i * 1024, C.A.in[18] + i * 512, WSP(const bf16_t, WS_KS), WSP(const bf16_t, WS_KK), WSP(float, WS_DEC), WSP(bf16_t, WS_KD), WSP(bf16_t, WS_BB), WSP(bf16_t, WS_G)}};
                  if (PON(4)) pg8::gemm_phase(ring, g, S, E); }
                { pg8::Gemm g{WSP(const bf16_t, WS_QN), WSP(const bf16_t, WS_WQUP) + (size_t)i * 768 * 384, 384, 384, 384}; pg8::StaticOrder S; S.init(NT, 768, C.G, C.bid);
                  pg8::Epi<FQup, false> E{{WSP(bf16_t, WS_Q), WSP(const float, WS_ROPE), 0.10206207261596577f}};
                  if (PON(16)) pg8::gemm_phase(ring, g, S, E); }
                { pg8::Gemm g{WSP(const bf16_t, WS_KVN), WSP(const bf16_t, WS_WKVUP) + (size_t)i * 1024 * 256, 256, 256, 256}; pg8::StaticOrder S; S.init(NT, 1024, C.G, C.bid);
                  pg8::Epi<FStoreBf16, false> E{{WSP(bf16_t, WS_KV), 1024, 1.f, 0}};
                  if (PON(17)) pg8::gemm_phase(ring, g, S, E); }
                SEAM(base + 2); }
            if (RUN(base + 3)) { const Ctx C = relaunder(C0); if (PON(5)) a4_scan(C); if (PON(6)) a4_mla_naive(C); SEAM(base + 3); }
            if (RUN(base + 4)) { const Ctx C = relaunder(C0); if (PON(7)) a5_output(C, i); SEAM(base + 4); }
        } else {
            if (RUN(base + 0)) { const Ctx C = relaunder(C0);
                pg8::Gemm g{WSP(const bf16_t, WS_H), WSP(const bf16_t, WS_WQKV) + (size_t)i * 3072 * 1024, 1024, 1024, 1024}; pg8::StaticOrder S; S.init(NT, 3072, C.G, C.bid);
                pg8::Epi<FStoreBf16, false> E{{WSP(bf16_t, WS_Z), 3072, 0.125f, 1024}};
                if (PON(8)) pg8::gemm_phase(ring, g, S, E); SEAM(base + 0); }
            if (RUN(base + 1)) { const Ctx C = relaunder(C0); if (PON(9)) b2_na_naive(C, i, need_ctx); SEAM(base + 1); }
        }
        if (RUN(base + 5)) { const Ctx C = relaunder(C0);
            const bf16_t* W = (layer & 1) ? WSP(const bf16_t, WS_WOUTC) + (size_t)i * 1024 * 1024 : WSP(const bf16_t, WS_WOUTA) + (size_t)i * 1024 * 1024;
            pg8::Gemm g{WSP(const bf16_t, WS_MIX), W, 1024, 1024, 1024}; pg8::StaticOrder S; S.init(need_ctx ? NT : NLAT, 1024, C.G, C.bid);
            pg8::Epi<FResid, false> E{{WSP(float, WS_X), WSP(const float, WS_MOD), layer}};
            if (PON(10)) pg8::gemm_phase(ring, g, S, E); SEAM(base + 5); }
        if (RUN(base + 6)) { const Ctx C = relaunder(C0); if (PON(11)) c2_router(C, layer, need_ctx ? NT : NLAT); SEAM(base + 6); }
        if (RUN(base + 7)) { const Ctx C = relaunder(C0); if (PON(12)) c3_topk(C, need_ctx); SEAM(base + 7); }
        if (RUN(base + 8)) { const Ctx C = relaunder(C0);
            pg8::Gemm g{WSP(const bf16_t, WS_XIN), WSP(const bf16_t, WS_W13) + (size_t)layer * 16 * 4096 * 1024, 1024, 1024, 1024}; pg8::MoeOrder S; S.init(need_ctx ? 9 : 8, 16, C.G, C.bid);
            pg8::Epi<FSwiglu, true> E{{WSP(bf16_t, WS_HID)}};
            if (PON(13)) pg8::gemm_phase(ring, g, S, E); SEAM(base + 8); }
        if (RUN(base + 9)) { const Ctx C = relaunder(C0);
            pg8::Gemm g{WSP(const bf16_t, WS_HID), WSP(const bf16_t, WS_W2) + (size_t)layer * 16 * 1024 * 2048, 2048, 2048, 2048}; pg8::MoeOrder S; S.init(need_ctx ? 9 : 8, 4, C.G, C.bid);
            pg8::Epi<FGate, false> E{{WSP(bf16_t, WS_YB), WSP(const float, WS_GATE)}};
            if (PON(14)) pg8::gemm_phase(ring, g, S, E); SEAM(base + 9); }
        if (RUN(base + 10)) { const Ctx C = relaunder(C0); if (PON(15)) c6_combine(C, layer, need_ctx ? NT : NLAT); if (layer < 3) SEAM(base + 10); }
    }
#undef RUN
#undef SEAM
}

extern "C" void kernel_launch(void* const* d_in, const int* in_sizes, int n_in, void* d_out, int out_size, void* d_ws, size_t ws_size, hipStream_t stream) {
    static int grid = 0;
    if (grid == 0) {
        if (n_in != 33 || out_size != NLAT * DM || ws_size < WS_END) { fprintf(stderr, "kernel_launch: unexpected shapes (n_in %d out %d ws %zu need %zu)\n", n_in, out_size, ws_size, (size_t)WS_END); grid = -1; return; }
        int dev = 0, cus = 0, per_cu = 0;
        if (hipGetDevice(&dev) != hipSuccess || hipDeviceGetAttribute(&cus, hipDeviceAttributeMultiprocessorCount, dev) != hipSuccess) { grid = -1; return; }
        if (hipFuncSetAttribute((const void*)fwd, hipFuncAttributeMaxDynamicSharedMemorySize, LDS_BYTES) != hipSuccess) { fprintf(stderr, "kernel_launch: hipFuncSetAttribute failed\n"); grid = -1; return; }
        if (hipOccupancyMaxActiveBlocksPerMultiprocessor(&per_cu, (const void*)fwd, 512, LDS_BYTES) != hipSuccess || per_cu < 1) fprintf(stderr, "kernel_launch: occupancy query says %d\n", per_cu);
        (void)hipGetLastError();
        grid = cus;
    }
    if (grid < 0) return;
    (void)hipMemsetAsync((char*)d_ws + WS_CTL, 0, CTL_BYTES, stream);
    Args a{};
    for (int i = 0; i < 33; ++i) a.in[i] = (const float*)d_in[i];
    a.out = (float*)d_out; a.ws = (unsigned char*)d_ws;
#if SINGLE_LAUNCH
    a.ph_lo = 0; a.ph_hi = N_PHASE_IDS;
    hipLaunchKernelGGL(fwd, dim3(grid), dim3(512), LDS_BYTES, stream, a);
#else
    for (int p = 0; p < N_PHASE_IDS; ++p) { if (!phase_exists(p)) continue; a.ph_lo = p; a.ph_hi = p + 1; hipLaunchKernelGGL(fwd, dim3(grid), dim3(512), LDS_BYTES, stream, a); }
#endif
}
```

```cpp
#include <hip/hip_runtime.h>
#include <cstdio>
#include <cstdint>

#ifndef PHMASK
#define PHMASK 0xFFFFFFFFu
#endif
#define PON(n) (((PHMASK) >> (n)) & 1u)
#ifndef ATTN_NAIVE
#define ATTN_NAIVE 0
#endif
#ifndef SINGLE_LAUNCH
#define SINGLE_LAUNCH 1
#endif

#define LAS __attribute__((address_space(3)))
#define GAS __attribute__((address_space(1)))
typedef unsigned short bf16_t;
typedef short bf16x8 __attribute__((ext_vector_type(8)));
typedef float f32x4 __attribute__((ext_vector_type(4)));
typedef float f32x2 __attribute__((ext_vector_type(2)));
typedef unsigned u32x4 __attribute__((ext_vector_type(4)));
typedef unsigned u32x2 __attribute__((ext_vector_type(2)));

constexpr int NB = 8, SEQ = 2048, CTXL = 256, DM = 1024;
constexpr int NLAT = NB * SEQ, NCTX = NB * CTXL, NT = NLAT + NCTX;
constexpr int ADIM = 512, ZP = 2816;
constexpr int NEXP = 16, FF = 2048, ROWS_E = 2304;
constexpr float NORM_EPS = 1e-6f;

constexpr size_t MiB = 1u << 20;
constexpr size_t WS_CTL = 0, CTL_BYTES = 1 * MiB;
constexpr size_t WS_MOD = 1 * MiB;
constexpr size_t WS_ROPE = 2 * MiB;
constexpr size_t WS_WIN = 4 * MiB;
constexpr size_t WS_WLORA = 16 * MiB;
constexpr size_t WS_WQUP = 20 * MiB;
constexpr size_t WS_WKVUP = 22 * MiB;
constexpr size_t WS_WOUTA = 24 * MiB;
constexpr size_t WS_WQKV = 28 * MiB;
constexpr size_t WS_WOUTC = 40 * MiB;
constexpr size_t WS_W13 = 48 * MiB;
constexpr size_t WS_W2 = 560 * MiB;
constexpr size_t WS_X = 816 * MiB;
constexpr size_t WS_H = 888 * MiB;
constexpr size_t WS_MIX = 924 * MiB;
constexpr size_t WS_Z = 960 * MiB;
constexpr size_t WS_R = 1068 * MiB;
constexpr size_t WS_V = 1086 * MiB;
constexpr size_t WS_KS = 1104 * MiB;
constexpr size_t WS_KK = 1122 * MiB;
constexpr size_t WS_LIN = 1140 * MiB;
constexpr size_t WS_QN = 1154 * MiB;
constexpr size_t WS_KVN = 1168 * MiB;
constexpr size_t WS_KR = 1177 * MiB;
constexpr size_t WS_DEC = 1179 * MiB;
constexpr size_t WS_KD = 1251 * MiB;
constexpr size_t WS_BB = 1287 * MiB;
constexpr size_t WS_G = 1323 * MiB;
constexpr size_t WS_Y = 1341 * MiB;
constexpr size_t WS_Q = 1413 * MiB;
constexpr size_t WS_KV = 1440 * MiB;
constexpr size_t WS_AFF = 1476 * MiB;
constexpr size_t WS_SEL = 1478 * MiB;
constexpr size_t WS_IDX = 1480 * MiB;
constexpr size_t WS_GATE = 1481 * MiB;
constexpr size_t WS_XIN = 1482 * MiB;
constexpr size_t WS_HID = 1554 * MiB;
constexpr size_t WS_YB = 1698 * MiB;
constexpr size_t WS_END = 1770 * MiB;

constexpr int CW_TMO = 0, CW_BAR = 4096;

constexpr int RING_BYTES = 133120;
constexpr int LDSCTL_OFF = RING_BYTES;
constexpr int LDS_BYTES = 147456;

__device__ __forceinline__ float bf2f(unsigned short b) { return __uint_as_float(((unsigned)b) << 16); }
__device__ __forceinline__ unsigned f2bf(float f) { unsigned u = __float_as_uint(f); return (u + 0x7fffu + ((u >> 16) & 1u)) >> 16; }
__device__ __forceinline__ unsigned pk2(float lo, float hi) { return f2bf(lo) | (f2bf(hi) << 16); }
__device__ __forceinline__ void unpk8(const u32x4 w, float (&f)[8]) {
    f[0] = __uint_as_float(w.x << 16); f[1] = __uint_as_float(w.x & 0xffff0000u); f[2] = __uint_as_float(w.y << 16); f[3] = __uint_as_float(w.y & 0xffff0000u);
    f[4] = __uint_as_float(w.z << 16); f[5] = __uint_as_float(w.z & 0xffff0000u); f[6] = __uint_as_float(w.w << 16); f[7] = __uint_as_float(w.w & 0xffff0000u); }
__device__ __forceinline__ void ld8(const bf16_t* p, float (&f)[8]) { unpk8(*(const u32x4*)p, f); }
__device__ __forceinline__ u32x4 pack8(const float (&f)[8]) { u32x4 w; w.x = pk2(f[0], f[1]); w.y = pk2(f[2], f[3]); w.z = pk2(f[4], f[5]); w.w = pk2(f[6], f[7]); return w; }
__device__ __forceinline__ void st8(bf16_t* p, const float (&f)[8]) { *(u32x4*)p = pack8(f); }
__device__ __forceinline__ float wave_sum(float v) {
#pragma unroll
    for (int o = 1; o < 64; o <<= 1) v += __shfl_xor(v, o);
    return v; }
__device__ __forceinline__ float sum8(float v) { v += __shfl_xor(v, 1); v += __shfl_xor(v, 2); v += __shfl_xor(v, 4); return v; }
__device__ __forceinline__ float sigmoidf_(float x) { return 1.f / (1.f + __expf(-x)); }
__device__ __forceinline__ int mod_group(int row) { return row < NLAT ? (row >> 11) : NB; }

namespace pg8 {
constexpr int BM = 256, BK = 64, HALF = 128, HTB = HALF * BK * 2, STAGE_BYTES = 8 * HTB, NXCD = 8, WGM = 8;
__host__ __device__ __forceinline__ int lds_byte(int r, int c) { const int st = (r >> 4) * 2 + (c >> 5), rr = r & 15, cc = c & 31, ob = rr * 64 + cc * 2; return st * 1024 + (ob ^ (((ob >> 9) & 1) << 5)); }
__host__ __device__ __forceinline__ void stage_rc(int b, int& R, int& C) { const int st = b / 1024, sb = b % 1024, swz = sb ^ (((sb >> 9) & 1) << 5); R = (st >> 1) * 16 + swz / 64; C = (st & 1) * 32 + (swz % 64) / 2; }
__host__ __device__ __forceinline__ int perm32(int rho) { const int n = rho >> 4, i = rho & 15; return 8 * (i >> 2) + 4 * n + (i & 3); }
struct Unit { int pm, pn; };
struct Gemm { const bf16_t* A; const bf16_t* Bt; int lda, ldb, K; };

struct StaticOrder {
    int nM, nN, nwg, G, c;
    __device__ void init(int M, int N, int G_, int c_) { nM = M / BM; nN = N / BM; nwg = nM * nN; G = G_; c = c_; }
    __device__ bool next(int i, Unit& u) const {
        const long L = (long)i * G + c; if (L >= nwg) return false;
        int wgid = (int)L; { const int q = nwg / NXCD, r = nwg % NXCD, xcd = wgid % NXCD, off = wgid / NXCD; wgid = (xcd < r ? xcd * (q + 1) : r * (q + 1) + (xcd - r) * q) + off; }
        const int nig = WGM * nN, gid = wgid / nig, fm = gid * WGM, gsz = (nM - fm) < WGM ? (nM - fm) : WGM;
        u.pm = fm + ((wgid % nig) % gsz); u.pn = (wgid % nig) / gsz; return true;
    }
};
struct MoeOrder {
    int nrt, nct, nwg, G, c;
    __device__ void init(int nrt_, int nct_, int G_, int c_) { nrt = nrt_; nct = nct_; nwg = NEXP * nrt * nct; G = G_; c = c_; }
    __device__ bool next(int i, Unit& u) const {
        const long L = (long)i * G + c; if (L >= nwg) return false;
        const int wgid = (int)(L % NXCD) * (nwg / NXCD) + (int)(L / NXCD);
        const int per = nrt * nct, e = wgid / per, rem = wgid % per, ct = rem / nrt, rt = rem % nrt;
        u.pm = e * 9 + rt; u.pn = e * nct + ct; return true;
    }
};

template <class F, bool PAIR> struct Epi {
    F f;
    __device__ __forceinline__ void operator()(const f32x4 (&acc)[2][2][4][2], const Unit& u, int wr, int wc, int fr, int fq) const {
#pragma unroll
        for (int ai = 0; ai < 2; ++ai)
#pragma unroll
            for (int m = 0; m < 4; ++m) {
                const int row = u.pm * BM + ai * HALF + wr * 64 + m * 16 + fr;
                if constexpr (PAIR) {
                    float a[8], b[8];
#pragma unroll
                    for (int j = 0; j < 4; ++j) { a[j] = acc[ai][0][m][0][j]; a[4 + j] = acc[ai][0][m][1][j]; b[j] = acc[ai][1][m][0][j]; b[4 + j] = acc[ai][1][m][1][j]; }
                    f(row, u.pn * HALF + wc * 32 + 8 * fq, a, b);
                } else {
#pragma unroll
                    for (int bj = 0; bj < 2; ++bj) { float a[8];
#pragma unroll
                        for (int j = 0; j < 4; ++j) { a[j] = acc[ai][bj][m][0][j]; a[4 + j] = acc[ai][bj][m][1][j]; }
                        f(row, u.pn * BM + bj * HALF + wc * 32 + 8 * fq, a); }
                }
            }
    }
};

template <class EpiT, class Sched>
__device__ __forceinline__ void gemm_phase(LAS unsigned char* lds, const Gemm g, const Sched& S, const EpiT& E) {
    int tid = threadIdx.x; asm volatile("" : "+v"(tid));
    const int wid = __builtin_amdgcn_readfirstlane(tid >> 6), lane = tid & 63, wr = wid >> 2, wc = wid & 3, fr = lane & 15, fq = lane >> 4;
    const int K = g.K, nt = K / BK;
    unsigned voffA[2], voffB[2];
#pragma unroll
    for (int i = 0; i < 2; ++i) { int R, C; stage_rc(tid * 16 + i * 8192, R, C); const int Rb = (R & ~31) + perm32(R & 31);
        voffA[i] = (unsigned)(R * g.lda + C) * 2u; voffB[i] = (unsigned)(Rb * g.ldb + C) * 2u; }
    const size_t kstep = (size_t)(BK * 2);
    const size_t hsA = (size_t)HALF * g.lda * 2, hsB = (size_t)HALF * g.ldb * 2, tsA = 2 * hsA, tsB = 2 * hsB;
    const unsigned ldsw = (unsigned)wid * 1024u;
    const int aoff = lds_byte(wr * 64 + fr, fq * 8), boff = lds_byte(wc * 32 + fr, fq * 8);
#define PG8_SA(b, h) (((b) * 2 + (h)) * HTB)
#define PG8_SB(b, h) ((4 + (b) * 2 + (h)) * HTB)
#define PG8_STAGE(bufoff, gbase, voff) do { _Pragma("unroll") for (int _i = 0; _i < 2; ++_i) \
        __builtin_amdgcn_global_load_lds((const unsigned*)((const char*)(gbase) + (voff)[_i]), (LAS unsigned*)(lds + (bufoff) + ldsw + _i * 8192), 16, 0, 0); } while (0)
#define PG8_LDA(dst, b, h) do { _Pragma("unroll") for (int m = 0; m < 4; ++m) _Pragma("unroll") for (int k = 0; k < 2; ++k) dst[m][k] = *(const LAS bf16x8*)(lds + PG8_SA(b, h) + aoff + m * 2048 + k * 1024); } while (0)
#define PG8_LDB(dst, b, h) do { _Pragma("unroll") for (int n = 0; n < 2; ++n) _Pragma("unroll") for (int k = 0; k < 2; ++k) dst[n][k] = *(const LAS bf16x8*)(lds + PG8_SB(b, h) + boff + n * 2048 + k * 1024); } while (0)
#define PG8_MMA(ai, bj, At, Bt) do { __builtin_amdgcn_s_setprio(1); _Pragma("unroll") for (int m = 0; m < 4; ++m) _Pragma("unroll") for (int n = 0; n < 2; ++n) _Pragma("unroll") for (int k = 0; k < 2; ++k) \
        acc[ai][bj][m][n] = __builtin_amdgcn_mfma_f32_16x16x32_bf16(Bt[n][k], At[m][k], acc[ai][bj][m][n], 0, 0, 0); __builtin_amdgcn_s_setprio(0); } while (0)
#define PG8_WAIT_V(n) asm volatile("s_waitcnt vmcnt(" #n ")" ::: "memory")
#define PG8_WAIT_L(n) asm volatile("s_waitcnt lgkmcnt(" #n ")" ::: "memory")
#define PG8_BAR __builtin_amdgcn_s_barrier()
#define PG8_SCHED __builtin_amdgcn_sched_barrier(0)
    Unit cur, nxt; int ui = 0;
    if (!S.next(0, cur)) return;
    f32x4 acc[2][2][4][2];
#pragma unroll
    for (int a = 0; a < 2; ++a)
#pragma unroll
        for (int b = 0; b < 2; ++b)
#pragma unroll
            for (int m = 0; m < 4; ++m)
#pragma unroll
                for (int n = 0; n < 2; ++n) acc[a][b][m][n] = (f32x4){0.f, 0.f, 0.f, 0.f};
    bf16x8 At[4][2], B0[2][2], B1[2][2];
    const char* cA = (const char*)g.A + (size_t)cur.pm * tsA; const char* cB = (const char*)g.Bt + (size_t)cur.pn * tsB;
    PG8_STAGE(PG8_SB(0, 0), cB, voffB); PG8_STAGE(PG8_SB(0, 1), cB + hsB, voffB); PG8_STAGE(PG8_SA(0, 0), cA, voffA); PG8_STAGE(PG8_SA(0, 1), cA + hsA, voffA);
    if (wr == 1) PG8_BAR;
    PG8_WAIT_V(2); PG8_BAR;
    PG8_STAGE(PG8_SB(1, 0), cB + kstep, voffB); PG8_STAGE(PG8_SA(1, 0), cA + kstep, voffA); PG8_STAGE(PG8_SB(1, 1), cB + hsB + kstep, voffB);
    PG8_WAIT_V(6); PG8_BAR;
    for (;;) {
        const bool has_next = S.next(ui + 1, nxt);
        const char* nA = has_next ? (const char*)g.A + (size_t)nxt.pm * tsA : cA; const char* nB = has_next ? (const char*)g.Bt + (size_t)nxt.pn * tsB : cB;
#pragma unroll 1
        for (int t = 0; t < nt; t += 2) {
            const bool last = (t == nt - 2);
            const char* a1 = cA + (size_t)(t + 1) * kstep;
            const char* a2 = last ? nA : cA + (size_t)(t + 2) * kstep; const char* b2 = last ? nB : cB + (size_t)(t + 2) * kstep;
            const char* a3 = a2 + kstep; const char* b3 = b2 + kstep;
            PG8_LDB(B0, 0, 0); PG8_LDB(B1, 0, 1); PG8_SCHED; PG8_LDA(At, 0, 0); PG8_STAGE(PG8_SA(1, 1), a1 + hsA, voffA);
            PG8_WAIT_V(8); PG8_WAIT_L(0); PG8_BAR; PG8_MMA(0, 0, At, B0); PG8_MMA(0, 1, At, B1); PG8_BAR; PG8_SCHED;
            PG8_LDA(At, 0, 1); PG8_STAGE(PG8_SB(0, 0), b2, voffB); PG8_STAGE(PG8_SB(0, 1), b2 + hsB, voffB); PG8_STAGE(PG8_SA(0, 0), a2, voffA);
            PG8_WAIT_V(8); PG8_WAIT_L(0); PG8_BAR; PG8_MMA(1, 0, At, B0); PG8_MMA(1, 1, At, B1); PG8_BAR; PG8_SCHED;
            PG8_LDB(B0, 1, 0); PG8_LDB(B1, 1, 1); PG8_SCHED; PG8_LDA(At, 1, 0); PG8_STAGE(PG8_SA(0, 1), a2 + hsA, voffA);
            PG8_WAIT_V(8); PG8_WAIT_L(0); PG8_BAR; PG8_MMA(0, 0, At, B0); PG8_MMA(0, 1, At, B1); PG8_BAR; PG8_SCHED;
            PG8_LDA(At, 1, 1); PG8_STAGE(PG8_SB(1, 0), b3, voffB); PG8_STAGE(PG8_SB(1, 1), b3 + hsB, voffB); PG8_STAGE(PG8_SA(1, 0), a3, voffA);
            PG8_WAIT_V(8); PG8_WAIT_L(0); PG8_BAR; PG8_MMA(1, 0, At, B0); PG8_MMA(1, 1, At, B1); PG8_BAR; PG8_SCHED;
        }
        if (wr == 0) PG8_BAR;
        E(acc, cur, wr, wc, fr, fq);
        if (!has_next) break;
#pragma unroll
        for (int a = 0; a < 2; ++a)
#pragma unroll
            for (int b = 0; b < 2; ++b)
#pragma unroll
                for (int m = 0; m < 4; ++m)
#pragma unroll
                    for (int n = 0; n < 2; ++n) acc[a][b][m][n] = (f32x4){0.f, 0.f, 0.f, 0.f};
        cur = nxt; cA = nA; cB = nB; ++ui;
        if (wr == 1) PG8_BAR;
    }
    PG8_WAIT_V(0);
    PG8_BAR;
#undef PG8_SA
#undef PG8_SB
#undef PG8_STAGE
#undef PG8_LDA
#undef PG8_LDB
#undef PG8_MMA
#undef PG8_WAIT_V
#undef PG8_WAIT_L
#undef PG8_BAR
#undef PG8_SCHED
}
}

#define XB_TMO      128
#define XB_XCNT(j)  (256  + 64 * (j))
#define XB_XSUB(j)  (1280 + 64 * (j))
#define XB_XGEN(j)  (2304 + 64 * (j))
#define XB_TOP      3328
#define XB_TOPGEN   3392
#define XCD_BAR_WORDS 3456
#define XB_SPIN_CAP (1u << 22)
__device__ __forceinline__ unsigned xb_ld(unsigned* p)              { return __hip_atomic_load(p, __ATOMIC_RELAXED, __HIP_MEMORY_SCOPE_AGENT); }
__device__ __forceinline__ unsigned xb_add(unsigned* p, unsigned v) { return __hip_atomic_fetch_add(p, v, __ATOMIC_RELAXED, __HIP_MEMORY_SCOPE_AGENT); }
__device__ __forceinline__ unsigned xb_xcc_id() { return (unsigned)__builtin_amdgcn_s_getreg((3 << 11) | 20) & 0xFu; }
#define XB_SPIN(cond, bar) do { unsigned _sp = 0; while (cond) { __builtin_amdgcn_s_sleep(1); \
    if ((++_sp & 255u) == 0u) { if (xb_ld(&(bar)[XB_TMO])) break; if (_sp > XB_SPIN_CAP) { atomicAdd(&(bar)[XB_TMO], 1u); break; } } } } while (0)
struct XcdBarrier { unsigned* bar; unsigned x; volatile LAS unsigned* st; };
__device__ __forceinline__ XcdBarrier xcd_barrier_post(unsigned* bar, volatile LAS unsigned* st) {
    XcdBarrier b; b.bar = bar; b.x = xb_xcc_id(); b.st = st;
    if (threadIdx.x == 0) (void)xb_add(&bar[XB_XCNT(b.x)], 1u);
    return b;
}
__device__ __forceinline__ void xcd_barrier_complete(unsigned* bar, unsigned x, unsigned& nloc, unsigned& nx) {
    const unsigned G = gridDim.x * gridDim.y * gridDim.z;
    unsigned sum, cnt, mine, sp = 0u;
    for (;;) {
        sum = 0u; cnt = 0u; mine = 0u;
#pragma unroll
        for (unsigned j = 0; j < 16; ++j) { const unsigned c = xb_ld(&bar[XB_XCNT(j)]); sum += c; cnt += (c > 0u) ? 1u : 0u; mine = (j == x) ? c : mine; }
        if (sum == G) break;
        __builtin_amdgcn_s_sleep(1);
        if ((++sp & 255u) == 0u) { if (xb_ld(&bar[XB_TMO])) break; if (sp > XB_SPIN_CAP) { atomicAdd(&bar[XB_TMO], 1u); break; } }
    }
    nloc = mine > 0u ? mine : 1u; nx = cnt > 0u ? cnt : 1u;
}
__device__ __forceinline__ void xcd_barrier(const XcdBarrier& b) {
    asm volatile("s_waitcnt vmcnt(0)" ::: "memory");
    __syncthreads();
    if (threadIdx.x == 0) {
        unsigned* bar = b.bar;
        __builtin_amdgcn_s_waitcnt(0);
        unsigned nloc = b.st[0], nx = b.st[1];
        if (nloc == 0u) { xcd_barrier_complete(bar, b.x, nloc, nx); b.st[0] = nloc; b.st[1] = nx; }
        const unsigned old = xb_add(&bar[XB_XSUB(b.x)], 1u);
        const unsigned gen = old / nloc;
        if (old + 1u == (gen + 1u) * nloc) {
            __builtin_amdgcn_fence(__ATOMIC_RELEASE, "agent");
            asm volatile("s_waitcnt vmcnt(0)" ::: "memory");
            const unsigned og = xb_add(&bar[XB_TOP], 1u);
            const unsigned tg = og / nx;
            if (og + 1u == (tg + 1u) * nx) xb_add(&bar[XB_TOPGEN], 1u);
            else XB_SPIN(xb_ld(&bar[XB_TOPGEN]) == tg, bar);
            __builtin_amdgcn_fence(__ATOMIC_ACQUIRE, "agent");
            xb_add(&bar[XB_XGEN(b.x)], 1u);
            asm volatile("s_waitcnt vmcnt(0)" ::: "memory");
        } else {
            XB_SPIN(xb_ld(&bar[XB_XGEN(b.x)]) == gen, bar);
            __builtin_amdgcn_fence(__ATOMIC_ACQUIRE, "agent");
            asm volatile("s_waitcnt vmcnt(0)" ::: "memory");
        }
    }
    __syncthreads();
}

struct Args { const float* in[33]; float* out; unsigned char* ws; int ph_lo, ph_hi; };
struct Ctx {
    const Args& A; float* out; unsigned char* ws;
    LAS unsigned char* lds; int tid, lane, wave, G, bid, gw, ngw;
};
#define WSP(T, off) ((T*)(C.ws + (off)))
__device__ __forceinline__ Ctx relaunder(const Ctx& C0) {
    int tid = C0.tid; unsigned char* ws = C0.ws; LAS unsigned char* lds = C0.lds;
    asm volatile("" : "+v"(tid), "+s"(ws));
    const int wave = __builtin_amdgcn_readfirstlane(tid >> 6);
    return Ctx{C0.A, C0.out, ws, lds, tid, tid & 63, wave, C0.G, C0.bid, C0.bid * 8 + wave, C0.G * 8};
}
__device__ __forceinline__ const float* modp(const Ctx& C, int layer, int mg, int chunk) { return WSP(const float, WS_MOD) + ((size_t)(layer * 9 + mg) * 6 + chunk) * 1024; }

__device__ __forceinline__ void tr_item(const float* src, int ld_src, int nvalid, int k0, int n0, bf16_t* dst, int ld_dst, int drow0, int dk0, LAS float* scr, int lane) {
    {
        const int n = (lane & 15) * 4; const bool ok = (n0 + n) < nvalid;
#pragma unroll 4
        for (int i = 0; i < 16; ++i) { const int k = 4 * i + (lane >> 4);
            f32x4 v = (f32x4){0.f, 0.f, 0.f, 0.f};
            if (ok) v = *(const f32x4*)(src + (size_t)(k0 + k) * ld_src + n0 + n);
            LAS float* s = scr + k * 65 + n; s[0] = v.x; s[1] = v.y; s[2] = v.z; s[3] = v.w; }
    }
    asm volatile("s_waitcnt lgkmcnt(0)" ::: "memory");
    const int c = lane & 7;
#pragma unroll
    for (int jj = 0; jj < 8; ++jj) { const int nl = (lane >> 3) + 8 * jj; const LAS float* s = scr + (8 * c) * 65 + nl;
        u32x4 o; o.x = pk2(s[0 * 65], s[1 * 65]); o.y = pk2(s[2 * 65], s[3 * 65]); o.z = pk2(s[4 * 65], s[5 * 65]); o.w = pk2(s[6 * 65], s[7 * 65]);
        if (n0 + nl < nvalid) *(u32x4*)(dst + (size_t)(drow0 + nl) * ld_dst + dk0 + 8 * c) = o; }
    asm volatile("s_waitcnt lgkmcnt(0)" ::: "memory");
}
constexpr int CV_SMALL = 2120, CV_MOE = 4 * 16 * 3 * 512;
__device__ __forceinline__ void p0_convert(const Ctx& C) {
    LAS float* scr = (LAS float*)(C.lds + C.wave * 16640);
    for (int it = C.gw; it < 2 * CV_SMALL + CV_MOE; it += C.ngw) {
        const float* src; int ld_src, nvalid, k0, n0, ld_dst, drow0, dk0; bf16_t* dst;
        if (it < 2 * CV_SMALL) {
            const int i = it / CV_SMALL; int r = it % CV_SMALL;
            if (r < 656) { src = C.A.in[9] + (size_t)i * 1024 * 2592; ld_src = 2592; nvalid = 2592; k0 = (r / 41) * 64; n0 = (r % 41) * 64; dst = WSP(bf16_t, WS_WIN) + (size_t)i * ZP * 1024; ld_dst = 1024; drow0 = n0; dk0 = k0; }
            else if ((r -= 656) < 16) { const int d = r >> 3; src = C.A.in[13] + (size_t)(i * 2 + d) * 64 * 512; ld_src = 512; nvalid = 512; k0 = 0; n0 = (r & 7) * 64; dst = WSP(bf16_t, WS_WLORA) + (size_t)i * 2560 * 384; ld_dst = 384; drow0 = d * 512 + n0; dk0 = d * 64; }
            else if ((r -= 16) < 16) { const int d = r >> 3; src = C.A.in[15] + (size_t)(i * 2 + d) * 64 * 512; ld_src = 512; nvalid = 512; k0 = 0; n0 = (r & 7) * 64; dst = WSP(bf16_t, WS_WLORA) + (size_t)i * 2560 * 384; ld_dst = 384; drow0 = 1024 + d * 512 + n0; dk0 = 128 + d * 64; }
            else if ((r -= 16) < 16) { src = C.A.in[16] + (size_t)i * 128 * 512; ld_src = 512; nvalid = 512; k0 = (r >> 3) * 64; n0 = (r & 7) * 64; dst = WSP(bf16_t, WS_WLORA) + (size_t)i * 2560 * 384; ld_dst = 384; drow0 = 2048 + n0; dk0 = 256 + k0; }
            else if ((r -= 16) < 72) { src = C.A.in[23] + (size_t)i * 384 * 768; ld_src = 768; nvalid = 768; k0 = (r / 12) * 64; n0 = (r % 12) * 64; dst = WSP(bf16_t, WS_WQUP) + (size_t)i * 768 * 384; ld_dst = 384; drow0 = n0; dk0 = k0; }
            else if ((r -= 72) < 64) { src = C.A.in[25] + (size_t)i * 256 * 1024; ld_src = 1024; nvalid = 1024; k0 = (r / 16) * 64; n0 = (r % 16) * 64; dst = WSP(bf16_t, WS_WKVUP) + (size_t)i * 1024 * 256; ld_dst = 256; drow0 = n0; dk0 = k0; }
            else if ((r -= 64) < 256) { src = C.A.in[10] + (size_t)i * 1024 * 1024; ld_src = 1024; nvalid = 1024; k0 = (r / 16) * 64; n0 = (r % 16) * 64; dst = WSP(bf16_t, WS_WOUTA) + (size_t)i * 1024 * 1024; ld_dst = 1024; drow0 = n0; dk0 = k0; }
            else if ((r -= 256) < 768) { src = C.A.in[26] + (size_t)i * 1024 * 3072; ld_src = 3072; nvalid = 3072; k0 = (r / 48) * 64; n0 = (r % 48) * 64; dst = WSP(bf16_t, WS_WQKV) + (size_t)i * 3072 * 1024; ld_dst = 1024; drow0 = n0; dk0 = k0; }
            else { r -= 768; src = C.A.in[28] + (size_t)i * 1024 * 1024; ld_src = 1024; nvalid = 1024; k0 = (r / 16) * 64; n0 = (r % 16) * 64; dst = WSP(bf16_t, WS_WOUTC) + (size_t)i * 1024 * 1024; ld_dst = 1024; drow0 = n0; dk0 = k0; }
        } else {
            const int m = it - 2 * CV_SMALL, le = m / 1536, r = m % 1536, which = r / 512, q = r % 512;
            if (which < 2) { src = C.A.in[which == 0 ? 30 : 31] + (size_t)le * 1024 * 2048; ld_src = 2048; nvalid = 2048; k0 = (q / 32) * 64; n0 = (q % 32) * 64;
                dst = WSP(bf16_t, WS_W13) + (size_t)le * 4096 * 1024; ld_dst = 1024; drow0 = (n0 >> 7) * 256 + which * 128 + (n0 & 127); dk0 = k0; }
            else { src = C.A.in[32] + (size_t)le * 2048 * 1024; ld_src = 1024; nvalid = 1024; k0 = (q / 16) * 64; n0 = (q % 16) * 64;
                dst = WSP(bf16_t, WS_W2) + (size_t)le * 1024 * 2048; ld_dst = 2048; drow0 = n0; dk0 = k0; }
        }
        tr_item(src, ld_src, nvalid, k0, n0, dst, ld_dst, drow0, dk0, scr, C.lane);
    }
    const u32x4 z4 = (u32x4){0u, 0u, 0u, 0u};
    const int gt = C.bid * 512 + C.tid, ngt = C.G * 512;
    for (int idx = gt; idx < 2 * 224 * 128; idx += ngt) { const int i = idx / (224 * 128), r = (idx / 128) % 224, ch = idx % 128;
        *(u32x4*)(WSP(bf16_t, WS_WIN) + ((size_t)i * ZP + 2592 + r) * 1024 + ch * 8) = z4; }
    for (int idx = gt; idx < 2 * 2560 * 48; idx += ngt) { const int i = idx / (2560 * 48), r = (idx / 48) % 2560, ch = idx % 48, seg = r >> 9;
        const int lo = seg < 4 ? seg * 8 : 32, hi = seg < 4 ? seg * 8 + 8 : 48;
        if (ch < lo || ch >= hi) *(u32x4*)(WSP(bf16_t, WS_WLORA) + ((size_t)i * 2560 + r) * 384 + ch * 8) = z4; }
    for (int idx = gt; idx < 2048 * 16; idx += ngt) { const int t = idx >> 4, i = idx & 15; const float pos = (float)(i < 8 ? (t >> 6) : (t & 63));
        const float inv = powf(10000.0f, -(float)(i & 7) / 8.0f); const float ang = pos * inv;
        WSP(float, WS_ROPE)[idx * 2] = cosf(ang); WSP(float, WS_ROPE)[idx * 2 + 1] = sinf(ang); }
}
__device__ __forceinline__ void p0_mod(const Ctx& C) {
    LAS float* sc = (LAS float*)C.lds;
    LAS float* part = (LAS float*)(C.lds + 36864);
    __syncthreads();
    for (int idx = C.tid; idx < 9 * 1024; idx += 512) { const int r = idx >> 10, k = idx & 1023; const float cv = r < 8 ? C.A.in[1][r * 1024 + k] : C.A.in[3][k]; sc[idx] = cv / (1.f + __expf(-cv)); }
    __syncthreads();
    for (int unit = C.bid; unit < 192; unit += C.G) {
        const int l = unit / 48, jb = unit % 48, jj = C.tid & 127, kc = C.tid >> 7;
        const float* w = C.A.in[4] + ((size_t)l * 1024 + kc * 256) * 6144 + jb * 128 + jj;
        float acc[9];
#pragma unroll
        for (int r = 0; r < 9; ++r) acc[r] = 0.f;
#pragma unroll 4
        for (int k = 0; k < 256; ++k) { const float wv = w[(size_t)k * 6144];
#pragma unroll
            for (int r = 0; r < 9; ++r) acc[r] += sc[r * 1024 + kc * 256 + k] * wv; }
#pragma unroll
        for (int r = 0; r < 9; ++r) part[(kc * 9 + r) * 128 + jj] = acc[r];
        __syncthreads();
        for (int idx = C.tid; idx < 9 * 128; idx += 512) { const int r = idx >> 7, j2 = idx & 127;
            const float s = part[(0 * 9 + r) * 128 + j2] + part[(1 * 9 + r) * 128 + j2] + part[(2 * 9 + r) * 128 + j2] + part[(3 * 9 + r) * 128 + j2] + C.A.in[5][l * 6144 + jb * 128 + j2];
            WSP(float, WS_MOD)[(size_t)(l * 9 + r) * 6144 + jb * 128 + j2] = s; }
        __syncthreads();
    }
}

__device__ __forceinline__ void row_load(const float* p, int lane, f32x4 (&v)[4]) {
#pragma unroll
    for (int j = 0; j < 4; ++j) v[j] = *(const f32x4*)(p + (lane + 64 * j) * 4); }
__device__ __forceinline__ void row_store(float* p, int lane, const f32x4 (&v)[4]) {
#pragma unroll
    for (int j = 0; j < 4; ++j) *(f32x4*)(p + (lane + 64 * j) * 4) = v[j]; }
__device__ __forceinline__ float row_rstd(const f32x4 (&v)[4]) {
    float s = 0.f;
#pragma unroll
    for (int j = 0; j < 4; ++j) s += (v[j].x * v[j].x + v[j].y * v[j].y) + (v[j].z * v[j].z + v[j].w * v[j].w);
    return rsqrtf(wave_sum(s) * (1.f / 1024.f) + NORM_EPS); }
__device__ __forceinline__ void row_modulate(const f32x4 (&v)[4], float rstd, const float* nw, const float* sh, const float* sc, int lane, f32x4 (&h)[4]) {
#pragma unroll
    for (int j = 0; j < 4; ++j) { const int c = (lane + 64 * j) * 4; const f32x4 w = *(const f32x4*)(nw + c), s1 = *(const f32x4*)(sc + c), s0 = *(const f32x4*)(sh + c);
        h[j] = (v[j] * rstd * w) * (s1 + 1.0f) + s0; } }
__device__ __forceinline__ void row_store_bf16(bf16_t* p, int lane, const f32x4 (&h)[4]) {
#pragma unroll
    for (int j = 0; j < 4; ++j) { u32x2 w; w.x = pk2(h[j].x, h[j].y); w.y = pk2(h[j].z, h[j].w); *(u32x2*)(p + (lane + 64 * j) * 4) = w; } }

__device__ __forceinline__ void p1_init(const Ctx& C) {
    for (int row = C.gw; row < NT; row += C.ngw) {
        const float* src = row < NLAT ? C.A.in[0] + (size_t)row * DM : C.A.in[2] + (size_t)(row - NLAT) * DM;
        f32x4 v[4], h[4]; row_load(src, C.lane, v); row_store(WSP(float, WS_X) + (size_t)row * DM, C.lane, v);
        const int mg = mod_group(row); const float rstd = row_rstd(v);
        row_modulate(v, rstd, C.A.in[6], modp(C, 0, mg, 0), modp(C, 0, mg, 1), C.lane, h);
        row_store_bf16(WSP(bf16_t, WS_H) + (size_t)row * DM, C.lane, h);
    }
}

__device__ __forceinline__ void a2_prepare(const Ctx& C, int i) {
    const bf16_t* Z = WSP(const bf16_t, WS_Z);
    const float* mu = C.A.in[11] + (size_t)i * 2 * 1920;
    const int lane = C.lane;
    for (int row = C.gw; row < NT; row += C.ngw) {
        const bool isctx = row >= NLAT; const int t = isctx ? ((row - NLAT) & 255) : (row & 2047), T = isctx ? 256 : 2048;
        const bf16_t* z = Z + (size_t)row * ZP; const bool hp = t > 0, hn = t < T - 1;
        float r8[8], k8[8], v8[8];
#pragma unroll
        for (int seg = 0; seg < 3; ++seg) {
            const int c0 = seg * 512 + lane * 8; float zc[8], zp[8], zn[8], m0[8], m1[8];
            ld8(z + c0, zc);
            if (hp) ld8(z - ZP + c0, zp); else { for (int j = 0; j < 8; ++j) zp[j] = 0.f; }
            if (hn) ld8(z + ZP + c0, zn); else { for (int j = 0; j < 8; ++j) zn[j] = 0.f; }
            *(f32x4*)&m0[0] = *(const f32x4*)(mu + c0); *(f32x4*)&m0[4] = *(const f32x4*)(mu + c0 + 4);
            *(f32x4*)&m1[0] = *(const f32x4*)(mu + 1920 + c0); *(f32x4*)&m1[4] = *(const f32x4*)(mu + 1920 + c0 + 4);
#pragma unroll
            for (int j = 0; j < 8; ++j) { const float o = zc[j] + m0[j] * (zp[j] - zc[j]) + m1[j] * (zn[j] - zc[j]); if (seg == 0) r8[j] = o; else if (seg == 1) k8[j] = o; else v8[j] = o; }
        }
        st8(WSP(bf16_t, WS_R) + (size_t)row * ADIM + lane * 8, r8);
        st8(WSP(bf16_t, WS_KS) + (size_t)row * ADIM + lane * 8, k8);
        st8(WSP(bf16_t, WS_V) + (size_t)row * ADIM + lane * 8, v8);
        { float kk[8], ss = 0.f; const float* kkw = C.A.in[17] + i * ADIM + lane * 8;
#pragma unroll
            for (int j = 0; j < 8; ++j) { kk[j] = k8[j] * kkw[j]; ss += kk[j] * kk[j]; }
            ss = sum8(ss); const float inv = 1.f / fmaxf(sqrtf(ss), 1e-12f);
#pragma unroll
            for (int j = 0; j < 8; ++j) kk[j] *= inv;
            st8(WSP(bf16_t, WS_KK) + (size_t)row * ADIM + lane * 8, kk); }
#pragma unroll
        for (int seg = 0; seg < 3; ++seg) {
            const int c0 = 1536 + seg * 128 + lane * 2; const unsigned wc_ = *(const unsigned*)(z + c0);
            const unsigned wp_ = hp ? *(const unsigned*)(z - ZP + c0) : 0u, wn_ = hn ? *(const unsigned*)(z + ZP + c0) : 0u;
            float o[2];
#pragma unroll
            for (int j = 0; j < 2; ++j) { const float zc = j ? __uint_as_float(wc_ & 0xffff0000u) : __uint_as_float(wc_ << 16), zp = j ? __uint_as_float(wp_ & 0xffff0000u) : __uint_as_float(wp_ << 16),
                                                      zn = j ? __uint_as_float(wn_ & 0xffff0000u) : __uint_as_float(wn_ << 16);
                const float s = zc + mu[c0 + j] * (zp - zc) + mu[1920 + c0 + j] * (zn - zc);
                o[j] = seg == 0 ? tanhf(s) : (seg == 1 ? s : sigmoidf_(s)); }
            *(unsigned*)(WSP(bf16_t, WS_LIN) + (size_t)row * 384 + seg * 128 + lane * 2) = pk2(o[0], o[1]);
        }
        { float q[6], ss = 0.f;
#pragma unroll
            for (int j = 0; j < 3; ++j) { const unsigned w = *(const unsigned*)(z + 1920 + j * 128 + lane * 2); q[2 * j] = __uint_as_float(w << 16); q[2 * j + 1] = __uint_as_float(w & 0xffff0000u); ss += q[2 * j] * q[2 * j] + q[2 * j + 1] * q[2 * j + 1]; }
            const float rstd = rsqrtf(wave_sum(ss) * (1.f / 384.f) + NORM_EPS); const float* nw = C.A.in[22] + i * 384;
#pragma unroll
            for (int j = 0; j < 3; ++j) { const int c = j * 128 + lane * 2; *(unsigned*)(WSP(bf16_t, WS_QN) + (size_t)row * 384 + c) = pk2(q[2 * j] * rstd * nw[c], q[2 * j + 1] * rstd * nw[c + 1]); } }
        { const u32x2 w = *(const u32x2*)(z + 2304 + lane * 4); float q[4] = {__uint_as_float(w.x << 16), __uint_as_float(w.x & 0xffff0000u), __uint_as_float(w.y << 16), __uint_as_float(w.y & 0xffff0000u)};
            const float ss = q[0] * q[0] + q[1] * q[1] + q[2] * q[2] + q[3] * q[3];
            const float rstd = rsqrtf(wave_sum(ss) * (1.f / 256.f) + NORM_EPS); const float* nw = C.A.in[24] + i * 256 + lane * 4;
            u32x2 o; o.x = pk2(q[0] * rstd * nw[0], q[1] * rstd * nw[1]); o.y = pk2(q[2] * rstd * nw[2], q[3] * rstd * nw[3]);
            *(u32x2*)(WSP(bf16_t, WS_KVN) + (size_t)row * 256 + lane * 4) = o; }
        if (lane < 16) { const unsigned w = *(const unsigned*)(z + 2560 + lane * 2); float x0 = __uint_as_float(w << 16), x1 = __uint_as_float(w & 0xffff0000u);
            if (!isctx) { const float cs = WSP(const float, WS_ROPE)[(t * 16 + lane) * 2], sn = WSP(const float, WS_ROPE)[(t * 16 + lane) * 2 + 1]; const float o0 = x0 * cs - x1 * sn, o1 = x0 * sn + x1 * cs; x0 = o0; x1 = o1; }
            *(unsigned*)(WSP(bf16_t, WS_KR) + (size_t)row * 32 + lane * 2) = pk2(x0, x1); }
    }
}

struct FStoreBf16 { bf16_t* O; int ldo; float scale; int scale_cols;
    __device__ __forceinline__ void operator()(int row, int col, const float (&v)[8]) const { float o[8]; const float s = col < scale_cols ? scale : 1.f;
#pragma unroll
        for (int j = 0; j < 8; ++j) o[j] = v[j] * s;
        st8(O + (size_t)row * ldo + col, o); } };
struct FLora { const float* w0; const float* a0; const float* ka; const bf16_t* KS; const bf16_t* KK; float* DEC; bf16_t* KD; bf16_t* BB; bf16_t* G;
    __device__ __forceinline__ void operator()(int row, int col, const float (&v)[8]) const {
        const int seg = col >> 9, c = col & 511;
        if (seg < 2) { float o[8];
#pragma unroll
            for (int j = 0; j < 8; ++j) { const float x = w0[seg * 512 + c + j] + v[j]; const float sp = fmaxf(-x, 0.f) + __logf(1.f + __expf(-fabsf(x)));
                o[j] = __expf(-__expf(-sp - 0.5f)); }
            float* d = DEC + ((size_t)seg * NT + row) * ADIM + c; *(f32x4*)d = *(const f32x4*)&o[0]; *(f32x4*)(d + 4) = *(const f32x4*)&o[4];
        } else if (seg < 4) { const int d_ = seg - 2; float k[8], kk[8], kd[8], bb[8]; ld8(KS + (size_t)row * ADIM + c, k); ld8(KK + (size_t)row * ADIM + c, kk);
#pragma unroll
            for (int j = 0; j < 8; ++j) { const float a = sigmoidf_(a0[d_ * 512 + c + j] + v[j]); kd[j] = k[j] * (1.f + (a - 1.f) * ka[c + j]); bb[j] = kk[j] * a; }
            st8(KD + ((size_t)d_ * NT + row) * ADIM + c, kd); st8(BB + ((size_t)d_ * NT + row) * ADIM + c, bb);
        } else st8(G + (size_t)row * ADIM + c, v);
    } };
struct FQup { bf16_t* Q; const float* rope; float scale;
    __device__ __forceinline__ void operator()(int row, int col, const float (&v)[8]) const {
        const int d = col % 96; float o[8];
#pragma unroll
        for (int j = 0; j < 8; ++j) o[j] = v[j] * scale;
        if (d >= 64 && row < NLAT) { const int t = row & 2047, p0 = (d - 64) >> 1;
#pragma unroll
            for (int p = 0; p < 4; ++p) { const float cs = rope[(t * 16 + p0 + p) * 2], sn = rope[(t * 16 + p0 + p) * 2 + 1]; const float x0 = o[2 * p], x1 = o[2 * p + 1]; o[2 * p] = x0 * cs - x1 * sn; o[2 * p + 1] = x0 * sn + x1 * cs; } }
        st8(Q + (size_t)row * 768 + col, o);
    } };
struct FResid { float* X; const float* mod; int layer;
    __device__ __forceinline__ void operator()(int row, int col, const float (&v)[8]) const {
        const float* g = mod + ((size_t)(layer * 9 + mod_group(row)) * 6 + 2) * 1024 + col; float* x = X + (size_t)row * DM + col;
        f32x4 x0 = *(const f32x4*)x, x1 = *(const f32x4*)(x + 4); const f32x4 g0 = *(const f32x4*)g, g1 = *(const f32x4*)(g + 4);
        x0 += g0 * (f32x4){v[0], v[1], v[2], v[3]}; x1 += g1 * (f32x4){v[4], v[5], v[6], v[7]};
        *(f32x4*)x = x0; *(f32x4*)(x + 4) = x1;
    } };
struct FSwiglu { bf16_t* HID;
    __device__ __forceinline__ void operator()(int row, int col, const float (&a)[8], const float (&b)[8]) const { float o[8];
#pragma unroll
        for (int j = 0; j < 8; ++j) o[j] = a[j] / (1.f + __expf(-a[j])) * b[j];
        st8(HID + (size_t)row * FF + (col & (FF - 1)), o); } };
struct FGate { bf16_t* YB; const float* gate;
    __device__ __forceinline__ void operator()(int row, int col, const float (&v)[8]) const { const float g = gate[row]; float o[8];
#pragma unroll
        for (int j = 0; j < 8; ++j) o[j] = v[j] * g;
        st8(YB + (size_t)row * DM + (col & (DM - 1)), o); } };

constexpr int SC_TC = 32;
__device__ __forceinline__ void a4_scan(const Ctx& C) {
    LAS float* L = (LAS float*)C.lds;
    const int tid = C.tid, rowi = tid >> 3, j = tid & 7;
    const int ls_ld = tid >> 4, c4 = (tid & 15) * 4;
    for (int unit = C.bid; unit < 128; unit += C.G) {
        const int b = unit >> 4, h = (unit >> 1) & 7, dir = unit & 1;
        const float* DEC = WSP(const float, WS_DEC) + (size_t)dir * NT * ADIM + h * 64;
        const bf16_t* KD = WSP(const bf16_t, WS_KD) + (size_t)dir * NT * ADIM + h * 64;
        const bf16_t* BB = WSP(const bf16_t, WS_BB) + (size_t)dir * NT * ADIM + h * 64;
        const bf16_t* KK = WSP(const bf16_t, WS_KK) + h * 64; const bf16_t* R = WSP(const bf16_t, WS_R) + h * 64; const bf16_t* V = WSP(const bf16_t, WS_V) + h * 64;
        float* Y = WSP(float, WS_Y) + (size_t)dir * NT * ADIM + h * 64;
        auto row_of = [&](int s) -> int { return s < 256 ? NLAT + b * 256 + (dir ? 255 - s : s) : b * 2048 + (dir ? 2047 - (s - 256) : (s - 256)); };
        f32x4 pw; u32x2 pkd, pbb, pkk, pr, pv;
        auto gload = [&](int chunk) { const size_t o = (size_t)row_of(chunk * SC_TC + ls_ld) * ADIM + c4;
            pw = *(const f32x4*)(DEC + o); pkd = *(const u32x2*)(KD + o); pbb = *(const u32x2*)(BB + o); pkk = *(const u32x2*)(KK + o); pr = *(const u32x2*)(R + o); pv = *(const u32x2*)(V + o); };
        auto lwrite = [&](int buf) { LAS float* Bf = L + buf * 12288 + ls_ld * 64 + c4;
            *(LAS f32x4*)(Bf) = pw;
            *(LAS f32x4*)(Bf + 2048) = (f32x4){__uint_as_float(pkd.x << 16), __uint_as_float(pkd.x & 0xffff0000u), __uint_as_float(pkd.y << 16), __uint_as_float(pkd.y & 0xffff0000u)};
            *(LAS f32x4*)(Bf + 4096) = (f32x4){__uint_as_float(pbb.x << 16), __uint_as_float(pbb.x & 0xffff0000u), __uint_as_float(pbb.y << 16), __uint_as_float(pbb.y & 0xffff0000u)};
            *(LAS f32x4*)(Bf + 6144) = (f32x4){__uint_as_float(pkk.x << 16), __uint_as_float(pkk.x & 0xffff0000u), __uint_as_float(pkk.y << 16), __uint_as_float(pkk.y & 0xffff0000u)};
            *(LAS f32x4*)(Bf + 8192) = (f32x4){__uint_as_float(pr.x << 16), __uint_as_float(pr.x & 0xffff0000u), __uint_as_float(pr.y << 16), __uint_as_float(pr.y & 0xffff0000u)};
            *(LAS f32x4*)(Bf + 10240) = (f32x4){__uint_as_float(pv.x << 16), __uint_as_float(pv.x & 0xffff0000u), __uint_as_float(pv.y << 16), __uint_as_float(pv.y & 0xffff0000u)}; };
        float S[8];
#pragma unroll
        for (int q = 0; q < 8; ++q) S[q] = 0.f;
        __syncthreads();
        gload(0); lwrite(0);
        __syncthreads();
        constexpr int NCH = 2304 / SC_TC;
        for (int ch = 0; ch < NCH; ++ch) {
            if (ch + 1 < NCH) gload(ch + 1);
            const LAS float* Bf = L + (ch & 1) * 12288 + j * 8;
#pragma unroll 4
            for (int ls = 0; ls < SC_TC; ++ls) {
                const LAS float* p = Bf + ls * 64;
                const f32x4 w0 = *(const LAS f32x4*)(p), w1 = *(const LAS f32x4*)(p + 4);
                const f32x4 d0 = *(const LAS f32x4*)(p + 2048), d1 = *(const LAS f32x4*)(p + 2052);
                const f32x4 b0 = *(const LAS f32x4*)(p + 4096), b1 = *(const LAS f32x4*)(p + 4100);
                const f32x4 k0 = *(const LAS f32x4*)(p + 6144), k1 = *(const LAS f32x4*)(p + 6148);
                const f32x4 r0 = *(const LAS f32x4*)(p + 8192), r1 = *(const LAS f32x4*)(p + 8196);
                const float vv = L[(ch & 1) * 12288 + 10240 + ls * 64 + rowi];
                float sa = (S[0] * k0.x + S[1] * k0.y) + (S[2] * k0.z + S[3] * k0.w) + (S[4] * k1.x + S[5] * k1.y) + (S[6] * k1.z + S[7] * k1.w);
                sa = -sum8(sa);
                S[0] = S[0] * w0.x + sa * b0.x + vv * d0.x; S[1] = S[1] * w0.y + sa * b0.y + vv * d0.y; S[2] = S[2] * w0.z + sa * b0.z + vv * d0.z; S[3] = S[3] * w0.w + sa * b0.w + vv * d0.w;
                S[4] = S[4] * w1.x + sa * b1.x + vv * d1.x; S[5] = S[5] * w1.y + sa * b1.y + vv * d1.y; S[6] = S[6] * w1.z + sa * b1.z + vv * d1.z; S[7] = S[7] * w1.w + sa * b1.w + vv * d1.w;
                float y = (S[0] * r0.x + S[1] * r0.y) + (S[2] * r0.z + S[3] * r0.w) + (S[4] * r1.x + S[5] * r1.y) + (S[6] * r1.z + S[7] * r1.w);
                y = sum8(y);
                if (j == 0) Y[(size_t)row_of(ch * SC_TC + ls) * ADIM + rowi] = y;
            }
            if (ch + 1 < NCH) lwrite((ch + 1) & 1);
            __syncthreads();
        }
    }
}

__device__ __forceinline__ void a4_mla_naive(const Ctx& C) {
    LAS float* Kt = (LAS float*)C.lds;
    LAS float* Vt = Kt + 32 * 96;
    const bf16_t* Q = WSP(const bf16_t, WS_Q); const bf16_t* KV = WSP(const bf16_t, WS_KV); const bf16_t* KR = WSP(const bf16_t, WS_KR); bf16_t* MIX = WSP(bf16_t, WS_MIX);
    const int tid = C.tid;
    for (int unit = C.bid; unit < 320; unit += C.G) {
        int b, h, qrow, nkeys; bool active = true;
        if (unit < 256) { b = unit >> 5; h = (unit >> 2) & 7; qrow = b * 2048 + (unit & 3) * 512 + tid; nkeys = 2304; }
        else { const int u = unit - 256; b = u >> 3; h = u & 7; qrow = NLAT + b * 256 + (tid & 255); nkeys = 256; active = tid < 256; }
        float q[96], acc[64], m = -1e30f, l = 0.f;
#pragma unroll
        for (int d8 = 0; d8 < 12; ++d8) { float t8[8]; ld8(Q + (size_t)qrow * 768 + h * 96 + d8 * 8, t8);
#pragma unroll
            for (int jj = 0; jj < 8; ++jj) q[d8 * 8 + jj] = t8[jj]; }
#pragma unroll
        for (int d = 0; d < 64; ++d) acc[d] = 0.f;
        for (int kt = 0; kt < nkeys; kt += 32) {
            __syncthreads();
            for (int idx = tid; idx < 32 * 48; idx += 512) { const int key = idx / 48, dp = idx % 48, kj = kt + key; const int krow = kj < 256 ? NLAT + b * 256 + kj : b * 2048 + (kj - 256);
                const unsigned w = dp < 32 ? *(const unsigned*)(KV + (size_t)krow * 1024 + h * 128 + dp * 2) : *(const unsigned*)(KR + (size_t)krow * 32 + (dp - 32) * 2);
                Kt[key * 96 + dp * 2] = __uint_as_float(w << 16); Kt[key * 96 + dp * 2 + 1] = __uint_as_float(w & 0xffff0000u); }
            for (int idx = tid; idx < 32 * 32; idx += 512) { const int key = idx >> 5, dp = idx & 31, kj = kt + key; const int krow = kj < 256 ? NLAT + b * 256 + kj : b * 2048 + (kj - 256);
                const unsigned w = *(const unsigned*)(KV + (size_t)krow * 1024 + h * 128 + 64 + dp * 2);
                Vt[key * 64 + dp * 2] = __uint_as_float(w << 16); Vt[key * 64 + dp * 2 + 1] = __uint_as_float(w & 0xffff0000u); }
            __syncthreads();
            for (int key = 0; key < 32; ++key) {
                float s = 0.f;
#pragma unroll
                for (int d4 = 0; d4 < 24; ++d4) { const f32x4 kv = *(const LAS f32x4*)(Kt + key * 96 + d4 * 4); s += q[d4 * 4] * kv.x + q[d4 * 4 + 1] * kv.y + q[d4 * 4 + 2] * kv.z + q[d4 * 4 + 3] * kv.w; }
                const float mn = fmaxf(m, s), corr = __expf(m - mn), p = __expf(s - mn); m = mn; l = l * corr + p;
#pragma unroll
                for (int d4 = 0; d4 < 16; ++d4) { const f32x4 vv = *(const LAS f32x4*)(Vt + key * 64 + d4 * 4);
                    acc[d4 * 4] = acc[d4 * 4] * corr + p * vv.x; acc[d4 * 4 + 1] = acc[d4 * 4 + 1] * corr + p * vv.y; acc[d4 * 4 + 2] = acc[d4 * 4 + 2] * corr + p * vv.z; acc[d4 * 4 + 3] = acc[d4 * 4 + 3] * corr + p * vv.w; }
            }
        }
        if (active) { const float il = 1.f / l;
#pragma unroll
            for (int d8 = 0; d8 < 8; ++d8) { float o[8];
#pragma unroll
                for (int jj = 0; jj < 8; ++jj) o[jj] = acc[d8 * 8 + jj] * il;
                st8(MIX + (size_t)qrow * DM + 512 + h * 64 + d8 * 8, o); } }
    }
    __syncthreads();
}

typedef float f32x16 __attribute__((ext_vector_type(16)));
__device__ __forceinline__ int crow(int r, int hi) { return (r & 3) + 8 * (r >> 2) + 4 * hi; }
constexpr int AT_VP = 136;
template <class Spec> __device__ __forceinline__ void attn_unit(const Ctx& C, const Spec& sp) {
    constexpr int DQ = Spec::DQ, NS = DQ / 16, KP = Spec::KPITCH, KBUF = 64 * KP, VBUF = 64 * AT_VP, BUF = KBUF + VBUF;
    static_assert(BUF % 16 == 0 && KP % 16 == 0, "alignment");
    LAS unsigned char* L = C.lds;
    const int tid = C.tid, lane = C.lane, w = C.wave, r32 = lane & 31, hi = lane >> 5;
    bf16x8 qf[NS];
    { const bf16_t* qp = sp.qptr(w * 32 + r32);
#pragma unroll
      for (int s_ = 0; s_ < NS; ++s_) qf[s_] = *(const bf16x8*)(qp + 16 * s_ + 8 * hi); }
    f32x16 o0, o1;
#pragma unroll
    for (int r = 0; r < 16; ++r) { o0[r] = 0.f; o1[r] = 0.f; }
    float m = -1e30f, lsum = 0.f;
    const int nt = sp.nt;
    const int skey = tid >> 3, sch = tid & 7, rkey = (tid >> 2) & 63, rch = 8 + (tid & 3);
    u32x4 gk, gk2, gv;
    gk2 = (u32x4){0u, 0u, 0u, 0u};
    auto gload = [&](int t) { gk = *(const u32x4*)sp.kptr(t, skey, sch); if (NS > 4 && tid < 256) gk2 = *(const u32x4*)sp.kptr(t, rkey, rch); gv = *(const u32x4*)sp.vptr(t, skey, sch); };
    auto lwrite = [&](int buf) { LAS unsigned char* Bk = L + buf * BUF;
        *(LAS u32x4*)(Bk + skey * KP + sch * 16) = gk; if (NS > 4 && tid < 256) *(LAS u32x4*)(Bk + rkey * KP + rch * 16) = gk2;
        LAS unsigned short* Bv = (LAS unsigned short*)(Bk + KBUF);
#pragma unroll
        for (int j = 0; j < 8; ++j) { const unsigned wv = gv[j >> 1]; Bv[(sch * 8 + j) * (AT_VP / 2) + skey] = (unsigned short)((j & 1) ? (wv >> 16) : (wv & 0xffffu)); } };
    __syncthreads();
    sp.prologue(C);
    gload(0); lwrite(0);
    __syncthreads();
    for (int t = 0; t < nt; ++t) {
        if (t + 1 < nt) gload(t + 1);
        if (sp.active(t, w)) {
            const LAS unsigned char* Bk = L + (t & 1) * BUF; const LAS unsigned char* Bv = Bk + KBUF;
            f32x16 p0, p1;
#pragma unroll
            for (int r = 0; r < 16; ++r) { p0[r] = 0.f; p1[r] = 0.f; }
#pragma unroll
            for (int s_ = 0; s_ < NS; ++s_) {
                const bf16x8 k0 = *(const LAS bf16x8*)(Bk + r32 * KP + 32 * s_ + 16 * hi), k1 = *(const LAS bf16x8*)(Bk + (32 + r32) * KP + 32 * s_ + 16 * hi);
                p0 = __builtin_amdgcn_mfma_f32_32x32x16_bf16(k0, qf[s_], p0, 0, 0, 0); p1 = __builtin_amdgcn_mfma_f32_32x32x16_bf16(k1, qf[s_], p1, 0, 0, 0); }
            sp.bias(C, t, w, r32, hi, p0, p1);
            float mx = fmaxf(p0[0], p1[0]);
#pragma unroll
            for (int r = 1; r < 16; ++r) mx = fmaxf(mx, fmaxf(p0[r], p1[r]));
            mx = fmaxf(mx, __shfl_xor(mx, 32));
            const float mn = fmaxf(m, mx), corr = __builtin_amdgcn_exp2f(m - mn); m = mn;
            float ps = 0.f;
#pragma unroll
            for (int r = 0; r < 16; ++r) { p0[r] = __builtin_amdgcn_exp2f(p0[r] - mn); p1[r] = __builtin_amdgcn_exp2f(p1[r] - mn); ps += p0[r] + p1[r]; }
            lsum = lsum * corr + ps;
#pragma unroll
            for (int r = 0; r < 16; ++r) { o0[r] *= corr; o1[r] *= corr; }
#pragma unroll
            for (int s_ = 0; s_ < 4; ++s_) {
                u32x4 pw;
                if (s_ < 2) { pw.x = pk2(p0[8 * s_ + 0], p0[8 * s_ + 1]); pw.y = pk2(p0[8 * s_ + 2], p0[8 * s_ + 3]); pw.z = pk2(p0[8 * s_ + 4], p0[8 * s_ + 5]); pw.w = pk2(p0[8 * s_ + 6], p0[8 * s_ + 7]); }
                else { const int q_ = 8 * (s_ - 2); pw.x = pk2(p1[q_ + 0], p1[q_ + 1]); pw.y = pk2(p1[q_ + 2], p1[q_ + 3]); pw.z = pk2(p1[q_ + 4], p1[q_ + 5]); pw.w = pk2(p1[q_ + 6], p1[q_ + 7]); }
                const bf16x8 pb = __builtin_bit_cast(bf16x8, pw);
#pragma unroll
                for (int dvh = 0; dvh < 2; ++dvh) {
                    const LAS unsigned char* vp = Bv + (dvh * 32 + r32) * AT_VP + 32 * s_ + 8 * hi;
                    const u32x2 a = *(const LAS u32x2*)vp, b = *(const LAS u32x2*)(vp + 16);
                    const bf16x8 vf = __builtin_bit_cast(bf16x8, (u32x4){a.x, a.y, b.x, b.y});
                    if (dvh == 0) o0 = __builtin_amdgcn_mfma_f32_32x32x16_bf16(vf, pb, o0, 0, 0, 0); else o1 = __builtin_amdgcn_mfma_f32_32x32x16_bf16(vf, pb, o1, 0, 0, 0);
                }
            }
        }
        if (t + 1 < nt) lwrite((t + 1) & 1);
        __syncthreads();
    }
    lsum += __shfl_xor(lsum, 32);
    const float il = 1.f / lsum;
    bf16_t* op = sp.optr(w * 32 + r32);
#pragma unroll
    for (int g = 0; g < 4; ++g) { u32x2 w0, w1;
        w0.x = pk2(o0[4 * g] * il, o0[4 * g + 1] * il); w0.y = pk2(o0[4 * g + 2] * il, o0[4 * g + 3] * il);
        w1.x = pk2(o1[4 * g] * il, o1[4 * g + 1] * il); w1.y = pk2(o1[4 * g + 2] * il, o1[4 * g + 3] * il);
        *(u32x2*)(op + 8 * g + 4 * hi) = w0; *(u32x2*)(op + 32 + 8 * g + 4 * hi) = w1; }
}
struct MlaSpec { static constexpr int DQ = 96, KPITCH = 208;
    const bf16_t* Q; const bf16_t* KV; const bf16_t* KR; bf16_t* O; int b, h, q0, nt;
    __device__ __forceinline__ const bf16_t* qptr(int i) const { return Q + (size_t)(q0 + i) * 768 + h * 96; }
    __device__ __forceinline__ bf16_t* optr(int i) const { return O + (size_t)(q0 + i) * DM + 512 + h * 64; }
    __device__ __forceinline__ int krow(int t, int key) const { return t < 4 ? NLAT + b * 256 + 64 * t + key : b * 2048 + 64 * (t - 4) + key; }
    __device__ __forceinline__ const bf16_t* kptr(int t, int key, int c) const { const int kr = krow(t, key); return c < 8 ? KV + (size_t)kr * 1024 + h * 128 + c * 8 : KR + (size_t)kr * 32 + (c - 8) * 8; }
    __device__ __forceinline__ const bf16_t* vptr(int t, int key, int c) const { return KV + (size_t)krow(t, key) * 1024 + h * 128 + 64 + c * 8; }
    __device__ __forceinline__ bool active(int, int) const { return true; }
    __device__ __forceinline__ void prologue(const Ctx&) const {}
    __device__ __forceinline__ void bias(const Ctx&, int, int, int, int, f32x16&, f32x16&) const {}
};
struct NaSpec { static constexpr int DQ = 64, KPITCH = 144; static constexpr int TAB_OFF = 2 * (64 * 144 + 64 * AT_VP);
    const bf16_t* QKV; bf16_t* O; const float* rpb; int b, h, rb, kr0, ntw, nt, isctx;
    __device__ __forceinline__ const bf16_t* qptr(int i) const { return QKV + (size_t)(isctx ? NLAT + b * 256 + i : b * 2048 + rb * 256 + i) * 3072 + h * 64; }
    __device__ __forceinline__ bf16_t* optr(int i) const { return O + (size_t)(isctx ? NLAT + b * 256 + i : b * 2048 + rb * 256 + i) * DM + h * 64; }
    __device__ __forceinline__ int krow(int t, int key) const { return t < ntw ? b * 2048 + (kr0 + t) * 64 + key : NLAT + b * 256 + 64 * (t - ntw) + key; }
    __device__ __forceinline__ const bf16_t* kptr(int t, int key, int c) const { return QKV + (size_t)krow(t, key) * 3072 + 1024 + h * 64 + c * 8; }
    __device__ __forceinline__ const bf16_t* vptr(int t, int key, int c) const { return QKV + (size_t)krow(t, key) * 3072 + 2048 + h * 64 + c * 8; }
    __device__ __forceinline__ bool active(int t, int w) const { if (t >= ntw) return true; const int qr = 4 * rb + (w >> 1), rs = min(max(qr - 4, 0), 24), kr = kr0 + t; return kr >= rs && kr < rs + 8; }
    __device__ __forceinline__ void prologue(const Ctx& C) const { if (!isctx) { LAS float* tab = (LAS float*)(C.lds + TAB_OFF); for (int idx = C.tid; idx < 465; idx += 512) tab[idx] = rpb[h * 465 + idx] * 1.4426950408889634f; } }
    __device__ __forceinline__ void bias(const Ctx& C, int t, int w, int r32, int hi, f32x16& p0, f32x16& p1) const {
        if (t >= ntw) return;
        const LAS float* tab = (const LAS float*)(C.lds + TAB_OFF);
        const int qr = 4 * rb + (w >> 1), qc = 32 * (w & 1) + r32, cs = min(max(qc - 8, 0), 48), ro = (kr0 + t - qr + 7) * 31 - qc + 15;
#pragma unroll
        for (int r = 0; r < 16; ++r) { const int k0 = crow(r, hi), k1 = k0 + 32;
            const bool v0 = k0 >= cs && k0 < cs + 16, v1 = k1 >= cs && k1 < cs + 16;
            const float b0 = tab[min(max(ro + k0, 0), 464)], b1 = tab[min(max(ro + k1, 0), 464)];
            p0[r] = v0 ? p0[r] + b0 : -INFINITY; p1[r] = v1 ? p1[r] + b1 : -INFINITY; }
    }
};
__device__ __forceinline__ void a4_mla(const Ctx& C) {
    for (int unit = C.bid; unit < 512 + 64; unit += C.G) {
        MlaSpec sp; sp.Q = WSP(const bf16_t, WS_Q); sp.KV = WSP(const bf16_t, WS_KV); sp.KR = WSP(const bf16_t, WS_KR); sp.O = WSP(bf16_t, WS_MIX);
        if (unit < 512) { sp.b = unit >> 6; sp.h = (unit >> 3) & 7; sp.q0 = sp.b * 2048 + (unit & 7) * 256; sp.nt = 36; }
        else { const int u = unit - 512; sp.b = u >> 3; sp.h = u & 7; sp.q0 = NLAT + sp.b * 256; sp.nt = 4; }
        attn_unit(C, sp);
    }
}
__device__ __forceinline__ void b2_na(const Ctx& C, int i, bool need_ctx) {
    for (int unit = C.bid; unit < 1024 + (need_ctx ? 128 : 0); unit += C.G) {
        NaSpec sp; sp.QKV = WSP(const bf16_t, WS_Z); sp.O = WSP(bf16_t, WS_MIX); sp.rpb = C.A.in[27] + (size_t)i * 16 * 465;
        if (unit < 1024) { sp.b = unit >> 7; sp.h = (unit >> 3) & 15; sp.rb = unit & 7; sp.isctx = 0;
            sp.kr0 = min(max(4 * sp.rb - 4, 0), 24); const int krl = min(max(4 * sp.rb + 3 - 4, 0), 24) + 7; sp.ntw = krl - sp.kr0 + 1; sp.nt = sp.ntw + 4; }
        else { const int u = unit - 1024; sp.b = u >> 4; sp.h = u & 15; sp.rb = 0; sp.isctx = 1; sp.kr0 = 0; sp.ntw = 0; sp.nt = 4; }
        attn_unit(C, sp);
    }
}

__device__ __forceinline__ void a5_output(const Ctx& C, int i) {
    const int lane = C.lane, c0 = lane * 8;
    const float* rk = C.A.in[19] + i * ADIM + c0; const float* lnw = C.A.in[20] + i * ADIM + c0; const float* lnb = C.A.in[21] + i * ADIM + c0;
    for (int row = C.gw; row < NT; row += C.ngw) {
        const float* yf = WSP(const float, WS_Y) + (size_t)row * ADIM + c0; const float* yb = yf + (size_t)NT * ADIM;
        float y[8]; { const f32x4 a0 = *(const f32x4*)yf, a1 = *(const f32x4*)(yf + 4), b0 = *(const f32x4*)yb, b1 = *(const f32x4*)(yb + 4);
            y[0] = a0.x + b0.x; y[1] = a0.y + b0.y; y[2] = a0.z + b0.z; y[3] = a0.w + b0.w; y[4] = a1.x + b1.x; y[5] = a1.y + b1.y; y[6] = a1.z + b1.z; y[7] = a1.w + b1.w; }
        float s = 0.f;
#pragma unroll
        for (int j = 0; j < 8; ++j) s += y[j];
        const float mean = sum8(s) * (1.f / 64.f); float q = 0.f;
#pragma unroll
        for (int j = 0; j < 8; ++j) { const float d = y[j] - mean; q += d * d; }
        const float rstd = rsqrtf(sum8(q) * (1.f / 64.f) + 64e-5f);
        float r[8], v[8], g[8], kd0[8], kd1[8];
        ld8(WSP(const bf16_t, WS_R) + (size_t)row * ADIM + c0, r); ld8(WSP(const bf16_t, WS_V) + (size_t)row * ADIM + c0, v); ld8(WSP(const bf16_t, WS_G) + (size_t)row * ADIM + c0, g);
        ld8(WSP(const bf16_t, WS_KD) + (size_t)row * ADIM + c0, kd0); ld8(WSP(const bf16_t, WS_KD) + ((size_t)NT + row) * ADIM + c0, kd1);
        float bs = 0.f;
#pragma unroll
        for (int j = 0; j < 8; ++j) bs += r[j] * (kd0[j] + kd1[j]) * rk[j];
        bs = sum8(bs);
        float o[8];
#pragma unroll
        for (int j = 0; j < 8; ++j) o[j] = ((y[j] - mean) * rstd * lnw[j] + lnb[j] + bs * v[j]) * g[j];
        st8(WSP(bf16_t, WS_MIX) + (size_t)row * DM + c0, o);
    }
}

__device__ __forceinline__ void b2_na_naive(const Ctx& C, int i, bool need_ctx) {
    const bf16_t* QKV = WSP(const bf16_t, WS_Z); bf16_t* MIX = WSP(bf16_t, WS_MIX);
    const float* rpb = C.A.in[27] + (size_t)i * 16 * 15 * 31;
    const int nq = need_ctx ? NT : NLAT;
    const int nblk = nq / 512;
    for (int unit = C.bid; unit < nblk * 16; unit += C.G) {
        const int h = unit & 15, qrow = (unit >> 4) * 512 + C.tid;
        float q[64], acc[64], m = -1e30f, l = 0.f;
#pragma unroll
        for (int d8 = 0; d8 < 8; ++d8) { float t8[8]; ld8(QKV + (size_t)qrow * 3072 + h * 64 + d8 * 8, t8);
#pragma unroll
            for (int jj = 0; jj < 8; ++jj) q[d8 * 8 + jj] = t8[jj]; }
#pragma unroll
        for (int d = 0; d < 64; ++d) acc[d] = 0.f;
        const bool isctx = qrow >= NLAT; const int b = isctx ? (qrow - NLAT) >> 8 : qrow >> 11;
        int qr = 0, qc = 0, rs = 0, cs = 0, nwin = 0;
        if (!isctx) { const int t = qrow & 2047; qr = t >> 6; qc = t & 63; rs = min(max(qr - 4, 0), 24); cs = min(max(qc - 8, 0), 48); nwin = 128; }
        const int nk = nwin + 256;
        for (int kj = 0; kj < nk; ++kj) {
            int krow; float bias = 0.f;
            if (kj < nwin) { const int kr = rs + (kj >> 4), kc = cs + (kj & 15); krow = b * 2048 + kr * 64 + kc; bias = rpb[(h * 15 + (kr - qr + 7)) * 31 + (kc - qc + 15)]; }
            else krow = NLAT + b * 256 + (kj - nwin);
            const bf16_t* kp = QKV + (size_t)krow * 3072 + 1024 + h * 64; const bf16_t* vp = kp + 1024;
            float s = 0.f;
#pragma unroll
            for (int d8 = 0; d8 < 8; ++d8) { float t8[8]; ld8(kp + d8 * 8, t8);
#pragma unroll
                for (int jj = 0; jj < 8; ++jj) s += q[d8 * 8 + jj] * t8[jj]; }
            s += bias;
            const float mn = fmaxf(m, s), corr = __expf(m - mn), p = __expf(s - mn); m = mn; l = l * corr + p;
#pragma unroll
            for (int d8 = 0; d8 < 8; ++d8) { float t8[8]; ld8(vp + d8 * 8, t8);
#pragma unroll
                for (int jj = 0; jj < 8; ++jj) acc[d8 * 8 + jj] = acc[d8 * 8 + jj] * corr + p * t8[jj]; }
        }
        const float il = 1.f / l;
#pragma unroll
        for (int d8 = 0; d8 < 8; ++d8) { float o[8];
#pragma unroll
            for (int jj = 0; jj < 8; ++jj) o[jj] = acc[d8 * 8 + jj] * il;
            st8(MIX + (size_t)qrow * DM + h * 64 + d8 * 8, o); }
    }
}

__device__ __forceinline__ void c2_router(const Ctx& C, int layer, int nrows) {
    const float* rw = C.A.in[29] + (size_t)layer * DM * NEXP; const int lane = C.lane;
    for (int row = C.gw; row < nrows; row += C.ngw) {
        f32x4 v[4], h[4]; row_load(WSP(const float, WS_X) + (size_t)row * DM, lane, v);
        const int mg = mod_group(row); const float rstd = row_rstd(v);
        row_modulate(v, rstd, C.A.in[7] + layer * DM, modp(C, layer, mg, 3), modp(C, layer, mg, 4), lane, h);
        row_store_bf16(WSP(bf16_t, WS_H) + (size_t)row * DM, lane, h);
        float lg[16];
#pragma unroll
        for (int e = 0; e < 16; ++e) lg[e] = 0.f;
#pragma unroll
        for (int j = 0; j < 4; ++j)
#pragma unroll
            for (int q = 0; q < 4; ++q) { const float hv = h[j][q]; const float* wr_ = rw + (size_t)((lane + 64 * j) * 4 + q) * NEXP;
#pragma unroll
                for (int e4 = 0; e4 < 4; ++e4) { const f32x4 w = *(const f32x4*)(wr_ + e4 * 4); lg[e4 * 4] += hv * w.x; lg[e4 * 4 + 1] += hv * w.y; lg[e4 * 4 + 2] += hv * w.z; lg[e4 * 4 + 3] += hv * w.w; } }
#pragma unroll
        for (int e = 0; e < 16; ++e) lg[e] = wave_sum(lg[e]);
        float mx = lg[0];
#pragma unroll
        for (int e = 1; e < 16; ++e) mx = fmaxf(mx, lg[e]);
        float den = 0.f;
#pragma unroll
        for (int e = 0; e < 16; ++e) { lg[e] = __expf(lg[e] - mx); den += lg[e]; }
        const float inv = 1.f / den;
        if (lane < 16) { float a = 0.f;
#pragma unroll
            for (int e = 0; e < 16; ++e) a = (lane == e) ? lg[e] * inv : a;
            float* AFF = WSP(float, WS_AFF);
            if (row < NLAT) AFF[((size_t)(row >> 11) * 16 + lane) * 2048 + (row & 2047)] = a;
            else { const int r2 = row - NLAT; AFF[(size_t)NB * 16 * 2048 + ((size_t)(r2 >> 8) * 16 + lane) * 256 + (r2 & 255)] = a; } }
    }
}

__device__ __forceinline__ void c3_topk(const Ctx& C, bool need_ctx) {
    LAS float* vals = (LAS float*)C.lds;
    LAS int* list = (LAS int*)(C.lds + 8192);
    LAS int* cnt = (LAS int*)(C.lds + 8192 + 4096);
    const int nunits = 512 + (need_ctx ? 128 : 0), tid = C.tid;
    for (int unit = C.bid; unit < nunits; unit += C.G) {
        int b, e, part, n, cap; bool lat = unit < 512;
        if (lat) { b = unit >> 6; e = (unit >> 2) & 15; part = unit & 3; n = 2048; cap = 256; } else { const int u = unit - 512; b = u >> 4; e = u & 15; part = 0; n = 256; cap = 32; }
        const float* src = lat ? WSP(const float, WS_AFF) + ((size_t)b * 16 + e) * 2048 : WSP(const float, WS_AFF) + (size_t)NB * 16 * 2048 + ((size_t)b * 16 + e) * 256;
        __syncthreads();
        for (int idx = tid; idx < n; idx += 512) vals[idx] = src[idx];
        if (tid == 0) cnt[0] = 0;
        __syncthreads();
        const int iel = part * 512 + tid; const bool act = iel < n;
        const float a = vals[act ? iel : 0]; int rank = 0;
        for (int j4 = 0; j4 < n; j4 += 4) { const f32x4 o = *(const LAS f32x4*)(vals + j4);
            rank += (o.x > a || (o.x == a && j4 < iel)) ? 1 : 0; rank += (o.y > a || (o.y == a && j4 + 1 < iel)) ? 1 : 0;
            rank += (o.z > a || (o.z == a && j4 + 2 < iel)) ? 1 : 0; rank += (o.w > a || (o.w == a && j4 + 3 < iel)) ? 1 : 0; }
        if (act) { const int trow = lat ? b * 2048 + iel : NLAT + b * 256 + iel; int grow = -1;
            if (rank < cap) { grow = e * ROWS_E + (lat ? b * 256 + rank : 2048 + b * 32 + rank);
                WSP(int, WS_IDX)[grow] = trow; WSP(float, WS_GATE)[grow] = a;
                const int slot = atomicAdd((int*)cnt, 1); list[slot * 2] = trow; list[slot * 2 + 1] = grow; }
            WSP(int, WS_SEL)[(size_t)trow * 16 + e] = grow; }
        __syncthreads();
        const int nsel = cnt[0];
        for (int s = C.wave; s < nsel; s += 8) { const int trow = list[s * 2], grow = list[s * 2 + 1];
            const u32x4* sp = (const u32x4*)(WSP(const bf16_t, WS_H) + (size_t)trow * DM); u32x4* dp = (u32x4*)(WSP(bf16_t, WS_XIN) + (size_t)grow * DM);
            dp[C.lane] = sp[C.lane]; dp[C.lane + 64] = sp[C.lane + 64]; }
    }
    __syncthreads();
}

__device__ __forceinline__ void c6_combine(const Ctx& C, int layer, int nrows) {
    const int lane = C.lane;
    for (int row = C.gw; row < nrows; row += C.ngw) {
        f32x4 v[4], a[4]; row_load(WSP(const float, WS_X) + (size_t)row * DM, lane, v);
#pragma unroll
        for (int j = 0; j < 4; ++j) a[j] = (f32x4){0.f, 0.f, 0.f, 0.f};
        const int* sel = WSP(const int, WS_SEL) + (size_t)row * 16;
        for (int e = 0; e < 16; ++e) { const int g = __builtin_amdgcn_readfirstlane(sel[e]);
            if (g >= 0) { const bf16_t* y = WSP(const bf16_t, WS_YB) + (size_t)g * DM;
#pragma unroll
                for (int j = 0; j < 4; ++j) { const u32x2 w = *(const u32x2*)(y + (lane + 64 * j) * 4);
                    a[j] += (f32x4){__uint_as_float(w.x << 16), __uint_as_float(w.x & 0xffff0000u), __uint_as_float(w.y << 16), __uint_as_float(w.y & 0xffff0000u)}; } } }
        const int mg = mod_group(row); const float* g2 = modp(C, layer, mg, 5);
#pragma unroll
        for (int j = 0; j < 4; ++j) v[j] += *(const f32x4*)(g2 + (lane + 64 * j) * 4) * a[j];
        const float rstd = row_rstd(v);
        if (layer < 3) { row_store(WSP(float, WS_X) + (size_t)row * DM, lane, v);
            f32x4 h[4]; row_modulate(v, rstd, C.A.in[6] + (layer + 1) * DM, modp(C, layer + 1, mg, 0), modp(C, layer + 1, mg, 1), lane, h);
            row_store_bf16(WSP(bf16_t, WS_H) + (size_t)row * DM, lane, h);
        } else {
#pragma unroll
            for (int j = 0; j < 4; ++j) { const int c = (lane + 64 * j) * 4; *(f32x4*)(C.out + (size_t)row * DM + c) = v[j] * rstd * *(const f32x4*)(C.A.in[8] + c); }
        }
    }
}

constexpr int N_PHASE_IDS = 2 + 12 * 4;
__host__ __device__ inline bool phase_exists(int p) { if (p < 2) return true; const int l = (p - 2) / 12, k = (p - 2) % 12; if (k == 11) return false; if (l & 1) return !(k >= 2 && k <= 4); return true; }

__global__ void __launch_bounds__(512, 2) fwd(Args args) {
    extern __shared__ __attribute__((aligned(16))) unsigned char lds_raw[];
    const int tid_ = threadIdx.x, wave_ = __builtin_amdgcn_readfirstlane(tid_ >> 6);
    const Ctx C0{args, args.out, args.ws, (LAS unsigned char*)lds_raw, tid_, tid_ & 63, wave_, (int)gridDim.x, (int)blockIdx.x, (int)blockIdx.x * 8 + wave_, (int)gridDim.x * 8};
    volatile LAS unsigned* MISC = (volatile LAS unsigned*)(C0.lds + LDSCTL_OFF);
    if (C0.tid < 128) MISC[C0.tid] = 0u;
    __syncthreads();
    const int lo = args.ph_lo, hi = args.ph_hi;
    XcdBarrier bar; bar.bar = (unsigned*)(C0.ws + WS_CTL) + CW_BAR; bar.x = 0; bar.st = nullptr;
    if (hi - lo > 1) bar = xcd_barrier_post((unsigned*)(C0.ws + WS_CTL) + CW_BAR, MISC + 8);
#define RUN(p) (lo <= (p) && (p) < hi)
#define SEAM(p) do { if (hi > (p) + 1) xcd_barrier(bar); } while (0)
    LAS unsigned char* ring = C0.lds;

    if (RUN(0)) { const Ctx C = relaunder(C0); if (PON(0)) { p0_convert(C); p0_mod(C); } SEAM(0); }
    if (RUN(1)) { const Ctx C = relaunder(C0); if (PON(1)) p1_init(C); SEAM(1); }

    for (int layer = 0; layer < 4; ++layer) {
        const int base = 2 + 12 * layer, i = layer >> 1;
        const bool need_ctx = layer < 3;
        if (!(layer & 1)) {
            if (RUN(base + 0)) { const Ctx C = relaunder(C0);
                pg8::Gemm g{WSP(const bf16_t, WS_H), WSP(const bf16_t, WS_WIN) + (size_t)i * ZP * 1024, 1024, 1024, 1024}; pg8::StaticOrder S; S.init(NT, ZP, C.G, C.bid);
                pg8::Epi<FStoreBf16, false> E{{WSP(bf16_t, WS_Z), ZP, 1.f, 0}};
                if (PON(2)) pg8::gemm_phase(ring, g, S, E); SEAM(base + 0); }
            if (RUN(base + 1)) { const Ctx C = relaunder(C0); if (PON(3)) a2_prepare(C, i); SEAM(base + 1); }
            if (RUN(base + 2)) { const Ctx C = relaunder(C0);
                { pg8::Gemm g{WSP(const bf16_t, WS_LIN), WSP(const bf16_t, WS_WLORA) + (size_t)i * 2560 * 384, 384, 384, 384}; pg8::StaticOrder S; S.init(NT, 2560, C.G, C.bid);
                  pg8::Epi<FLora, false> E{{C.A.in[12] + i * 1024, C.A.in[14] + i * 1024, C.A.in[18] + i * 512, WSP(const bf16_t, WS_KS), WSP(const bf16_t, WS_KK), WSP(float, WS_DEC), WSP(bf16_t, WS_KD), WSP(bf16_t, WS_BB), WSP(bf16_t, WS_G)}};
                  if (PON(4)) pg8::gemm_phase(ring, g, S, E); }
                { pg8::Gemm g{WSP(const bf16_t, WS_QN), WSP(const bf16_t, WS_WQUP) + (size_t)i * 768 * 384, 384, 384, 384}; pg8::StaticOrder S; S.init(NT, 768, C.G, C.bid);
                  pg8::Epi<FQup, false> E{{WSP(bf16_t, WS_Q), WSP(const float, WS_ROPE), ATTN_NAIVE ? 0.10206207261596577f : 0.10206207261596577f * 1.4426950408889634f}};
                  if (PON(16)) pg8::gemm_phase(ring, g, S, E); }
                { pg8::Gemm g{WSP(const bf16_t, WS_KVN), WSP(const bf16_t, WS_WKVUP) + (size_t)i * 1024 * 256, 256, 256, 256}; pg8::StaticOrder S; S.init(NT, 1024, C.G, C.bid);
                  pg8::Epi<FStoreBf16, false> E{{WSP(bf16_t, WS_KV), 1024, 1.f, 0}};
                  if (PON(17)) pg8::gemm_phase(ring, g, S, E); }
                SEAM(base + 2); }
            if (RUN(base + 3)) { const Ctx C = relaunder(C0); if (PON(5)) a4_scan(C); if (PON(6)) { if (ATTN_NAIVE) a4_mla_naive(C); else a4_mla(C); } SEAM(base + 3); }
            if (RUN(base + 4)) { const Ctx C = relaunder(C0); if (PON(7)) a5_output(C, i); SEAM(base + 4); }
        } else {
            if (RUN(base + 0)) { const Ctx C = relaunder(C0);
                pg8::Gemm g{WSP(const bf16_t, WS_H), WSP(const bf16_t, WS_WQKV) + (size_t)i * 3072 * 1024, 1024, 1024, 1024}; pg8::StaticOrder S; S.init(NT, 3072, C.G, C.bid);
                pg8::Epi<FStoreBf16, false> E{{WSP(bf16_t, WS_Z), 3072, ATTN_NAIVE ? 0.125f : 0.125f * 1.4426950408889634f, 1024}};
                if (PON(8)) pg8::gemm_phase(ring, g, S, E); SEAM(base + 0); }
            if (RUN(base + 1)) { const Ctx C = relaunder(C0); if (PON(9)) { if (ATTN_NAIVE) b2_na_naive(C, i, need_ctx); else b2_na(C, i, need_ctx); } SEAM(base + 1); }
        }
        if (RUN(base + 5)) { const Ctx C = relaunder(C0);
            const bf16_t* W = (layer & 1) ? WSP(const bf16_t, WS_WOUTC) + (size_t)i * 1024 * 1024 : WSP(const bf16_t, WS_WOUTA) + (size_t)i * 1024 * 1024;
            pg8::Gemm g{WSP(const bf16_t, WS_MIX), W, 1024, 1024, 1024}; pg8::StaticOrder S; S.init(need_ctx ? NT : NLAT, 1024, C.G, C.bid);
            pg8::Epi<FResid, false> E{{WSP(float, WS_X), WSP(const float, WS_MOD), layer}};
            if (PON(10)) pg8::gemm_phase(ring, g, S, E); SEAM(base + 5); }
        if (RUN(base + 6)) { const Ctx C = relaunder(C0); if (PON(11)) c2_router(C, layer, need_ctx ? NT : NLAT); SEAM(base + 6); }
        if (RUN(base + 7)) { const Ctx C = relaunder(C0); if (PON(12)) c3_topk(C, need_ctx); SEAM(base + 7); }
        if (RUN(base + 8)) { const Ctx C = relaunder(C0);
            pg8::Gemm g{WSP(const bf16_t, WS_XIN), WSP(const bf16_t, WS_W13) + (size_t)layer * 16 * 4096 * 1024, 1024, 1024, 1024}; pg8::MoeOrder S; S.init(need_ctx ? 9 : 8, 16, C.G, C.bid);
            pg8::Epi<FSwiglu, true> E{{WSP(bf16_t, WS_HID)}};
            if (PON(13)) pg8::gemm_phase(ring, g, S, E); SEAM(base + 8); }
        if (RUN(base + 9)) { const Ctx C = relaunder(C0);
            pg8::Gemm g{WSP(const bf16_t, WS_HID), WSP(const bf16_t, WS_W2) + (size_t)layer * 16 * 1024 * 2048, 2048, 2048, 2048}; pg8::MoeOrder S; S.init(need_ctx ? 9 : 8, 4, C.G, C.bid);
            pg8::Epi<FGate, false> E{{WSP(bf16_t, WS_YB), WSP(const float, WS_GATE)}};
            if (PON(14)) pg8::gemm_phase(ring, g, S, E); SEAM(base + 9); }
        if (RUN(base + 10)) { const Ctx C = relaunder(C0); if (PON(15)) c6_combine(C, layer, need_ctx ? NT : NLAT); if (layer < 3) SEAM(base + 10); }
    }
#undef RUN
#undef SEAM
}

extern "C" void kernel_launch(void* const* d_in, const int* in_sizes, int n_in, void* d_out, int out_size, void* d_ws, size_t ws_size, hipStream_t stream) {
    static int grid = 0;
    if (grid == 0) {
        if (n_in != 33 || out_size != NLAT * DM || ws_size < WS_END) { fprintf(stderr, "kernel_launch: unexpected shapes (n_in %d out %d ws %zu need %zu)\n", n_in, out_size, ws_size, (size_t)WS_END); grid = -1; return; }
        int dev = 0, cus = 0, per_cu = 0;
        if (hipGetDevice(&dev) != hipSuccess || hipDeviceGetAttribute(&cus, hipDeviceAttributeMultiprocessorCount, dev) != hipSuccess) { grid = -1; return; }
        if (hipFuncSetAttribute((const void*)fwd, hipFuncAttributeMaxDynamicSharedMemorySize, LDS_BYTES) != hipSuccess) { fprintf(stderr, "kernel_launch: hipFuncSetAttribute failed\n"); grid = -1; return; }
        if (hipOccupancyMaxActiveBlocksPerMultiprocessor(&per_cu, (const void*)fwd, 512, LDS_BYTES) != hipSuccess || per_cu < 1) fprintf(stderr, "kernel_launch: occupancy query says %d\n", per_cu);
        (void)hipGetLastError();
        grid = cus;
    }
    if (grid < 0) return;
    (void)hipMemsetAsync((char*)d_ws + WS_CTL, 0, CTL_BYTES, stream);
    Args a{};
    for (int i = 0; i < 33; ++i) a.in[i] = (const float*)d_in[i];
    a.out = (float*)d_out; a.ws = (unsigned char*)d_ws;
#if SINGLE_LAUNCH
    a.ph_lo = 0; a.ph_hi = N_PHASE_IDS;
    hipLaunchKernelGGL(fwd, dim3(grid), dim3(512), LDS_BYTES, stream, a);
#else
    for (int p = 0; p < N_PHASE_IDS; ++p) { if (!phase_exists(p)) continue; a.ph_lo = p; a.ph_hi = p + 1; hipLaunchKernelGGL(fwd, dim3(grid), dim3(512), LDS_BYTES, stream, a); }
#endif
}
```

```cpp
#include <hip/hip_runtime.h>
#include <cstdio>
#include <cstdint>

#ifndef PHMASK
#define PHMASK 0xFFFFFFFFu
#endif
#define PON(n) (((PHMASK) >> (n)) & 1u)
#ifndef PROBE_MASK
#define PROBE_MASK 0u
#endif
#define PH(n, ...) do { if (PON(n)) { if (((PROBE_MASK) >> (n)) & 1u) { const unsigned long long t0_ = __builtin_amdgcn_s_memrealtime(); { __VA_ARGS__; } __syncthreads(); const unsigned long long d_ = __builtin_amdgcn_s_memrealtime() - t0_; while (__builtin_amdgcn_s_memrealtime() - t0_ < 2 * d_) __builtin_amdgcn_s_sleep(8); } else { __VA_ARGS__; } } } while (0)
#ifndef ATTN_NAIVE
#define ATTN_NAIVE 0
#endif
#ifndef SINGLE_LAUNCH
#define SINGLE_LAUNCH 1
#endif

#define LAS __attribute__((address_space(3)))
#define GAS __attribute__((address_space(1)))
typedef unsigned short bf16_t;
typedef short bf16x8 __attribute__((ext_vector_type(8)));
typedef float f32x4 __attribute__((ext_vector_type(4)));
typedef float f32x2 __attribute__((ext_vector_type(2)));
typedef unsigned u32x4 __attribute__((ext_vector_type(4)));
typedef unsigned u32x2 __attribute__((ext_vector_type(2)));

constexpr int NB = 8, SEQ = 2048, CTXL = 256, DM = 1024;
constexpr int NLAT = NB * SEQ, NCTX = NB * CTXL, NT = NLAT + NCTX;
constexpr int ADIM = 512, ZP = 2816;
constexpr int NEXP = 16, FF = 2048, ROWS_E = 2304;
constexpr float NORM_EPS = 1e-6f;

constexpr size_t MiB = 1u << 20;
constexpr size_t WS_CTL = 0, CTL_BYTES = 1 * MiB;
constexpr size_t WS_MOD = 1 * MiB;
constexpr size_t WS_ROPE = 2 * MiB;
constexpr size_t WS_WIN = 4 * MiB;
constexpr size_t WS_WLORA = 16 * MiB;
constexpr size_t WS_WQUP = 20 * MiB;
constexpr size_t WS_WKVUP = 22 * MiB;
constexpr size_t WS_WOUTA = 24 * MiB;
constexpr size_t WS_WQKV = 28 * MiB;
constexpr size_t WS_WOUTC = 40 * MiB;
constexpr size_t WS_W13 = 48 * MiB;
constexpr size_t WS_W2 = 560 * MiB;
constexpr size_t WS_X = 816 * MiB;
constexpr size_t WS_H = 888 * MiB;
constexpr size_t WS_MIX = 924 * MiB;
constexpr size_t WS_Z = 960 * MiB;
constexpr size_t WS_R = 1068 * MiB;
constexpr size_t WS_V = 1086 * MiB;
constexpr size_t WS_KS = 1104 * MiB;
constexpr size_t WS_KK = 1122 * MiB;
constexpr size_t WS_LIN = 1140 * MiB;
constexpr size_t WS_QN = 1154 * MiB;
constexpr size_t WS_KVN = 1168 * MiB;
constexpr size_t WS_KR = 1177 * MiB;
constexpr size_t WS_DEC = 1179 * MiB;
constexpr size_t WS_KD = 1251 * MiB;
constexpr size_t WS_BB = 1287 * MiB;
constexpr size_t WS_G = 1323 * MiB;
constexpr size_t WS_Y = 1341 * MiB;
constexpr size_t WS_Q = 1413 * MiB;
constexpr size_t WS_KV = 1440 * MiB;
constexpr size_t WS_AFF = 1476 * MiB;
constexpr size_t WS_SEL = 1478 * MiB;
constexpr size_t WS_IDX = 1480 * MiB;
constexpr size_t WS_GATE = 1481 * MiB;
constexpr size_t WS_XIN = 1482 * MiB;
constexpr size_t WS_HID = 1554 * MiB;
constexpr size_t WS_YB = 1698 * MiB;
constexpr size_t WS_END = 1770 * MiB;

constexpr int CW_TMO = 0, CW_BAR = 4096, CW_QUEUE = 8192;

constexpr int RING_BYTES = 133120;
constexpr int LDSCTL_OFF = RING_BYTES;
constexpr int LDS_BYTES = 147456;

__device__ __forceinline__ float bf2f(unsigned short b) { return __uint_as_float(((unsigned)b) << 16); }
__device__ __forceinline__ unsigned f2bf(float f) { unsigned u = __float_as_uint(f); return (u + 0x7fffu + ((u >> 16) & 1u)) >> 16; }
__device__ __forceinline__ unsigned pk2(float lo, float hi) { return f2bf(lo) | (f2bf(hi) << 16); }
__device__ __forceinline__ void unpk8(const u32x4 w, float (&f)[8]) {
    f[0] = __uint_as_float(w.x << 16); f[1] = __uint_as_float(w.x & 0xffff0000u); f[2] = __uint_as_float(w.y << 16); f[3] = __uint_as_float(w.y & 0xffff0000u);
    f[4] = __uint_as_float(w.z << 16); f[5] = __uint_as_float(w.z & 0xffff0000u); f[6] = __uint_as_float(w.w << 16); f[7] = __uint_as_float(w.w & 0xffff0000u); }
__device__ __forceinline__ void ld8(const bf16_t* p, float (&f)[8]) { unpk8(*(const u32x4*)p, f); }
__device__ __forceinline__ u32x4 pack8(const float (&f)[8]) { u32x4 w; w.x = pk2(f[0], f[1]); w.y = pk2(f[2], f[3]); w.z = pk2(f[4], f[5]); w.w = pk2(f[6], f[7]); return w; }
__device__ __forceinline__ void st8(bf16_t* p, const float (&f)[8]) { *(u32x4*)p = pack8(f); }
__device__ __forceinline__ float wave_sum_slow(float v) {
#pragma unroll
    for (int o = 1; o < 64; o <<= 1) v += __shfl_xor(v, o);
    return v; }
template <int CTRL> __device__ __forceinline__ float dpp_f(float x) { return __int_as_float(__builtin_amdgcn_update_dpp(0, __float_as_int(x), CTRL, 0xF, 0xF, true)); }
__device__ __forceinline__ float sum8(float v) { v += dpp_f<0xB1>(v); v += dpp_f<0x4E>(v); v += dpp_f<0x141>(v); return v; }
__device__ __forceinline__ float sum16(float v) { v = sum8(v); v += dpp_f<0x140>(v); return v; }
__device__ __forceinline__ float wave_sum(float v) { v = sum16(v); v += __shfl_xor(v, 16); v += __shfl_xor(v, 32); return v; }
__device__ __forceinline__ float sigmoidf_(float x) { return 1.f / (1.f + __expf(-x)); }
__device__ __forceinline__ int mod_group(int row) { return row < NLAT ? (row >> 11) : NB; }

namespace pg8 {
constexpr int BM = 256, BK = 64, HALF = 128, HTB = HALF * BK * 2, STAGE_BYTES = 8 * HTB, NXCD = 8, WGM = 8;
__host__ __device__ __forceinline__ int lds_byte(int r, int c) { const int st = (r >> 4) * 2 + (c >> 5), rr = r & 15, cc = c & 31, ob = rr * 64 + cc * 2; return st * 1024 + (ob ^ (((ob >> 9) & 1) << 5)); }
__host__ __device__ __forceinline__ void stage_rc(int b, int& R, int& C) { const int st = b / 1024, sb = b % 1024, swz = sb ^ (((sb >> 9) & 1) << 5); R = (st >> 1) * 16 + swz / 64; C = (st & 1) * 32 + (swz % 64) / 2; }
__host__ __device__ __forceinline__ int perm32(int rho) { const int n = rho >> 4, i = rho & 15; return 8 * (i >> 2) + 4 * n + (i & 3); }
struct Unit { int pm, pn; };
struct Gemm { const bf16_t* A; const bf16_t* Bt; int lda, ldb, K; };

struct StaticOrder {
    int nM, nN, nwg, G, c;
    __device__ void init(int M, int N, int G_, int c_) { nM = M / BM; nN = N / BM; nwg = nM * nN; G = G_; c = c_; }
    __device__ bool next(int i, Unit& u) const {
        const long L = (long)i * G + c; if (L >= nwg) return false;
        int wgid = (int)L; { const int q = nwg / NXCD, r = nwg % NXCD, xcd = wgid % NXCD, off = wgid / NXCD; wgid = (xcd < r ? xcd * (q + 1) : r * (q + 1) + (xcd - r) * q) + off; }
        const int nig = WGM * nN, gid = wgid / nig, fm = gid * WGM, gsz = (nM - fm) < WGM ? (nM - fm) : WGM;
        u.pm = fm + ((wgid % nig) % gsz); u.pn = (wgid % nig) / gsz; return true;
    }
};
struct MoeOrder {
    int nrt, nct, nwg, G, c;
    __device__ void init(int nrt_, int nct_, int G_, int c_) { nrt = nrt_; nct = nct_; nwg = NEXP * nrt * nct; G = G_; c = c_; }
    __device__ bool next(int i, Unit& u) const {
        const long L = (long)i * G + c; if (L >= nwg) return false;
        const int wgid = (int)(L % NXCD) * (nwg / NXCD) + (int)(L / NXCD);
        const int per = nrt * nct, e = wgid / per, rem = wgid % per, ct = rem / nrt, rt = rem % nrt;
        u.pm = e * 9 + rt; u.pn = e * nct + ct; return true;
    }
};

template <class F, bool PAIR> struct Epi {
    F f;
    __device__ __forceinline__ void operator()(const f32x4 (&acc)[2][2][4][2], const Unit& u, int wr, int wc, int fr, int fq) const {
#pragma unroll
        for (int ai = 0; ai < 2; ++ai)
#pragma unroll
            for (int m = 0; m < 4; ++m) {
                const int row = u.pm * BM + ai * HALF + wr * 64 + m * 16 + fr;
                if constexpr (PAIR) {
                    float a[8], b[8];
#pragma unroll
                    for (int j = 0; j < 4; ++j) { a[j] = acc[ai][0][m][0][j]; a[4 + j] = acc[ai][0][m][1][j]; b[j] = acc[ai][1][m][0][j]; b[4 + j] = acc[ai][1][m][1][j]; }
                    f(row, u.pn * HALF + wc * 32 + 8 * fq, a, b);
                } else {
#pragma unroll
                    for (int bj = 0; bj < 2; ++bj) { float a[8];
#pragma unroll
                        for (int j = 0; j < 4; ++j) { a[j] = acc[ai][bj][m][0][j]; a[4 + j] = acc[ai][bj][m][1][j]; }
                        f(row, u.pn * BM + bj * HALF + wc * 32 + 8 * fq, a); }
                }
            }
    }
};

template <class EpiT, class Sched>
__device__ __forceinline__ void gemm_phase(LAS unsigned char* lds, const Gemm g, const Sched& S, const EpiT& E) {
    int tid = threadIdx.x; asm volatile("" : "+v"(tid));
    const int wid = __builtin_amdgcn_readfirstlane(tid >> 6), lane = tid & 63, wr = wid >> 2, wc = wid & 3, fr = lane & 15, fq = lane >> 4;
    const int K = g.K, nt = K / BK;
    unsigned voffA[2], voffB[2];
#pragma unroll
    for (int i = 0; i < 2; ++i) { int R, C; stage_rc(tid * 16 + i * 8192, R, C); const int Rb = (R & ~31) + perm32(R & 31);
        voffA[i] = (unsigned)(R * g.lda + C) * 2u; voffB[i] = (unsigned)(Rb * g.ldb + C) * 2u; }
    const size_t kstep = (size_t)(BK * 2);
    const size_t hsA = (size_t)HALF * g.lda * 2, hsB = (size_t)HALF * g.ldb * 2, tsA = 2 * hsA, tsB = 2 * hsB;
    const unsigned ldsw = (unsigned)wid * 1024u;
    const int aoff = lds_byte(wr * 64 + fr, fq * 8), boff = lds_byte(wc * 32 + fr, fq * 8);
#define PG8_SA(b, h) (((b) * 2 + (h)) * HTB)
#define PG8_SB(b, h) ((4 + (b) * 2 + (h)) * HTB)
#define PG8_STAGE(bufoff, gbase, voff) do { _Pragma("unroll") for (int _i = 0; _i < 2; ++_i) \
        __builtin_amdgcn_global_load_lds((const unsigned*)((const char*)(gbase) + (voff)[_i]), (LAS unsigned*)(lds + (bufoff) + ldsw + _i * 8192), 16, 0, 0); } while (0)
#define PG8_LDA(dst, b, h) do { _Pragma("unroll") for (int m = 0; m < 4; ++m) _Pragma("unroll") for (int k = 0; k < 2; ++k) dst[m][k] = *(const LAS bf16x8*)(lds + PG8_SA(b, h) + aoff + m * 2048 + k * 1024); } while (0)
#define PG8_LDB(dst, b, h) do { _Pragma("unroll") for (int n = 0; n < 2; ++n) _Pragma("unroll") for (int k = 0; k < 2; ++k) dst[n][k] = *(const LAS bf16x8*)(lds + PG8_SB(b, h) + boff + n * 2048 + k * 1024); } while (0)
#define PG8_MMA(ai, bj, At, Bt) do { __builtin_amdgcn_s_setprio(1); _Pragma("unroll") for (int m = 0; m < 4; ++m) _Pragma("unroll") for (int n = 0; n < 2; ++n) _Pragma("unroll") for (int k = 0; k < 2; ++k) \
        acc[ai][bj][m][n] = __builtin_amdgcn_mfma_f32_16x16x32_bf16(Bt[n][k], At[m][k], acc[ai][bj][m][n], 0, 0, 0); __builtin_amdgcn_s_setprio(0); } while (0)
#define PG8_WAIT_V(n) asm volatile("s_waitcnt vmcnt(" #n ")" ::: "memory")
#define PG8_WAIT_L(n) asm volatile("s_waitcnt lgkmcnt(" #n ")" ::: "memory")
#define PG8_BAR __builtin_amdgcn_s_barrier()
#define PG8_SCHED __builtin_amdgcn_sched_barrier(0)
    Unit cur, nxt; int ui = 0;
    if (!S.next(0, cur)) return;
    f32x4 acc[2][2][4][2];
#pragma unroll
    for (int a = 0; a < 2; ++a)
#pragma unroll
        for (int b = 0; b < 2; ++b)
#pragma unroll
            for (int m = 0; m < 4; ++m)
#pragma unroll
                for (int n = 0; n < 2; ++n) acc[a][b][m][n] = (f32x4){0.f, 0.f, 0.f, 0.f};
    bf16x8 At[4][2], B0[2][2], B1[2][2];
    const char* cA = (const char*)g.A + (size_t)cur.pm * tsA; const char* cB = (const char*)g.Bt + (size_t)cur.pn * tsB;
    PG8_STAGE(PG8_SB(0, 0), cB, voffB); PG8_STAGE(PG8_SB(0, 1), cB + hsB, voffB); PG8_STAGE(PG8_SA(0, 0), cA, voffA); PG8_STAGE(PG8_SA(0, 1), cA + hsA, voffA);
    if (wr == 1) PG8_BAR;
    PG8_WAIT_V(2); PG8_BAR;
    PG8_STAGE(PG8_SB(1, 0), cB + kstep, voffB); PG8_STAGE(PG8_SA(1, 0), cA + kstep, voffA); PG8_STAGE(PG8_SB(1, 1), cB + hsB + kstep, voffB);
    PG8_WAIT_V(6); PG8_BAR;
    for (;;) {
        const bool has_next = S.next(ui + 1, nxt);
        const char* nA = has_next ? (const char*)g.A + (size_t)nxt.pm * tsA : cA; const char* nB = has_next ? (const char*)g.Bt + (size_t)nxt.pn * tsB : cB;
#pragma unroll 1
        for (int t = 0; t < nt; t += 2) {
            const bool last = (t == nt - 2);
            const char* a1 = cA + (size_t)(t + 1) * kstep;
            const char* a2 = last ? nA : cA + (size_t)(t + 2) * kstep; const char* b2 = last ? nB : cB + (size_t)(t + 2) * kstep;
            const char* a3 = a2 + kstep; const char* b3 = b2 + kstep;
            PG8_LDB(B0, 0, 0); PG8_LDB(B1, 0, 1); PG8_SCHED; PG8_LDA(At, 0, 0); PG8_STAGE(PG8_SA(1, 1), a1 + hsA, voffA);
            PG8_WAIT_V(8); PG8_WAIT_L(0); PG8_BAR; PG8_MMA(0, 0, At, B0); PG8_MMA(0, 1, At, B1); PG8_BAR; PG8_SCHED;
            PG8_LDA(At, 0, 1); PG8_STAGE(PG8_SB(0, 0), b2, voffB); PG8_STAGE(PG8_SB(0, 1), b2 + hsB, voffB); PG8_STAGE(PG8_SA(0, 0), a2, voffA);
            PG8_WAIT_V(8); PG8_WAIT_L(0); PG8_BAR; PG8_MMA(1, 0, At, B0); PG8_MMA(1, 1, At, B1); PG8_BAR; PG8_SCHED;
            PG8_LDB(B0, 1, 0); PG8_LDB(B1, 1, 1); PG8_SCHED; PG8_LDA(At, 1, 0); PG8_STAGE(PG8_SA(0, 1), a2 + hsA, voffA);
            PG8_WAIT_V(8); PG8_WAIT_L(0); PG8_BAR; PG8_MMA(0, 0, At, B0); PG8_MMA(0, 1, At, B1); PG8_BAR; PG8_SCHED;
            PG8_LDA(At, 1, 1); PG8_STAGE(PG8_SB(1, 0), b3, voffB); PG8_STAGE(PG8_SB(1, 1), b3 + hsB, voffB); PG8_STAGE(PG8_SA(1, 0), a3, voffA);
            PG8_WAIT_V(8); PG8_WAIT_L(0); PG8_BAR; PG8_MMA(1, 0, At, B0); PG8_MMA(1, 1, At, B1); PG8_BAR; PG8_SCHED;
        }
        if (wr == 0) PG8_BAR;
        E(acc, cur, wr, wc, fr, fq);
        if (!has_next) break;
#pragma unroll
        for (int a = 0; a < 2; ++a)
#pragma unroll
            for (int b = 0; b < 2; ++b)
#pragma unroll
                for (int m = 0; m < 4; ++m)
#pragma unroll
                    for (int n = 0; n < 2; ++n) acc[a][b][m][n] = (f32x4){0.f, 0.f, 0.f, 0.f};
        cur = nxt; cA = nA; cB = nB; ++ui;
        if (wr == 1) PG8_BAR;
    }
    PG8_WAIT_V(0);
    PG8_BAR;
#undef PG8_SA
#undef PG8_SB
#undef PG8_STAGE
#undef PG8_LDA
#undef PG8_LDB
#undef PG8_MMA
#undef PG8_WAIT_V
#undef PG8_WAIT_L
#undef PG8_BAR
#undef PG8_SCHED
}
}

#define XB_TMO      128
#define XB_XCNT(j)  (256  + 64 * (j))
#define XB_XSUB(j)  (1280 + 64 * (j))
#define XB_XGEN(j)  (2304 + 64 * (j))
#define XB_TOP      3328
#define XB_TOPGEN   3392
#define XCD_BAR_WORDS 3456
#define XB_SPIN_CAP (1u << 22)
__device__ __forceinline__ unsigned xb_ld(unsigned* p)              { return __hip_atomic_load(p, __ATOMIC_RELAXED, __HIP_MEMORY_SCOPE_AGENT); }
__device__ __forceinline__ unsigned xb_add(unsigned* p, unsigned v) { return __hip_atomic_fetch_add(p, v, __ATOMIC_RELAXED, __HIP_MEMORY_SCOPE_AGENT); }
__device__ __forceinline__ unsigned xb_xcc_id() { return (unsigned)__builtin_amdgcn_s_getreg((3 << 11) | 20) & 0xFu; }
#define XB_SPIN(cond, bar) do { unsigned _sp = 0; while (cond) { __builtin_amdgcn_s_sleep(1); \
    if ((++_sp & 255u) == 0u) { if (xb_ld(&(bar)[XB_TMO])) break; if (_sp > XB_SPIN_CAP) { atomicAdd(&(bar)[XB_TMO], 1u); break; } } } } while (0)
struct XcdBarrier { unsigned* bar; unsigned x; volatile LAS unsigned* st; };
__device__ __forceinline__ XcdBarrier xcd_barrier_post(unsigned* bar, volatile LAS unsigned* st) {
    XcdBarrier b; b.bar = bar; b.x = xb_xcc_id(); b.st = st;
    if (threadIdx.x == 0) (void)xb_add(&bar[XB_XCNT(b.x)], 1u);
    return b;
}
__device__ __forceinline__ void xcd_barrier_complete(unsigned* bar, unsigned x, unsigned& nloc, unsigned& nx) {
    const unsigned G = gridDim.x * gridDim.y * gridDim.z;
    unsigned sum, cnt, mine, sp = 0u;
    for (;;) {
        sum = 0u; cnt = 0u; mine = 0u;
#pragma unroll
        for (unsigned j = 0; j < 16; ++j) { const unsigned c = xb_ld(&bar[XB_XCNT(j)]); sum += c; cnt += (c > 0u) ? 1u : 0u; mine = (j == x) ? c : mine; }
        if (sum == G) break;
        __builtin_amdgcn_s_sleep(1);
        if ((++sp & 255u) == 0u) { if (xb_ld(&bar[XB_TMO])) break; if (sp > XB_SPIN_CAP) { atomicAdd(&bar[XB_TMO], 1u); break; } }
    }
    nloc = mine > 0u ? mine : 1u; nx = cnt > 0u ? cnt : 1u;
}
__device__ __forceinline__ void xcd_barrier(const XcdBarrier& b) {
    asm volatile("s_waitcnt vmcnt(0)" ::: "memory");
    __syncthreads();
    if (threadIdx.x == 0) {
        unsigned* bar = b.bar;
        __builtin_amdgcn_s_waitcnt(0);
        unsigned nloc = b.st[0], nx = b.st[1];
        if (nloc == 0u) { xcd_barrier_complete(bar, b.x, nloc, nx); b.st[0] = nloc; b.st[1] = nx; }
        const unsigned old = xb_add(&bar[XB_XSUB(b.x)], 1u);
        const unsigned gen = old / nloc;
        if (old + 1u == (gen + 1u) * nloc) {
            __builtin_amdgcn_fence(__ATOMIC_RELEASE, "agent");
            asm volatile("s_waitcnt vmcnt(0)" ::: "memory");
            const unsigned og = xb_add(&bar[XB_TOP], 1u);
            const unsigned tg = og / nx;
            if (og + 1u == (tg + 1u) * nx) xb_add(&bar[XB_TOPGEN], 1u);
            else XB_SPIN(xb_ld(&bar[XB_TOPGEN]) == tg, bar);
            __builtin_amdgcn_fence(__ATOMIC_ACQUIRE, "agent");
            xb_add(&bar[XB_XGEN(b.x)], 1u);
            asm volatile("s_waitcnt vmcnt(0)" ::: "memory");
        } else {
            XB_SPIN(xb_ld(&bar[XB_XGEN(b.x)]) == gen, bar);
            __builtin_amdgcn_fence(__ATOMIC_ACQUIRE, "agent");
            asm volatile("s_waitcnt vmcnt(0)" ::: "memory");
        }
    }
    __syncthreads();
}

struct Args { const float* in[33]; float* out; unsigned char* ws; int ph_lo, ph_hi; };
struct Ctx {
    const Args& A; float* out; unsigned char* ws;
    LAS unsigned char* lds; int tid, lane, wave, G, bid, gw, ngw;
};
#define WSP(T, off) ((T*)(C.ws + (off)))
__device__ __forceinline__ Ctx relaunder(const Ctx& C0) {
    int tid = C0.tid; unsigned char* ws = C0.ws; LAS unsigned char* lds = C0.lds;
    asm volatile("" : "+v"(tid), "+s"(ws));
    const int wave = __builtin_amdgcn_readfirstlane(tid >> 6);
    return Ctx{C0.A, C0.out, ws, lds, tid, tid & 63, wave, C0.G, C0.bid, C0.bid * 8 + wave, C0.G * 8};
}
__device__ __forceinline__ const float* modp(const Ctx& C, int layer, int mg, int chunk) { return WSP(const float, WS_MOD) + ((size_t)(layer * 9 + mg) * 6 + chunk) * 1024; }

__device__ __forceinline__ void tr_item(const float* src, int ld_src, int nvalid, int k0, int n0, bf16_t* dst, int ld_dst, int drow0, int dk0, LAS float* scr, int lane) {
    {
        const int n = (lane & 15) * 4; const bool ok = (n0 + n) < nvalid;
#pragma unroll 4
        for (int i = 0; i < 16; ++i) { const int k = 4 * i + (lane >> 4);
            f32x4 v = (f32x4){0.f, 0.f, 0.f, 0.f};
            if (ok) v = *(const f32x4*)(src + (size_t)(k0 + k) * ld_src + n0 + n);
            LAS float* s = scr + k * 65 + n; s[0] = v.x; s[1] = v.y; s[2] = v.z; s[3] = v.w; }
    }
    asm volatile("s_waitcnt lgkmcnt(0)" ::: "memory");
    const int c = lane & 7;
#pragma unroll
    for (int jj = 0; jj < 8; ++jj) { const int nl = (lane >> 3) + 8 * jj; const LAS float* s = scr + (8 * c) * 65 + nl;
        u32x4 o; o.x = pk2(s[0 * 65], s[1 * 65]); o.y = pk2(s[2 * 65], s[3 * 65]); o.z = pk2(s[4 * 65], s[5 * 65]); o.w = pk2(s[6 * 65], s[7 * 65]);
        if (n0 + nl < nvalid) *(u32x4*)(dst + (size_t)(drow0 + nl) * ld_dst + dk0 + 8 * c) = o; }
    asm volatile("s_waitcnt lgkmcnt(0)" ::: "memory");
}
constexpr int CV_SMALL = 2120, CV_MOE = 4 * 16 * 3 * 512;
__device__ __forceinline__ void p0_convert(const Ctx& C) {
    LAS float* scr = (LAS float*)(C.lds + C.wave * 16640);
    for (int it = C.gw; it < 2 * CV_SMALL + CV_MOE; it += C.ngw) {
        const float* src; int ld_src, nvalid, k0, n0, ld_dst, drow0, dk0; bf16_t* dst;
        if (it < 2 * CV_SMALL) {
            const int i = it / CV_SMALL; int r = it % CV_SMALL;
            if (r < 656) { src = C.A.in[9] + (size_t)i * 1024 * 2592; ld_src = 2592; nvalid = 2592; k0 = (r / 41) * 64; n0 = (r % 41) * 64; dst = WSP(bf16_t, WS_WIN) + (size_t)i * ZP * 1024; ld_dst = 1024; drow0 = n0; dk0 = k0; }
            else if ((r -= 656) < 16) { const int d = r >> 3; src = C.A.in[13] + (size_t)(i * 2 + d) * 64 * 512; ld_src = 512; nvalid = 512; k0 = 0; n0 = (r & 7) * 64; dst = WSP(bf16_t, WS_WLORA) + (size_t)i * 2560 * 384; ld_dst = 384; drow0 = d * 512 + n0; dk0 = d * 64; }
            else if ((r -= 16) < 16) { const int d = r >> 3; src = C.A.in[15] + (size_t)(i * 2 + d) * 64 * 512; ld_src = 512; nvalid = 512; k0 = 0; n0 = (r & 7) * 64; dst = WSP(bf16_t, WS_WLORA) + (size_t)i * 2560 * 384; ld_dst = 384; drow0 = 1024 + d * 512 + n0; dk0 = 128 + d * 64; }
            else if ((r -= 16) < 16) { src = C.A.in[16] + (size_t)i * 128 * 512; ld_src = 512; nvalid = 512; k0 = (r >> 3) * 64; n0 = (r & 7) * 64; dst = WSP(bf16_t, WS_WLORA) + (size_t)i * 2560 * 384; ld_dst = 384; drow0 = 2048 + n0; dk0 = 256 + k0; }
            else if ((r -= 16) < 72) { src = C.A.in[23] + (size_t)i * 384 * 768; ld_src = 768; nvalid = 768; k0 = (r / 12) * 64; n0 = (r % 12) * 64; dst = WSP(bf16_t, WS_WQUP) + (size_t)i * 768 * 384; ld_dst = 384; drow0 = n0; dk0 = k0; }
            else if ((r -= 72) < 64) { src = C.A.in[25] + (size_t)i * 256 * 1024; ld_src = 1024; nvalid = 1024; k0 = (r / 16) * 64; n0 = (r % 16) * 64; dst = WSP(bf16_t, WS_WKVUP) + (size_t)i * 1024 * 256; ld_dst = 256; drow0 = n0; dk0 = k0; }
            else if ((r -= 64) < 256) { src = C.A.in[10] + (size_t)i * 1024 * 1024; ld_src = 1024; nvalid = 1024; k0 = (r / 16) * 64; n0 = (r % 16) * 64; dst = WSP(bf16_t, WS_WOUTA) + (size_t)i * 1024 * 1024; ld_dst = 1024; drow0 = n0; dk0 = k0; }
            else if ((r -= 256) < 768) { src = C.A.in[26] + (size_t)i * 1024 * 3072; ld_src = 3072; nvalid = 3072; k0 = (r / 48) * 64; n0 = (r % 48) * 64; dst = WSP(bf16_t, WS_WQKV) + (size_t)i * 3072 * 1024; ld_dst = 1024; drow0 = n0; dk0 = k0; }
            else { r -= 768; src = C.A.in[28] + (size_t)i * 1024 * 1024; ld_src = 1024; nvalid = 1024; k0 = (r / 16) * 64; n0 = (r % 16) * 64; dst = WSP(bf16_t, WS_WOUTC) + (size_t)i * 1024 * 1024; ld_dst = 1024; drow0 = n0; dk0 = k0; }
        } else {
            const int m = it - 2 * CV_SMALL, le = m / 1536, r = m % 1536, which = r / 512, q = r % 512;
            if (which < 2) { src = C.A.in[which == 0 ? 30 : 31] + (size_t)le * 1024 * 2048; ld_src = 2048; nvalid = 2048; k0 = (q / 32) * 64; n0 = (q % 32) * 64;
                dst = WSP(bf16_t, WS_W13) + (size_t)le * 4096 * 1024; ld_dst = 1024; drow0 = (n0 >> 7) * 256 + which * 128 + (n0 & 127); dk0 = k0; }
            else { src = C.A.in[32] + (size_t)le * 2048 * 1024; ld_src = 1024; nvalid = 1024; k0 = (q / 16) * 64; n0 = (q % 16) * 64;
                dst = WSP(bf16_t, WS_W2) + (size_t)le * 1024 * 2048; ld_dst = 2048; drow0 = n0; dk0 = k0; }
        }
        tr_item(src, ld_src, nvalid, k0, n0, dst, ld_dst, drow0, dk0, scr, C.lane);
    }
    const u32x4 z4 = (u32x4){0u, 0u, 0u, 0u};
    const int gt = C.bid * 512 + C.tid, ngt = C.G * 512;
    for (int idx = gt; idx < 2 * 224 * 128; idx += ngt) { const int i = idx / (224 * 128), r = (idx / 128) % 224, ch = idx % 128;
        *(u32x4*)(WSP(bf16_t, WS_WIN) + ((size_t)i * ZP + 2592 + r) * 1024 + ch * 8) = z4; }
    for (int idx = gt; idx < 2 * 2560 * 48; idx += ngt) { const int i = idx / (2560 * 48), r = (idx / 48) % 2560, ch = idx % 48, seg = r >> 9;
        const int lo = seg < 4 ? seg * 8 : 32, hi = seg < 4 ? seg * 8 + 8 : 48;
        if (ch < lo || ch >= hi) *(u32x4*)(WSP(bf16_t, WS_WLORA) + ((size_t)i * 2560 + r) * 384 + ch * 8) = z4; }
    for (int idx = gt; idx < 2048 * 16; idx += ngt) { const int t = idx >> 4, i = idx & 15; const float pos = (float)(i < 8 ? (t >> 6) : (t & 63));
        const float inv = powf(10000.0f, -(float)(i & 7) / 8.0f); const float ang = pos * inv;
        WSP(float, WS_ROPE)[idx * 2] = cosf(ang); WSP(float, WS_ROPE)[idx * 2 + 1] = sinf(ang); }
}
__device__ __forceinline__ void p0_mod(const Ctx& C) {
    LAS float* sc = (LAS float*)C.lds;
    LAS float* part = (LAS float*)(C.lds + 36864);
    __syncthreads();
    for (int idx = C.tid; idx < 9 * 1024; idx += 512) { const int r = idx >> 10, k = idx & 1023; const float cv = r < 8 ? C.A.in[1][r * 1024 + k] : C.A.in[3][k]; sc[idx] = cv / (1.f + __expf(-cv)); }
    __syncthreads();
    for (int unit = C.bid; unit < 192; unit += C.G) {
        const int l = unit / 48, jb = unit % 48, jj = C.tid & 127, kc = C.tid >> 7;
        const float* w = C.A.in[4] + ((size_t)l * 1024 + kc * 256) * 6144 + jb * 128 + jj;
        float acc[9];
#pragma unroll
        for (int r = 0; r < 9; ++r) acc[r] = 0.f;
#pragma unroll 4
        for (int k = 0; k < 256; ++k) { const float wv = w[(size_t)k * 6144];
#pragma unroll
            for (int r = 0; r < 9; ++r) acc[r] += sc[r * 1024 + kc * 256 + k] * wv; }
#pragma unroll
        for (int r = 0; r < 9; ++r) part[(kc * 9 + r) * 128 + jj] = acc[r];
        __syncthreads();
        for (int idx = C.tid; idx < 9 * 128; idx += 512) { const int r = idx >> 7, j2 = idx & 127;
            const float s = part[(0 * 9 + r) * 128 + j2] + part[(1 * 9 + r) * 128 + j2] + part[(2 * 9 + r) * 128 + j2] + part[(3 * 9 + r) * 128 + j2] + C.A.in[5][l * 6144 + jb * 128 + j2];
            WSP(float, WS_MOD)[(size_t)(l * 9 + r) * 6144 + jb * 128 + j2] = s; }
        __syncthreads();
    }
}

__device__ __forceinline__ void row_load(const float* p, int lane, f32x4 (&v)[4]) {
#pragma unroll
    for (int j = 0; j < 4; ++j) v[j] = *(const f32x4*)(p + (lane + 64 * j) * 4); }
__device__ __forceinline__ void row_store(float* p, int lane, const f32x4 (&v)[4]) {
#pragma unroll
    for (int j = 0; j < 4; ++j) *(f32x4*)(p + (lane + 64 * j) * 4) = v[j]; }
__device__ __forceinline__ float row_rstd(const f32x4 (&v)[4]) {
    float s = 0.f;
#pragma unroll
    for (int j = 0; j < 4; ++j) s += (v[j].x * v[j].x + v[j].y * v[j].y) + (v[j].z * v[j].z + v[j].w * v[j].w);
    return rsqrtf(wave_sum(s) * (1.f / 1024.f) + NORM_EPS); }
__device__ __forceinline__ void row_modulate(const f32x4 (&v)[4], float rstd, const float* nw, const float* sh, const float* sc, int lane, f32x4 (&h)[4]) {
#pragma unroll
    for (int j = 0; j < 4; ++j) { const int c = (lane + 64 * j) * 4; const f32x4 w = *(const f32x4*)(nw + c), s1 = *(const f32x4*)(sc + c), s0 = *(const f32x4*)(sh + c);
        h[j] = (v[j] * rstd * w) * (s1 + 1.0f) + s0; } }
__device__ __forceinline__ void row_store_bf16(bf16_t* p, int lane, const f32x4 (&h)[4]) {
#pragma unroll
    for (int j = 0; j < 4; ++j) { u32x2 w; w.x = pk2(h[j].x, h[j].y); w.y = pk2(h[j].z, h[j].w); *(u32x2*)(p + (lane + 64 * j) * 4) = w; } }

__device__ __forceinline__ void p1_init(const Ctx& C) {
    for (int row = C.gw; row < NT; row += C.ngw) {
        const float* src = row < NLAT ? C.A.in[0] + (size_t)row * DM : C.A.in[2] + (size_t)(row - NLAT) * DM;
        f32x4 v[4], h[4]; row_load(src, C.lane, v); row_store(WSP(float, WS_X) + (size_t)row * DM, C.lane, v);
        const int mg = mod_group(row); const float rstd = row_rstd(v);
        row_modulate(v, rstd, C.A.in[6], modp(C, 0, mg, 0), modp(C, 0, mg, 1), C.lane, h);
        row_store_bf16(WSP(bf16_t, WS_H) + (size_t)row * DM, C.lane, h);
    }
}

__device__ __forceinline__ void a2_prepare(const Ctx& C, int i) {
    const bf16_t* Z = WSP(const bf16_t, WS_Z);
    const float* mu = C.A.in[11] + (size_t)i * 2 * 1920;
    const int lane = C.lane;
    for (int row = C.gw; row < NT; row += C.ngw) {
        const bool isctx = row >= NLAT; const int t = isctx ? ((row - NLAT) & 255) : (row & 2047), T = isctx ? 256 : 2048;
        const bf16_t* z = Z + (size_t)row * ZP; const bool hp = t > 0, hn = t < T - 1;
        float r8[8], k8[8], v8[8];
#pragma unroll
        for (int seg = 0; seg < 3; ++seg) {
            const int c0 = seg * 512 + lane * 8; float zc[8], zp[8], zn[8], m0[8], m1[8];
            ld8(z + c0, zc);
            if (hp) ld8(z - ZP + c0, zp); else { for (int j = 0; j < 8; ++j) zp[j] = 0.f; }
            if (hn) ld8(z + ZP + c0, zn); else { for (int j = 0; j < 8; ++j) zn[j] = 0.f; }
            *(f32x4*)&m0[0] = *(const f32x4*)(mu + c0); *(f32x4*)&m0[4] = *(const f32x4*)(mu + c0 + 4);
            *(f32x4*)&m1[0] = *(const f32x4*)(mu + 1920 + c0); *(f32x4*)&m1[4] = *(const f32x4*)(mu + 1920 + c0 + 4);
#pragma unroll
            for (int j = 0; j < 8; ++j) { const float o = zc[j] + m0[j] * (zp[j] - zc[j]) + m1[j] * (zn[j] - zc[j]); if (seg == 0) r8[j] = o; else if (seg == 1) k8[j] = o; else v8[j] = o; }
        }
        st8(WSP(bf16_t, WS_R) + (size_t)row * ADIM + lane * 8, r8);
        st8(WSP(bf16_t, WS_KS) + (size_t)row * ADIM + lane * 8, k8);
        st8(WSP(bf16_t, WS_V) + (size_t)row * ADIM + lane * 8, v8);
        { float kk[8], ss = 0.f; const float* kkw = C.A.in[17] + i * ADIM + lane * 8;
#pragma unroll
            for (int j = 0; j < 8; ++j) { kk[j] = k8[j] * kkw[j]; ss += kk[j] * kk[j]; }
            ss = sum8(ss); const float inv = 1.f / fmaxf(sqrtf(ss), 1e-12f);
#pragma unroll
            for (int j = 0; j < 8; ++j) kk[j] *= inv;
            st8(WSP(bf16_t, WS_KK) + (size_t)row * ADIM + lane * 8, kk); }
#pragma unroll
        for (int seg = 0; seg < 3; ++seg) {
            const int c0 = 1536 + seg * 128 + lane * 2; const unsigned wc_ = *(const unsigned*)(z + c0);
            const unsigned wp_ = hp ? *(const unsigned*)(z - ZP + c0) : 0u, wn_ = hn ? *(const unsigned*)(z + ZP + c0) : 0u;
            float o[2];
#pragma unroll
            for (int j = 0; j < 2; ++j) { const float zc = j ? __uint_as_float(wc_ & 0xffff0000u) : __uint_as_float(wc_ << 16), zp = j ? __uint_as_float(wp_ & 0xffff0000u) : __uint_as_float(wp_ << 16),
                                                      zn = j ? __uint_as_float(wn_ & 0xffff0000u) : __uint_as_float(wn_ << 16);
                const float s = zc + mu[c0 + j] * (zp - zc) + mu[1920 + c0 + j] * (zn - zc);
                o[j] = seg == 0 ? tanhf(s) : (seg == 1 ? s : sigmoidf_(s)); }
            *(unsigned*)(WSP(bf16_t, WS_LIN) + (size_t)row * 384 + seg * 128 + lane * 2) = pk2(o[0], o[1]);
        }
        { float q[6], ss = 0.f;
#pragma unroll
            for (int j = 0; j < 3; ++j) { const unsigned w = *(const unsigned*)(z + 1920 + j * 128 + lane * 2); q[2 * j] = __uint_as_float(w << 16); q[2 * j + 1] = __uint_as_float(w & 0xffff0000u); ss += q[2 * j] * q[2 * j] + q[2 * j + 1] * q[2 * j + 1]; }
            const float rstd = rsqrtf(wave_sum(ss) * (1.f / 384.f) + NORM_EPS); const float* nw = C.A.in[22] + i * 384;
#pragma unroll
            for (int j = 0; j < 3; ++j) { const int c = j * 128 + lane * 2; *(unsigned*)(WSP(bf16_t, WS_QN) + (size_t)row * 384 + c) = pk2(q[2 * j] * rstd * nw[c], q[2 * j + 1] * rstd * nw[c + 1]); } }
        { const u32x2 w = *(const u32x2*)(z + 2304 + lane * 4); float q[4] = {__uint_as_float(w.x << 16), __uint_as_float(w.x & 0xffff0000u), __uint_as_float(w.y << 16), __uint_as_float(w.y & 0xffff0000u)};
            const float ss = q[0] * q[0] + q[1] * q[1] + q[2] * q[2] + q[3] * q[3];
            const float rstd = rsqrtf(wave_sum(ss) * (1.f / 256.f) + NORM_EPS); const float* nw = C.A.in[24] + i * 256 + lane * 4;
            u32x2 o; o.x = pk2(q[0] * rstd * nw[0], q[1] * rstd * nw[1]); o.y = pk2(q[2] * rstd * nw[2], q[3] * rstd * nw[3]);
            *(u32x2*)(WSP(bf16_t, WS_KVN) + (size_t)row * 256 + lane * 4) = o; }
        if (lane < 16) { const unsigned w = *(const unsigned*)(z + 2560 + lane * 2); float x0 = __uint_as_float(w << 16), x1 = __uint_as_float(w & 0xffff0000u);
            if (!isctx) { const float cs = WSP(const float, WS_ROPE)[(t * 16 + lane) * 2], sn = WSP(const float, WS_ROPE)[(t * 16 + lane) * 2 + 1]; const float o0 = x0 * cs - x1 * sn, o1 = x0 * sn + x1 * cs; x0 = o0; x1 = o1; }
            *(unsigned*)(WSP(bf16_t, WS_KR) + (size_t)row * 32 + lane * 2) = pk2(x0, x1); }
    }
}

struct FStoreBf16 { bf16_t* O; int ldo; float scale; int scale_cols;
    __device__ __forceinline__ void operator()(int row, int col, const float (&v)[8]) const { float o[8]; const float s = col < scale_cols ? scale : 1.f;
#pragma unroll
        for (int j = 0; j < 8; ++j) o[j] = v[j] * s;
        st8(O + (size_t)row * ldo + col, o); } };
struct FLora { const float* w0; const float* a0; const float* ka; const bf16_t* KS; const bf16_t* KK; float* DEC; bf16_t* KD; bf16_t* BB; bf16_t* G;
    __device__ __forceinline__ void operator()(int row, int col, const float (&v)[8]) const {
        const int seg = col >> 9, c = col & 511;
        if (seg < 2) { float o[8];
#pragma unroll
            for (int j = 0; j < 8; ++j) { const float x = w0[seg * 512 + c + j] + v[j]; const float sp = fmaxf(-x, 0.f) + __logf(1.f + __expf(-fabsf(x)));
                o[j] = __expf(-__expf(-sp - 0.5f)); }
            float* d = DEC + ((size_t)seg * NT + row) * ADIM + c; *(f32x4*)d = *(const f32x4*)&o[0]; *(f32x4*)(d + 4) = *(const f32x4*)&o[4];
        } else if (seg < 4) { const int d_ = seg - 2; float k[8], kk[8], kd[8], bb[8]; ld8(KS + (size_t)row * ADIM + c, k); ld8(KK + (size_t)row * ADIM + c, kk);
#pragma unroll
            for (int j = 0; j < 8; ++j) { const float a = sigmoidf_(a0[d_ * 512 + c + j] + v[j]); kd[j] = k[j] * (1.f + (a - 1.f) * ka[c + j]); bb[j] = kk[j] * a; }
            st8(KD + ((size_t)d_ * NT + row) * ADIM + c, kd); st8(BB + ((size_t)d_ * NT + row) * ADIM + c, bb);
        } else st8(G + (size_t)row * ADIM + c, v);
    } };
struct FQup { bf16_t* Q; const float* rope; float scale;
    __device__ __forceinline__ void operator()(int row, int col, const float (&v)[8]) const {
        const int d = col % 96; float o[8];
#pragma unroll
        for (int j = 0; j < 8; ++j) o[j] = v[j] * scale;
        if (d >= 64 && row < NLAT) { const int t = row & 2047, p0 = (d - 64) >> 1;
#pragma unroll
            for (int p = 0; p < 4; ++p) { const float cs = rope[(t * 16 + p0 + p) * 2], sn = rope[(t * 16 + p0 + p) * 2 + 1]; const float x0 = o[2 * p], x1 = o[2 * p + 1]; o[2 * p] = x0 * cs - x1 * sn; o[2 * p + 1] = x0 * sn + x1 * cs; } }
        st8(Q + (size_t)row * 768 + col, o);
    } };
struct FResid { float* X; const float* mod; int layer;
    __device__ __forceinline__ void operator()(int row, int col, const float (&v)[8]) const {
        const float* g = mod + ((size_t)(layer * 9 + mod_group(row)) * 6 + 2) * 1024 + col; float* x = X + (size_t)row * DM + col;
        f32x4 x0 = *(const f32x4*)x, x1 = *(const f32x4*)(x + 4); const f32x4 g0 = *(const f32x4*)g, g1 = *(const f32x4*)(g + 4);
        x0 += g0 * (f32x4){v[0], v[1], v[2], v[3]}; x1 += g1 * (f32x4){v[4], v[5], v[6], v[7]};
        *(f32x4*)x = x0; *(f32x4*)(x + 4) = x1;
    } };
struct FSwiglu { bf16_t* HID;
    __device__ __forceinline__ void operator()(int row, int col, const float (&a)[8], const float (&b)[8]) const { float o[8];
#pragma unroll
        for (int j = 0; j < 8; ++j) o[j] = a[j] / (1.f + __expf(-a[j])) * b[j];
        st8(HID + (size_t)row * FF + (col & (FF - 1)), o); } };
struct FGate { bf16_t* YB; const float* gate;
    __device__ __forceinline__ void operator()(int row, int col, const float (&v)[8]) const { const float g = gate[row]; float o[8];
#pragma unroll
        for (int j = 0; j < 8; ++j) o[j] = v[j] * g;
        st8(YB + (size_t)row * DM + (col & (DM - 1)), o); } };

constexpr int SC_TC = 32;
constexpr int SC_ARR = SC_TC * 64, SC_BUF = 6 * SC_ARR + 2 * SC_TC;
__device__ __forceinline__ void a4_scan(const Ctx& C) {
    LAS float* L = (LAS float*)C.lds;
    LAS float* YB_ = L + 2 * SC_BUF;
    const int tid = C.tid, rowi = tid >> 3, j = tid & 7;
    const int ls_ld = tid >> 4, c4 = (tid & 15) * 4;
    for (int unit = C.bid; unit < 128; unit += C.G) {
        const int b = unit >> 4, h = (unit >> 1) & 7, dir = unit & 1;
        const float* DEC = WSP(const float, WS_DEC) + (size_t)dir * NT * ADIM + h * 64;
        const bf16_t* KD = WSP(const bf16_t, WS_KD) + (size_t)dir * NT * ADIM + h * 64;
        const bf16_t* BB = WSP(const bf16_t, WS_BB) + (size_t)dir * NT * ADIM + h * 64;
        const bf16_t* KK = WSP(const bf16_t, WS_KK) + h * 64; const bf16_t* R = WSP(const bf16_t, WS_R) + h * 64; const bf16_t* V = WSP(const bf16_t, WS_V) + h * 64;
        float* Y = WSP(float, WS_Y) + (size_t)dir * NT * ADIM + h * 64;
        auto row_of = [&](int s_) -> int { return s_ < 256 ? NLAT + b * 256 + (dir ? 255 - s_ : s_) : b * 2048 + (dir ? 2047 - (s_ - 256) : (s_ - 256)); };
        f32x4 pw; u32x2 pkd, pbb, pkk, pr, pv;
        auto gload = [&](int chunk) { const size_t o = (size_t)row_of(chunk * SC_TC + ls_ld) * ADIM + c4;
            pw = *(const f32x4*)(DEC + o); pkd = *(const u32x2*)(KD + o); pbb = *(const u32x2*)(BB + o); pkk = *(const u32x2*)(KK + o); pr = *(const u32x2*)(R + o); pv = *(const u32x2*)(V + o); };
        auto up4 = [](const u32x2 p) -> f32x4 { return (f32x4){__uint_as_float(p.x << 16), __uint_as_float(p.x & 0xffff0000u), __uint_as_float(p.y << 16), __uint_as_float(p.y & 0xffff0000u)}; };
        auto lwrite = [&](int buf) { LAS float* Bf = L + buf * SC_BUF + ls_ld * 64 + c4;
            const f32x4 kd4 = up4(pkd), b4 = up4(pbb), r4 = up4(pr);
            *(LAS f32x4*)(Bf) = pw; *(LAS f32x4*)(Bf + SC_ARR) = kd4; *(LAS f32x4*)(Bf + 2 * SC_ARR) = b4; *(LAS f32x4*)(Bf + 3 * SC_ARR) = up4(pkk);
            *(LAS f32x4*)(Bf + 4 * SC_ARR) = pw * r4; *(LAS f32x4*)(Bf + 5 * SC_ARR) = up4(pv);
            float br = (b4.x * r4.x + b4.y * r4.y) + (b4.z * r4.z + b4.w * r4.w), kr = (kd4.x * r4.x + kd4.y * r4.y) + (kd4.z * r4.z + kd4.w * r4.w);
            br = sum16(br); kr = sum16(kr);
            if ((tid & 15) == 0) *(LAS f32x2*)(L + buf * SC_BUF + 6 * SC_ARR + ls_ld * 2) = (f32x2){br, kr}; };
        f32x2 S[4];
#pragma unroll
        for (int q = 0; q < 4; ++q) S[q] = (f32x2){0.f, 0.f};
        __syncthreads();
        gload(0); lwrite(0);
        __syncthreads();
        constexpr int NCH = 2304 / SC_TC;
        for (int ch = 0; ch < NCH; ++ch) {
            if (ch + 1 < NCH) gload(ch + 1);
            const LAS float* Bf = L + (ch & 1) * SC_BUF + j * 8;
            const LAS float* Bv = L + (ch & 1) * SC_BUF + 5 * SC_ARR + rowi;
            const LAS float* Bs = L + (ch & 1) * SC_BUF + 6 * SC_ARR;
            LAS float* yb = YB_ + (ch & 1) * SC_ARR + rowi;
#pragma unroll 4
            for (int ls = 0; ls < SC_TC; ++ls) {
                const LAS float* p = Bf + ls * 64;
                const f32x4 w0 = *(const LAS f32x4*)(p), w1 = *(const LAS f32x4*)(p + 4);
                const f32x4 d0 = *(const LAS f32x4*)(p + SC_ARR), d1 = *(const LAS f32x4*)(p + SC_ARR + 4);
                const f32x4 b0 = *(const LAS f32x4*)(p + 2 * SC_ARR), b1 = *(const LAS f32x4*)(p + 2 * SC_ARR + 4);
                const f32x4 k0 = *(const LAS f32x4*)(p + 3 * SC_ARR), k1 = *(const LAS f32x4*)(p + 3 * SC_ARR + 4);
                const f32x4 r0 = *(const LAS f32x4*)(p + 4 * SC_ARR), r1 = *(const LAS f32x4*)(p + 4 * SC_ARR + 4);
                const float vv = Bv[ls * 64]; const f32x2 sc = *(const LAS f32x2*)(Bs + ls * 2);
                f32x2 a1 = S[0] * (f32x2){k0.x, k0.y}; a1 += S[1] * (f32x2){k0.z, k0.w}; a1 += S[2] * (f32x2){k1.x, k1.y}; a1 += S[3] * (f32x2){k1.z, k1.w};
                f32x2 a2 = S[0] * (f32x2){r0.x, r0.y}; a2 += S[1] * (f32x2){r0.z, r0.w}; a2 += S[2] * (f32x2){r1.x, r1.y}; a2 += S[3] * (f32x2){r1.z, r1.w};
                const float sa = -sum8(a1.x + a1.y), y = sum8(a2.x + a2.y) + sa * sc.x + vv * sc.y;
                const f32x2 sa2 = (f32x2){sa, sa}, vv2 = (f32x2){vv, vv};
                S[0] = S[0] * (f32x2){w0.x, w0.y} + sa2 * (f32x2){b0.x, b0.y} + vv2 * (f32x2){d0.x, d0.y};
                S[1] = S[1] * (f32x2){w0.z, w0.w} + sa2 * (f32x2){b0.z, b0.w} + vv2 * (f32x2){d0.z, d0.w};
                S[2] = S[2] * (f32x2){w1.x, w1.y} + sa2 * (f32x2){b1.x, b1.y} + vv2 * (f32x2){d1.x, d1.y};
                S[3] = S[3] * (f32x2){w1.z, w1.w} + sa2 * (f32x2){b1.z, b1.w} + vv2 * (f32x2){d1.z, d1.w};
                yb[ls * 64] = y;
            }
            if (ch + 1 < NCH) lwrite((ch + 1) & 1);
            __syncthreads();
            *(f32x4*)(Y + (size_t)row_of(ch * SC_TC + ls_ld) * ADIM + c4) = *(const LAS f32x4*)(YB_ + (ch & 1) * SC_ARR + ls_ld * 64 + c4);
        }
    }
}

__device__ __forceinline__ void a4_mla_naive(const Ctx& C) {
    LAS float* Kt = (LAS float*)C.lds;
    LAS float* Vt = Kt + 32 * 96;
    const bf16_t* Q = WSP(const bf16_t, WS_Q); const bf16_t* KV = WSP(const bf16_t, WS_KV); const bf16_t* KR = WSP(const bf16_t, WS_KR); bf16_t* MIX = WSP(bf16_t, WS_MIX);
    const int tid = C.tid;
    for (int unit = C.bid; unit < 320; unit += C.G) {
        int b, h, qrow, nkeys; bool active = true;
        if (unit < 256) { b = unit >> 5; h = (unit >> 2) & 7; qrow = b * 2048 + (unit & 3) * 512 + tid; nkeys = 2304; }
        else { const int u = unit - 256; b = u >> 3; h = u & 7; qrow = NLAT + b * 256 + (tid & 255); nkeys = 256; active = tid < 256; }
        float q[96], acc[64], m = -1e30f, l = 0.f;
#pragma unroll
        for (int d8 = 0; d8 < 12; ++d8) { float t8[8]; ld8(Q + (size_t)qrow * 768 + h * 96 + d8 * 8, t8);
#pragma unroll
            for (int jj = 0; jj < 8; ++jj) q[d8 * 8 + jj] = t8[jj]; }
#pragma unroll
        for (int d = 0; d < 64; ++d) acc[d] = 0.f;
        for (int kt = 0; kt < nkeys; kt += 32) {
            __syncthreads();
            for (int idx = tid; idx < 32 * 48; idx += 512) { const int key = idx / 48, dp = idx % 48, kj = kt + key; const int krow = kj < 256 ? NLAT + b * 256 + kj : b * 2048 + (kj - 256);
                const unsigned w = dp < 32 ? *(const unsigned*)(KV + (size_t)krow * 1024 + h * 128 + dp * 2) : *(const unsigned*)(KR + (size_t)krow * 32 + (dp - 32) * 2);
                Kt[key * 96 + dp * 2] = __uint_as_float(w << 16); Kt[key * 96 + dp * 2 + 1] = __uint_as_float(w & 0xffff0000u); }
            for (int idx = tid; idx < 32 * 32; idx += 512) { const int key = idx >> 5, dp = idx & 31, kj = kt + key; const int krow = kj < 256 ? NLAT + b * 256 + kj : b * 2048 + (kj - 256);
                const unsigned w = *(const unsigned*)(KV + (size_t)krow * 1024 + h * 128 + 64 + dp * 2);
                Vt[key * 64 + dp * 2] = __uint_as_float(w << 16); Vt[key * 64 + dp * 2 + 1] = __uint_as_float(w & 0xffff0000u); }
            __syncthreads();
            for (int key = 0; key < 32; ++key) {
                float s = 0.f;
#pragma unroll
                for (int d4 = 0; d4 < 24; ++d4) { const f32x4 kv = *(const LAS f32x4*)(Kt + key * 96 + d4 * 4); s += q[d4 * 4] * kv.x + q[d4 * 4 + 1] * kv.y + q[d4 * 4 + 2] * kv.z + q[d4 * 4 + 3] * kv.w; }
                const float mn = fmaxf(m, s), corr = __expf(m - mn), p = __expf(s - mn); m = mn; l = l * corr + p;
#pragma unroll
                for (int d4 = 0; d4 < 16; ++d4) { const f32x4 vv = *(const LAS f32x4*)(Vt + key * 64 + d4 * 4);
                    acc[d4 * 4] = acc[d4 * 4] * corr + p * vv.x; acc[d4 * 4 + 1] = acc[d4 * 4 + 1] * corr + p * vv.y; acc[d4 * 4 + 2] = acc[d4 * 4 + 2] * corr + p * vv.z; acc[d4 * 4 + 3] = acc[d4 * 4 + 3] * corr + p * vv.w; }
            }
        }
        if (active) { const float il = 1.f / l;
#pragma unroll
            for (int d8 = 0; d8 < 8; ++d8) { float o[8];
#pragma unroll
                for (int jj = 0; jj < 8; ++jj) o[jj] = acc[d8 * 8 + jj] * il;
                st8(MIX + (size_t)qrow * DM + 512 + h * 64 + d8 * 8, o); } }
    }
    __syncthreads();
}

typedef float f32x16 __attribute__((ext_vector_type(16)));
__device__ __forceinline__ int crow(int r, int hi) { return (r & 3) + 8 * (r >> 2) + 4 * hi; }
constexpr int AT_VP = 136;
template <class Spec> __device__ __forceinline__ void attn_unit(const Ctx& C, const Spec& sp) {
    constexpr int DQ = Spec::DQ, NS = DQ / 16, KP = Spec::KPITCH, KBUF = 64 * KP, VBUF = 64 * AT_VP, BUF = KBUF + VBUF;
    static_assert(BUF % 16 == 0 && KP % 16 == 0, "alignment");
    LAS unsigned char* L = C.lds;
    const int tid = C.tid, lane = C.lane, w = C.wave, r32 = lane & 31, hi = lane >> 5;
    bf16x8 qf[NS];
    { const bf16_t* qp = sp.qptr(w * 32 + r32);
#pragma unroll
      for (int s_ = 0; s_ < NS; ++s_) qf[s_] = *(const bf16x8*)(qp + 16 * s_ + 8 * hi); }
    f32x16 o0, o1;
#pragma unroll
    for (int r = 0; r < 16; ++r) { o0[r] = 0.f; o1[r] = 0.f; }
    float m = -1e30f, lsum = 0.f;
    const int nt = sp.nt;
    const int skey = tid >> 3, sch = tid & 7, rkey = (tid >> 2) & 63, rch = 8 + (tid & 3);
    u32x4 gk, gk2, gv;
    gk2 = (u32x4){0u, 0u, 0u, 0u};
    auto gload = [&](int t) { gk = *(const u32x4*)sp.kptr(t, skey, sch); if (NS > 4 && tid < 256) gk2 = *(const u32x4*)sp.kptr(t, rkey, rch); gv = *(const u32x4*)sp.vptr(t, skey, sch); };
    auto lwrite = [&](int buf) { LAS unsigned char* Bk = L + buf * BUF;
        *(LAS u32x4*)(Bk + skey * KP + sch * 16) = gk; if (NS > 4 && tid < 256) *(LAS u32x4*)(Bk + rkey * KP + rch * 16) = gk2;
        LAS unsigned short* Bv = (LAS unsigned short*)(Bk + KBUF);
#pragma unroll
        for (int j = 0; j < 8; ++j) { const unsigned wv = gv[j >> 1]; Bv[(sch * 8 + j) * (AT_VP / 2) + skey] = (unsigned short)((j & 1) ? (wv >> 16) : (wv & 0xffffu)); } };
    __syncthreads();
    sp.prologue(C);
    gload(0); lwrite(0);
    __syncthreads();
    for (int t = 0; t < nt; ++t) {
        if (t + 1 < nt) gload(t + 1);
        if (sp.active(t, w)) {
            const LAS unsigned char* Bk = L + (t & 1) * BUF; const LAS unsigned char* Bv = Bk + KBUF;
            f32x16 p0, p1;
#pragma unroll
            for (int r = 0; r < 16; ++r) { p0[r] = 0.f; p1[r] = 0.f; }
#pragma unroll
            for (int s_ = 0; s_ < NS; ++s_) {
                const bf16x8 k0 = *(const LAS bf16x8*)(Bk + r32 * KP + 32 * s_ + 16 * hi), k1 = *(const LAS bf16x8*)(Bk + (32 + r32) * KP + 32 * s_ + 16 * hi);
                p0 = __builtin_amdgcn_mfma_f32_32x32x16_bf16(k0, qf[s_], p0, 0, 0, 0); p1 = __builtin_amdgcn_mfma_f32_32x32x16_bf16(k1, qf[s_], p1, 0, 0, 0); }
            sp.bias(C, t, w, r32, hi, p0, p1);
            float mx = fmaxf(p0[0], p1[0]);
#pragma unroll
            for (int r = 1; r < 16; ++r) mx = fmaxf(mx, fmaxf(p0[r], p1[r]));
            mx = fmaxf(mx, __shfl_xor(mx, 32));
            const float mn = fmaxf(m, mx), corr = __builtin_amdgcn_exp2f(m - mn); m = mn;
            float ps = 0.f;
#pragma unroll
            for (int r = 0; r < 16; ++r) { p0[r] = __builtin_amdgcn_exp2f(p0[r] - mn); p1[r] = __builtin_amdgcn_exp2f(p1[r] - mn); ps += p0[r] + p1[r]; }
            lsum = lsum * corr + ps;
#pragma unroll
            for (int r = 0; r < 16; ++r) { o0[r] *= corr; o1[r] *= corr; }
#pragma unroll
            for (int s_ = 0; s_ < 4; ++s_) {
                u32x4 pw;
                if (s_ < 2) { pw.x = pk2(p0[8 * s_ + 0], p0[8 * s_ + 1]); pw.y = pk2(p0[8 * s_ + 2], p0[8 * s_ + 3]); pw.z = pk2(p0[8 * s_ + 4], p0[8 * s_ + 5]); pw.w = pk2(p0[8 * s_ + 6], p0[8 * s_ + 7]); }
                else { const int q_ = 8 * (s_ - 2); pw.x = pk2(p1[q_ + 0], p1[q_ + 1]); pw.y = pk2(p1[q_ + 2], p1[q_ + 3]); pw.z = pk2(p1[q_ + 4], p1[q_ + 5]); pw.w = pk2(p1[q_ + 6], p1[q_ + 7]); }
                const bf16x8 pb = __builtin_bit_cast(bf16x8, pw);
#pragma unroll
                for (int dvh = 0; dvh < 2; ++dvh) {
                    const LAS unsigned char* vp = Bv + (dvh * 32 + r32) * AT_VP + 32 * s_ + 8 * hi;
                    const u32x2 a = *(const LAS u32x2*)vp, b = *(const LAS u32x2*)(vp + 16);
                    const bf16x8 vf = __builtin_bit_cast(bf16x8, (u32x4){a.x, a.y, b.x, b.y});
                    if (dvh == 0) o0 = __builtin_amdgcn_mfma_f32_32x32x16_bf16(vf, pb, o0, 0, 0, 0); else o1 = __builtin_amdgcn_mfma_f32_32x32x16_bf16(vf, pb, o1, 0, 0, 0);
                }
            }
        }
        if (t + 1 < nt) lwrite((t + 1) & 1);
        __syncthreads();
    }
    lsum += __shfl_xor(lsum, 32);
    const float il = 1.f / lsum;
    bf16_t* op = sp.optr(w * 32 + r32);
#pragma unroll
    for (int g = 0; g < 4; ++g) { u32x2 w0, w1;
        w0.x = pk2(o0[4 * g] * il, o0[4 * g + 1] * il); w0.y = pk2(o0[4 * g + 2] * il, o0[4 * g + 3] * il);
        w1.x = pk2(o1[4 * g] * il, o1[4 * g + 1] * il); w1.y = pk2(o1[4 * g + 2] * il, o1[4 * g + 3] * il);
        *(u32x2*)(op + 8 * g + 4 * hi) = w0; *(u32x2*)(op + 32 + 8 * g + 4 * hi) = w1; }
}
struct MlaSpec { static constexpr int DQ = 96, KPITCH = 208;
    const bf16_t* Q; const bf16_t* KV; const bf16_t* KR; bf16_t* O; int b, h, q0, nt;
    __device__ __forceinline__ const bf16_t* qptr(int i) const { return Q + (size_t)(q0 + i) * 768 + h * 96; }
    __device__ __forceinline__ bf16_t* optr(int i) const { return O + (size_t)(q0 + i) * DM + 512 + h * 64; }
    __device__ __forceinline__ int krow(int t, int key) const { return t < 4 ? NLAT + b * 256 + 64 * t + key : b * 2048 + 64 * (t - 4) + key; }
    __device__ __forceinline__ const bf16_t* kptr(int t, int key, int c) const { const int kr = krow(t, key); return c < 8 ? KV + (size_t)kr * 1024 + h * 128 + c * 8 : KR + (size_t)kr * 32 + (c - 8) * 8; }
    __device__ __forceinline__ const bf16_t* vptr(int t, int key, int c) const { return KV + (size_t)krow(t, key) * 1024 + h * 128 + 64 + c * 8; }
    __device__ __forceinline__ bool active(int, int) const { return true; }
    __device__ __forceinline__ void prologue(const Ctx&) const {}
    __device__ __forceinline__ void bias(const Ctx&, int, int, int, int, f32x16&, f32x16&) const {}
};
struct NaSpec { static constexpr int DQ = 64, KPITCH = 144; static constexpr int TAB_OFF = 2 * (64 * 144 + 64 * AT_VP);
    const bf16_t* QKV; bf16_t* O; const float* rpb; int b, h, rb, kr0, ntw, nt, isctx;
    __device__ __forceinline__ const bf16_t* qptr(int i) const { return QKV + (size_t)(isctx ? NLAT + b * 256 + i : b * 2048 + rb * 256 + i) * 3072 + h * 64; }
    __device__ __forceinline__ bf16_t* optr(int i) const { return O + (size_t)(isctx ? NLAT + b * 256 + i : b * 2048 + rb * 256 + i) * DM + h * 64; }
    __device__ __forceinline__ int krow(int t, int key) const { return t < ntw ? b * 2048 + (kr0 + t) * 64 + key : NLAT + b * 256 + 64 * (t - ntw) + key; }
    __device__ __forceinline__ const bf16_t* kptr(int t, int key, int c) const { return QKV + (size_t)krow(t, key) * 3072 + 1024 + h * 64 + c * 8; }
    __device__ __forceinline__ const bf16_t* vptr(int t, int key, int c) const { return QKV + (size_t)krow(t, key) * 3072 + 2048 + h * 64 + c * 8; }
    __device__ __forceinline__ bool active(int t, int w) const { if (t >= ntw) return true; const int qr = 4 * rb + (w >> 1), rs = min(max(qr - 4, 0), 24), kr = kr0 + t; return kr >= rs && kr < rs + 8; }
    __device__ __forceinline__ void prologue(const Ctx& C) const { if (!isctx) { LAS float* tab = (LAS float*)(C.lds + TAB_OFF); for (int idx = C.tid; idx < 465; idx += 512) tab[idx] = rpb[h * 465 + idx] * 1.4426950408889634f; } }
    __device__ __forceinline__ void bias(const Ctx& C, int t, int w, int r32, int hi, f32x16& p0, f32x16& p1) const {
        if (t >= ntw) return;
        const LAS float* tab = (const LAS float*)(C.lds + TAB_OFF);
        const int qr = 4 * rb + (w >> 1), qc = 32 * (w & 1) + r32, cs = min(max(qc - 8, 0), 48), ro = (kr0 + t - qr + 7) * 31 - qc + 15;
#pragma unroll
        for (int r = 0; r < 16; ++r) { const int k0 = crow(r, hi), k1 = k0 + 32;
            const bool v0 = k0 >= cs && k0 < cs + 16, v1 = k1 >= cs && k1 < cs + 16;
            const float b0 = tab[min(max(ro + k0, 0), 464)], b1 = tab[min(max(ro + k1, 0), 464)];
            p0[r] = v0 ? p0[r] + b0 : -INFINITY; p1[r] = v1 ? p1[r] + b1 : -INFINITY; }
    }
};
__device__ __forceinline__ void a4_mla(const Ctx& C, int layer) {
    volatile LAS int* slot = (volatile LAS int*)(C.lds + LDSCTL_OFF + 64);
    unsigned* ctr = (unsigned*)(C.ws + WS_CTL) + CW_QUEUE + 64 * layer;
    for (;;) {
        __syncthreads();
        if (C.tid == 0) slot[0] = (int)__hip_atomic_fetch_add(ctr, 1u, __ATOMIC_RELAXED, __HIP_MEMORY_SCOPE_AGENT);
        __syncthreads();
        const int unit = slot[0];
        if (unit >= 512 + 64) break;
        MlaSpec sp; sp.Q = WSP(const bf16_t, WS_Q); sp.KV = WSP(const bf16_t, WS_KV); sp.KR = WSP(const bf16_t, WS_KR); sp.O = WSP(bf16_t, WS_MIX);
        if (unit < 512) { sp.b = unit >> 6; sp.h = (unit >> 3) & 7; sp.q0 = sp.b * 2048 + (unit & 7) * 256; sp.nt = 36; }
        else { const int u = unit - 512; sp.b = u >> 3; sp.h = u & 7; sp.q0 = NLAT + sp.b * 256; sp.nt = 4; }
        attn_unit(C, sp);
    }
}
__device__ __forceinline__ void b2_na(const Ctx& C, int i, bool need_ctx) {
    for (int unit = C.bid; unit < 1024 + (need_ctx ? 128 : 0); unit += C.G) {
        NaSpec sp; sp.QKV = WSP(const bf16_t, WS_Z); sp.O = WSP(bf16_t, WS_MIX); sp.rpb = C.A.in[27] + (size_t)i * 16 * 465;
        if (unit < 1024) { sp.b = unit >> 7; sp.h = (unit >> 3) & 15; sp.rb = unit & 7; sp.isctx = 0;
            sp.kr0 = min(max(4 * sp.rb - 4, 0), 24); const int krl = min(max(4 * sp.rb + 3 - 4, 0), 24) + 7; sp.ntw = krl - sp.kr0 + 1; sp.nt = sp.ntw + 4; }
        else { const int u = unit - 1024; sp.b = u >> 4; sp.h = u & 15; sp.rb = 0; sp.isctx = 1; sp.kr0 = 0; sp.ntw = 0; sp.nt = 4; }
        attn_unit(C, sp);
    }
}

__device__ __forceinline__ void a5_output(const Ctx& C, int i) {
    const int lane = C.lane, c0 = lane * 8;
    const float* rk = C.A.in[19] + i * ADIM + c0; const float* lnw = C.A.in[20] + i * ADIM + c0; const float* lnb = C.A.in[21] + i * ADIM + c0;
    for (int row = C.gw; row < NT; row += C.ngw) {
        const float* yf = WSP(const float, WS_Y) + (size_t)row * ADIM + c0; const float* yb = yf + (size_t)NT * ADIM;
        float y[8]; { const f32x4 a0 = *(const f32x4*)yf, a1 = *(const f32x4*)(yf + 4), b0 = *(const f32x4*)yb, b1 = *(const f32x4*)(yb + 4);
            y[0] = a0.x + b0.x; y[1] = a0.y + b0.y; y[2] = a0.z + b0.z; y[3] = a0.w + b0.w; y[4] = a1.x + b1.x; y[5] = a1.y + b1.y; y[6] = a1.z + b1.z; y[7] = a1.w + b1.w; }
        float s = 0.f;
#pragma unroll
        for (int j = 0; j < 8; ++j) s += y[j];
        const float mean = sum8(s) * (1.f / 64.f); float q = 0.f;
#pragma unroll
        for (int j = 0; j < 8; ++j) { const float d = y[j] - mean; q += d * d; }
        const float rstd = rsqrtf(sum8(q) * (1.f / 64.f) + 64e-5f);
        float r[8], v[8], g[8], kd0[8], kd1[8];
        ld8(WSP(const bf16_t, WS_R) + (size_t)row * ADIM + c0, r); ld8(WSP(const bf16_t, WS_V) + (size_t)row * ADIM + c0, v); ld8(WSP(const bf16_t, WS_G) + (size_t)row * ADIM + c0, g);
        ld8(WSP(const bf16_t, WS_KD) + (size_t)row * ADIM + c0, kd0); ld8(WSP(const bf16_t, WS_KD) + ((size_t)NT + row) * ADIM + c0, kd1);
        float bs = 0.f;
#pragma unroll
        for (int j = 0; j < 8; ++j) bs += r[j] * (kd0[j] + kd1[j]) * rk[j];
        bs = sum8(bs);
        float o[8];
#pragma unroll
        for (int j = 0; j < 8; ++j) o[j] = ((y[j] - mean) * rstd * lnw[j] + lnb[j] + bs * v[j]) * g[j];
        st8(WSP(bf16_t, WS_MIX) + (size_t)row * DM + c0, o);
    }
}

__device__ __forceinline__ void b2_na_naive(const Ctx& C, int i, bool need_ctx) {
    const bf16_t* QKV = WSP(const bf16_t, WS_Z); bf16_t* MIX = WSP(bf16_t, WS_MIX);
    const float* rpb = C.A.in[27] + (size_t)i * 16 * 15 * 31;
    const int nq = need_ctx ? NT : NLAT;
    const int nblk = nq / 512;
    for (int unit = C.bid; unit < nblk * 16; unit += C.G) {
        const int h = unit & 15, qrow = (unit >> 4) * 512 + C.tid;
        float q[64], acc[64], m = -1e30f, l = 0.f;
#pragma unroll
        for (int d8 = 0; d8 < 8; ++d8) { float t8[8]; ld8(QKV + (size_t)qrow * 3072 + h * 64 + d8 * 8, t8);
#pragma unroll
            for (int jj = 0; jj < 8; ++jj) q[d8 * 8 + jj] = t8[jj]; }
#pragma unroll
        for (int d = 0; d < 64; ++d) acc[d] = 0.f;
        const bool isctx = qrow >= NLAT; const int b = isctx ? (qrow - NLAT) >> 8 : qrow >> 11;
        int qr = 0, qc = 0, rs = 0, cs = 0, nwin = 0;
        if (!isctx) { const int t = qrow & 2047; qr = t >> 6; qc = t & 63; rs = min(max(qr - 4, 0), 24); cs = min(max(qc - 8, 0), 48); nwin = 128; }
        const int nk = nwin + 256;
        for (int kj = 0; kj < nk; ++kj) {
            int krow; float bias = 0.f;
            if (kj < nwin) { const int kr = rs + (kj >> 4), kc = cs + (kj & 15); krow = b * 2048 + kr * 64 + kc; bias = rpb[(h * 15 + (kr - qr + 7)) * 31 + (kc - qc + 15)]; }
            else krow = NLAT + b * 256 + (kj - nwin);
            const bf16_t* kp = QKV + (size_t)krow * 3072 + 1024 + h * 64; const bf16_t* vp = kp + 1024;
            float s = 0.f;
#pragma unroll
            for (int d8 = 0; d8 < 8; ++d8) { float t8[8]; ld8(kp + d8 * 8, t8);
#pragma unroll
                for (int jj = 0; jj < 8; ++jj) s += q[d8 * 8 + jj] * t8[jj]; }
            s += bias;
            const float mn = fmaxf(m, s), corr = __expf(m - mn), p = __expf(s - mn); m = mn; l = l * corr + p;
#pragma unroll
            for (int d8 = 0; d8 < 8; ++d8) { float t8[8]; ld8(vp + d8 * 8, t8);
#pragma unroll
                for (int jj = 0; jj < 8; ++jj) acc[d8 * 8 + jj] = acc[d8 * 8 + jj] * corr + p * t8[jj]; }
        }
        const float il = 1.f / l;
#pragma unroll
        for (int d8 = 0; d8 < 8; ++d8) { float o[8];
#pragma unroll
            for (int jj = 0; jj < 8; ++jj) o[jj] = acc[d8 * 8 + jj] * il;
            st8(MIX + (size_t)qrow * DM + h * 64 + d8 * 8, o); }
    }
}

__device__ __forceinline__ void c2_router(const Ctx& C, int layer, int nrows) {
    const float* rw = C.A.in[29] + (size_t)layer * DM * NEXP; const int lane = C.lane;
    for (int row = C.gw; row < nrows; row += C.ngw) {
        f32x4 v[4], h[4]; row_load(WSP(const float, WS_X) + (size_t)row * DM, lane, v);
        const int mg = mod_group(row); const float rstd = row_rstd(v);
        row_modulate(v, rstd, C.A.in[7] + layer * DM, modp(C, layer, mg, 3), modp(C, layer, mg, 4), lane, h);
        row_store_bf16(WSP(bf16_t, WS_H) + (size_t)row * DM, lane, h);
        float lg[16];
#pragma unroll
        for (int e = 0; e < 16; ++e) lg[e] = 0.f;
#pragma unroll
        for (int j = 0; j < 4; ++j)
#pragma unroll
            for (int q = 0; q < 4; ++q) { const float hv = h[j][q]; const float* wr_ = rw + (size_t)((lane + 64 * j) * 4 + q) * NEXP;
#pragma unroll
                for (int e4 = 0; e4 < 4; ++e4) { const f32x4 w = *(const f32x4*)(wr_ + e4 * 4); lg[e4 * 4] += hv * w.x; lg[e4 * 4 + 1] += hv * w.y; lg[e4 * 4 + 2] += hv * w.z; lg[e4 * 4 + 3] += hv * w.w; } }
#pragma unroll
        for (int e = 0; e < 16; ++e) lg[e] = wave_sum(lg[e]);
        float mx = lg[0];
#pragma unroll
        for (int e = 1; e < 16; ++e) mx = fmaxf(mx, lg[e]);
        float den = 0.f;
#pragma unroll
        for (int e = 0; e < 16; ++e) { lg[e] = __expf(lg[e] - mx); den += lg[e]; }
        const float inv = 1.f / den;
        if (lane < 16) { float a = 0.f;
#pragma unroll
            for (int e = 0; e < 16; ++e) a = (lane == e) ? lg[e] * inv : a;
            float* AFF = WSP(float, WS_AFF);
            if (row < NLAT) AFF[((size_t)(row >> 11) * 16 + lane) * 2048 + (row & 2047)] = a;
            else { const int r2 = row - NLAT; AFF[(size_t)NB * 16 * 2048 + ((size_t)(r2 >> 8) * 16 + lane) * 256 + (r2 & 255)] = a; } }
    }
}

__device__ __forceinline__ void c3_topk(const Ctx& C, bool need_ctx) {
    LAS unsigned* cntw = (LAS unsigned*)C.lds;
    LAS unsigned* wtot = (LAS unsigned*)(C.lds + 256);
    LAS int* list = (LAS int*)(C.lds + 1024);
    const int nunits = 128 + (need_ctx ? 128 : 0), tid = C.tid, lane = C.lane, w = C.wave;
    const unsigned long long lt = (1ull << lane) - 1ull;
    for (int unit = C.bid; unit < nunits; unit += C.G) {
        const bool lat = unit < 128; const int u = lat ? unit : unit - 128, b = u >> 4, e = u & 15, n = lat ? 2048 : 256; const unsigned cap = lat ? 256u : 32u;
        const float* src = lat ? WSP(const float, WS_AFF) + ((size_t)b * 16 + e) * 2048 : WSP(const float, WS_AFF) + (size_t)NB * 16 * 2048 + ((size_t)b * 16 + e) * 256;
        const bool valid = 4 * tid < n;
        unsigned key[4] = {0u, 0u, 0u, 0u};
        if (valid) { const u32x4 kv = *(const u32x4*)(src + 4 * tid); key[0] = kv.x; key[1] = kv.y; key[2] = kv.z; key[3] = kv.w; }
        __syncthreads();
        if (tid < 64) cntw[tid] = 0u;
        __syncthreads();
        unsigned T = 0u;
        for (int bit = 29; bit >= 0; --bit) {
            const unsigned cand = T | (1u << bit); unsigned c = 0u;
#pragma unroll
            for (int q = 0; q < 4; ++q) c += (unsigned)__popcll(__ballot(key[q] >= cand));
            if (lane == 0 && c) atomicAdd((unsigned*)&cntw[bit], c);
            __syncthreads();
            if (cntw[bit] >= cap) T = cand;
        }
        unsigned long long bg[4], be[4]; unsigned cg = 0u, ce = 0u;
#pragma unroll
        for (int q = 0; q < 4; ++q) { bg[q] = __ballot(key[q] > T); be[q] = __ballot(valid && key[q] == T); cg += (unsigned)__popcll(bg[q]); ce += (unsigned)__popcll(be[q]); }
        if (lane == 0) { wtot[w] = cg; wtot[8 + w] = ce; }
        __syncthreads();
        unsigned tg = 0u, eoff = 0u;
#pragma unroll
        for (int k = 0; k < 8; ++k) { tg += wtot[k]; eoff += k < w ? wtot[8 + k] : 0u; }
        const unsigned need = cap - tg;
        bool selq[4]; unsigned long long bs[4]; unsigned cs_ = 0u;
#pragma unroll
        for (int q = 0; q < 4; ++q) { unsigned er = eoff;
#pragma unroll
            for (int q2 = 0; q2 < 4; ++q2) er += (unsigned)__popcll(be[q2] & lt) + ((q2 < q && ((be[q2] >> lane) & 1ull)) ? 1u : 0u);
            selq[q] = key[q] > T || (valid && key[q] == T && er < need); bs[q] = __ballot(selq[q]); cs_ += (unsigned)__popcll(bs[q]); }
        if (lane == 0) wtot[16 + w] = cs_;
        __syncthreads();
        unsigned soff = 0u;
#pragma unroll
        for (int k = 0; k < 8; ++k) soff += k < w ? wtot[16 + k] : 0u;
        if (valid) {
            int gsel[4];
#pragma unroll
            for (int q = 0; q < 4; ++q) { unsigned sl = soff;
#pragma unroll
                for (int q2 = 0; q2 < 4; ++q2) sl += (unsigned)__popcll(bs[q2] & lt) + ((q2 < q && ((bs[q2] >> lane) & 1ull)) ? 1u : 0u);
                const int i = 4 * tid + q, trow = lat ? b * 2048 + i : NLAT + b * 256 + i; int grow = -1;
                if (selq[q]) { grow = e * ROWS_E + (lat ? b * 256 + (int)sl : 2048 + b * 32 + (int)sl);
                    WSP(int, WS_IDX)[grow] = trow; WSP(float, WS_GATE)[grow] = __uint_as_float(key[q]); list[sl * 2] = trow; list[sl * 2 + 1] = grow; }
                gsel[q] = grow; }
            const int trow0 = lat ? b * 2048 + 4 * tid : NLAT + b * 256 + 4 * tid;
#pragma unroll
            for (int q = 0; q < 4; ++q) WSP(int, WS_SEL)[(size_t)(trow0 + q) * 16 + e] = gsel[q];
        }
        __syncthreads();
        for (int s_ = w; s_ < (int)cap; s_ += 8) { const int trow = list[s_ * 2], grow = list[s_ * 2 + 1];
            const u32x4* sp = (const u32x4*)(WSP(const bf16_t, WS_H) + (size_t)trow * DM); u32x4* dp = (u32x4*)(WSP(bf16_t, WS_XIN) + (size_t)grow * DM);
            dp[lane] = sp[lane]; dp[lane + 64] = sp[lane + 64]; }
    }
    __syncthreads();
}

__device__ __forceinline__ void c6_combine(const Ctx& C, int layer, int nrows) {
    const int lane = C.lane;
    for (int row = C.gw; row < nrows; row += C.ngw) {
        f32x4 v[4], a[4]; row_load(WSP(const float, WS_X) + (size_t)row * DM, lane, v);
#pragma unroll
        for (int j = 0; j < 4; ++j) a[j] = (f32x4){0.f, 0.f, 0.f, 0.f};
        const int selv = WSP(const int, WS_SEL)[(size_t)row * 16 + (lane & 15)];
        unsigned long long em = __ballot(selv >= 0) & 0xFFFFull;
        while (em) { const int e = __builtin_ctzll(em); em &= em - 1; const int g = __builtin_amdgcn_readlane(selv, e);
            { const bf16_t* y = WSP(const bf16_t, WS_YB) + (size_t)g * DM;
#pragma unroll
                for (int j = 0; j < 4; ++j) { const u32x2 w = *(const u32x2*)(y + (lane + 64 * j) * 4);
                    a[j] += (f32x4){__uint_as_float(w.x << 16), __uint_as_float(w.x & 0xffff0000u), __uint_as_float(w.y << 16), __uint_as_float(w.y & 0xffff0000u)}; } } }
        const int mg = mod_group(row); const float* g2 = modp(C, layer, mg, 5);
#pragma unroll
        for (int j = 0; j < 4; ++j) v[j] += *(const f32x4*)(g2 + (lane + 64 * j) * 4) * a[j];
        const float rstd = row_rstd(v);
        if (layer < 3) { row_store(WSP(float, WS_X) + (size_t)row * DM, lane, v);
            f32x4 h[4]; row_modulate(v, rstd, C.A.in[6] + (layer + 1) * DM, modp(C, layer + 1, mg, 0), modp(C, layer + 1, mg, 1), lane, h);
            row_store_bf16(WSP(bf16_t, WS_H) + (size_t)row * DM, lane, h);
        } else {
#pragma unroll
            for (int j = 0; j < 4; ++j) { const int c = (lane + 64 * j) * 4; *(f32x4*)(C.out + (size_t)row * DM + c) = v[j] * rstd * *(const f32x4*)(C.A.in[8] + c); }
        }
    }
}

constexpr int N_PHASE_IDS = 2 + 12 * 4;
__host__ __device__ inline bool phase_exists(int p) { if (p < 2) return true; const int l = (p - 2) / 12, k = (p - 2) % 12; if (k == 11) return false; if (l & 1) return !(k >= 2 && k <= 4); return true; }

__global__ void __launch_bounds__(512, 2) fwd(Args args) {
    extern __shared__ __attribute__((aligned(16))) unsigned char lds_raw[];
    const int tid_ = threadIdx.x, wave_ = __builtin_amdgcn_readfirstlane(tid_ >> 6);
    const Ctx C0{args, args.out, args.ws, (LAS unsigned char*)lds_raw, tid_, tid_ & 63, wave_, (int)gridDim.x, (int)blockIdx.x, (int)blockIdx.x * 8 + wave_, (int)gridDim.x * 8};
    volatile LAS unsigned* MISC = (volatile LAS unsigned*)(C0.lds + LDSCTL_OFF);
    if (C0.tid < 128) MISC[C0.tid] = 0u;
    __syncthreads();
    const int lo = args.ph_lo, hi = args.ph_hi;
    XcdBarrier bar; bar.bar = (unsigned*)(C0.ws + WS_CTL) + CW_BAR; bar.x = 0; bar.st = nullptr;
    if (hi - lo > 1) bar = xcd_barrier_post((unsigned*)(C0.ws + WS_CTL) + CW_BAR, MISC + 8);
#define RUN(p) (lo <= (p) && (p) < hi)
#define SEAM(p) do { if (hi > (p) + 1) xcd_barrier(bar); } while (0)
    LAS unsigned char* ring = C0.lds;

    if (RUN(0)) { const Ctx C = relaunder(C0); PH(0, p0_convert(C)); PH(18, p0_mod(C)); SEAM(0); }
    if (RUN(1)) { const Ctx C = relaunder(C0); PH(1, p1_init(C)); SEAM(1); }

    for (int layer = 0; layer < 4; ++layer) {
        const int base = 2 + 12 * layer, i = layer >> 1;
        const bool need_ctx = layer < 3;
        if (!(layer & 1)) {
            if (RUN(base + 0)) { const Ctx C = relaunder(C0);
                pg8::Gemm g{WSP(const bf16_t, WS_H), WSP(const bf16_t, WS_WIN) + (size_t)i * ZP * 1024, 1024, 1024, 1024}; pg8::StaticOrder S; S.init(NT, ZP, C.G, C.bid);
                pg8::Epi<FStoreBf16, false> E{{WSP(bf16_t, WS_Z), ZP, 1.f, 0}};
                PH(2, pg8::gemm_phase(ring, g, S, E)); SEAM(base + 0); }
            if (RUN(base + 1)) { const Ctx C = relaunder(C0); PH(3, a2_prepare(C, i)); SEAM(base + 1); }
            if (RUN(base + 2)) { const Ctx C = relaunder(C0);
                { pg8::Gemm g{WSP(const bf16_t, WS_LIN), WSP(const bf16_t, WS_WLORA) + (size_t)i * 2560 * 384, 384, 384, 384}; pg8::StaticOrder S; S.init(NT, 2560, C.G, C.bid);
                  pg8::Epi<FLora, false> E{{C.A.in[12] + i * 1024, C.A.in[14] + i * 1024, C.A.in[18] + i * 512, WSP(const bf16_t, WS_KS), WSP(const bf16_t, WS_KK), WSP(float, WS_DEC), WSP(bf16_t, WS_KD), WSP(bf16_t, WS_BB), WSP(bf16_t, WS_G)}};
                  PH(4, pg8::gemm_phase(ring, g, S, E)); }
                { pg8::Gemm g{WSP(const bf16_t, WS_QN), WSP(const bf16_t, WS_WQUP) + (size_t)i * 768 * 384, 384, 384, 384}; pg8::StaticOrder S; S.init(NT, 768, C.G, C.bid);
                  pg8::Epi<FQup, false> E{{WSP(bf16_t, WS_Q), WSP(const float, WS_ROPE), ATTN_NAIVE ? 0.10206207261596577f : 0.10206207261596577f * 1.4426950408889634f}};
                  PH(16, pg8::gemm_phase(ring, g, S, E)); }
                { pg8::Gemm g{WSP(const bf16_t, WS_KVN), WSP(const bf16_t, WS_WKVUP) + (size_t)i * 1024 * 256, 256, 256, 256}; pg8::StaticOrder S; S.init(NT, 1024, C.G, C.bid);
                  pg8::Epi<FStoreBf16, false> E{{WSP(bf16_t, WS_KV), 1024, 1.f, 0}};
                  PH(17, pg8::gemm_phase(ring, g, S, E)); }
                SEAM(base + 2); }
            if (RUN(base + 3)) { const Ctx C = relaunder(C0); PH(5, a4_scan(C)); PH(6, if (ATTN_NAIVE) a4_mla_naive(C); else a4_mla(C, layer)); SEAM(base + 3); }
            if (RUN(base + 4)) { const Ctx C = relaunder(C0); PH(7, a5_output(C, i)); SEAM(base + 4); }
        } else {
            if (RUN(base + 0)) { const Ctx C = relaunder(C0);
                pg8::Gemm g{WSP(const bf16_t, WS_H), WSP(const bf16_t, WS_WQKV) + (size_t)i * 3072 * 1024, 1024, 1024, 1024}; pg8::StaticOrder S; S.init(NT, 3072, C.G, C.bid);
                pg8::Epi<FStoreBf16, false> E{{WSP(bf16_t, WS_Z), 3072, ATTN_NAIVE ? 0.125f : 0.125f * 1.4426950408889634f, 1024}};
                PH(8, pg8::gemm_phase(ring, g, S, E)); SEAM(base + 0); }
            if (RUN(base + 1)) { const Ctx C = relaunder(C0); PH(9, if (ATTN_NAIVE) b2_na_naive(C, i, need_ctx); else b2_na(C, i, need_ctx)); SEAM(base + 1); }
        }
        if (RUN(base + 5)) { const Ctx C = relaunder(C0);
            const bf16_t* W = (layer & 1) ? WSP(const bf16_t, WS_WOUTC) + (size_t)i * 1024 * 1024 : WSP(const bf16_t, WS_WOUTA) + (size_t)i * 1024 * 1024;
            pg8::Gemm g{WSP(const bf16_t, WS_MIX), W, 1024, 1024, 1024}; pg8::StaticOrder S; S.init(need_ctx ? NT : NLAT, 1024, C.G, C.bid);
            pg8::Epi<FResid, false> E{{WSP(float, WS_X), WSP(const float, WS_MOD), layer}};
            PH(10, pg8::gemm_phase(ring, g, S, E)); SEAM(base + 5); }
        if (RUN(base + 6)) { const Ctx C = relaunder(C0); PH(11, c2_router(C, layer, need_ctx ? NT : NLAT)); SEAM(base + 6); }
        if (RUN(base + 7)) { const Ctx C = relaunder(C0); PH(12, c3_topk(C, need_ctx)); SEAM(base + 7); }
        if (RUN(base + 8)) { const Ctx C = relaunder(C0);
            pg8::Gemm g{WSP(const bf16_t, WS_XIN), WSP(const bf16_t, WS_W13) + (size_t)layer * 16 * 4096 * 1024, 1024, 1024, 1024}; pg8::MoeOrder S; S.init(need_ctx ? 9 : 8, 16, C.G, C.bid);
            pg8::Epi<FSwiglu, true> E{{WSP(bf16_t, WS_HID)}};
            PH(13, pg8::gemm_phase(ring, g, S, E)); SEAM(base + 8); }
        if (RUN(base + 9)) { const Ctx C = relaunder(C0);
            pg8::Gemm g{WSP(const bf16_t, WS_HID), WSP(const bf16_t, WS_W2) + (size_t)layer * 16 * 1024 * 2048, 2048, 2048, 2048}; pg8::MoeOrder S; S.init(need_ctx ? 9 : 8, 4, C.G, C.bid);
            pg8::Epi<FGate, false> E{{WSP(bf16_t, WS_YB), WSP(const float, WS_GATE)}};
            PH(14, pg8::gemm_phase(ring, g, S, E)); SEAM(base + 9); }
        if (RUN(base + 10)) { const Ctx C = relaunder(C0); PH(15, c6_combine(C, layer, need_ctx ? NT : NLAT)); if (layer < 3) SEAM(base + 10); }
    }
#undef RUN
#undef SEAM
}

extern "C" void kernel_launch(void* const* d_in, const int* in_sizes, int n_in, void* d_out, int out_size, void* d_ws, size_t ws_size, hipStream_t stream) {
    static int grid = 0;
    if (grid == 0) {
        if (n_in != 33 || out_size != NLAT * DM || ws_size < WS_END) { fprintf(stderr, "kernel_launch: unexpected shapes (n_in %d out %d ws %zu need %zu)\n", n_in, out_size, ws_size, (size_t)WS_END); grid = -1; return; }
        int dev = 0, cus = 0, per_cu = 0;
        if (hipGetDevice(&dev) != hipSuccess || hipDeviceGetAttribute(&cus, hipDeviceAttributeMultiprocessorCount, dev) != hipSuccess) { grid = -1; return; }
        if (hipFuncSetAttribute((const void*)fwd, hipFuncAttributeMaxDynamicSharedMemorySize, LDS_BYTES) != hipSuccess) { fprintf(stderr, "kernel_launch: hipFuncSetAttribute failed\n"); grid = -1; return; }
        if (hipOccupancyMaxActiveBlocksPerMultiprocessor(&per_cu, (const void*)fwd, 512, LDS_BYTES) != hipSuccess || per_cu < 1) fprintf(stderr, "kernel_launch: occupancy query says %d\n", per_cu);
        (void)hipGetLastError();
        grid = cus;
    }
    if (grid < 0) return;
    (void)hipMemsetAsync((char*)d_ws + WS_CTL, 0, CTL_BYTES, stream);
    Args a{};
    for (int i = 0; i < 33; ++i) a.in[i] = (const float*)d_in[i];
    a.out = (float*)d_out; a.ws = (unsigned char*)d_ws;
#if SINGLE_LAUNCH
    a.ph_lo = 0; a.ph_hi = N_PHASE_IDS;
    hipLaunchKernelGGL(fwd, dim3(grid), dim3(512), LDS_BYTES, stream, a);
#else
    for (int p = 0; p < N_PHASE_IDS; ++p) { if (!phase_exists(p)) continue; a.ph_lo = p; a.ph_hi = p + 1; hipLaunchKernelGGL(fwd, dim3(grid), dim3(512), LDS_BYTES, stream, a); }
#endif
}
```

```cpp
#include <hip/hip_runtime.h>
#include <cstdio>
#include <cstdint>

#ifndef PHMASK
#define PHMASK 0xFFFFFFFFu
#endif
#define PON(n) (((PHMASK) >> (n)) & 1u)
#ifndef PROBE_MASK
#define PROBE_MASK 0u
#endif
#define PH(n, ...) do { if (PON(n)) { if (((PROBE_MASK) >> (n)) & 1u) { const unsigned long long t0_ = __builtin_amdgcn_s_memrealtime(); { __VA_ARGS__; } __syncthreads(); const unsigned long long d_ = __builtin_amdgcn_s_memrealtime() - t0_; while (__builtin_amdgcn_s_memrealtime() - t0_ < 2 * d_) __builtin_amdgcn_s_sleep(8); } else { __VA_ARGS__; } } } while (0)
#ifndef BG_A4
#define BG_A4 12
#endif
#ifndef ATTN_NAIVE
#define ATTN_NAIVE 0
#endif
#ifndef SINGLE_LAUNCH
#define SINGLE_LAUNCH 1
#endif

#define LAS __attribute__((address_space(3)))
#define GAS __attribute__((address_space(1)))
typedef unsigned short bf16_t;
typedef short bf16x8 __attribute__((ext_vector_type(8)));
typedef float f32x4 __attribute__((ext_vector_type(4)));
typedef float f32x2 __attribute__((ext_vector_type(2)));
typedef unsigned u32x4 __attribute__((ext_vector_type(4)));
typedef unsigned u32x2 __attribute__((ext_vector_type(2)));

constexpr int NB = 8, SEQ = 2048, CTXL = 256, DM = 1024;
constexpr int NLAT = NB * SEQ, NCTX = NB * CTXL, NT = NLAT + NCTX;
constexpr int ADIM = 512, ZP = 2816;
constexpr int NEXP = 16, FF = 2048, ROWS_E = 2304;
constexpr float NORM_EPS = 1e-6f;

constexpr size_t MiB = 1u << 20;
constexpr size_t WS_CTL = 0, CTL_BYTES = 1 * MiB;
constexpr size_t WS_MOD = 1 * MiB;
constexpr size_t WS_ROPE = 2 * MiB;
constexpr size_t WS_WIN = 4 * MiB;
constexpr size_t WS_WLORA = 16 * MiB;
constexpr size_t WS_WQUP = 20 * MiB;
constexpr size_t WS_WKVUP = 22 * MiB;
constexpr size_t WS_WOUTA = 24 * MiB;
constexpr size_t WS_WQKV = 28 * MiB;
constexpr size_t WS_WOUTC = 40 * MiB;
constexpr size_t WS_W13 = 48 * MiB;
constexpr size_t WS_W2 = 560 * MiB;
constexpr size_t WS_X = 816 * MiB;
constexpr size_t WS_H = 888 * MiB;
constexpr size_t WS_MIX = 924 * MiB;
constexpr size_t WS_Z = 960 * MiB;
constexpr size_t WS_R = 1068 * MiB;
constexpr size_t WS_V = 1086 * MiB;
constexpr size_t WS_KS = 1104 * MiB;
constexpr size_t WS_KK = 1122 * MiB;
constexpr size_t WS_LIN = 1140 * MiB;
constexpr size_t WS_QN = 1154 * MiB;
constexpr size_t WS_KVN = 1168 * MiB;
constexpr size_t WS_KR = 1177 * MiB;
constexpr size_t WS_DEC = 1179 * MiB;
constexpr size_t WS_KD = 1251 * MiB;
constexpr size_t WS_BB = 1287 * MiB;
constexpr size_t WS_G = 1323 * MiB;
constexpr size_t WS_Y = 1341 * MiB;
constexpr size_t WS_Q = 1413 * MiB;
constexpr size_t WS_KV = 1440 * MiB;
constexpr size_t WS_AFF = 1476 * MiB;
constexpr size_t WS_SEL = 1478 * MiB;
constexpr size_t WS_IDX = 1480 * MiB;
constexpr size_t WS_GATE = 1481 * MiB;
constexpr size_t WS_XIN = 1482 * MiB;
constexpr size_t WS_HID = 1554 * MiB;
constexpr size_t WS_YB = 1698 * MiB;
constexpr size_t WS_END = 1770 * MiB;

constexpr int CW_TMO = 0, CW_BAR = 4096, CW_QUEUE = 8192;

constexpr int RING_BYTES = 133120;
constexpr int LDSCTL_OFF = RING_BYTES;
constexpr int LDS_BYTES = 147456;

__device__ __forceinline__ float bf2f(unsigned short b) { return __uint_as_float(((unsigned)b) << 16); }
__device__ __forceinline__ unsigned f2bf(float f) { unsigned u = __float_as_uint(f); return (u + 0x7fffu + ((u >> 16) & 1u)) >> 16; }
typedef __bf16 bf16x2_t __attribute__((ext_vector_type(2)));
__device__ __forceinline__ unsigned pk2(float lo, float hi) { const f32x2 v = {lo, hi}; return __builtin_bit_cast(unsigned, __builtin_convertvector(v, bf16x2_t)); }
__device__ __forceinline__ void unpk8(const u32x4 w, float (&f)[8]) {
    f[0] = __uint_as_float(w.x << 16); f[1] = __uint_as_float(w.x & 0xffff0000u); f[2] = __uint_as_float(w.y << 16); f[3] = __uint_as_float(w.y & 0xffff0000u);
    f[4] = __uint_as_float(w.z << 16); f[5] = __uint_as_float(w.z & 0xffff0000u); f[6] = __uint_as_float(w.w << 16); f[7] = __uint_as_float(w.w & 0xffff0000u); }
__device__ __forceinline__ void ld8(const bf16_t* p, float (&f)[8]) { unpk8(*(const u32x4*)p, f); }
__device__ __forceinline__ u32x4 pack8(const float (&f)[8]) { u32x4 w; w.x = pk2(f[0], f[1]); w.y = pk2(f[2], f[3]); w.z = pk2(f[4], f[5]); w.w = pk2(f[6], f[7]); return w; }
__device__ __forceinline__ void st8(bf16_t* p, const float (&f)[8]) { *(u32x4*)p = pack8(f); }
__device__ __forceinline__ float wave_sum_slow(float v) {
#pragma unroll
    for (int o = 1; o < 64; o <<= 1) v += __shfl_xor(v, o);
    return v; }
template <int CTRL> __device__ __forceinline__ float dpp_f(float x) { return __int_as_float(__builtin_amdgcn_update_dpp(0, __float_as_int(x), CTRL, 0xF, 0xF, true)); }
__device__ __forceinline__ float sum8(float v) { v += dpp_f<0xB1>(v); v += dpp_f<0x4E>(v); v += dpp_f<0x141>(v); return v; }
__device__ __forceinline__ float sum16(float v) { v = sum8(v); v += dpp_f<0x140>(v); return v; }
__device__ __forceinline__ float wave_sum(float v) { v = sum16(v); v += __shfl_xor(v, 16); v += __shfl_xor(v, 32); return v; }
__device__ __forceinline__ float sigmoidf_(float x) { return 1.f / (1.f + __expf(-x)); }
__device__ __forceinline__ int mod_group(int row) { return row < NLAT ? (row >> 11) : NB; }

namespace pg8 {
constexpr int BM = 256, BK = 64, HALF = 128, HTB = HALF * BK * 2, STAGE_BYTES = 8 * HTB, NXCD = 8, WGM = 8;
__host__ __device__ __forceinline__ int lds_byte(int r, int c) { const int st = (r >> 4) * 2 + (c >> 5), rr = r & 15, cc = c & 31, ob = rr * 64 + cc * 2; return st * 1024 + (ob ^ (((ob >> 9) & 1) << 5)); }
__host__ __device__ __forceinline__ void stage_rc(int b, int& R, int& C) { const int st = b / 1024, sb = b % 1024, swz = sb ^ (((sb >> 9) & 1) << 5); R = (st >> 1) * 16 + swz / 64; C = (st & 1) * 32 + (swz % 64) / 2; }
__host__ __device__ __forceinline__ int perm32(int rho) { const int n = rho >> 4, i = rho & 15; return 8 * (i >> 2) + 4 * n + (i & 3); }
struct Unit { int pm, pn; };
struct Gemm { const bf16_t* A; const bf16_t* Bt; int lda, ldb, K; };

struct StaticOrder {
    int nM, nN, nwg, G, c;
    __device__ void init(int M, int N, int G_, int c_) { nM = M / BM; nN = N / BM; nwg = nM * nN; G = G_; c = c_; }
    __device__ bool next(int i, Unit& u) const {
        const long L = (long)i * G + c; if (L >= nwg) return false;
        int wgid = (int)L; { const int q = nwg / NXCD, r = nwg % NXCD, xcd = wgid % NXCD, off = wgid / NXCD; wgid = (xcd < r ? xcd * (q + 1) : r * (q + 1) + (xcd - r) * q) + off; }
        const int nig = WGM * nN, gid = wgid / nig, fm = gid * WGM, gsz = (nM - fm) < WGM ? (nM - fm) : WGM;
        u.pm = fm + ((wgid % nig) % gsz); u.pn = (wgid % nig) / gsz; return true;
    }
};
struct MoeOrder {
    int nrt, nct, nwg, G, c;
    __device__ void init(int nrt_, int nct_, int G_, int c_) { nrt = nrt_; nct = nct_; nwg = NEXP * nrt * nct; G = G_; c = c_; }
    __device__ bool next(int i, Unit& u) const {
        const long L = (long)i * G + c; if (L >= nwg) return false;
        const int wgid = (int)(L % NXCD) * (nwg / NXCD) + (int)(L / NXCD);
        const int per = nrt * nct, e = wgid / per, rem = wgid % per, ct = rem / nrt, rt = rem % nrt;
        u.pm = e * 9 + rt; u.pn = e * nct + ct; return true;
    }
};

template <class F, bool PAIR> struct Epi {
    F f;
    __device__ __forceinline__ void operator()(const f32x4 (&acc)[2][2][4][2], const Unit& u, int wr, int wc, int fr, int fq) const {
#pragma unroll
        for (int ai = 0; ai < 2; ++ai)
#pragma unroll
            for (int m = 0; m < 4; ++m) {
                const int row = u.pm * BM + ai * HALF + wr * 64 + m * 16 + fr;
                if constexpr (PAIR) {
                    float a[8], b[8];
#pragma unroll
                    for (int j = 0; j < 4; ++j) { a[j] = acc[ai][0][m][0][j]; a[4 + j] = acc[ai][0][m][1][j]; b[j] = acc[ai][1][m][0][j]; b[4 + j] = acc[ai][1][m][1][j]; }
                    f(row, u.pn * HALF + wc * 32 + 8 * fq, a, b);
                } else {
#pragma unroll
                    for (int bj = 0; bj < 2; ++bj) { float a[8];
#pragma unroll
                        for (int j = 0; j < 4; ++j) { a[j] = acc[ai][bj][m][0][j]; a[4 + j] = acc[ai][bj][m][1][j]; }
                        f(row, u.pn * BM + bj * HALF + wc * 32 + 8 * fq, a); }
                }
            }
    }
};

template <class EpiT, class Sched>
__device__ __forceinline__ void gemm_phase(LAS unsigned char* lds, const Gemm g, const Sched& S, const EpiT& E) {
    int tid = threadIdx.x; asm volatile("" : "+v"(tid));
    const int wid = __builtin_amdgcn_readfirstlane(tid >> 6), lane = tid & 63, wr = wid >> 2, wc = wid & 3, fr = lane & 15, fq = lane >> 4;
    const int K = g.K, nt = K / BK;
    unsigned voffA[2], voffB[2];
#pragma unroll
    for (int i = 0; i < 2; ++i) { int R, C; stage_rc(tid * 16 + i * 8192, R, C); const int Rb = (R & ~31) + perm32(R & 31);
        voffA[i] = (unsigned)(R * g.lda + C) * 2u; voffB[i] = (unsigned)(Rb * g.ldb + C) * 2u; }
    const size_t kstep = (size_t)(BK * 2);
    const size_t hsA = (size_t)HALF * g.lda * 2, hsB = (size_t)HALF * g.ldb * 2, tsA = 2 * hsA, tsB = 2 * hsB;
    const unsigned ldsw = (unsigned)wid * 1024u;
    const int aoff = lds_byte(wr * 64 + fr, fq * 8), boff = lds_byte(wc * 32 + fr, fq * 8);
#define PG8_SA(b, h) (((b) * 2 + (h)) * HTB)
#define PG8_SB(b, h) ((4 + (b) * 2 + (h)) * HTB)
#define PG8_STAGE(bufoff, gbase, voff) do { _Pragma("unroll") for (int _i = 0; _i < 2; ++_i) \
        __builtin_amdgcn_global_load_lds((const unsigned*)((const char*)(gbase) + (voff)[_i]), (LAS unsigned*)(lds + (bufoff) + ldsw + _i * 8192), 16, 0, 0); } while (0)
#define PG8_LDA(dst, b, h) do { _Pragma("unroll") for (int m = 0; m < 4; ++m) _Pragma("unroll") for (int k = 0; k < 2; ++k) dst[m][k] = *(const LAS bf16x8*)(lds + PG8_SA(b, h) + aoff + m * 2048 + k * 1024); } while (0)
#define PG8_LDB(dst, b, h) do { _Pragma("unroll") for (int n = 0; n < 2; ++n) _Pragma("unroll") for (int k = 0; k < 2; ++k) dst[n][k] = *(const LAS bf16x8*)(lds + PG8_SB(b, h) + boff + n * 2048 + k * 1024); } while (0)
#define PG8_MMA(ai, bj, At, Bt) do { __builtin_amdgcn_s_setprio(1); _Pragma("unroll") for (int m = 0; m < 4; ++m) _Pragma("unroll") for (int n = 0; n < 2; ++n) _Pragma("unroll") for (int k = 0; k < 2; ++k) \
        acc[ai][bj][m][n] = __builtin_amdgcn_mfma_f32_16x16x32_bf16(Bt[n][k], At[m][k], acc[ai][bj][m][n], 0, 0, 0); __builtin_amdgcn_s_setprio(0); } while (0)
#define PG8_WAIT_V(n) asm volatile("s_waitcnt vmcnt(" #n ")" ::: "memory")
#define PG8_WAIT_L(n) asm volatile("s_waitcnt lgkmcnt(" #n ")" ::: "memory")
#define PG8_BAR __builtin_amdgcn_s_barrier()
#define PG8_SCHED __builtin_amdgcn_sched_barrier(0)
    Unit cur, nxt; int ui = 0;
    if (!S.next(0, cur)) return;
    f32x4 acc[2][2][4][2];
#pragma unroll
    for (int a = 0; a < 2; ++a)
#pragma unroll
        for (int b = 0; b < 2; ++b)
#pragma unroll
            for (int m = 0; m < 4; ++m)
#pragma unroll
                for (int n = 0; n < 2; ++n) acc[a][b][m][n] = (f32x4){0.f, 0.f, 0.f, 0.f};
    bf16x8 At[4][2], B0[2][2], B1[2][2];
    const char* cA = (const char*)g.A + (size_t)cur.pm * tsA; const char* cB = (const char*)g.Bt + (size_t)cur.pn * tsB;
    PG8_STAGE(PG8_SB(0, 0), cB, voffB); PG8_STAGE(PG8_SB(0, 1), cB + hsB, voffB); PG8_STAGE(PG8_SA(0, 0), cA, voffA); PG8_STAGE(PG8_SA(0, 1), cA + hsA, voffA);
    if (wr == 1) PG8_BAR;
    PG8_WAIT_V(2); PG8_BAR;
    PG8_STAGE(PG8_SB(1, 0), cB + kstep, voffB); PG8_STAGE(PG8_SA(1, 0), cA + kstep, voffA); PG8_STAGE(PG8_SB(1, 1), cB + hsB + kstep, voffB);
    PG8_WAIT_V(6); PG8_BAR;
    for (;;) {
        const bool has_next = S.next(ui + 1, nxt);
        const char* nA = has_next ? (const char*)g.A + (size_t)nxt.pm * tsA : cA; const char* nB = has_next ? (const char*)g.Bt + (size_t)nxt.pn * tsB : cB;
#pragma unroll 1
        for (int t = 0; t < nt; t += 2) {
            const bool last = (t == nt - 2);
            const char* a1 = cA + (size_t)(t + 1) * kstep;
            const char* a2 = last ? nA : cA + (size_t)(t + 2) * kstep; const char* b2 = last ? nB : cB + (size_t)(t + 2) * kstep;
            const char* a3 = a2 + kstep; const char* b3 = b2 + kstep;
            PG8_LDB(B0, 0, 0); PG8_LDB(B1, 0, 1); PG8_SCHED; PG8_LDA(At, 0, 0); PG8_STAGE(PG8_SA(1, 1), a1 + hsA, voffA);
            PG8_WAIT_V(8); PG8_WAIT_L(0); PG8_BAR; PG8_MMA(0, 0, At, B0); PG8_MMA(0, 1, At, B1); PG8_BAR; PG8_SCHED;
            PG8_LDA(At, 0, 1); PG8_STAGE(PG8_SB(0, 0), b2, voffB); PG8_STAGE(PG8_SB(0, 1), b2 + hsB, voffB); PG8_STAGE(PG8_SA(0, 0), a2, voffA);
            PG8_WAIT_V(8); PG8_WAIT_L(0); PG8_BAR; PG8_MMA(1, 0, At, B0); PG8_MMA(1, 1, At, B1); PG8_BAR; PG8_SCHED;
            PG8_LDB(B0, 1, 0); PG8_LDB(B1, 1, 1); PG8_SCHED; PG8_LDA(At, 1, 0); PG8_STAGE(PG8_SA(0, 1), a2 + hsA, voffA);
            PG8_WAIT_V(8); PG8_WAIT_L(0); PG8_BAR; PG8_MMA(0, 0, At, B0); PG8_MMA(0, 1, At, B1); PG8_BAR; PG8_SCHED;
            PG8_LDA(At, 1, 1); PG8_STAGE(PG8_SB(1, 0), b3, voffB); PG8_STAGE(PG8_SB(1, 1), b3 + hsB, voffB); PG8_STAGE(PG8_SA(1, 0), a3, voffA);
            PG8_WAIT_V(8); PG8_WAIT_L(0); PG8_BAR; PG8_MMA(1, 0, At, B0); PG8_MMA(1, 1, At, B1); PG8_BAR; PG8_SCHED;
        }
        if (wr == 0) PG8_BAR;
        E(acc, cur, wr, wc, fr, fq);
        if (!has_next) break;
#pragma unroll
        for (int a = 0; a < 2; ++a)
#pragma unroll
            for (int b = 0; b < 2; ++b)
#pragma unroll
                for (int m = 0; m < 4; ++m)
#pragma unroll
                    for (int n = 0; n < 2; ++n) acc[a][b][m][n] = (f32x4){0.f, 0.f, 0.f, 0.f};
        cur = nxt; cA = nA; cB = nB; ++ui;
        if (wr == 1) PG8_BAR;
    }
    PG8_WAIT_V(0);
    PG8_BAR;
#undef PG8_SA
#undef PG8_SB
#undef PG8_STAGE
#undef PG8_LDA
#undef PG8_LDB
#undef PG8_MMA
#undef PG8_WAIT_V
#undef PG8_WAIT_L
#undef PG8_BAR
#undef PG8_SCHED
}
}

#define XB_TMO      128
#define XB_XCNT(j)  (256  + 64 * (j))
#define XB_XSUB(j)  (1280 + 64 * (j))
#define XB_XGEN(j)  (2304 + 64 * (j))
#define XB_TOP      3328
#define XB_TOPGEN   3392
#define XCD_BAR_WORDS 3456
#define XB_SPIN_CAP (1u << 22)
__device__ __forceinline__ unsigned xb_ld(unsigned* p)              { return __hip_atomic_load(p, __ATOMIC_RELAXED, __HIP_MEMORY_SCOPE_AGENT); }
__device__ __forceinline__ unsigned xb_add(unsigned* p, unsigned v) { return __hip_atomic_fetch_add(p, v, __ATOMIC_RELAXED, __HIP_MEMORY_SCOPE_AGENT); }
__device__ __forceinline__ unsigned xb_xcc_id() { return (unsigned)__builtin_amdgcn_s_getreg((3 << 11) | 20) & 0xFu; }
#define XB_SPIN(cond, bar) do { unsigned _sp = 0; while (cond) { __builtin_amdgcn_s_sleep(1); \
    if ((++_sp & 255u) == 0u) { if (xb_ld(&(bar)[XB_TMO])) break; if (_sp > XB_SPIN_CAP) { atomicAdd(&(bar)[XB_TMO], 1u); break; } } } } while (0)
struct XcdBarrier { unsigned* bar; unsigned x; volatile LAS unsigned* st; };
__device__ __forceinline__ XcdBarrier xcd_barrier_post(unsigned* bar, volatile LAS unsigned* st) {
    XcdBarrier b; b.bar = bar; b.x = xb_xcc_id(); b.st = st;
    if (threadIdx.x == 0) (void)xb_add(&bar[XB_XCNT(b.x)], 1u);
    return b;
}
__device__ __forceinline__ void xcd_barrier_complete(unsigned* bar, unsigned x, unsigned& nloc, unsigned& nx) {
    const unsigned G = gridDim.x * gridDim.y * gridDim.z;
    unsigned sum, cnt, mine, sp = 0u;
    for (;;) {
        sum = 0u; cnt = 0u; mine = 0u;
#pragma unroll
        for (unsigned j = 0; j < 16; ++j) { const unsigned c = xb_ld(&bar[XB_XCNT(j)]); sum += c; cnt += (c > 0u) ? 1u : 0u; mine = (j == x) ? c : mine; }
        if (sum == G) break;
        __builtin_amdgcn_s_sleep(1);
        if ((++sp & 255u) == 0u) { if (xb_ld(&bar[XB_TMO])) break; if (sp > XB_SPIN_CAP) { atomicAdd(&bar[XB_TMO], 1u); break; } }
    }
    nloc = mine > 0u ? mine : 1u; nx = cnt > 0u ? cnt : 1u;
}
__device__ __forceinline__ void xcd_barrier(const XcdBarrier& b) {
    asm volatile("s_waitcnt vmcnt(0)" ::: "memory");
    __syncthreads();
    if (threadIdx.x == 0) {
        unsigned* bar = b.bar;
        __builtin_amdgcn_s_waitcnt(0);
        unsigned nloc = b.st[0], nx = b.st[1];
        if (nloc == 0u) { xcd_barrier_complete(bar, b.x, nloc, nx); b.st[0] = nloc; b.st[1] = nx; }
        const unsigned old = xb_add(&bar[XB_XSUB(b.x)], 1u);
        const unsigned gen = old / nloc;
        if (old + 1u == (gen + 1u) * nloc) {
            __builtin_amdgcn_fence(__ATOMIC_RELEASE, "agent");
            asm volatile("s_waitcnt vmcnt(0)" ::: "memory");
            const unsigned og = xb_add(&bar[XB_TOP], 1u);
            const unsigned tg = og / nx;
            if (og + 1u == (tg + 1u) * nx) xb_add(&bar[XB_TOPGEN], 1u);
            else XB_SPIN(xb_ld(&bar[XB_TOPGEN]) == tg, bar);
            __builtin_amdgcn_fence(__ATOMIC_ACQUIRE, "agent");
            xb_add(&bar[XB_XGEN(b.x)], 1u);
            asm volatile("s_waitcnt vmcnt(0)" ::: "memory");
        } else {
            XB_SPIN(xb_ld(&bar[XB_XGEN(b.x)]) == gen, bar);
            __builtin_amdgcn_fence(__ATOMIC_ACQUIRE, "agent");
            asm volatile("s_waitcnt vmcnt(0)" ::: "memory");
        }
    }
    __syncthreads();
}

struct Args { const float* in[33]; float* out; unsigned char* ws; int ph_lo, ph_hi; };
struct Ctx {
    const Args& A; float* out; unsigned char* ws;
    LAS unsigned char* lds; int tid, lane, wave, G, bid, gw, ngw;
};
#define WSP(T, off) ((T*)(C.ws + (off)))
__device__ __forceinline__ Ctx relaunder(const Ctx& C0) {
    int tid = C0.tid; unsigned char* ws = C0.ws; LAS unsigned char* lds = C0.lds;
    asm volatile("" : "+v"(tid), "+s"(ws));
    const int wave = __builtin_amdgcn_readfirstlane(tid >> 6);
    return Ctx{C0.A, C0.out, ws, lds, tid, tid & 63, wave, C0.G, C0.bid, C0.bid * 8 + wave, C0.G * 8};
}
__device__ __forceinline__ const float* modp(const Ctx& C, int layer, int mg, int chunk) { return WSP(const float, WS_MOD) + ((size_t)(layer * 9 + mg) * 6 + chunk) * 1024; }

__device__ __forceinline__ void tr_item(const float* src, int ld_src, int nvalid, int k0, int n0, bf16_t* dst, int ld_dst, int drow0, int dk0, LAS float* scr, int lane) {
    {
        const int n = (lane & 15) * 4; const bool ok = (n0 + n) < nvalid;
#pragma unroll 4
        for (int i = 0; i < 16; ++i) { const int k = 4 * i + (lane >> 4);
            f32x4 v = (f32x4){0.f, 0.f, 0.f, 0.f};
            if (ok) v = __builtin_nontemporal_load((const f32x4*)(src + (size_t)(k0 + k) * ld_src + n0 + n));
            LAS float* s = scr + k * 65 + n; s[0] = v.x; s[1] = v.y; s[2] = v.z; s[3] = v.w; }
    }
    asm volatile("s_waitcnt lgkmcnt(0)" ::: "memory");
    const int c = lane & 7;
#pragma unroll
    for (int jj = 0; jj < 8; ++jj) { const int nl = (lane >> 3) + 8 * jj; const LAS float* s = scr + (8 * c) * 65 + nl;
        u32x4 o; o.x = pk2(s[0 * 65], s[1 * 65]); o.y = pk2(s[2 * 65], s[3 * 65]); o.z = pk2(s[4 * 65], s[5 * 65]); o.w = pk2(s[6 * 65], s[7 * 65]);
        if (n0 + nl < nvalid) __builtin_nontemporal_store(o, (u32x4*)(dst + (size_t)(drow0 + nl) * ld_dst + dk0 + 8 * c)); }
    asm volatile("s_waitcnt lgkmcnt(0)" ::: "memory");
}
constexpr int CV_SMALL = 2120, CV_MOE_L = 16 * 3 * 512, CV_MOE = 4 * CV_MOE_L;
__device__ __forceinline__ void convert_item(const Ctx& C, int it, LAS float* scr) {
    {
        const float* src; int ld_src, nvalid, k0, n0, ld_dst, drow0, dk0; bf16_t* dst;
        if (it < 2 * CV_SMALL) {
            const int i = it / CV_SMALL; int r = it % CV_SMALL;
            if (r < 656) { src = C.A.in[9] + (size_t)i * 1024 * 2592; ld_src = 2592; nvalid = 2592; k0 = (r / 41) * 64; n0 = (r % 41) * 64; dst = WSP(bf16_t, WS_WIN) + (size_t)i * ZP * 1024; ld_dst = 1024; drow0 = n0; dk0 = k0; }
            else if ((r -= 656) < 16) { const int d = r >> 3; src = C.A.in[13] + (size_t)(i * 2 + d) * 64 * 512; ld_src = 512; nvalid = 512; k0 = 0; n0 = (r & 7) * 64; dst = WSP(bf16_t, WS_WLORA) + (size_t)i * 2560 * 384; ld_dst = 384; drow0 = d * 512 + n0; dk0 = d * 64; }
            else if ((r -= 16) < 16) { const int d = r >> 3; src = C.A.in[15] + (size_t)(i * 2 + d) * 64 * 512; ld_src = 512; nvalid = 512; k0 = 0; n0 = (r & 7) * 64; dst = WSP(bf16_t, WS_WLORA) + (size_t)i * 2560 * 384; ld_dst = 384; drow0 = 1024 + d * 512 + n0; dk0 = 128 + d * 64; }
            else if ((r -= 16) < 16) { src = C.A.in[16] + (size_t)i * 128 * 512; ld_src = 512; nvalid = 512; k0 = (r >> 3) * 64; n0 = (r & 7) * 64; dst = WSP(bf16_t, WS_WLORA) + (size_t)i * 2560 * 384; ld_dst = 384; drow0 = 2048 + n0; dk0 = 256 + k0; }
            else if ((r -= 16) < 72) { src = C.A.in[23] + (size_t)i * 384 * 768; ld_src = 768; nvalid = 768; k0 = (r / 12) * 64; n0 = (r % 12) * 64; dst = WSP(bf16_t, WS_WQUP) + (size_t)i * 768 * 384; ld_dst = 384; drow0 = n0; dk0 = k0; }
            else if ((r -= 72) < 64) { src = C.A.in[25] + (size_t)i * 256 * 1024; ld_src = 1024; nvalid = 1024; k0 = (r / 16) * 64; n0 = (r % 16) * 64; dst = WSP(bf16_t, WS_WKVUP) + (size_t)i * 1024 * 256; ld_dst = 256; drow0 = n0; dk0 = k0; }
            else if ((r -= 64) < 256) { src = C.A.in[10] + (size_t)i * 1024 * 1024; ld_src = 1024; nvalid = 1024; k0 = (r / 16) * 64; n0 = (r % 16) * 64; dst = WSP(bf16_t, WS_WOUTA) + (size_t)i * 1024 * 1024; ld_dst = 1024; drow0 = n0; dk0 = k0; }
            else if ((r -= 256) < 768) { src = C.A.in[26] + (size_t)i * 1024 * 3072; ld_src = 3072; nvalid = 3072; k0 = (r / 48) * 64; n0 = (r % 48) * 64; dst = WSP(bf16_t, WS_WQKV) + (size_t)i * 3072 * 1024; ld_dst = 1024; drow0 = n0; dk0 = k0; }
            else { r -= 768; src = C.A.in[28] + (size_t)i * 1024 * 1024; ld_src = 1024; nvalid = 1024; k0 = (r / 16) * 64; n0 = (r % 16) * 64; dst = WSP(bf16_t, WS_WOUTC) + (size_t)i * 1024 * 1024; ld_dst = 1024; drow0 = n0; dk0 = k0; }
        } else {
            const int m = it - 2 * CV_SMALL, le = m / 1536, r = m % 1536, which = r / 512, q = r % 512;
            if (which < 2) { src = C.A.in[which == 0 ? 30 : 31] + (size_t)le * 1024 * 2048; ld_src = 2048; nvalid = 2048; k0 = (q / 32) * 64; n0 = (q % 32) * 64;
                dst = WSP(bf16_t, WS_W13) + (size_t)le * 4096 * 1024; ld_dst = 1024; drow0 = (n0 >> 7) * 256 + which * 128 + (n0 & 127); dk0 = k0; }
            else { src = C.A.in[32] + (size_t)le * 2048 * 1024; ld_src = 1024; nvalid = 1024; k0 = (q / 16) * 64; n0 = (q % 16) * 64;
                dst = WSP(bf16_t, WS_W2) + (size_t)le * 1024 * 2048; ld_dst = 2048; drow0 = n0; dk0 = k0; }
        }
        tr_item(src, ld_src, nvalid, k0, n0, dst, ld_dst, drow0, dk0, scr, C.lane);
    }
}
constexpr int CV_BATCH = 16, CV_NB_L = CV_MOE_L / CV_BATCH, CV_NB = 4 * CV_NB_L;
__device__ __forceinline__ int bg_pull(const Ctx& C, unsigned* ctr, int limit) {
    volatile LAS int* slot = (volatile LAS int*)(C.lds + LDSCTL_OFF + 64);
    __syncthreads();
    if (C.tid == 0) { int b = -1; if ((int)__hip_atomic_load(ctr, __ATOMIC_RELAXED, __HIP_MEMORY_SCOPE_AGENT) < limit) { b = (int)__hip_atomic_fetch_add(ctr, 1u, __ATOMIC_RELAXED, __HIP_MEMORY_SCOPE_AGENT); if (b >= CV_NB) b = -1; } slot[0] = b; }
    __syncthreads();
    return slot[0];
}
__device__ __forceinline__ void bg_batch(const Ctx& C, int b) { LAS float* scr = (LAS float*)(C.lds + C.wave * 16640); for (int k = C.wave; k < CV_BATCH; k += 8) convert_item(C, 2 * CV_SMALL + b * CV_BATCH + k, scr); }
__device__ __forceinline__ void bg_fill(const Ctx& C, int budget) { unsigned* ctr = (unsigned*)(C.ws + WS_CTL) + CW_QUEUE + 64 * 8; for (int n = 0; n < budget; ++n) { const int b = bg_pull(C, ctr, CV_NB); if (b < 0) break; bg_batch(C, b); } }
__device__ __forceinline__ void bg_catch_up(const Ctx& C, int limit) { unsigned* ctr = (unsigned*)(C.ws + WS_CTL) + CW_QUEUE + 64 * 8; for (;;) { const int b = bg_pull(C, ctr, limit); if (b < 0) break; bg_batch(C, b); } }
__device__ __forceinline__ int units_missing(int nwg, int G, int c) { const int mx = (nwg + G - 1) / G, mine = c < nwg ? (nwg - c + G - 1) / G : 0; return mx - mine; }
__device__ __forceinline__ void p0_convert(const Ctx& C) {
    LAS float* scr = (LAS float*)(C.lds + C.wave * 16640);
    for (int it = C.gw; it < 2 * CV_SMALL; it += C.ngw) convert_item(C, it, scr);
    const u32x4 z4 = (u32x4){0u, 0u, 0u, 0u};
    const int gt = C.bid * 512 + C.tid, ngt = C.G * 512;
    for (int idx = gt; idx < 2 * 224 * 128; idx += ngt) { const int i = idx / (224 * 128), r = (idx / 128) % 224, ch = idx % 128;
        *(u32x4*)(WSP(bf16_t, WS_WIN) + ((size_t)i * ZP + 2592 + r) * 1024 + ch * 8) = z4; }
    for (int idx = gt; idx < 2 * 2560 * 48; idx += ngt) { const int i = idx / (2560 * 48), r = (idx / 48) % 2560, ch = idx % 48, seg = r >> 9;
        const int lo = seg < 4 ? seg * 8 : 32, hi = seg < 4 ? seg * 8 + 8 : 48;
        if (ch < lo || ch >= hi) *(u32x4*)(WSP(bf16_t, WS_WLORA) + ((size_t)i * 2560 + r) * 384 + ch * 8) = z4; }
    for (int idx = gt; idx < 2048 * 16; idx += ngt) { const int t = idx >> 4, i = idx & 15; const float pos = (float)(i < 8 ? (t >> 6) : (t & 63));
        const float inv = powf(10000.0f, -(float)(i & 7) / 8.0f); const float ang = pos * inv;
        WSP(float, WS_ROPE)[idx * 2] = cosf(ang); WSP(float, WS_ROPE)[idx * 2 + 1] = sinf(ang); }
}
__device__ __forceinline__ void p0_mod(const Ctx& C) {
    LAS float* sc = (LAS float*)C.lds;
    LAS float* part = (LAS float*)(C.lds + 36864);
    __syncthreads();
    for (int idx = C.tid; idx < 9 * 1024; idx += 512) { const int r = idx >> 10, k = idx & 1023; const float cv = r < 8 ? C.A.in[1][r * 1024 + k] : C.A.in[3][k]; sc[idx] = cv / (1.f + __expf(-cv)); }
    __syncthreads();
    for (int unit = C.bid; unit < 192; unit += C.G) {
        const int l = unit / 48, jb = unit % 48, jj = C.tid & 127, kc = C.tid >> 7;
        const float* w = C.A.in[4] + ((size_t)l * 1024 + kc * 256) * 6144 + jb * 128 + jj;
        float acc[9];
#pragma unroll
        for (int r = 0; r < 9; ++r) acc[r] = 0.f;
#pragma unroll 4
        for (int k = 0; k < 256; ++k) { const float wv = w[(size_t)k * 6144];
#pragma unroll
            for (int r = 0; r < 9; ++r) acc[r] += sc[r * 1024 + kc * 256 + k] * wv; }
#pragma unroll
        for (int r = 0; r < 9; ++r) part[(kc * 9 + r) * 128 + jj] = acc[r];
        __syncthreads();
        for (int idx = C.tid; idx < 9 * 128; idx += 512) { const int r = idx >> 7, j2 = idx & 127;
            const float s = part[(0 * 9 + r) * 128 + j2] + part[(1 * 9 + r) * 128 + j2] + part[(2 * 9 + r) * 128 + j2] + part[(3 * 9 + r) * 128 + j2] + C.A.in[5][l * 6144 + jb * 128 + j2];
            WSP(float, WS_MOD)[(size_t)(l * 9 + r) * 6144 + jb * 128 + j2] = s; }
        __syncthreads();
    }
}

__device__ __forceinline__ void row_load(const float* p, int lane, f32x4 (&v)[4]) {
#pragma unroll
    for (int j = 0; j < 4; ++j) v[j] = *(const f32x4*)(p + (lane + 64 * j) * 4); }
__device__ __forceinline__ void row_store(float* p, int lane, const f32x4 (&v)[4]) {
#pragma unroll
    for (int j = 0; j < 4; ++j) *(f32x4*)(p + (lane + 64 * j) * 4) = v[j]; }
__device__ __forceinline__ float row_rstd(const f32x4 (&v)[4]) {
    float s = 0.f;
#pragma unroll
    for (int j = 0; j < 4; ++j) s += (v[j].x * v[j].x + v[j].y * v[j].y) + (v[j].z * v[j].z + v[j].w * v[j].w);
    return rsqrtf(wave_sum(s) * (1.f / 1024.f) + NORM_EPS); }
__device__ __forceinline__ void row_modulate(const f32x4 (&v)[4], float rstd, const float* nw, const float* sh, const float* sc, int lane, f32x4 (&h)[4]) {
#pragma unroll
    for (int j = 0; j < 4; ++j) { const int c = (lane + 64 * j) * 4; const f32x4 w = *(const f32x4*)(nw + c), s1 = *(const f32x4*)(sc + c), s0 = *(const f32x4*)(sh + c);
        h[j] = (v[j] * rstd * w) * (s1 + 1.0f) + s0; } }
__device__ __forceinline__ void row_store_bf16(bf16_t* p, int lane, const f32x4 (&h)[4]) {
#pragma unroll
    for (int j = 0; j < 4; ++j) { u32x2 w; w.x = pk2(h[j].x, h[j].y); w.y = pk2(h[j].z, h[j].w); *(u32x2*)(p + (lane + 64 * j) * 4) = w; } }

__device__ __forceinline__ void p1_init(const Ctx& C) {
    for (int row = C.gw; row < NT; row += C.ngw) {
        const float* src = row < NLAT ? C.A.in[0] + (size_t)row * DM : C.A.in[2] + (size_t)(row - NLAT) * DM;
        f32x4 v[4], h[4]; row_load(src, C.lane, v); row_store(WSP(float, WS_X) + (size_t)row * DM, C.lane, v);
        const int mg = mod_group(row); const float rstd = row_rstd(v);
        row_modulate(v, rstd, C.A.in[6], modp(C, 0, mg, 0), modp(C, 0, mg, 1), C.lane, h);
        row_store_bf16(WSP(bf16_t, WS_H) + (size_t)row * DM, C.lane, h);
    }
}

__device__ __forceinline__ void a2_prepare(const Ctx& C, int i) {
    const bf16_t* Z = WSP(const bf16_t, WS_Z);
    const float* mu = C.A.in[11] + (size_t)i * 2 * 1920;
    const int lane = C.lane;
    for (int row = C.gw; row < NT; row += C.ngw) {
        const bool isctx = row >= NLAT; const int t = isctx ? ((row - NLAT) & 255) : (row & 2047), T = isctx ? 256 : 2048;
        const bf16_t* z = Z + (size_t)row * ZP; const bool hp = t > 0, hn = t < T - 1;
        float r8[8], k8[8], v8[8];
#pragma unroll
        for (int seg = 0; seg < 3; ++seg) {
            const int c0 = seg * 512 + lane * 8; float zc[8], zp[8], zn[8], m0[8], m1[8];
            ld8(z + c0, zc);
            if (hp) ld8(z - ZP + c0, zp); else { for (int j = 0; j < 8; ++j) zp[j] = 0.f; }
            if (hn) ld8(z + ZP + c0, zn); else { for (int j = 0; j < 8; ++j) zn[j] = 0.f; }
            *(f32x4*)&m0[0] = *(const f32x4*)(mu + c0); *(f32x4*)&m0[4] = *(const f32x4*)(mu + c0 + 4);
            *(f32x4*)&m1[0] = *(const f32x4*)(mu + 1920 + c0); *(f32x4*)&m1[4] = *(const f32x4*)(mu + 1920 + c0 + 4);
#pragma unroll
            for (int j = 0; j < 8; ++j) { const float o = zc[j] + m0[j] * (zp[j] - zc[j]) + m1[j] * (zn[j] - zc[j]); if (seg == 0) r8[j] = o; else if (seg == 1) k8[j] = o; else v8[j] = o; }
        }
        st8(WSP(bf16_t, WS_R) + (size_t)row * ADIM + lane * 8, r8);
        st8(WSP(bf16_t, WS_KS) + (size_t)row * ADIM + lane * 8, k8);
        st8(WSP(bf16_t, WS_V) + (size_t)row * ADIM + lane * 8, v8);
        { float kk[8], ss = 0.f; const float* kkw = C.A.in[17] + i * ADIM + lane * 8;
#pragma unroll
            for (int j = 0; j < 8; ++j) { kk[j] = k8[j] * kkw[j]; ss += kk[j] * kk[j]; }
            ss = sum8(ss); const float inv = 1.f / fmaxf(sqrtf(ss), 1e-12f);
#pragma unroll
            for (int j = 0; j < 8; ++j) kk[j] *= inv;
            st8(WSP(bf16_t, WS_KK) + (size_t)row * ADIM + lane * 8, kk); }
#pragma unroll
        for (int seg = 0; seg < 3; ++seg) {
            const int c0 = 1536 + seg * 128 + lane * 2; const unsigned wc_ = *(const unsigned*)(z + c0);
            const unsigned wp_ = hp ? *(const unsigned*)(z - ZP + c0) : 0u, wn_ = hn ? *(const unsigned*)(z + ZP + c0) : 0u;
            float o[2];
#pragma unroll
            for (int j = 0; j < 2; ++j) { const float zc = j ? __uint_as_float(wc_ & 0xffff0000u) : __uint_as_float(wc_ << 16), zp = j ? __uint_as_float(wp_ & 0xffff0000u) : __uint_as_float(wp_ << 16),
                                                      zn = j ? __uint_as_float(wn_ & 0xffff0000u) : __uint_as_float(wn_ << 16);
                const float s = zc + mu[c0 + j] * (zp - zc) + mu[1920 + c0 + j] * (zn - zc);
                o[j] = seg == 0 ? tanhf(s) : (seg == 1 ? s : sigmoidf_(s)); }
            *(unsigned*)(WSP(bf16_t, WS_LIN) + (size_t)row * 384 + seg * 128 + lane * 2) = pk2(o[0], o[1]);
        }
        { float q[6], ss = 0.f;
#pragma unroll
            for (int j = 0; j < 3; ++j) { const unsigned w = *(const unsigned*)(z + 1920 + j * 128 + lane * 2); q[2 * j] = __uint_as_float(w << 16); q[2 * j + 1] = __uint_as_float(w & 0xffff0000u); ss += q[2 * j] * q[2 * j] + q[2 * j + 1] * q[2 * j + 1]; }
            const float rstd = rsqrtf(wave_sum(ss) * (1.f / 384.f) + NORM_EPS); const float* nw = C.A.in[22] + i * 384;
#pragma unroll
            for (int j = 0; j < 3; ++j) { const int c = j * 128 + lane * 2; *(unsigned*)(WSP(bf16_t, WS_QN) + (size_t)row * 384 + c) = pk2(q[2 * j] * rstd * nw[c], q[2 * j + 1] * rstd * nw[c + 1]); } }
        { const u32x2 w = *(const u32x2*)(z + 2304 + lane * 4); float q[4] = {__uint_as_float(w.x << 16), __uint_as_float(w.x & 0xffff0000u), __uint_as_float(w.y << 16), __uint_as_float(w.y & 0xffff0000u)};
            const float ss = q[0] * q[0] + q[1] * q[1] + q[2] * q[2] + q[3] * q[3];
            const float rstd = rsqrtf(wave_sum(ss) * (1.f / 256.f) + NORM_EPS); const float* nw = C.A.in[24] + i * 256 + lane * 4;
            u32x2 o; o.x = pk2(q[0] * rstd * nw[0], q[1] * rstd * nw[1]); o.y = pk2(q[2] * rstd * nw[2], q[3] * rstd * nw[3]);
            *(u32x2*)(WSP(bf16_t, WS_KVN) + (size_t)row * 256 + lane * 4) = o; }
        if (lane < 16) { const unsigned w = *(const unsigned*)(z + 2560 + lane * 2); float x0 = __uint_as_float(w << 16), x1 = __uint_as_float(w & 0xffff0000u);
            if (!isctx) { const float cs = WSP(const float, WS_ROPE)[(t * 16 + lane) * 2], sn = WSP(const float, WS_ROPE)[(t * 16 + lane) * 2 + 1]; const float o0 = x0 * cs - x1 * sn, o1 = x0 * sn + x1 * cs; x0 = o0; x1 = o1; }
            *(unsigned*)(WSP(bf16_t, WS_KR) + (size_t)row * 32 + lane * 2) = pk2(x0, x1); }
    }
}

struct FStoreBf16 { bf16_t* O; int ldo; float scale; int scale_cols;
    __device__ __forceinline__ void operator()(int row, int col, const float (&v)[8]) const { float o[8]; const float s = col < scale_cols ? scale : 1.f;
#pragma unroll
        for (int j = 0; j < 8; ++j) o[j] = v[j] * s;
        st8(O + (size_t)row * ldo + col, o); } };
struct FLora { const float* w0; const float* a0; const float* ka; const bf16_t* KS; const bf16_t* KK; float* DEC; bf16_t* KD; bf16_t* BB; bf16_t* G;
    __device__ __forceinline__ void operator()(int row, int col, const float (&v)[8]) const {
        const int seg = col >> 9, c = col & 511;
        if (seg < 2) { float o[8];
#pragma unroll
            for (int j = 0; j < 8; ++j) { const float x = w0[seg * 512 + c + j] + v[j]; const float sp = fmaxf(-x, 0.f) + __logf(1.f + __expf(-fabsf(x)));
                o[j] = __expf(-__expf(-sp - 0.5f)); }
            float* d = DEC + ((size_t)seg * NT + row) * ADIM + c; *(f32x4*)d = *(const f32x4*)&o[0]; *(f32x4*)(d + 4) = *(const f32x4*)&o[4];
        } else if (seg < 4) { const int d_ = seg - 2; float k[8], kk[8], kd[8], bb[8]; ld8(KS + (size_t)row * ADIM + c, k); ld8(KK + (size_t)row * ADIM + c, kk);
#pragma unroll
            for (int j = 0; j < 8; ++j) { const float a = sigmoidf_(a0[d_ * 512 + c + j] + v[j]); kd[j] = k[j] * (1.f + (a - 1.f) * ka[c + j]); bb[j] = kk[j] * a; }
            st8(KD + ((size_t)d_ * NT + row) * ADIM + c, kd); st8(BB + ((size_t)d_ * NT + row) * ADIM + c, bb);
        } else st8(G + (size_t)row * ADIM + c, v);
    } };
struct FQup { bf16_t* Q; const float* rope; float scale;
    __device__ __forceinline__ void operator()(int row, int col, const float (&v)[8]) const {
        const int d = col % 96; float o[8];
#pragma unroll
        for (int j = 0; j < 8; ++j) o[j] = v[j] * scale;
        if (d >= 64 && row < NLAT) { const int t = row & 2047, p0 = (d - 64) >> 1;
#pragma unroll
            for (int p = 0; p < 4; ++p) { const float cs = rope[(t * 16 + p0 + p) * 2], sn = rope[(t * 16 + p0 + p) * 2 + 1]; const float x0 = o[2 * p], x1 = o[2 * p + 1]; o[2 * p] = x0 * cs - x1 * sn; o[2 * p + 1] = x0 * sn + x1 * cs; } }
        st8(Q + (size_t)row * 768 + col, o);
    } };
struct FResid { float* X; const float* mod; int layer;
    __device__ __forceinline__ void operator()(int row, int col, const float (&v)[8]) const {
        const float* g = mod + ((size_t)(layer * 9 + mod_group(row)) * 6 + 2) * 1024 + col; float* x = X + (size_t)row * DM + col;
        f32x4 x0 = *(const f32x4*)x, x1 = *(const f32x4*)(x + 4); const f32x4 g0 = *(const f32x4*)g, g1 = *(const f32x4*)(g + 4);
        x0 += g0 * (f32x4){v[0], v[1], v[2], v[3]}; x1 += g1 * (f32x4){v[4], v[5], v[6], v[7]};
        *(f32x4*)x = x0; *(f32x4*)(x + 4) = x1;
    } };
struct FSwiglu { bf16_t* HID;
    __device__ __forceinline__ void operator()(int row, int col, const float (&a)[8], const float (&b)[8]) const { float o[8];
#pragma unroll
        for (int j = 0; j < 8; ++j) o[j] = a[j] / (1.f + __expf(-a[j])) * b[j];
        st8(HID + (size_t)row * FF + (col & (FF - 1)), o); } };
struct FGate { bf16_t* YB; const float* gate;
    __device__ __forceinline__ void operator()(int row, int col, const float (&v)[8]) const { const float g = gate[row]; float o[8];
#pragma unroll
        for (int j = 0; j < 8; ++j) o[j] = v[j] * g;
        st8(YB + (size_t)row * DM + (col & (DM - 1)), o); } };

constexpr int SC_TC = 32;
constexpr int SC_ARR = SC_TC * 64, SC_BUF = 6 * SC_ARR + 2 * SC_TC;
__device__ __forceinline__ void a4_scan(const Ctx& C) {
    LAS float* L = (LAS float*)C.lds;
    LAS float* YB_ = L + 2 * SC_BUF;
    const int tid = C.tid; const bool stager = tid >= 256;
    const int rp = (tid >> 3) & 31, j = tid & 7;
    const int t2 = tid & 255, ls_ld = t2 >> 3, c8 = (t2 & 7) * 8;
    for (int unit = C.bid; unit < 128; unit += C.G) {
        const int b = unit >> 4, h = (unit >> 1) & 7, dir = unit & 1;
        const float* DEC = WSP(const float, WS_DEC) + (size_t)dir * NT * ADIM + h * 64;
        const bf16_t* KD = WSP(const bf16_t, WS_KD) + (size_t)dir * NT * ADIM + h * 64;
        const bf16_t* BB = WSP(const bf16_t, WS_BB) + (size_t)dir * NT * ADIM + h * 64;
        const bf16_t* KK = WSP(const bf16_t, WS_KK) + h * 64; const bf16_t* R = WSP(const bf16_t, WS_R) + h * 64; const bf16_t* V = WSP(const bf16_t, WS_V) + h * 64;
        float* Y = WSP(float, WS_Y) + (size_t)dir * NT * ADIM + h * 64;
        auto row_of = [&](int s_) -> int { return s_ < 256 ? NLAT + b * 256 + (dir ? 255 - s_ : s_) : b * 2048 + (dir ? 2047 - (s_ - 256) : (s_ - 256)); };
        f32x4 pw0, pw1; u32x4 pkd, pbb, pkk, pr, pv;
        auto gload = [&](int chunk) { const size_t o = (size_t)row_of(chunk * SC_TC + ls_ld) * ADIM + c8;
            pw0 = *(const f32x4*)(DEC + o); pw1 = *(const f32x4*)(DEC + o + 4); pkd = *(const u32x4*)(KD + o); pbb = *(const u32x4*)(BB + o); pkk = *(const u32x4*)(KK + o); pr = *(const u32x4*)(R + o); pv = *(const u32x4*)(V + o); };
        auto lwrite = [&](int buf) { LAS float* Bf = L + buf * SC_BUF + ls_ld * 64 + c8;
            float kd[8], bb[8], kk[8], r[8], v[8]; unpk8(pkd, kd); unpk8(pbb, bb); unpk8(pkk, kk); unpk8(pr, r); unpk8(pv, v);
            *(LAS f32x4*)(Bf) = pw0; *(LAS f32x4*)(Bf + 4) = pw1;
            *(LAS f32x4*)(Bf + SC_ARR) = *(const f32x4*)&kd[0]; *(LAS f32x4*)(Bf + SC_ARR + 4) = *(const f32x4*)&kd[4];
            *(LAS f32x4*)(Bf + 2 * SC_ARR) = *(const f32x4*)&bb[0]; *(LAS f32x4*)(Bf + 2 * SC_ARR + 4) = *(const f32x4*)&bb[4];
            *(LAS f32x4*)(Bf + 3 * SC_ARR) = *(const f32x4*)&kk[0]; *(LAS f32x4*)(Bf + 3 * SC_ARR + 4) = *(const f32x4*)&kk[4];
            *(LAS f32x4*)(Bf + 4 * SC_ARR) = pw0 * *(const f32x4*)&r[0]; *(LAS f32x4*)(Bf + 4 * SC_ARR + 4) = pw1 * *(const f32x4*)&r[4];
            *(LAS f32x4*)(Bf + 5 * SC_ARR) = *(const f32x4*)&v[0]; *(LAS f32x4*)(Bf + 5 * SC_ARR + 4) = *(const f32x4*)&v[4];
            float br = 0.f, kr = 0.f;
#pragma unroll
            for (int q = 0; q < 8; ++q) { br += bb[q] * r[q]; kr += kd[q] * r[q]; }
            br = sum8(br); kr = sum8(kr);
            if ((tid & 7) == 0) *(LAS f32x2*)(L + buf * SC_BUF + 6 * SC_ARR + ls_ld * 2) = (f32x2){br, kr}; };
        f32x2 S0[4], S1[4];
#pragma unroll
        for (int q = 0; q < 4; ++q) { S0[q] = (f32x2){0.f, 0.f}; S1[q] = (f32x2){0.f, 0.f}; }
        __syncthreads();
        if (stager) { gload(0); lwrite(0); }
        __syncthreads();
        constexpr int NCH = 2304 / SC_TC;
        for (int ch = 0; ch < NCH; ++ch) {
            if (stager) {
                if (ch > 0) { const LAS float* yp = YB_ + ((ch - 1) & 1) * SC_ARR + ls_ld * 64 + c8; float* yg = Y + (size_t)row_of((ch - 1) * SC_TC + ls_ld) * ADIM + c8;
                    *(f32x4*)yg = *(const LAS f32x4*)yp; *(f32x4*)(yg + 4) = *(const LAS f32x4*)(yp + 4); }
                if (ch + 1 < NCH) { gload(ch + 1); lwrite((ch + 1) & 1); }
            } else {
                const LAS float* Bf = L + (ch & 1) * SC_BUF + j * 8;
                const LAS float* Bv = L + (ch & 1) * SC_BUF + 5 * SC_ARR + 2 * rp;
                const LAS float* Bs = L + (ch & 1) * SC_BUF + 6 * SC_ARR;
                LAS float* yb = YB_ + (ch & 1) * SC_ARR + 2 * rp;
#pragma unroll 2
                for (int ls = 0; ls < SC_TC; ++ls) {
                    const LAS float* p = Bf + ls * 64;
                    const f32x4 w0 = *(const LAS f32x4*)(p), w1 = *(const LAS f32x4*)(p + 4);
                    const f32x4 d0 = *(const LAS f32x4*)(p + SC_ARR), d1 = *(const LAS f32x4*)(p + SC_ARR + 4);
                    const f32x4 b0 = *(const LAS f32x4*)(p + 2 * SC_ARR), b1 = *(const LAS f32x4*)(p + 2 * SC_ARR + 4);
                    const f32x4 k0 = *(const LAS f32x4*)(p + 3 * SC_ARR), k1 = *(const LAS f32x4*)(p + 3 * SC_ARR + 4);
                    const f32x4 r0 = *(const LAS f32x4*)(p + 4 * SC_ARR), r1 = *(const LAS f32x4*)(p + 4 * SC_ARR + 4);
                    const f32x2 vv = *(const LAS f32x2*)(Bv + ls * 64), sc = *(const LAS f32x2*)(Bs + ls * 2);
                    const f32x2 kA = {k0.x, k0.y}, kB = {k0.z, k0.w}, kC = {k1.x, k1.y}, kD = {k1.z, k1.w}, rA = {r0.x, r0.y}, rB = {r0.z, r0.w}, rC = {r1.x, r1.y}, rD = {r1.z, r1.w};
                    f32x2 a10 = S0[0] * kA; a10 += S0[1] * kB; a10 += S0[2] * kC; a10 += S0[3] * kD;
                    f32x2 a11 = S1[0] * kA; a11 += S1[1] * kB; a11 += S1[2] * kC; a11 += S1[3] * kD;
                    f32x2 a20 = S0[0] * rA; a20 += S0[1] * rB; a20 += S0[2] * rC; a20 += S0[3] * rD;
                    f32x2 a21 = S1[0] * rA; a21 += S1[1] * rB; a21 += S1[2] * rC; a21 += S1[3] * rD;
                    float q10 = a10.x + a10.y, q11 = a11.x + a11.y, q20 = a20.x + a20.y, q21 = a21.x + a21.y;
                    q10 += dpp_f<0xB1>(q10); q11 += dpp_f<0xB1>(q11); q20 += dpp_f<0xB1>(q20); q21 += dpp_f<0xB1>(q21);
                    q10 += dpp_f<0x4E>(q10); q11 += dpp_f<0x4E>(q11); q20 += dpp_f<0x4E>(q20); q21 += dpp_f<0x4E>(q21);
                    q10 += dpp_f<0x141>(q10); q11 += dpp_f<0x141>(q11); q20 += dpp_f<0x141>(q20); q21 += dpp_f<0x141>(q21);
                    const float sa0 = -q10, sa1 = -q11;
                    const f32x2 y2 = {q20 + sa0 * sc.x + vv.x * sc.y, q21 + sa1 * sc.x + vv.y * sc.y};
                    const f32x2 sA = {sa0, sa0}, sB = {sa1, sa1}, vA = {vv.x, vv.x}, vB = {vv.y, vv.y};
                    const f32x2 wA = {w0.x, w0.y}, wB = {w0.z, w0.w}, wC = {w1.x, w1.y}, wD = {w1.z, w1.w}, bA = {b0.x, b0.y}, bB = {b0.z, b0.w}, bC = {b1.x, b1.y}, bD = {b1.z, b1.w};
                    const f32x2 dA = {d0.x, d0.y}, dB = {d0.z, d0.w}, dC = {d1.x, d1.y}, dD = {d1.z, d1.w};
                    S0[0] = S0[0] * wA + sA * bA + vA * dA; S0[1] = S0[1] * wB + sA * bB + vA * dB; S0[2] = S0[2] * wC + sA * bC + vA * dC; S0[3] = S0[3] * wD + sA * bD + vA * dD;
                    S1[0] = S1[0] * wA + sB * bA + vB * dA; S1[1] = S1[1] * wB + sB * bB + vB * dB; S1[2] = S1[2] * wC + sB * bC + vB * dC; S1[3] = S1[3] * wD + sB * bD + vB * dD;
                    *(LAS f32x2*)(yb + ls * 64) = y2;
                }
            }
            __syncthreads();
        }
        if (stager) { const LAS float* yp = YB_ + ((NCH - 1) & 1) * SC_ARR + ls_ld * 64 + c8; float* yg = Y + (size_t)row_of((NCH - 1) * SC_TC + ls_ld) * ADIM + c8;
            *(f32x4*)yg = *(const LAS f32x4*)yp; *(f32x4*)(yg + 4) = *(const LAS f32x4*)(yp + 4); }
    }
}

__device__ __forceinline__ void a4_mla_naive(const Ctx& C) {
    LAS float* Kt = (LAS float*)C.lds;
    LAS float* Vt = Kt + 32 * 96;
    const bf16_t* Q = WSP(const bf16_t, WS_Q); const bf16_t* KV = WSP(const bf16_t, WS_KV); const bf16_t* KR = WSP(const bf16_t, WS_KR); bf16_t* MIX = WSP(bf16_t, WS_MIX);
    const int tid = C.tid;
    for (int unit = C.bid; unit < 320; unit += C.G) {
        int b, h, qrow, nkeys; bool active = true;
        if (unit < 256) { b = unit >> 5; h = (unit >> 2) & 7; qrow = b * 2048 + (unit & 3) * 512 + tid; nkeys = 2304; }
        else { const int u = unit - 256; b = u >> 3; h = u & 7; qrow = NLAT + b * 256 + (tid & 255); nkeys = 256; active = tid < 256; }
        float q[96], acc[64], m = -1e30f, l = 0.f;
#pragma unroll
        for (int d8 = 0; d8 < 12; ++d8) { float t8[8]; ld8(Q + (size_t)qrow * 768 + h * 96 + d8 * 8, t8);
#pragma unroll
            for (int jj = 0; jj < 8; ++jj) q[d8 * 8 + jj] = t8[jj]; }
#pragma unroll
        for (int d = 0; d < 64; ++d) acc[d] = 0.f;
        for (int kt = 0; kt < nkeys; kt += 32) {
            __syncthreads();
            for (int idx = tid; idx < 32 * 48; idx += 512) { const int key = idx / 48, dp = idx % 48, kj = kt + key; const int krow = kj < 256 ? NLAT + b * 256 + kj : b * 2048 + (kj - 256);
                const unsigned w = dp < 32 ? *(const unsigned*)(KV + (size_t)krow * 1024 + h * 128 + dp * 2) : *(const unsigned*)(KR + (size_t)krow * 32 + (dp - 32) * 2);
                Kt[key * 96 + dp * 2] = __uint_as_float(w << 16); Kt[key * 96 + dp * 2 + 1] = __uint_as_float(w & 0xffff0000u); }
            for (int idx = tid; idx < 32 * 32; idx += 512) { const int key = idx >> 5, dp = idx & 31, kj = kt + key; const int krow = kj < 256 ? NLAT + b * 256 + kj : b * 2048 + (kj - 256);
                const unsigned w = *(const unsigned*)(KV + (size_t)krow * 1024 + h * 128 + 64 + dp * 2);
                Vt[key * 64 + dp * 2] = __uint_as_float(w << 16); Vt[key * 64 + dp * 2 + 1] = __uint_as_float(w & 0xffff0000u); }
            __syncthreads();
            for (int key = 0; key < 32; ++key) {
                float s = 0.f;
#pragma unroll
                for (int d4 = 0; d4 < 24; ++d4) { const f32x4 kv = *(const LAS f32x4*)(Kt + key * 96 + d4 * 4); s += q[d4 * 4] * kv.x + q[d4 * 4 + 1] * kv.y + q[d4 * 4 + 2] * kv.z + q[d4 * 4 + 3] * kv.w; }
                const float mn = fmaxf(m, s), corr = __expf(m - mn), p = __expf(s - mn); m = mn; l = l * corr + p;
#pragma unroll
                for (int d4 = 0; d4 < 16; ++d4) { const f32x4 vv = *(const LAS f32x4*)(Vt + key * 64 + d4 * 4);
                    acc[d4 * 4] = acc[d4 * 4] * corr + p * vv.x; acc[d4 * 4 + 1] = acc[d4 * 4 + 1] * corr + p * vv.y; acc[d4 * 4 + 2] = acc[d4 * 4 + 2] * corr + p * vv.z; acc[d4 * 4 + 3] = acc[d4 * 4 + 3] * corr + p * vv.w; }
            }
        }
        if (active) { const float il = 1.f / l;
#pragma unroll
            for (int d8 = 0; d8 < 8; ++d8) { float o[8];
#pragma unroll
                for (int jj = 0; jj < 8; ++jj) o[jj] = acc[d8 * 8 + jj] * il;
                st8(MIX + (size_t)qrow * DM + 512 + h * 64 + d8 * 8, o); } }
    }
    __syncthreads();
}

typedef float f32x16 __attribute__((ext_vector_type(16)));
__device__ __forceinline__ int crow(int r, int hi) { return (r & 3) + 8 * (r >> 2) + 4 * hi; }
constexpr int AT_VP = 136;
template <class Spec> __device__ __forceinline__ void attn_unit(const Ctx& C, const Spec& sp) {
    constexpr int DQ = Spec::DQ, NS = DQ / 16, KP = Spec::KPITCH, KBUF = 64 * KP, VBUF = 64 * AT_VP, BUF = KBUF + VBUF;
    static_assert(BUF % 16 == 0 && KP % 16 == 0, "alignment");
    LAS unsigned char* L = C.lds;
    const int tid = C.tid, lane = C.lane, w = C.wave, r32 = lane & 31, hi = lane >> 5;
    bf16x8 qf[NS];
    { const bf16_t* qp = sp.qptr(w * 32 + r32);
#pragma unroll
      for (int s_ = 0; s_ < NS; ++s_) qf[s_] = *(const bf16x8*)(qp + 16 * s_ + 8 * hi); }
    f32x16 o0, o1;
#pragma unroll
    for (int r = 0; r < 16; ++r) { o0[r] = 0.f; o1[r] = 0.f; }
    float m = -1e30f, lsum = 0.f;
    const int nt = sp.nt;
    const int skey = tid >> 3, sch = tid & 7, rkey = (tid >> 2) & 63, rch = 8 + (tid & 3);
    u32x4 gk, gk2, gv;
    gk2 = (u32x4){0u, 0u, 0u, 0u};
    auto gload = [&](int t) { gk = *(const u32x4*)sp.kptr(t, skey, sch); if (NS > 4 && tid < 256) gk2 = *(const u32x4*)sp.kptr(t, rkey, rch); gv = *(const u32x4*)sp.vptr(t, skey, sch); };
    auto lwrite = [&](int buf) { LAS unsigned char* Bk = L + buf * BUF;
        *(LAS u32x4*)(Bk + skey * KP + sch * 16) = gk; if (NS > 4 && tid < 256) *(LAS u32x4*)(Bk + rkey * KP + rch * 16) = gk2;
        LAS unsigned short* Bv = (LAS unsigned short*)(Bk + KBUF);
#pragma unroll
        for (int j = 0; j < 8; ++j) { const unsigned wv = gv[j >> 1]; Bv[(sch * 8 + j) * (AT_VP / 2) + skey] = (unsigned short)((j & 1) ? (wv >> 16) : (wv & 0xffffu)); } };
    __syncthreads();
    sp.prologue(C);
    gload(0); lwrite(0);
    __syncthreads();
    for (int t = 0; t < nt; ++t) {
        if (t + 1 < nt) gload(t + 1);
        if (sp.active(t, w)) {
            const LAS unsigned char* Bk = L + (t & 1) * BUF; const LAS unsigned char* Bv = Bk + KBUF;
            f32x16 p0, p1;
#pragma unroll
            for (int r = 0; r < 16; ++r) { p0[r] = 0.f; p1[r] = 0.f; }
#pragma unroll
            for (int s_ = 0; s_ < NS; ++s_) {
                const bf16x8 k0 = *(const LAS bf16x8*)(Bk + r32 * KP + 32 * s_ + 16 * hi), k1 = *(const LAS bf16x8*)(Bk + (32 + r32) * KP + 32 * s_ + 16 * hi);
                p0 = __builtin_amdgcn_mfma_f32_32x32x16_bf16(k0, qf[s_], p0, 0, 0, 0); p1 = __builtin_amdgcn_mfma_f32_32x32x16_bf16(k1, qf[s_], p1, 0, 0, 0); }
            sp.bias(C, t, w, r32, hi, p0, p1);
            float mx = fmaxf(p0[0], p1[0]);
#pragma unroll
            for (int r = 1; r < 16; ++r) mx = fmaxf(mx, fmaxf(p0[r], p1[r]));
            mx = fmaxf(mx, __shfl_xor(mx, 32));
            if (__any(mx > m + 8.0f)) {
                const float mn = fmaxf(m, mx), corr = __builtin_amdgcn_exp2f(m - mn); m = mn; lsum *= corr;
#pragma unroll
                for (int r = 0; r < 16; ++r) { o0[r] *= corr; o1[r] *= corr; }
            }
            float ps = 0.f;
#pragma unroll
            for (int r = 0; r < 16; ++r) { p0[r] = __builtin_amdgcn_exp2f(p0[r] - m); p1[r] = __builtin_amdgcn_exp2f(p1[r] - m); ps += p0[r] + p1[r]; }
            lsum += ps;
#pragma unroll
            for (int s_ = 0; s_ < 4; ++s_) {
                u32x4 pw;
                if (s_ < 2) { pw.x = pk2(p0[8 * s_ + 0], p0[8 * s_ + 1]); pw.y = pk2(p0[8 * s_ + 2], p0[8 * s_ + 3]); pw.z = pk2(p0[8 * s_ + 4], p0[8 * s_ + 5]); pw.w = pk2(p0[8 * s_ + 6], p0[8 * s_ + 7]); }
                else { const int q_ = 8 * (s_ - 2); pw.x = pk2(p1[q_ + 0], p1[q_ + 1]); pw.y = pk2(p1[q_ + 2], p1[q_ + 3]); pw.z = pk2(p1[q_ + 4], p1[q_ + 5]); pw.w = pk2(p1[q_ + 6], p1[q_ + 7]); }
                const bf16x8 pb = __builtin_bit_cast(bf16x8, pw);
#pragma unroll
                for (int dvh = 0; dvh < 2; ++dvh) {
                    const LAS unsigned char* vp = Bv + (dvh * 32 + r32) * AT_VP + 32 * s_ + 8 * hi;
                    const u32x2 a = *(const LAS u32x2*)vp, b = *(const LAS u32x2*)(vp + 16);
                    const bf16x8 vf = __builtin_bit_cast(bf16x8, (u32x4){a.x, a.y, b.x, b.y});
                    if (dvh == 0) o0 = __builtin_amdgcn_mfma_f32_32x32x16_bf16(vf, pb, o0, 0, 0, 0); else o1 = __builtin_amdgcn_mfma_f32_32x32x16_bf16(vf, pb, o1, 0, 0, 0);
                }
            }
        }
        if (t + 1 < nt) lwrite((t + 1) & 1);
        __syncthreads();
    }
    lsum += __shfl_xor(lsum, 32);
    const float il = 1.f / lsum;
    bf16_t* op = sp.optr(w * 32 + r32);
#pragma unroll
    for (int g = 0; g < 4; ++g) { u32x2 w0, w1;
        w0.x = pk2(o0[4 * g] * il, o0[4 * g + 1] * il); w0.y = pk2(o0[4 * g + 2] * il, o0[4 * g + 3] * il);
        w1.x = pk2(o1[4 * g] * il, o1[4 * g + 1] * il); w1.y = pk2(o1[4 * g + 2] * il, o1[4 * g + 3] * il);
        *(u32x2*)(op + 8 * g + 4 * hi) = w0; *(u32x2*)(op + 32 + 8 * g + 4 * hi) = w1; }
}
struct MlaSpec { static constexpr int DQ = 96, KPITCH = 208;
    const bf16_t* Q; const bf16_t* KV; const bf16_t* KR; bf16_t* O; int b, h, q0, nt;
    __device__ __forceinline__ const bf16_t* qptr(int i) const { return Q + (size_t)(q0 + i) * 768 + h * 96; }
    __device__ __forceinline__ bf16_t* optr(int i) const { return O + (size_t)(q0 + i) * DM + 512 + h * 64; }
    __device__ __forceinline__ int krow(int t, int key) const { return t < 4 ? NLAT + b * 256 + 64 * t + key : b * 2048 + 64 * (t - 4) + key; }
    __device__ __forceinline__ const bf16_t* kptr(int t, int key, int c) const { const int kr = krow(t, key); return c < 8 ? KV + (size_t)kr * 1024 + h * 128 + c * 8 : KR + (size_t)kr * 32 + (c - 8) * 8; }
    __device__ __forceinline__ const bf16_t* vptr(int t, int key, int c) const { return KV + (size_t)krow(t, key) * 1024 + h * 128 + 64 + c * 8; }
    __device__ __forceinline__ bool active(int, int) const { return true; }
    __device__ __forceinline__ void prologue(const Ctx&) const {}
    __device__ __forceinline__ void bias(const Ctx&, int, int, int, int, f32x16&, f32x16&) const {}
};
struct NaSpec { static constexpr int DQ = 64, KPITCH = 144; static constexpr int TAB_OFF = 2 * (64 * 144 + 64 * AT_VP);
    const bf16_t* QKV; bf16_t* O; const float* rpb; int b, h, rb, kr0, ntw, nt, isctx;
    __device__ __forceinline__ const bf16_t* qptr(int i) const { return QKV + (size_t)(isctx ? NLAT + b * 256 + i : b * 2048 + rb * 256 + i) * 3072 + h * 64; }
    __device__ __forceinline__ bf16_t* optr(int i) const { return O + (size_t)(isctx ? NLAT + b * 256 + i : b * 2048 + rb * 256 + i) * DM + h * 64; }
    __device__ __forceinline__ int krow(int t, int key) const { return t < ntw ? b * 2048 + (kr0 + t) * 64 + key : NLAT + b * 256 + 64 * (t - ntw) + key; }
    __device__ __forceinline__ const bf16_t* kptr(int t, int key, int c) const { return QKV + (size_t)krow(t, key) * 3072 + 1024 + h * 64 + c * 8; }
    __device__ __forceinline__ const bf16_t* vptr(int t, int key, int c) const { return QKV + (size_t)krow(t, key) * 3072 + 2048 + h * 64 + c * 8; }
    __device__ __forceinline__ bool active(int t, int w) const { if (t >= ntw) return true; const int qr = 4 * rb + (w >> 1), rs = min(max(qr - 4, 0), 24), kr = kr0 + t; return kr >= rs && kr < rs + 8; }
    __device__ __forceinline__ void prologue(const Ctx& C) const { if (!isctx) { LAS float* tab = (LAS float*)(C.lds + TAB_OFF); for (int idx = C.tid; idx < 640; idx += 512) { const int k = idx - 64; tab[idx] = (k >= 0 && k < 465) ? rpb[h * 465 + k] * 1.4426950408889634f : 0.f; } } }
    __device__ __forceinline__ void bias(const Ctx& C, int t, int w, int r32, int hi, f32x16& p0, f32x16& p1) const {
        if (t >= ntw) return;
        const LAS float* tab = (const LAS float*)(C.lds + TAB_OFF);
        const int qr = 4 * rb + (w >> 1), qc = 32 * (w & 1) + r32, cs = min(max(qc - 8, 0), 48), ro = (kr0 + t - qr + 7) * 31 - qc + 15 + 64;
        const LAS float* tb = tab + ro + 4 * hi; const int kb = 4 * hi - cs;
#pragma unroll
        for (int r = 0; r < 16; ++r) { const int c = (r & 3) + 8 * (r >> 2);
            const bool v0 = (unsigned)(c + kb) < 16u, v1 = (unsigned)(c + 32 + kb) < 16u;
            p0[r] = v0 ? p0[r] + tb[c] : -INFINITY; p1[r] = v1 ? p1[r] + tb[c + 32] : -INFINITY; }
    }
};
__device__ __forceinline__ void a4_mla(const Ctx& C, int layer) {
    volatile LAS int* slot = (volatile LAS int*)(C.lds + LDSCTL_OFF + 64);
    unsigned* ctr = (unsigned*)(C.ws + WS_CTL) + CW_QUEUE + 64 * layer;
    for (;;) {
        __syncthreads();
        if (C.tid == 0) slot[0] = (int)__hip_atomic_fetch_add(ctr, 1u, __ATOMIC_RELAXED, __HIP_MEMORY_SCOPE_AGENT);
        __syncthreads();
        const int unit = slot[0];
        if (unit >= 512 + 64) break;
        MlaSpec sp; sp.Q = WSP(const bf16_t, WS_Q); sp.KV = WSP(const bf16_t, WS_KV); sp.KR = WSP(const bf16_t, WS_KR); sp.O = WSP(bf16_t, WS_MIX);
        if (unit < 512) { sp.b = unit >> 6; sp.h = (unit >> 3) & 7; sp.q0 = sp.b * 2048 + (unit & 7) * 256; sp.nt = 36; }
        else { const int u = unit - 512; sp.b = u >> 3; sp.h = u & 7; sp.q0 = NLAT + sp.b * 256; sp.nt = 4; }
        attn_unit(C, sp);
    }
}
__device__ __forceinline__ void b2_na(const Ctx& C, int i, bool need_ctx) {
    for (int unit = C.bid; unit < 1024 + (need_ctx ? 128 : 0); unit += C.G) {
        NaSpec sp; sp.QKV = WSP(const bf16_t, WS_Z); sp.O = WSP(bf16_t, WS_MIX); sp.rpb = C.A.in[27] + (size_t)i * 16 * 465;
        if (unit < 1024) { sp.b = unit >> 7; sp.h = (unit >> 3) & 15; sp.rb = unit & 7; sp.isctx = 0;
            sp.kr0 = min(max(4 * sp.rb - 4, 0), 24); const int krl = min(max(4 * sp.rb + 3 - 4, 0), 24) + 7; sp.ntw = krl - sp.kr0 + 1; sp.nt = sp.ntw + 4; }
        else { const int u = unit - 1024; sp.b = u >> 4; sp.h = u & 15; sp.rb = 0; sp.isctx = 1; sp.kr0 = 0; sp.ntw = 0; sp.nt = 4; }
        attn_unit(C, sp);
    }
}

__device__ __forceinline__ void a5_output(const Ctx& C, int i) {
    const int lane = C.lane, c0 = lane * 8;
    const float* rk = C.A.in[19] + i * ADIM + c0; const float* lnw = C.A.in[20] + i * ADIM + c0; const float* lnb = C.A.in[21] + i * ADIM + c0;
    for (int row = C.gw; row < NT; row += C.ngw) {
        const float* yf = WSP(const float, WS_Y) + (size_t)row * ADIM + c0; const float* yb = yf + (size_t)NT * ADIM;
        float y[8]; { const f32x4 a0 = *(const f32x4*)yf, a1 = *(const f32x4*)(yf + 4), b0 = *(const f32x4*)yb, b1 = *(const f32x4*)(yb + 4);
            y[0] = a0.x + b0.x; y[1] = a0.y + b0.y; y[2] = a0.z + b0.z; y[3] = a0.w + b0.w; y[4] = a1.x + b1.x; y[5] = a1.y + b1.y; y[6] = a1.z + b1.z; y[7] = a1.w + b1.w; }
        float s = 0.f;
#pragma unroll
        for (int j = 0; j < 8; ++j) s += y[j];
        const float mean = sum8(s) * (1.f / 64.f); float q = 0.f;
#pragma unroll
        for (int j = 0; j < 8; ++j) { const float d = y[j] - mean; q += d * d; }
        const float rstd = rsqrtf(sum8(q) * (1.f / 64.f) + 64e-5f);
        float r[8], v[8], g[8], kd0[8], kd1[8];
        ld8(WSP(const bf16_t, WS_R) + (size_t)row * ADIM + c0, r); ld8(WSP(const bf16_t, WS_V) + (size_t)row * ADIM + c0, v); ld8(WSP(const bf16_t, WS_G) + (size_t)row * ADIM + c0, g);
        ld8(WSP(const bf16_t, WS_KD) + (size_t)row * ADIM + c0, kd0); ld8(WSP(const bf16_t, WS_KD) + ((size_t)NT + row) * ADIM + c0, kd1);
        float bs = 0.f;
#pragma unroll
        for (int j = 0; j < 8; ++j) bs += r[j] * (kd0[j] + kd1[j]) * rk[j];
        bs = sum8(bs);
        float o[8];
#pragma unroll
        for (int j = 0; j < 8; ++j) o[j] = ((y[j] - mean) * rstd * lnw[j] + lnb[j] + bs * v[j]) * g[j];
        st8(WSP(bf16_t, WS_MIX) + (size_t)row * DM + c0, o);
    }
}

__device__ __forceinline__ void b2_na_naive(const Ctx& C, int i, bool need_ctx) {
    const bf16_t* QKV = WSP(const bf16_t, WS_Z); bf16_t* MIX = WSP(bf16_t, WS_MIX);
    const float* rpb = C.A.in[27] + (size_t)i * 16 * 15 * 31;
    const int nq = need_ctx ? NT : NLAT;
    const int nblk = nq / 512;
    for (int unit = C.bid; unit < nblk * 16; unit += C.G) {
        const int h = unit & 15, qrow = (unit >> 4) * 512 + C.tid;
        float q[64], acc[64], m = -1e30f, l = 0.f;
#pragma unroll
        for (int d8 = 0; d8 < 8; ++d8) { float t8[8]; ld8(QKV + (size_t)qrow * 3072 + h * 64 + d8 * 8, t8);
#pragma unroll
            for (int jj = 0; jj < 8; ++jj) q[d8 * 8 + jj] = t8[jj]; }
#pragma unroll
        for (int d = 0; d < 64; ++d) acc[d] = 0.f;
        const bool isctx = qrow >= NLAT; const int b = isctx ? (qrow - NLAT) >> 8 : qrow >> 11;
        int qr = 0, qc = 0, rs = 0, cs = 0, nwin = 0;
        if (!isctx) { const int t = qrow & 2047; qr = t >> 6; qc = t & 63; rs = min(max(qr - 4, 0), 24); cs = min(max(qc - 8, 0), 48); nwin = 128; }
        const int nk = nwin + 256;
        for (int kj = 0; kj < nk; ++kj) {
            int krow; float bias = 0.f;
            if (kj < nwin) { const int kr = rs + (kj >> 4), kc = cs + (kj & 15); krow = b * 2048 + kr * 64 + kc; bias = rpb[(h * 15 + (kr - qr + 7)) * 31 + (kc - qc + 15)]; }
            else krow = NLAT + b * 256 + (kj - nwin);
            const bf16_t* kp = QKV + (size_t)krow * 3072 + 1024 + h * 64; const bf16_t* vp = kp + 1024;
            float s = 0.f;
#pragma unroll
            for (int d8 = 0; d8 < 8; ++d8) { float t8[8]; ld8(kp + d8 * 8, t8);
#pragma unroll
                for (int jj = 0; jj < 8; ++jj) s += q[d8 * 8 + jj] * t8[jj]; }
            s += bias;
            const float mn = fmaxf(m, s), corr = __expf(m - mn), p = __expf(s - mn); m = mn; l = l * corr + p;
#pragma unroll
            for (int d8 = 0; d8 < 8; ++d8) { float t8[8]; ld8(vp + d8 * 8, t8);
#pragma unroll
                for (int jj = 0; jj < 8; ++jj) acc[d8 * 8 + jj] = acc[d8 * 8 + jj] * corr + p * t8[jj]; }
        }
        const float il = 1.f / l;
#pragma unroll
        for (int d8 = 0; d8 < 8; ++d8) { float o[8];
#pragma unroll
            for (int jj = 0; jj < 8; ++jj) o[jj] = acc[d8 * 8 + jj] * il;
            st8(MIX + (size_t)qrow * DM + h * 64 + d8 * 8, o); }
    }
}

template <int CTRL, int N> __device__ __forceinline__ void tr_step_dpp(const float (&in)[2 * N], float (&out)[N], bool bit) {
#pragma unroll
    for (int k = 0; k < N; ++k) { const float keep = bit ? in[k + N] : in[k], give = bit ? in[k] : in[k + N]; out[k] = keep + dpp_f<CTRL>(give); } }
__device__ __forceinline__ void c2_router(const Ctx& C, int layer, int nrows) {
    const float* rw = C.A.in[29] + (size_t)layer * DM * NEXP; const int lane = C.lane;
    LAS float* scr = (LAS float*)(C.lds + C.wave * 256);
    const float* nw = C.A.in[7] + layer * DM;
    for (int grp = C.gw; grp < nrows / 4; grp += C.ngw) {
        const int row0 = grp * 4, mg = mod_group(row0);
        const float* sh = modp(C, layer, mg, 3); const float* sc = modp(C, layer, mg, 4);
        f32x4 h[4][4];
#pragma unroll
        for (int rr = 0; rr < 4; ++rr) row_load(WSP(const float, WS_X) + (size_t)(row0 + rr) * DM, lane, h[rr]);
#pragma unroll
        for (int rr = 0; rr < 4; ++rr) { const float rstd = row_rstd(h[rr]); f32x4 t[4]; row_modulate(h[rr], rstd, nw, sh, sc, lane, t);
#pragma unroll
            for (int j = 0; j < 4; ++j) h[rr][j] = t[j];
            row_store_bf16(WSP(bf16_t, WS_H) + (size_t)(row0 + rr) * DM, lane, h[rr]); }
        float lg[64];
#pragma unroll
        for (int k = 0; k < 64; ++k) lg[k] = 0.f;
#pragma unroll
        for (int j = 0; j < 4; ++j)
#pragma unroll
            for (int q = 0; q < 4; ++q) { const float* wr_ = rw + (size_t)((lane + 64 * j) * 4 + q) * NEXP;
                const f32x4 w0 = *(const f32x4*)(wr_), w1 = *(const f32x4*)(wr_ + 4), w2 = *(const f32x4*)(wr_ + 8), w3 = *(const f32x4*)(wr_ + 12);
#pragma unroll
                for (int rr = 0; rr < 4; ++rr) { const float hv = h[rr][j][q]; float* l = lg + rr * 16;
                    l[0] += hv * w0.x; l[1] += hv * w0.y; l[2] += hv * w0.z; l[3] += hv * w0.w; l[4] += hv * w1.x; l[5] += hv * w1.y; l[6] += hv * w1.z; l[7] += hv * w1.w;
                    l[8] += hv * w2.x; l[9] += hv * w2.y; l[10] += hv * w2.z; l[11] += hv * w2.w; l[12] += hv * w3.x; l[13] += hv * w3.y; l[14] += hv * w3.z; l[15] += hv * w3.w; } }
        float r1[32], r2[16], r3[8], r4[4], r5[2];
        tr_step_dpp<0x140, 32>(lg, r1, (lane >> 3) & 1); tr_step_dpp<0x141, 16>(r1, r2, (lane >> 2) & 1); tr_step_dpp<0x4E, 8>(r2, r3, (lane >> 1) & 1); tr_step_dpp<0xB1, 4>(r3, r4, lane & 1);
        { const bool bit = (lane >> 4) & 1;
#pragma unroll
          for (int k = 0; k < 2; ++k) { const float keep = bit ? r4[k + 2] : r4[k], give = bit ? r4[k] : r4[k + 2]; r5[k] = keep + __shfl_xor(give, 16); } }
        float lgt; { const bool bit = (lane >> 5) & 1; const float keep = bit ? r5[1] : r5[0], give = bit ? r5[0] : r5[1]; lgt = keep + __shfl_xor(give, 32); }
        const int idx = (((lane >> 3) & 1) << 5) | (((lane >> 2) & 1) << 4) | (((lane >> 1) & 1) << 3) | ((lane & 1) << 2) | (((lane >> 4) & 1) << 1) | ((lane >> 5) & 1);
        scr[idx] = lgt;
        asm volatile("s_waitcnt lgkmcnt(0)" ::: "memory");
        const int rr = idx >> 4, e = idx & 15;
        const f32x4 a0 = *(const LAS f32x4*)(scr + rr * 16), a1 = *(const LAS f32x4*)(scr + rr * 16 + 4), a2 = *(const LAS f32x4*)(scr + rr * 16 + 8), a3 = *(const LAS f32x4*)(scr + rr * 16 + 12);
        asm volatile("s_waitcnt lgkmcnt(0)" ::: "memory");
        const float mx = fmaxf(fmaxf(fmaxf(fmaxf(a0.x, a0.y), fmaxf(a0.z, a0.w)), fmaxf(fmaxf(a1.x, a1.y), fmaxf(a1.z, a1.w))), fmaxf(fmaxf(fmaxf(a2.x, a2.y), fmaxf(a2.z, a2.w)), fmaxf(fmaxf(a3.x, a3.y), fmaxf(a3.z, a3.w))));
        const float den = ((__expf(a0.x - mx) + __expf(a0.y - mx)) + (__expf(a0.z - mx) + __expf(a0.w - mx))) + ((__expf(a1.x - mx) + __expf(a1.y - mx)) + (__expf(a1.z - mx) + __expf(a1.w - mx)))
                        + ((__expf(a2.x - mx) + __expf(a2.y - mx)) + (__expf(a2.z - mx) + __expf(a2.w - mx))) + ((__expf(a3.x - mx) + __expf(a3.y - mx)) + (__expf(a3.z - mx) + __expf(a3.w - mx)));
        const float a = __expf(lgt - mx) / den;
        const int row = row0 + rr; float* AFF = WSP(float, WS_AFF);
        if (row < NLAT) AFF[((size_t)(row >> 11) * 16 + e) * 2048 + (row & 2047)] = a;
        else { const int r2_ = row - NLAT; AFF[(size_t)NB * 16 * 2048 + ((size_t)(r2_ >> 8) * 16 + e) * 256 + (r2_ & 255)] = a; }
    }
}

__device__ __forceinline__ void c3_topk(const Ctx& C, bool need_ctx) {
    LAS unsigned* cntw = (LAS unsigned*)C.lds;
    LAS unsigned* wtot = (LAS unsigned*)(C.lds + 256);
    LAS int* list = (LAS int*)(C.lds + 1024);
    const int nunits = 128 + (need_ctx ? 128 : 0), tid = C.tid, lane = C.lane, w = C.wave;
    const unsigned long long lt = (1ull << lane) - 1ull;
    for (int unit = C.bid; unit < nunits; unit += C.G) {
        const bool lat = unit < 128; const int u = lat ? unit : unit - 128, b = u >> 4, e = u & 15, n = lat ? 2048 : 256; const unsigned cap = lat ? 256u : 32u;
        const float* src = lat ? WSP(const float, WS_AFF) + ((size_t)b * 16 + e) * 2048 : WSP(const float, WS_AFF) + (size_t)NB * 16 * 2048 + ((size_t)b * 16 + e) * 256;
        const bool valid = 4 * tid < n;
        unsigned key[4] = {0u, 0u, 0u, 0u};
        if (valid) { const u32x4 kv = *(const u32x4*)(src + 4 * tid); key[0] = kv.x; key[1] = kv.y; key[2] = kv.z; key[3] = kv.w; }
        __syncthreads();
        if (tid < 64) cntw[tid] = 0u;
        __syncthreads();
        unsigned T = 0u;
        for (int bit = 29; bit >= 0; --bit) {
            const unsigned cand = T | (1u << bit); unsigned c = 0u;
#pragma unroll
            for (int q = 0; q < 4; ++q) c += (unsigned)__popcll(__ballot(key[q] >= cand));
            if (lane == 0 && c) atomicAdd((unsigned*)&cntw[bit], c);
            __syncthreads();
            if (cntw[bit] >= cap) T = cand;
        }
        unsigned long long bg[4], be[4]; unsigned cg = 0u, ce = 0u;
#pragma unroll
        for (int q = 0; q < 4; ++q) { bg[q] = __ballot(key[q] > T); be[q] = __ballot(valid && key[q] == T); cg += (unsigned)__popcll(bg[q]); ce += (unsigned)__popcll(be[q]); }
        if (lane == 0) { wtot[w] = cg; wtot[8 + w] = ce; }
        __syncthreads();
        unsigned tg = 0u, eoff = 0u;
#pragma unroll
        for (int k = 0; k < 8; ++k) { tg += wtot[k]; eoff += k < w ? wtot[8 + k] : 0u; }
        const unsigned need = cap - tg;
        bool selq[4]; unsigned long long bs[4]; unsigned cs_ = 0u;
#pragma unroll
        for (int q = 0; q < 4; ++q) { unsigned er = eoff;
#pragma unroll
            for (int q2 = 0; q2 < 4; ++q2) er += (unsigned)__popcll(be[q2] & lt) + ((q2 < q && ((be[q2] >> lane) & 1ull)) ? 1u : 0u);
            selq[q] = key[q] > T || (valid && key[q] == T && er < need); bs[q] = __ballot(selq[q]); cs_ += (unsigned)__popcll(bs[q]); }
        if (lane == 0) wtot[16 + w] = cs_;
        __syncthreads();
        unsigned soff = 0u;
#pragma unroll
        for (int k = 0; k < 8; ++k) soff += k < w ? wtot[16 + k] : 0u;
        if (valid) {
            int gsel[4];
#pragma unroll
            for (int q = 0; q < 4; ++q) { unsigned sl = soff;
#pragma unroll
                for (int q2 = 0; q2 < 4; ++q2) sl += (unsigned)__popcll(bs[q2] & lt) + ((q2 < q && ((bs[q2] >> lane) & 1ull)) ? 1u : 0u);
                const int i = 4 * tid + q, trow = lat ? b * 2048 + i : NLAT + b * 256 + i; int grow = -1;
                if (selq[q]) { grow = e * ROWS_E + (lat ? b * 256 + (int)sl : 2048 + b * 32 + (int)sl);
                    WSP(int, WS_IDX)[grow] = trow; WSP(float, WS_GATE)[grow] = __uint_as_float(key[q]); list[sl * 2] = trow; list[sl * 2 + 1] = grow; }
                gsel[q] = grow; }
            const int trow0 = lat ? b * 2048 + 4 * tid : NLAT + b * 256 + 4 * tid;
#pragma unroll
            for (int q = 0; q < 4; ++q) WSP(int, WS_SEL)[(size_t)(trow0 + q) * 16 + e] = gsel[q];
        }
        __syncthreads();
        for (int s_ = w; s_ < (int)cap; s_ += 8) { const int trow = list[s_ * 2], grow = list[s_ * 2 + 1];
            const u32x4* sp = (const u32x4*)(WSP(const bf16_t, WS_H) + (size_t)trow * DM); u32x4* dp = (u32x4*)(WSP(bf16_t, WS_XIN) + (size_t)grow * DM);
            dp[lane] = sp[lane]; dp[lane + 64] = sp[lane + 64]; }
    }
    __syncthreads();
}

__device__ __forceinline__ void c6_combine(const Ctx& C, int layer, int nrows) {
    const int lane = C.lane;
    for (int row = C.gw; row < nrows; row += C.ngw) {
        f32x4 v[4], a[4]; row_load(WSP(const float, WS_X) + (size_t)row * DM, lane, v);
#pragma unroll
        for (int j = 0; j < 4; ++j) a[j] = (f32x4){0.f, 0.f, 0.f, 0.f};
        const int selv = WSP(const int, WS_SEL)[(size_t)row * 16 + (lane & 15)];
        unsigned long long em = __ballot(selv >= 0) & 0xFFFFull;
        while (em) { const int e = __builtin_ctzll(em); em &= em - 1; const int g = __builtin_amdgcn_readlane(selv, e);
            { const bf16_t* y = WSP(const bf16_t, WS_YB) + (size_t)g * DM;
#pragma unroll
                for (int j = 0; j < 4; ++j) { const u32x2 w = *(const u32x2*)(y + (lane + 64 * j) * 4);
                    a[j] += (f32x4){__uint_as_float(w.x << 16), __uint_as_float(w.x & 0xffff0000u), __uint_as_float(w.y << 16), __uint_as_float(w.y & 0xffff0000u)}; } } }
        const int mg = mod_group(row); const float* g2 = modp(C, layer, mg, 5);
#pragma unroll
        for (int j = 0; j < 4; ++j) v[j] += *(const f32x4*)(g2 + (lane + 64 * j) * 4) * a[j];
        const float rstd = row_rstd(v);
        if (layer < 3) { row_store(WSP(float, WS_X) + (size_t)row * DM, lane, v);
            f32x4 h[4]; row_modulate(v, rstd, C.A.in[6] + (layer + 1) * DM, modp(C, layer + 1, mg, 0), modp(C, layer + 1, mg, 1), lane, h);
            row_store_bf16(WSP(bf16_t, WS_H) + (size_t)row * DM, lane, h);
        } else {
#pragma unroll
            for (int j = 0; j < 4; ++j) { const int c = (lane + 64 * j) * 4; *(f32x4*)(C.out + (size_t)row * DM + c) = v[j] * rstd * *(const f32x4*)(C.A.in[8] + c); }
        }
    }
}

constexpr int N_PHASE_IDS = 2 + 12 * 4;
__host__ __device__ inline bool phase_exists(int p) { if (p < 2) return true; const int l = (p - 2) / 12, k = (p - 2) % 12; if (k == 11) return false; if (l & 1) return !(k >= 2 && k <= 4); return true; }

__global__ void __launch_bounds__(512, 2) fwd(Args args) {
    extern __shared__ __attribute__((aligned(16))) unsigned char lds_raw[];
    const int tid_ = threadIdx.x, wave_ = __builtin_amdgcn_readfirstlane(tid_ >> 6);
    const Ctx C0{args, args.out, args.ws, (LAS unsigned char*)lds_raw, tid_, tid_ & 63, wave_, (int)gridDim.x, (int)blockIdx.x, (int)blockIdx.x * 8 + wave_, (int)gridDim.x * 8};
    volatile LAS unsigned* MISC = (volatile LAS unsigned*)(C0.lds + LDSCTL_OFF);
    if (C0.tid < 128) MISC[C0.tid] = 0u;
    __syncthreads();
    const int lo = args.ph_lo, hi = args.ph_hi;
    XcdBarrier bar; bar.bar = (unsigned*)(C0.ws + WS_CTL) + CW_BAR; bar.x = 0; bar.st = nullptr;
    if (hi - lo > 1) bar = xcd_barrier_post((unsigned*)(C0.ws + WS_CTL) + CW_BAR, MISC + 8);
#define RUN(p) (lo <= (p) && (p) < hi)
#define SEAM(p) do { if (hi > (p) + 1) xcd_barrier(bar); } while (0)
    LAS unsigned char* ring = C0.lds;

    if (RUN(0)) { const Ctx C = relaunder(C0); PH(0, p0_convert(C)); PH(18, p0_mod(C)); SEAM(0); }
    if (RUN(1)) { const Ctx C = relaunder(C0); PH(1, p1_init(C)); SEAM(1); }

    for (int layer = 0; layer < 4; ++layer) {
        const int base = 2 + 12 * layer, i = layer >> 1;
        const bool need_ctx = layer < 3;
        if (!(layer & 1)) {
            if (RUN(base + 0)) { const Ctx C = relaunder(C0);
                pg8::Gemm g{WSP(const bf16_t, WS_H), WSP(const bf16_t, WS_WIN) + (size_t)i * ZP * 1024, 1024, 1024, 1024}; pg8::StaticOrder S; S.init(NT, ZP, C.G, C.bid);
                pg8::Epi<FStoreBf16, false> E{{WSP(bf16_t, WS_Z), ZP, 1.f, 0}};
                PH(2, pg8::gemm_phase(ring, g, S, E)); PH(19, bg_fill(C, units_missing(S.nwg, S.G, S.c))); SEAM(base + 0); }
            if (RUN(base + 1)) { const Ctx C = relaunder(C0); PH(3, a2_prepare(C, i)); SEAM(base + 1); }
            if (RUN(base + 2)) { const Ctx C = relaunder(C0); int nmiss = 0;
                { pg8::Gemm g{WSP(const bf16_t, WS_LIN), WSP(const bf16_t, WS_WLORA) + (size_t)i * 2560 * 384, 384, 384, 384}; pg8::StaticOrder S; S.init(NT, 2560, C.G, C.bid);
                  pg8::Epi<FLora, false> E{{C.A.in[12] + i * 1024, C.A.in[14] + i * 1024, C.A.in[18] + i * 512, WSP(const bf16_t, WS_KS), WSP(const bf16_t, WS_KK), WSP(float, WS_DEC), WSP(bf16_t, WS_KD), WSP(bf16_t, WS_BB), WSP(bf16_t, WS_G)}};
                  PH(4, pg8::gemm_phase(ring, g, S, E)); nmiss += units_missing(S.nwg, S.G, S.c); }
                { pg8::Gemm g{WSP(const bf16_t, WS_QN), WSP(const bf16_t, WS_WQUP) + (size_t)i * 768 * 384, 384, 384, 384}; pg8::StaticOrder S; S.init(NT, 768, C.G, C.bid);
                  pg8::Epi<FQup, false> E{{WSP(bf16_t, WS_Q), WSP(const float, WS_ROPE), ATTN_NAIVE ? 0.10206207261596577f : 0.10206207261596577f * 1.4426950408889634f}};
                  PH(16, pg8::gemm_phase(ring, g, S, E)); nmiss += units_missing(S.nwg, S.G, S.c); }
                { pg8::Gemm g{WSP(const bf16_t, WS_KVN), WSP(const bf16_t, WS_WKVUP) + (size_t)i * 1024 * 256, 256, 256, 256}; pg8::StaticOrder S; S.init(NT, 1024, C.G, C.bid);
                  pg8::Epi<FStoreBf16, false> E{{WSP(bf16_t, WS_KV), 1024, 1.f, 0}};
                  PH(17, pg8::gemm_phase(ring, g, S, E)); nmiss += units_missing(S.nwg, S.G, S.c); }
                (void)nmiss;
                SEAM(base + 2); }
            if (RUN(base + 3)) { const Ctx C = relaunder(C0); PH(5, a4_scan(C)); PH(6, if (ATTN_NAIVE) a4_mla_naive(C); else a4_mla(C, layer)); PH(19, bg_fill(C, C.bid < 128 ? 0 : BG_A4)); SEAM(base + 3); }
            if (RUN(base + 4)) { const Ctx C = relaunder(C0); PH(7, a5_output(C, i)); SEAM(base + 4); }
        } else {
            if (RUN(base + 0)) { const Ctx C = relaunder(C0);
                pg8::Gemm g{WSP(const bf16_t, WS_H), WSP(const bf16_t, WS_WQKV) + (size_t)i * 3072 * 1024, 1024, 1024, 1024}; pg8::StaticOrder S; S.init(NT, 3072, C.G, C.bid);
                pg8::Epi<FStoreBf16, false> E{{WSP(bf16_t, WS_Z), 3072, ATTN_NAIVE ? 0.125f : 0.125f * 1.4426950408889634f, 1024}};
                PH(8, pg8::gemm_phase(ring, g, S, E)); PH(19, bg_fill(C, units_missing(S.nwg, S.G, S.c))); SEAM(base + 0); }
            if (RUN(base + 1)) { const Ctx C = relaunder(C0); PH(9, if (ATTN_NAIVE) b2_na_naive(C, i, need_ctx); else b2_na(C, i, need_ctx)); SEAM(base + 1); }
        }
        if (RUN(base + 5)) { const Ctx C = relaunder(C0);
            const bf16_t* W = (layer & 1) ? WSP(const bf16_t, WS_WOUTC) + (size_t)i * 1024 * 1024 : WSP(const bf16_t, WS_WOUTA) + (size_t)i * 1024 * 1024;
            pg8::Gemm g{WSP(const bf16_t, WS_MIX), W, 1024, 1024, 1024}; pg8::StaticOrder S; S.init(need_ctx ? NT : NLAT, 1024, C.G, C.bid);
            pg8::Epi<FResid, false> E{{WSP(float, WS_X), WSP(const float, WS_MOD), layer}};
            PH(10, pg8::gemm_phase(ring, g, S, E)); PH(19, bg_fill(C, units_missing(S.nwg, S.G, S.c))); SEAM(base + 5); }
        if (RUN(base + 6)) { const Ctx C = relaunder(C0); PH(11, c2_router(C, layer, need_ctx ? NT : NLAT)); SEAM(base + 6); }
        if (RUN(base + 7)) { const Ctx C = relaunder(C0); PH(12, c3_topk(C, need_ctx)); PH(19, bg_catch_up(C, (layer + 1) * CV_NB_L)); SEAM(base + 7); }
        if (RUN(base + 8)) { const Ctx C = relaunder(C0);
            pg8::Gemm g{WSP(const bf16_t, WS_XIN), WSP(const bf16_t, WS_W13) + (size_t)layer * 16 * 4096 * 1024, 1024, 1024, 1024}; pg8::MoeOrder S; S.init(need_ctx ? 9 : 8, 16, C.G, C.bid);
            pg8::Epi<FSwiglu, true> E{{WSP(bf16_t, WS_HID)}};
            PH(13, pg8::gemm_phase(ring, g, S, E)); SEAM(base + 8); }
        if (RUN(base + 9)) { const Ctx C = relaunder(C0);
            pg8::Gemm g{WSP(const bf16_t, WS_HID), WSP(const bf16_t, WS_W2) + (size_t)layer * 16 * 1024 * 2048, 2048, 2048, 2048}; pg8::MoeOrder S; S.init(need_ctx ? 9 : 8, 4, C.G, C.bid);
            pg8::Epi<FGate, false> E{{WSP(bf16_t, WS_YB), WSP(const float, WS_GATE)}};
            PH(14, pg8::gemm_phase(ring, g, S, E)); PH(19, bg_fill(C, units_missing(S.nwg, S.G, S.c))); SEAM(base + 9); }
        if (RUN(base + 10)) { const Ctx C = relaunder(C0); PH(15, c6_combine(C, layer, need_ctx ? NT : NLAT)); if (layer < 3) SEAM(base + 10); }
    }
#undef RUN
#undef SEAM
}

extern "C" void kernel_launch(void* const* d_in, const int* in_sizes, int n_in, void* d_out, int out_size, void* d_ws, size_t ws_size, hipStream_t stream) {
    static int grid = 0;
    if (grid == 0) {
        if (n_in != 33 || out_size != NLAT * DM || ws_size < WS_END) { fprintf(stderr, "kernel_launch: unexpected shapes (n_in %d out %d ws %zu need %zu)\n", n_in, out_size, ws_size, (size_t)WS_END); grid = -1; return; }
        int dev = 0, cus = 0, per_cu = 0;
        if (hipGetDevice(&dev) != hipSuccess || hipDeviceGetAttribute(&cus, hipDeviceAttributeMultiprocessorCount, dev) != hipSuccess) { grid = -1; return; }
        if (hipFuncSetAttribute((const void*)fwd, hipFuncAttributeMaxDynamicSharedMemorySize, LDS_BYTES) != hipSuccess) { fprintf(stderr, "kernel_launch: hipFuncSetAttribute failed\n"); grid = -1; return; }
        if (hipOccupancyMaxActiveBlocksPerMultiprocessor(&per_cu, (const void*)fwd, 512, LDS_BYTES) != hipSuccess || per_cu < 1) fprintf(stderr, "kernel_launch: occupancy query says %d\n", per_cu);
        (void)hipGetLastError();
        grid = cus;
    }
    if (grid < 0) return;
    (void)hipMemsetAsync((char*)d_ws + WS_CTL, 0, CTL_BYTES, stream);
    Args a{};
    for (int i = 0; i < 33; ++i) a.in[i] = (const float*)d_in[i];
    a.out = (float*)d_out; a.ws = (unsigned char*)d_ws;
#if SINGLE_LAUNCH
    a.ph_lo = 0; a.ph_hi = N_PHASE_IDS;
    hipLaunchKernelGGL(fwd, dim3(grid), dim3(512), LDS_BYTES, stream, a);
#else
    for (int p = 0; p < N_PHASE_IDS; ++p) { if (!phase_exists(p)) continue; a.ph_lo = p; a.ph_hi = p + 1; hipLaunchKernelGGL(fwd, dim3(grid), dim3(512), LDS_BYTES, stream, a); }
#endif
}
```

```cpp
#include <hip/hip_runtime.h>
#include <cstdio>
#include <cstdint>

#ifndef PHMASK
#define PHMASK 0xFFFFFFFFu
#endif
#define PON(n) (((PHMASK) >> (n)) & 1u)
#ifndef PROBE_MASK
#define PROBE_MASK 0u
#endif
#define PH(n, ...) do { if (PON(n)) { if (((PROBE_MASK) >> (n)) & 1u) { const unsigned long long t0_ = __builtin_amdgcn_s_memrealtime(); { __VA_ARGS__; } __syncthreads(); const unsigned long long d_ = __builtin_amdgcn_s_memrealtime() - t0_; while (__builtin_amdgcn_s_memrealtime() - t0_ < 2 * d_) __builtin_amdgcn_s_sleep(8); } else { __VA_ARGS__; } } } while (0)
#ifndef BG_A4
#define BG_A4 20
#endif
#ifndef ATTN_NAIVE
#define ATTN_NAIVE 0
#endif
#ifndef SINGLE_LAUNCH
#define SINGLE_LAUNCH 1
#endif

#define LAS __attribute__((address_space(3)))
#define GAS __attribute__((address_space(1)))
typedef unsigned short bf16_t;
typedef short bf16x8 __attribute__((ext_vector_type(8)));
typedef float f32x4 __attribute__((ext_vector_type(4)));
typedef float f32x2 __attribute__((ext_vector_type(2)));
typedef unsigned u32x4 __attribute__((ext_vector_type(4)));
typedef unsigned u32x2 __attribute__((ext_vector_type(2)));

constexpr int NB = 8, SEQ = 2048, CTXL = 256, DM = 1024;
constexpr int NLAT = NB * SEQ, NCTX = NB * CTXL, NT = NLAT + NCTX;
constexpr int ADIM = 512, ZP = 2816;
constexpr int NEXP = 16, FF = 2048, ROWS_E = 2304;
constexpr float NORM_EPS = 1e-6f;

constexpr size_t MiB = 1u << 20;
constexpr size_t WS_CTL = 0, CTL_BYTES = 1 * MiB;
constexpr size_t WS_MOD = 1 * MiB;
constexpr size_t WS_ROPE = 2 * MiB;
constexpr size_t WS_WIN = 4 * MiB;
constexpr size_t WS_WLORA = 16 * MiB;
constexpr size_t WS_WQUP = 20 * MiB;
constexpr size_t WS_WKVUP = 22 * MiB;
constexpr size_t WS_WOUTA = 24 * MiB;
constexpr size_t WS_WQKV = 28 * MiB;
constexpr size_t WS_WOUTC = 40 * MiB;
constexpr size_t WS_W13 = 48 * MiB;
constexpr size_t WS_W2 = 560 * MiB;
constexpr size_t WS_X = 816 * MiB;
constexpr size_t WS_H = 888 * MiB;
constexpr size_t WS_MIX = 924 * MiB;
constexpr size_t WS_Z = 960 * MiB;
constexpr size_t WS_R = 1068 * MiB;
constexpr size_t WS_V = 1086 * MiB;
constexpr size_t WS_KS = 1104 * MiB;
constexpr size_t WS_KK = 1122 * MiB;
constexpr size_t WS_LIN = 1140 * MiB;
constexpr size_t WS_QN = 1154 * MiB;
constexpr size_t WS_KVN = 1168 * MiB;
constexpr size_t WS_KR = 1177 * MiB;
constexpr size_t WS_DEC = 1179 * MiB;
constexpr size_t WS_KD = 1251 * MiB;
constexpr size_t WS_BB = 1287 * MiB;
constexpr size_t WS_G = 1323 * MiB;
constexpr size_t WS_Y = 1341 * MiB;
constexpr size_t WS_Q = 1413 * MiB;
constexpr size_t WS_KV = 1440 * MiB;
constexpr size_t WS_AFF = 1476 * MiB;
constexpr size_t WS_SEL = 1478 * MiB;
constexpr size_t WS_IDX = 1480 * MiB;
constexpr size_t WS_GATE = 1481 * MiB;
constexpr size_t WS_XIN = 1482 * MiB;
constexpr size_t WS_HID = 1554 * MiB;
constexpr size_t WS_YB = 1698 * MiB;
constexpr size_t WS_END = 1770 * MiB;

constexpr int CW_TMO = 0, CW_BAR = 4096, CW_QUEUE = 8192;

constexpr int RING_BYTES = 133120;
constexpr int LDSCTL_OFF = RING_BYTES;
constexpr int LDS_BYTES = 147456;

__device__ __forceinline__ float bf2f(unsigned short b) { return __uint_as_float(((unsigned)b) << 16); }
__device__ __forceinline__ unsigned f2bf(float f) { unsigned u = __float_as_uint(f); return (u + 0x7fffu + ((u >> 16) & 1u)) >> 16; }
typedef __bf16 bf16x2_t __attribute__((ext_vector_type(2)));
__device__ __forceinline__ unsigned pk2(float lo, float hi) { const f32x2 v = {lo, hi}; return __builtin_bit_cast(unsigned, __builtin_convertvector(v, bf16x2_t)); }
__device__ __forceinline__ void unpk8(const u32x4 w, float (&f)[8]) {
    f[0] = __uint_as_float(w.x << 16); f[1] = __uint_as_float(w.x & 0xffff0000u); f[2] = __uint_as_float(w.y << 16); f[3] = __uint_as_float(w.y & 0xffff0000u);
    f[4] = __uint_as_float(w.z << 16); f[5] = __uint_as_float(w.z & 0xffff0000u); f[6] = __uint_as_float(w.w << 16); f[7] = __uint_as_float(w.w & 0xffff0000u); }
__device__ __forceinline__ void ld8(const bf16_t* p, float (&f)[8]) { unpk8(*(const u32x4*)p, f); }
__device__ __forceinline__ u32x4 pack8(const float (&f)[8]) { u32x4 w; w.x = pk2(f[0], f[1]); w.y = pk2(f[2], f[3]); w.z = pk2(f[4], f[5]); w.w = pk2(f[6], f[7]); return w; }
#ifndef WT_STORES
#define WT_STORES 0
#endif
#ifndef NT_STORES
#define NT_STORES 0
#endif
__device__ __forceinline__ void st16(void* p, u32x4 v) {
#if WT_STORES
    asm volatile("global_store_dwordx4 %0, %1, off sc1\n\ts_nop 1" :: "v"(p), "v"(v) : "memory");
#elif NT_STORES
    __builtin_nontemporal_store(v, (u32x4*)p);
#else
    *(u32x4*)p = v;
#endif
}
__device__ __forceinline__ void st8b(void* p, u32x2 v) {
#if WT_STORES
    asm volatile("global_store_dwordx2 %0, %1, off sc1\n\ts_nop 0" :: "v"(p), "v"(v) : "memory");
#else
    *(u32x2*)p = v;
#endif
}
__device__ __forceinline__ void st16f(float* p, f32x4 v) { st16(p, __builtin_bit_cast(u32x4, v)); }
__device__ __forceinline__ void st8(bf16_t* p, const float (&f)[8]) { st16(p, pack8(f)); }
__device__ __forceinline__ float wave_sum_slow(float v) {
#pragma unroll
    for (int o = 1; o < 64; o <<= 1) v += __shfl_xor(v, o);
    return v; }
template <int CTRL> __device__ __forceinline__ float dpp_f(float x) { return __int_as_float(__builtin_amdgcn_update_dpp(0, __float_as_int(x), CTRL, 0xF, 0xF, true)); }
__device__ __forceinline__ float sum8(float v) { v += dpp_f<0xB1>(v); v += dpp_f<0x4E>(v); v += dpp_f<0x141>(v); return v; }
__device__ __forceinline__ float sum16(float v) { v = sum8(v); v += dpp_f<0x140>(v); return v; }
__device__ __forceinline__ float wave_sum(float v) { v = sum16(v); v += __shfl_xor(v, 16); v += __shfl_xor(v, 32); return v; }
__device__ __forceinline__ float sigmoidf_(float x) { return 1.f / (1.f + __expf(-x)); }
__device__ __forceinline__ int mod_group(int row) { return row < NLAT ? (row >> 11) : NB; }

namespace pg8 {
constexpr int BM = 256, BK = 64, HALF = 128, HTB = HALF * BK * 2, STAGE_BYTES = 8 * HTB, NXCD = 8, WGM = 8;
__host__ __device__ __forceinline__ int lds_byte(int r, int c) { const int st = (r >> 4) * 2 + (c >> 5), rr = r & 15, cc = c & 31, ob = rr * 64 + cc * 2; return st * 1024 + (ob ^ (((ob >> 9) & 1) << 5)); }
__host__ __device__ __forceinline__ void stage_rc(int b, int& R, int& C) { const int st = b / 1024, sb = b % 1024, swz = sb ^ (((sb >> 9) & 1) << 5); R = (st >> 1) * 16 + swz / 64; C = (st & 1) * 32 + (swz % 64) / 2; }
__host__ __device__ __forceinline__ int perm32(int rho) { const int n = rho >> 4, i = rho & 15; return 8 * (i >> 2) + 4 * n + (i & 3); }
struct Unit { int pm, pn; };
struct Gemm { const bf16_t* A; const bf16_t* Bt; int lda, ldb, K; };

struct StaticOrder {
    int nM, nN, nwg, G, c;
    __device__ void init(int M, int N, int G_, int c_) { nM = M / BM; nN = N / BM; nwg = nM * nN; G = G_; c = c_; }
    __device__ bool next(int i, Unit& u) const {
        const long L = (long)i * G + c; if (L >= nwg) return false;
        int wgid = (int)L; { const int q = nwg / NXCD, r = nwg % NXCD, xcd = wgid % NXCD, off = wgid / NXCD; wgid = (xcd < r ? xcd * (q + 1) : r * (q + 1) + (xcd - r) * q) + off; }
        const int nig = WGM * nN, gid = wgid / nig, fm = gid * WGM, gsz = (nM - fm) < WGM ? (nM - fm) : WGM;
        u.pm = fm + ((wgid % nig) % gsz); u.pn = (wgid % nig) / gsz; return true;
    }
};
struct MoeOrder {
    int nrt, nct, nwg, G, c;
    __device__ void init(int nrt_, int nct_, int G_, int c_) { nrt = nrt_; nct = nct_; nwg = NEXP * nrt * nct; G = G_; c = c_; }
    __device__ bool next(int i, Unit& u) const {
        const long L = (long)i * G + c; if (L >= nwg) return false;
        const int wgid = (int)(L % NXCD) * (nwg / NXCD) + (int)(L / NXCD);
        const int per = nrt * nct, e = wgid / per, rem = wgid % per, ct = rem / nrt, rt = rem % nrt;
        u.pm = e * 9 + rt; u.pn = e * nct + ct; return true;
    }
};

template <class F, bool PAIR> struct Epi {
    F f;
    __device__ __forceinline__ void operator()(const f32x4 (&acc)[2][2][4][2], const Unit& u, int wr, int wc, int fr, int fq) const {
#pragma unroll
        for (int ai = 0; ai < 2; ++ai)
#pragma unroll
            for (int m = 0; m < 4; ++m) {
                const int row = u.pm * BM + ai * HALF + wr * 64 + m * 16 + fr;
                if constexpr (PAIR) {
                    float a[8], b[8];
#pragma unroll
                    for (int j = 0; j < 4; ++j) { a[j] = acc[ai][0][m][0][j]; a[4 + j] = acc[ai][0][m][1][j]; b[j] = acc[ai][1][m][0][j]; b[4 + j] = acc[ai][1][m][1][j]; }
                    f(row, u.pn * HALF + wc * 32 + 8 * fq, a, b);
                } else {
#pragma unroll
                    for (int bj = 0; bj < 2; ++bj) { float a[8];
#pragma unroll
                        for (int j = 0; j < 4; ++j) { a[j] = acc[ai][bj][m][0][j]; a[4 + j] = acc[ai][bj][m][1][j]; }
                        f(row, u.pn * BM + bj * HALF + wc * 32 + 8 * fq, a); }
                }
            }
    }
};

template <class EpiT, class Sched>
__device__ __forceinline__ void gemm_phase(LAS unsigned char* lds, const Gemm g, const Sched& S, const EpiT& E) {
    int tid = threadIdx.x; asm volatile("" : "+v"(tid));
    const int wid = __builtin_amdgcn_readfirstlane(tid >> 6), lane = tid & 63, wr = wid >> 2, wc = wid & 3, fr = lane & 15, fq = lane >> 4;
    const int K = g.K, nt = K / BK;
    unsigned voffA[2], voffB[2];
#pragma unroll
    for (int i = 0; i < 2; ++i) { int R, C; stage_rc(tid * 16 + i * 8192, R, C); const int Rb = (R & ~31) + perm32(R & 31);
        voffA[i] = (unsigned)(R * g.lda + C) * 2u; voffB[i] = (unsigned)(Rb * g.ldb + C) * 2u; }
    const size_t kstep = (size_t)(BK * 2);
    const size_t hsA = (size_t)HALF * g.lda * 2, hsB = (size_t)HALF * g.ldb * 2, tsA = 2 * hsA, tsB = 2 * hsB;
    const unsigned ldsw = (unsigned)wid * 1024u;
    const int aoff = lds_byte(wr * 64 + fr, fq * 8), boff = lds_byte(wc * 32 + fr, fq * 8);
#define PG8_SA(b, h) (((b) * 2 + (h)) * HTB)
#define PG8_SB(b, h) ((4 + (b) * 2 + (h)) * HTB)
#define PG8_STAGE(bufoff, gbase, voff) do { _Pragma("unroll") for (int _i = 0; _i < 2; ++_i) \
        __builtin_amdgcn_global_load_lds((const unsigned*)((const char*)(gbase) + (voff)[_i]), (LAS unsigned*)(lds + (bufoff) + ldsw + _i * 8192), 16, 0, 0); } while (0)
#define PG8_LDA(dst, b, h) do { _Pragma("unroll") for (int m = 0; m < 4; ++m) _Pragma("unroll") for (int k = 0; k < 2; ++k) dst[m][k] = *(const LAS bf16x8*)(lds + PG8_SA(b, h) + aoff + m * 2048 + k * 1024); } while (0)
#define PG8_LDB(dst, b, h) do { _Pragma("unroll") for (int n = 0; n < 2; ++n) _Pragma("unroll") for (int k = 0; k < 2; ++k) dst[n][k] = *(const LAS bf16x8*)(lds + PG8_SB(b, h) + boff + n * 2048 + k * 1024); } while (0)
#define PG8_MMA(ai, bj, At, Bt) do { __builtin_amdgcn_s_setprio(1); _Pragma("unroll") for (int m = 0; m < 4; ++m) _Pragma("unroll") for (int n = 0; n < 2; ++n) _Pragma("unroll") for (int k = 0; k < 2; ++k) \
        acc[ai][bj][m][n] = __builtin_amdgcn_mfma_f32_16x16x32_bf16(Bt[n][k], At[m][k], acc[ai][bj][m][n], 0, 0, 0); __builtin_amdgcn_s_setprio(0); } while (0)
#define PG8_WAIT_V(n) asm volatile("s_waitcnt vmcnt(" #n ")" ::: "memory")
#define PG8_WAIT_L(n) asm volatile("s_waitcnt lgkmcnt(" #n ")" ::: "memory")
#define PG8_BAR __builtin_amdgcn_s_barrier()
#define PG8_SCHED __builtin_amdgcn_sched_barrier(0)
    Unit cur, nxt; int ui = 0;
    if (!S.next(0, cur)) return;
    f32x4 acc[2][2][4][2];
#pragma unroll
    for (int a = 0; a < 2; ++a)
#pragma unroll
        for (int b = 0; b < 2; ++b)
#pragma unroll
            for (int m = 0; m < 4; ++m)
#pragma unroll
                for (int n = 0; n < 2; ++n) acc[a][b][m][n] = (f32x4){0.f, 0.f, 0.f, 0.f};
    bf16x8 At[4][2], B0[2][2], B1[2][2];
    const char* cA = (const char*)g.A + (size_t)cur.pm * tsA; const char* cB = (const char*)g.Bt + (size_t)cur.pn * tsB;
    PG8_STAGE(PG8_SB(0, 0), cB, voffB); PG8_STAGE(PG8_SB(0, 1), cB + hsB, voffB); PG8_STAGE(PG8_SA(0, 0), cA, voffA); PG8_STAGE(PG8_SA(0, 1), cA + hsA, voffA);
    if (wr == 1) PG8_BAR;
    PG8_WAIT_V(2); PG8_BAR;
    PG8_STAGE(PG8_SB(1, 0), cB + kstep, voffB); PG8_STAGE(PG8_SA(1, 0), cA + kstep, voffA); PG8_STAGE(PG8_SB(1, 1), cB + hsB + kstep, voffB);
    PG8_WAIT_V(6); PG8_BAR;
    for (;;) {
        const bool has_next = S.next(ui + 1, nxt);
        const char* nA = has_next ? (const char*)g.A + (size_t)nxt.pm * tsA : cA; const char* nB = has_next ? (const char*)g.Bt + (size_t)nxt.pn * tsB : cB;
#pragma unroll 1
        for (int t = 0; t < nt; t += 2) {
            const bool last = (t == nt - 2);
            const char* a1 = cA + (size_t)(t + 1) * kstep;
            const char* a2 = last ? nA : cA + (size_t)(t + 2) * kstep; const char* b2 = last ? nB : cB + (size_t)(t + 2) * kstep;
            const char* a3 = a2 + kstep; const char* b3 = b2 + kstep;
            PG8_LDB(B0, 0, 0); PG8_LDB(B1, 0, 1); PG8_SCHED; PG8_LDA(At, 0, 0); PG8_STAGE(PG8_SA(1, 1), a1 + hsA, voffA);
            PG8_WAIT_V(8); PG8_WAIT_L(0); PG8_BAR; PG8_MMA(0, 0, At, B0); PG8_MMA(0, 1, At, B1); PG8_BAR; PG8_SCHED;
            PG8_LDA(At, 0, 1); PG8_STAGE(PG8_SB(0, 0), b2, voffB); PG8_STAGE(PG8_SB(0, 1), b2 + hsB, voffB); PG8_STAGE(PG8_SA(0, 0), a2, voffA);
            PG8_WAIT_V(8); PG8_WAIT_L(0); PG8_BAR; PG8_MMA(1, 0, At, B0); PG8_MMA(1, 1, At, B1); PG8_BAR; PG8_SCHED;
            PG8_LDB(B0, 1, 0); PG8_LDB(B1, 1, 1); PG8_SCHED; PG8_LDA(At, 1, 0); PG8_STAGE(PG8_SA(0, 1), a2 + hsA, voffA);
            PG8_WAIT_V(8); PG8_WAIT_L(0); PG8_BAR; PG8_MMA(0, 0, At, B0); PG8_MMA(0, 1, At, B1); PG8_BAR; PG8_SCHED;
            PG8_LDA(At, 1, 1); PG8_STAGE(PG8_SB(1, 0), b3, voffB); PG8_STAGE(PG8_SB(1, 1), b3 + hsB, voffB); PG8_STAGE(PG8_SA(1, 0), a3, voffA);
            PG8_WAIT_V(8); PG8_WAIT_L(0); PG8_BAR; PG8_MMA(1, 0, At, B0); PG8_MMA(1, 1, At, B1); PG8_BAR; PG8_SCHED;
        }
        if (wr == 0) PG8_BAR;
        E(acc, cur, wr, wc, fr, fq);
        if (!has_next) break;
#pragma unroll
        for (int a = 0; a < 2; ++a)
#pragma unroll
            for (int b = 0; b < 2; ++b)
#pragma unroll
                for (int m = 0; m < 4; ++m)
#pragma unroll
                    for (int n = 0; n < 2; ++n) acc[a][b][m][n] = (f32x4){0.f, 0.f, 0.f, 0.f};
        cur = nxt; cA = nA; cB = nB; ++ui;
        if (wr == 1) PG8_BAR;
    }
    PG8_WAIT_V(0);
    PG8_BAR;
#undef PG8_SA
#undef PG8_SB
#undef PG8_STAGE
#undef PG8_LDA
#undef PG8_LDB
#undef PG8_MMA
#undef PG8_WAIT_V
#undef PG8_WAIT_L
#undef PG8_BAR
#undef PG8_SCHED
}
}

#define XB_TMO      128
#define XB_XCNT(j)  (256  + 64 * (j))
#define XB_XSUB(j)  (1280 + 64 * (j))
#define XB_XGEN(j)  (2304 + 64 * (j))
#define XB_TOP      3328
#define XB_TOPGEN   3392
#define XCD_BAR_WORDS 3456
#define XB_SPIN_CAP (1u << 22)
__device__ __forceinline__ unsigned xb_ld(unsigned* p)              { return __hip_atomic_load(p, __ATOMIC_RELAXED, __HIP_MEMORY_SCOPE_AGENT); }
__device__ __forceinline__ unsigned xb_add(unsigned* p, unsigned v) { return __hip_atomic_fetch_add(p, v, __ATOMIC_RELAXED, __HIP_MEMORY_SCOPE_AGENT); }
__device__ __forceinline__ unsigned xb_xcc_id() { return (unsigned)__builtin_amdgcn_s_getreg((3 << 11) | 20) & 0xFu; }
#define XB_SPIN(cond, bar) do { unsigned _sp = 0; while (cond) { __builtin_amdgcn_s_sleep(1); \
    if ((++_sp & 255u) == 0u) { if (xb_ld(&(bar)[XB_TMO])) break; if (_sp > XB_SPIN_CAP) { atomicAdd(&(bar)[XB_TMO], 1u); break; } } } } while (0)
struct XcdBarrier { unsigned* bar; unsigned x; volatile LAS unsigned* st; };
__device__ __forceinline__ XcdBarrier xcd_barrier_post(unsigned* bar, volatile LAS unsigned* st) {
    XcdBarrier b; b.bar = bar; b.x = xb_xcc_id(); b.st = st;
    if (threadIdx.x == 0) (void)xb_add(&bar[XB_XCNT(b.x)], 1u);
    return b;
}
__device__ __forceinline__ void xcd_barrier_complete(unsigned* bar, unsigned x, unsigned& nloc, unsigned& nx) {
    const unsigned G = gridDim.x * gridDim.y * gridDim.z;
    unsigned sum, cnt, mine, sp = 0u;
    for (;;) {
        sum = 0u; cnt = 0u; mine = 0u;
#pragma unroll
        for (unsigned j = 0; j < 16; ++j) { const unsigned c = xb_ld(&bar[XB_XCNT(j)]); sum += c; cnt += (c > 0u) ? 1u : 0u; mine = (j == x) ? c : mine; }
        if (sum == G) break;
        __builtin_amdgcn_s_sleep(1);
        if ((++sp & 255u) == 0u) { if (xb_ld(&bar[XB_TMO])) break; if (sp > XB_SPIN_CAP) { atomicAdd(&bar[XB_TMO], 1u); break; } }
    }
    nloc = mine > 0u ? mine : 1u; nx = cnt > 0u ? cnt : 1u;
}
__device__ __forceinline__ void xcd_barrier(const XcdBarrier& b) {
    asm volatile("s_waitcnt vmcnt(0)" ::: "memory");
    __syncthreads();
    if (threadIdx.x == 0) {
        unsigned* bar = b.bar;
        __builtin_amdgcn_s_waitcnt(0);
        unsigned nloc = b.st[0], nx = b.st[1];
        if (nloc == 0u) { xcd_barrier_complete(bar, b.x, nloc, nx); b.st[0] = nloc; b.st[1] = nx; }
        const unsigned old = xb_add(&bar[XB_XSUB(b.x)], 1u);
        const unsigned gen = old / nloc;
        if (old + 1u == (gen + 1u) * nloc) {
            __builtin_amdgcn_fence(__ATOMIC_RELEASE, "agent");
            asm volatile("s_waitcnt vmcnt(0)" ::: "memory");
            const unsigned og = xb_add(&bar[XB_TOP], 1u);
            const unsigned tg = og / nx;
            if (og + 1u == (tg + 1u) * nx) xb_add(&bar[XB_TOPGEN], 1u);
            else XB_SPIN(xb_ld(&bar[XB_TOPGEN]) == tg, bar);
            __builtin_amdgcn_fence(__ATOMIC_ACQUIRE, "agent");
            xb_add(&bar[XB_XGEN(b.x)], 1u);
            asm volatile("s_waitcnt vmcnt(0)" ::: "memory");
        } else {
            XB_SPIN(xb_ld(&bar[XB_XGEN(b.x)]) == gen, bar);
            __builtin_amdgcn_fence(__ATOMIC_ACQUIRE, "agent");
            asm volatile("s_waitcnt vmcnt(0)" ::: "memory");
        }
    }
    __syncthreads();
}

struct Args { const float* in[33]; float* out; unsigned char* ws; int ph_lo, ph_hi; };
struct Ctx {
    const Args& A; float* out; unsigned char* ws;
    LAS unsigned char* lds; int tid, lane, wave, G, bid, gw, ngw;
};
#define WSP(T, off) ((T*)(C.ws + (off)))
__device__ __forceinline__ Ctx relaunder(const Ctx& C0) {
    int tid = C0.tid; GAS unsigned char* wsg = (GAS unsigned char*)C0.ws; LAS unsigned char* lds = C0.lds;
    asm volatile("" : "+v"(tid), "+s"(wsg));
    unsigned char* ws = (unsigned char*)wsg;
    const int wave = __builtin_amdgcn_readfirstlane(tid >> 6);
    return Ctx{C0.A, C0.out, ws, lds, tid, tid & 63, wave, C0.G, C0.bid, C0.bid * 8 + wave, C0.G * 8};
}
__device__ __forceinline__ const float* modp(const Ctx& C, int layer, int mg, int chunk) { return WSP(const float, WS_MOD) + ((size_t)(layer * 9 + mg) * 6 + chunk) * 1024; }

__device__ __forceinline__ void tr_item(const float* src, int ld_src, int nvalid, int k0, int n0, bf16_t* dst, int ld_dst, int drow0, int dk0, LAS float* scr, int lane) {
    {
        const int n = (lane & 15) * 4; const bool ok = (n0 + n) < nvalid;
#pragma unroll 4
        for (int i = 0; i < 16; ++i) { const int k = 4 * i + (lane >> 4);
            f32x4 v = (f32x4){0.f, 0.f, 0.f, 0.f};
            if (ok) v = __builtin_nontemporal_load((const f32x4*)(src + (size_t)(k0 + k) * ld_src + n0 + n));
            LAS float* s = scr + k * 65 + n; s[0] = v.x; s[1] = v.y; s[2] = v.z; s[3] = v.w; }
    }
    asm volatile("s_waitcnt lgkmcnt(0)" ::: "memory");
    const int c = lane & 7;
#pragma unroll
    for (int jj = 0; jj < 8; ++jj) { const int nl = (lane >> 3) + 8 * jj; const LAS float* s = scr + (8 * c) * 65 + nl;
        u32x4 o; o.x = pk2(s[0 * 65], s[1 * 65]); o.y = pk2(s[2 * 65], s[3 * 65]); o.z = pk2(s[4 * 65], s[5 * 65]); o.w = pk2(s[6 * 65], s[7 * 65]);
        if (n0 + nl < nvalid) __builtin_nontemporal_store(o, (u32x4*)(dst + (size_t)(drow0 + nl) * ld_dst + dk0 + 8 * c)); }
    asm volatile("s_waitcnt lgkmcnt(0)" ::: "memory");
}
constexpr int CV_SMALL = 2120, CV_MOE_L = 16 * 3 * 512, CV_MOE = 4 * CV_MOE_L;
__device__ __forceinline__ void convert_item(const Ctx& C, int it, LAS float* scr) {
    {
        const float* src; int ld_src, nvalid, k0, n0, ld_dst, drow0, dk0; bf16_t* dst;
        if (it < 2 * CV_SMALL) {
            const int i = it / CV_SMALL; int r = it % CV_SMALL;
            if (r < 656) { src = C.A.in[9] + (size_t)i * 1024 * 2592; ld_src = 2592; nvalid = 2592; k0 = (r / 41) * 64; n0 = (r % 41) * 64; dst = WSP(bf16_t, WS_WIN) + (size_t)i * ZP * 1024; ld_dst = 1024; drow0 = n0; dk0 = k0; }
            else if ((r -= 656) < 16) { const int d = r >> 3; src = C.A.in[13] + (size_t)(i * 2 + d) * 64 * 512; ld_src = 512; nvalid = 512; k0 = 0; n0 = (r & 7) * 64; dst = WSP(bf16_t, WS_WLORA) + (size_t)i * 2560 * 384; ld_dst = 384; drow0 = d * 512 + n0; dk0 = d * 64; }
            else if ((r -= 16) < 16) { const int d = r >> 3; src = C.A.in[15] + (size_t)(i * 2 + d) * 64 * 512; ld_src = 512; nvalid = 512; k0 = 0; n0 = (r & 7) * 64; dst = WSP(bf16_t, WS_WLORA) + (size_t)i * 2560 * 384; ld_dst = 384; drow0 = 1024 + d * 512 + n0; dk0 = 128 + d * 64; }
            else if ((r -= 16) < 16) { src = C.A.in[16] + (size_t)i * 128 * 512; ld_src = 512; nvalid = 512; k0 = (r >> 3) * 64; n0 = (r & 7) * 64; dst = WSP(bf16_t, WS_WLORA) + (size_t)i * 2560 * 384; ld_dst = 384; drow0 = 2048 + n0; dk0 = 256 + k0; }
            else if ((r -= 16) < 72) { src = C.A.in[23] + (size_t)i * 384 * 768; ld_src = 768; nvalid = 768; k0 = (r / 12) * 64; n0 = (r % 12) * 64; dst = WSP(bf16_t, WS_WQUP) + (size_t)i * 768 * 384; ld_dst = 384; drow0 = n0; dk0 = k0; }
            else if ((r -= 72) < 64) { src = C.A.in[25] + (size_t)i * 256 * 1024; ld_src = 1024; nvalid = 1024; k0 = (r / 16) * 64; n0 = (r % 16) * 64; dst = WSP(bf16_t, WS_WKVUP) + (size_t)i * 1024 * 256; ld_dst = 256; drow0 = n0; dk0 = k0; }
            else if ((r -= 64) < 256) { src = C.A.in[10] + (size_t)i * 1024 * 1024; ld_src = 1024; nvalid = 1024; k0 = (r / 16) * 64; n0 = (r % 16) * 64; dst = WSP(bf16_t, WS_WOUTA) + (size_t)i * 1024 * 1024; ld_dst = 1024; drow0 = n0; dk0 = k0; }
            else if ((r -= 256) < 768) { src = C.A.in[26] + (size_t)i * 1024 * 3072; ld_src = 3072; nvalid = 3072; k0 = (r / 48) * 64; n0 = (r % 48) * 64; dst = WSP(bf16_t, WS_WQKV) + (size_t)i * 3072 * 1024; ld_dst = 1024; drow0 = n0; dk0 = k0; }
            else { r -= 768; src = C.A.in[28] + (size_t)i * 1024 * 1024; ld_src = 1024; nvalid = 1024; k0 = (r / 16) * 64; n0 = (r % 16) * 64; dst = WSP(bf16_t, WS_WOUTC) + (size_t)i * 1024 * 1024; ld_dst = 1024; drow0 = n0; dk0 = k0; }
        } else {
            const int m = it - 2 * CV_SMALL, le = m / 1536, r = m % 1536, which = r / 512, q = r % 512;
            if (which < 2) { src = C.A.in[which == 0 ? 30 : 31] + (size_t)le * 1024 * 2048; ld_src = 2048; nvalid = 2048; k0 = (q / 32) * 64; n0 = (q % 32) * 64;
                dst = WSP(bf16_t, WS_W13) + (size_t)le * 4096 * 1024; ld_dst = 1024; drow0 = (n0 >> 7) * 256 + which * 128 + (n0 & 127); dk0 = k0; }
            else { src = C.A.in[32] + (size_t)le * 2048 * 1024; ld_src = 1024; nvalid = 1024; k0 = (q / 16) * 64; n0 = (q % 16) * 64;
                dst = WSP(bf16_t, WS_W2) + (size_t)le * 1024 * 2048; ld_dst = 2048; drow0 = n0; dk0 = k0; }
        }
        tr_item(src, ld_src, nvalid, k0, n0, dst, ld_dst, drow0, dk0, scr, C.lane);
    }
}
constexpr int CV_BATCH = 16, CV_NB_L = CV_MOE_L / CV_BATCH, CV_NB = 4 * CV_NB_L;
__device__ __forceinline__ int bg_pull(const Ctx& C, unsigned* ctr, int limit) {
    volatile LAS int* slot = (volatile LAS int*)(C.lds + LDSCTL_OFF + 64);
    __syncthreads();
    if (C.tid == 0) { int b = -1; if ((int)__hip_atomic_load(ctr, __ATOMIC_RELAXED, __HIP_MEMORY_SCOPE_AGENT) < limit) { b = (int)__hip_atomic_fetch_add(ctr, 1u, __ATOMIC_RELAXED, __HIP_MEMORY_SCOPE_AGENT); if (b >= CV_NB) b = -1; } slot[0] = b; }
    __syncthreads();
    return slot[0];
}
struct MoeItem { const float* src; bf16_t* dst; int ld_src, ld_dst; };
__device__ __forceinline__ MoeItem moe_item(const Ctx& C, int m) {
    const int le = m / 1536, r = m % 1536, which = r / 512, q = r % 512; MoeItem it;
    if (which < 2) { const int k0 = (q / 32) * 64, n0 = (q % 32) * 64; it.ld_src = 2048; it.ld_dst = 1024;
        it.src = C.A.in[which == 0 ? 30 : 31] + (size_t)le * 1024 * 2048 + (size_t)k0 * 2048 + n0;
        it.dst = WSP(bf16_t, WS_W13) + (size_t)le * 4096 * 1024 + (size_t)((n0 >> 7) * 256 + which * 128 + (n0 & 127)) * 1024 + k0; }
    else { const int k0 = (q / 16) * 64, n0 = (q % 16) * 64; it.ld_src = 1024; it.ld_dst = 2048;
        it.src = C.A.in[32] + (size_t)le * 2048 * 1024 + (size_t)k0 * 1024 + n0; it.dst = WSP(bf16_t, WS_W2) + (size_t)le * 1024 * 2048 + (size_t)n0 * 2048 + k0; }
    return it;
}
__device__ __forceinline__ void tr_load(const MoeItem& it, int lane, f32x4 (&v)[16]) {
#pragma unroll
    for (int i = 0; i < 16; ++i) v[i] = __builtin_nontemporal_load((const f32x4*)(it.src + (size_t)(4 * i + (lane >> 4)) * it.ld_src + (lane & 15) * 4)); }
__device__ __forceinline__ void tr_store(const MoeItem& it, int lane, const f32x4 (&v)[16], LAS float* scr) {
#pragma unroll
    for (int i = 0; i < 16; ++i) { LAS float* s_ = scr + (4 * i + (lane >> 4)) * 65 + (lane & 15) * 4; s_[0] = v[i].x; s_[1] = v[i].y; s_[2] = v[i].z; s_[3] = v[i].w; }
    asm volatile("s_waitcnt lgkmcnt(0)" ::: "memory");
    const int c = lane & 7;
#pragma unroll
    for (int jj = 0; jj < 8; ++jj) { const int nl = (lane >> 3) + 8 * jj; const LAS float* s_ = scr + (8 * c) * 65 + nl;
        u32x4 o; o.x = pk2(s_[0 * 65], s_[1 * 65]); o.y = pk2(s_[2 * 65], s_[3 * 65]); o.z = pk2(s_[4 * 65], s_[5 * 65]); o.w = pk2(s_[6 * 65], s_[7 * 65]);
        __builtin_nontemporal_store(o, (u32x4*)(it.dst + (size_t)nl * it.ld_dst + 8 * c)); }
    asm volatile("s_waitcnt lgkmcnt(0)" ::: "memory");
}
__device__ __forceinline__ void bg_batch(const Ctx& C, int b) {
    LAS float* scr = (LAS float*)(C.lds + C.wave * 16640);
    const MoeItem ia = moe_item(C, b * CV_BATCH + C.wave), ib = moe_item(C, b * CV_BATCH + C.wave + 8);
    f32x4 va[16], vb[16]; tr_load(ia, C.lane, va); tr_load(ib, C.lane, vb);
    tr_store(ia, C.lane, va, scr); tr_store(ib, C.lane, vb, scr);
}
__device__ __forceinline__ void bg_fill(const Ctx& C, int budget) { unsigned* ctr = (unsigned*)(C.ws + WS_CTL) + CW_QUEUE + 64 * 8; for (int n = 0; n < budget; ++n) { const int b = bg_pull(C, ctr, CV_NB); if (b < 0) break; bg_batch(C, b); } }
__device__ __forceinline__ void bg_catch_up(const Ctx& C, int limit) { unsigned* ctr = (unsigned*)(C.ws + WS_CTL) + CW_QUEUE + 64 * 8; for (;;) { const int b = bg_pull(C, ctr, limit); if (b < 0) break; bg_batch(C, b); } }
__device__ __forceinline__ int units_missing(int nwg, int G, int c) { const int mx = (nwg + G - 1) / G, mine = c < nwg ? (nwg - c + G - 1) / G : 0; return mx - mine; }
__device__ __forceinline__ void p0_convert(const Ctx& C) {
    LAS float* scr = (LAS float*)(C.lds + C.wave * 16640);
    for (int it = C.gw; it < 2 * CV_SMALL; it += C.ngw) convert_item(C, it, scr);
    const u32x4 z4 = (u32x4){0u, 0u, 0u, 0u};
    const int gt = C.bid * 512 + C.tid, ngt = C.G * 512;
    for (int idx = gt; idx < 2 * 224 * 128; idx += ngt) { const int i = idx / (224 * 128), r = (idx / 128) % 224, ch = idx % 128;
        *(u32x4*)(WSP(bf16_t, WS_WIN) + ((size_t)i * ZP + 2592 + r) * 1024 + ch * 8) = z4; }
    for (int idx = gt; idx < 2 * 2560 * 48; idx += ngt) { const int i = idx / (2560 * 48), r = (idx / 48) % 2560, ch = idx % 48, seg = r >> 9;
        const int lo = seg < 4 ? seg * 8 : 32, hi = seg < 4 ? seg * 8 + 8 : 48;
        if (ch < lo || ch >= hi) *(u32x4*)(WSP(bf16_t, WS_WLORA) + ((size_t)i * 2560 + r) * 384 + ch * 8) = z4; }
    for (int idx = gt; idx < 2048 * 16; idx += ngt) { const int t = idx >> 4, i = idx & 15; const float pos = (float)(i < 8 ? (t >> 6) : (t & 63));
        const float inv = powf(10000.0f, -(float)(i & 7) / 8.0f); const float ang = pos * inv;
        WSP(float, WS_ROPE)[idx * 2] = cosf(ang); WSP(float, WS_ROPE)[idx * 2 + 1] = sinf(ang); }
}
__device__ __forceinline__ void p0_mod(const Ctx& C) {
    LAS float* sc = (LAS float*)C.lds;
    LAS float* part = (LAS float*)(C.lds + 36864);
    __syncthreads();
    for (int idx = C.tid; idx < 9 * 1024; idx += 512) { const int r = idx >> 10, k = idx & 1023; const float cv = r < 8 ? C.A.in[1][r * 1024 + k] : C.A.in[3][k]; sc[idx] = cv / (1.f + __expf(-cv)); }
    __syncthreads();
    for (int unit = C.bid; unit < 192; unit += C.G) {
        const int l = unit / 48, jb = unit % 48, jj = C.tid & 127, kc = C.tid >> 7;
        const float* w = C.A.in[4] + ((size_t)l * 1024 + kc * 256) * 6144 + jb * 128 + jj;
        float acc[9];
#pragma unroll
        for (int r = 0; r < 9; ++r) acc[r] = 0.f;
#pragma unroll 4
        for (int k = 0; k < 256; ++k) { const float wv = w[(size_t)k * 6144];
#pragma unroll
            for (int r = 0; r < 9; ++r) acc[r] += sc[r * 1024 + kc * 256 + k] * wv; }
#pragma unroll
        for (int r = 0; r < 9; ++r) part[(kc * 9 + r) * 128 + jj] = acc[r];
        __syncthreads();
        for (int idx = C.tid; idx < 9 * 128; idx += 512) { const int r = idx >> 7, j2 = idx & 127;
            const float s = part[(0 * 9 + r) * 128 + j2] + part[(1 * 9 + r) * 128 + j2] + part[(2 * 9 + r) * 128 + j2] + part[(3 * 9 + r) * 128 + j2] + C.A.in[5][l * 6144 + jb * 128 + j2];
            WSP(float, WS_MOD)[(size_t)(l * 9 + r) * 6144 + jb * 128 + j2] = s; }
        __syncthreads();
    }
}

__device__ __forceinline__ void row_load(const float* p, int lane, f32x4 (&v)[4]) {
#pragma unroll
    for (int j = 0; j < 4; ++j) v[j] = *(const f32x4*)(p + (lane + 64 * j) * 4); }
__device__ __forceinline__ void row_store(float* p, int lane, const f32x4 (&v)[4]) {
#pragma unroll
    for (int j = 0; j < 4; ++j) st16f(p + (lane + 64 * j) * 4, v[j]); }
__device__ __forceinline__ float row_rstd(const f32x4 (&v)[4]) {
    float s = 0.f;
#pragma unroll
    for (int j = 0; j < 4; ++j) s += (v[j].x * v[j].x + v[j].y * v[j].y) + (v[j].z * v[j].z + v[j].w * v[j].w);
    return rsqrtf(wave_sum(s) * (1.f / 1024.f) + NORM_EPS); }
__device__ __forceinline__ void row_modulate(const f32x4 (&v)[4], float rstd, const float* nw, const float* sh, const float* sc, int lane, f32x4 (&h)[4]) {
#pragma unroll
    for (int j = 0; j < 4; ++j) { const int c = (lane + 64 * j) * 4; const f32x4 w = *(const f32x4*)(nw + c), s1 = *(const f32x4*)(sc + c), s0 = *(const f32x4*)(sh + c);
        h[j] = (v[j] * rstd * w) * (s1 + 1.0f) + s0; } }
__device__ __forceinline__ void row_store_bf16(bf16_t* p, int lane, const f32x4 (&h)[4]) {
#pragma unroll
    for (int j = 0; j < 4; ++j) { u32x2 w; w.x = pk2(h[j].x, h[j].y); w.y = pk2(h[j].z, h[j].w); st8b(p + (lane + 64 * j) * 4, w); } }

__device__ __forceinline__ void p1_init(const Ctx& C) {
    for (int row = C.gw; row < NT; row += C.ngw) {
        const float* src = row < NLAT ? C.A.in[0] + (size_t)row * DM : C.A.in[2] + (size_t)(row - NLAT) * DM;
        f32x4 v[4], h[4]; row_load(src, C.lane, v); row_store(WSP(float, WS_X) + (size_t)row * DM, C.lane, v);
        const int mg = mod_group(row); const float rstd = row_rstd(v);
        row_modulate(v, rstd, C.A.in[6], modp(C, 0, mg, 0), modp(C, 0, mg, 1), C.lane, h);
        row_store_bf16(WSP(bf16_t, WS_H) + (size_t)row * DM, C.lane, h);
    }
}

__device__ __forceinline__ void a2_prepare(const Ctx& C, int i) {
    const bf16_t* Z = WSP(const bf16_t, WS_Z);
    const float* mu = C.A.in[11] + (size_t)i * 2 * 1920;
    const int lane = C.lane;
    for (int row = C.gw; row < NT; row += C.ngw) {
        const bool isctx = row >= NLAT; const int t = isctx ? ((row - NLAT) & 255) : (row & 2047), T = isctx ? 256 : 2048;
        const bf16_t* z = Z + (size_t)row * ZP; const bool hp = t > 0, hn = t < T - 1;
        float r8[8], k8[8], v8[8];
#pragma unroll
        for (int seg = 0; seg < 3; ++seg) {
            const int c0 = seg * 512 + lane * 8; float zc[8], zp[8], zn[8], m0[8], m1[8];
            ld8(z + c0, zc);
            if (hp) ld8(z - ZP + c0, zp); else { for (int j = 0; j < 8; ++j) zp[j] = 0.f; }
            if (hn) ld8(z + ZP + c0, zn); else { for (int j = 0; j < 8; ++j) zn[j] = 0.f; }
            *(f32x4*)&m0[0] = *(const f32x4*)(mu + c0); *(f32x4*)&m0[4] = *(const f32x4*)(mu + c0 + 4);
            *(f32x4*)&m1[0] = *(const f32x4*)(mu + 1920 + c0); *(f32x4*)&m1[4] = *(const f32x4*)(mu + 1920 + c0 + 4);
#pragma unroll
            for (int j = 0; j < 8; ++j) { const float o = zc[j] + m0[j] * (zp[j] - zc[j]) + m1[j] * (zn[j] - zc[j]); if (seg == 0) r8[j] = o; else if (seg == 1) k8[j] = o; else v8[j] = o; }
        }
        st8(WSP(bf16_t, WS_R) + (size_t)row * ADIM + lane * 8, r8);
        st8(WSP(bf16_t, WS_KS) + (size_t)row * ADIM + lane * 8, k8);
        st8(WSP(bf16_t, WS_V) + (size_t)row * ADIM + lane * 8, v8);
        { float kk[8], ss = 0.f; const float* kkw = C.A.in[17] + i * ADIM + lane * 8;
#pragma unroll
            for (int j = 0; j < 8; ++j) { kk[j] = k8[j] * kkw[j]; ss += kk[j] * kk[j]; }
            ss = sum8(ss); const float inv = 1.f / fmaxf(sqrtf(ss), 1e-12f);
#pragma unroll
            for (int j = 0; j < 8; ++j) kk[j] *= inv;
            st8(WSP(bf16_t, WS_KK) + (size_t)row * ADIM + lane * 8, kk); }
#pragma unroll
        for (int seg = 0; seg < 3; ++seg) {
            const int c0 = 1536 + seg * 128 + lane * 2; const unsigned wc_ = *(const unsigned*)(z + c0);
            const unsigned wp_ = hp ? *(const unsigned*)(z - ZP + c0) : 0u, wn_ = hn ? *(const unsigned*)(z + ZP + c0) : 0u;
            float o[2];
#pragma unroll
            for (int j = 0; j < 2; ++j) { const float zc = j ? __uint_as_float(wc_ & 0xffff0000u) : __uint_as_float(wc_ << 16), zp = j ? __uint_as_float(wp_ & 0xffff0000u) : __uint_as_float(wp_ << 16),
                                                      zn = j ? __uint_as_float(wn_ & 0xffff0000u) : __uint_as_float(wn_ << 16);
                const float s = zc + mu[c0 + j] * (zp - zc) + mu[1920 + c0 + j] * (zn - zc);
                o[j] = seg == 0 ? tanhf(s) : (seg == 1 ? s : sigmoidf_(s)); }
            *(unsigned*)(WSP(bf16_t, WS_LIN) + (size_t)row * 384 + seg * 128 + lane * 2) = pk2(o[0], o[1]);
        }
        { float q[6], ss = 0.f;
#pragma unroll
            for (int j = 0; j < 3; ++j) { const unsigned w = *(const unsigned*)(z + 1920 + j * 128 + lane * 2); q[2 * j] = __uint_as_float(w << 16); q[2 * j + 1] = __uint_as_float(w & 0xffff0000u); ss += q[2 * j] * q[2 * j] + q[2 * j + 1] * q[2 * j + 1]; }
            const float rstd = rsqrtf(wave_sum(ss) * (1.f / 384.f) + NORM_EPS); const float* nw = C.A.in[22] + i * 384;
#pragma unroll
            for (int j = 0; j < 3; ++j) { const int c = j * 128 + lane * 2; *(unsigned*)(WSP(bf16_t, WS_QN) + (size_t)row * 384 + c) = pk2(q[2 * j] * rstd * nw[c], q[2 * j + 1] * rstd * nw[c + 1]); } }
        { const u32x2 w = *(const u32x2*)(z + 2304 + lane * 4); float q[4] = {__uint_as_float(w.x << 16), __uint_as_float(w.x & 0xffff0000u), __uint_as_float(w.y << 16), __uint_as_float(w.y & 0xffff0000u)};
            const float ss = q[0] * q[0] + q[1] * q[1] + q[2] * q[2] + q[3] * q[3];
            const float rstd = rsqrtf(wave_sum(ss) * (1.f / 256.f) + NORM_EPS); const float* nw = C.A.in[24] + i * 256 + lane * 4;
            u32x2 o; o.x = pk2(q[0] * rstd * nw[0], q[1] * rstd * nw[1]); o.y = pk2(q[2] * rstd * nw[2], q[3] * rstd * nw[3]);
            *(u32x2*)(WSP(bf16_t, WS_KVN) + (size_t)row * 256 + lane * 4) = o; }
        if (lane < 16) { const unsigned w = *(const unsigned*)(z + 2560 + lane * 2); float x0 = __uint_as_float(w << 16), x1 = __uint_as_float(w & 0xffff0000u);
            if (!isctx) { const float cs = WSP(const float, WS_ROPE)[(t * 16 + lane) * 2], sn = WSP(const float, WS_ROPE)[(t * 16 + lane) * 2 + 1]; const float o0 = x0 * cs - x1 * sn, o1 = x0 * sn + x1 * cs; x0 = o0; x1 = o1; }
            *(unsigned*)(WSP(bf16_t, WS_KR) + (size_t)row * 32 + lane * 2) = pk2(x0, x1); }
    }
}

struct FStoreBf16 { bf16_t* O; int ldo; float scale; int scale_cols;
    __device__ __forceinline__ void operator()(int row, int col, const float (&v)[8]) const { float o[8]; const float s = col < scale_cols ? scale : 1.f;
#pragma unroll
        for (int j = 0; j < 8; ++j) o[j] = v[j] * s;
        st8(O + (size_t)row * ldo + col, o); } };
struct FLora { const float* w0; const float* a0; const float* ka; const bf16_t* KS; const bf16_t* KK; float* DEC; bf16_t* KD; bf16_t* BB; bf16_t* G;
    __device__ __forceinline__ void operator()(int row, int col, const float (&v)[8]) const {
        const int seg = col >> 9, c = col & 511;
        if (seg < 2) { float o[8];
#pragma unroll
            for (int j = 0; j < 8; ++j) { const float x = w0[seg * 512 + c + j] + v[j];
                o[j] = __expf(-0.6065306597126334f * sigmoidf_(x)); }
            float* d = DEC + ((size_t)seg * NT + row) * ADIM + c; st16f(d, *(const f32x4*)&o[0]); st16f(d + 4, *(const f32x4*)&o[4]);
        } else if (seg < 4) { const int d_ = seg - 2; float k[8], kk[8], kd[8], bb[8]; ld8(KS + (size_t)row * ADIM + c, k); ld8(KK + (size_t)row * ADIM + c, kk);
#pragma unroll
            for (int j = 0; j < 8; ++j) { const float a = sigmoidf_(a0[d_ * 512 + c + j] + v[j]); kd[j] = k[j] * (1.f + (a - 1.f) * ka[c + j]); bb[j] = kk[j] * a; }
            st8(KD + ((size_t)d_ * NT + row) * ADIM + c, kd); st8(BB + ((size_t)d_ * NT + row) * ADIM + c, bb);
        } else st8(G + (size_t)row * ADIM + c, v);
    } };
struct FQup { bf16_t* Q; const float* rope; float scale;
    __device__ __forceinline__ void operator()(int row, int col, const float (&v)[8]) const {
        const int d = col % 96; float o[8];
#pragma unroll
        for (int j = 0; j < 8; ++j) o[j] = v[j] * scale;
        if (d >= 64 && row < NLAT) { const int t = row & 2047, p0 = (d - 64) >> 1;
#pragma unroll
            for (int p = 0; p < 4; ++p) { const float cs = rope[(t * 16 + p0 + p) * 2], sn = rope[(t * 16 + p0 + p) * 2 + 1]; const float x0 = o[2 * p], x1 = o[2 * p + 1]; o[2 * p] = x0 * cs - x1 * sn; o[2 * p + 1] = x0 * sn + x1 * cs; } }
        st8(Q + (size_t)row * 768 + col, o);
    } };
struct FResid { float* X; const float* mod; int layer;
    __device__ __forceinline__ void operator()(int row, int col, const float (&v)[8]) const {
        const float* g = mod + ((size_t)(layer * 9 + mod_group(row)) * 6 + 2) * 1024 + col; float* x = X + (size_t)row * DM + col;
        f32x4 x0 = *(const f32x4*)x, x1 = *(const f32x4*)(x + 4); const f32x4 g0 = *(const f32x4*)g, g1 = *(const f32x4*)(g + 4);
        x0 += g0 * (f32x4){v[0], v[1], v[2], v[3]}; x1 += g1 * (f32x4){v[4], v[5], v[6], v[7]};
        st16f(x, x0); st16f(x + 4, x1);
    } };
struct FSwiglu { bf16_t* HID;
    __device__ __forceinline__ void operator()(int row, int col, const float (&a)[8], const float (&b)[8]) const { float o[8];
#pragma unroll
        for (int j = 0; j < 8; ++j) o[j] = a[j] / (1.f + __expf(-a[j])) * b[j];
        st8(HID + (size_t)row * FF + (col & (FF - 1)), o); } };
struct FGate { bf16_t* YB; const float* gate;
    __device__ __forceinline__ void operator()(int row, int col, const float (&v)[8]) const { const float g = gate[row]; float o[8];
#pragma unroll
        for (int j = 0; j < 8; ++j) o[j] = v[j] * g;
        st8(YB + (size_t)row * DM + (col & (DM - 1)), o); } };

constexpr int SC_TC = 32;
constexpr int SC_ARR = SC_TC * 64, SC_BUF = 6 * SC_ARR + 2 * SC_TC;
__device__ __forceinline__ void a4_scan(const Ctx& C) {
    LAS float* L = (LAS float*)C.lds;
    LAS float* YB_ = L + 2 * SC_BUF;
    const int tid = C.tid; const bool stager = tid >= 256;
    const int rp = (tid >> 3) & 31, j = tid & 7;
    const int t2 = tid & 255, ls_ld = t2 >> 3, c8 = (t2 & 7) * 8;
    for (int unit = C.bid; unit < 128; unit += C.G) {
        const int b = unit >> 4, h = (unit >> 1) & 7, dir = unit & 1;
        const float* DEC = WSP(const float, WS_DEC) + (size_t)dir * NT * ADIM + h * 64;
        const bf16_t* KD = WSP(const bf16_t, WS_KD) + (size_t)dir * NT * ADIM + h * 64;
        const bf16_t* BB = WSP(const bf16_t, WS_BB) + (size_t)dir * NT * ADIM + h * 64;
        const bf16_t* KK = WSP(const bf16_t, WS_KK) + h * 64; const bf16_t* R = WSP(const bf16_t, WS_R) + h * 64; const bf16_t* V = WSP(const bf16_t, WS_V) + h * 64;
        float* Y = WSP(float, WS_Y) + (size_t)dir * NT * ADIM + h * 64;
        auto row_of = [&](int s_) -> int { return s_ < 256 ? NLAT + b * 256 + (dir ? 255 - s_ : s_) : b * 2048 + (dir ? 2047 - (s_ - 256) : (s_ - 256)); };
        f32x4 pw0, pw1; u32x4 pkd, pbb, pkk, pr, pv;
        auto gload = [&](int chunk) { const size_t o = (size_t)row_of(chunk * SC_TC + ls_ld) * ADIM + c8;
            pw0 = *(const f32x4*)(DEC + o); pw1 = *(const f32x4*)(DEC + o + 4); pkd = *(const u32x4*)(KD + o); pbb = *(const u32x4*)(BB + o); pkk = *(const u32x4*)(KK + o); pr = *(const u32x4*)(R + o); pv = *(const u32x4*)(V + o); };
        auto lwrite = [&](int buf) { LAS float* Bf = L + buf * SC_BUF + ls_ld * 64 + c8;
            float kd[8], bb[8], kk[8], r[8], v[8]; unpk8(pkd, kd); unpk8(pbb, bb); unpk8(pkk, kk); unpk8(pr, r); unpk8(pv, v);
            *(LAS f32x4*)(Bf) = pw0; *(LAS f32x4*)(Bf + 4) = pw1;
            *(LAS f32x4*)(Bf + SC_ARR) = *(const f32x4*)&kd[0]; *(LAS f32x4*)(Bf + SC_ARR + 4) = *(const f32x4*)&kd[4];
            *(LAS f32x4*)(Bf + 2 * SC_ARR) = *(const f32x4*)&bb[0]; *(LAS f32x4*)(Bf + 2 * SC_ARR + 4) = *(const f32x4*)&bb[4];
            *(LAS f32x4*)(Bf + 3 * SC_ARR) = *(const f32x4*)&kk[0]; *(LAS f32x4*)(Bf + 3 * SC_ARR + 4) = *(const f32x4*)&kk[4];
            *(LAS f32x4*)(Bf + 4 * SC_ARR) = pw0 * *(const f32x4*)&r[0]; *(LAS f32x4*)(Bf + 4 * SC_ARR + 4) = pw1 * *(const f32x4*)&r[4];
            *(LAS f32x4*)(Bf + 5 * SC_ARR) = *(const f32x4*)&v[0]; *(LAS f32x4*)(Bf + 5 * SC_ARR + 4) = *(const f32x4*)&v[4];
            float br = 0.f, kr = 0.f;
#pragma unroll
            for (int q = 0; q < 8; ++q) { br += bb[q] * r[q]; kr += kd[q] * r[q]; }
            br = sum8(br); kr = sum8(kr);
            if ((tid & 7) == 0) *(LAS f32x2*)(L + buf * SC_BUF + 6 * SC_ARR + ls_ld * 2) = (f32x2){br, kr}; };
        f32x2 S0[4], S1[4];
#pragma unroll
        for (int q = 0; q < 4; ++q) { S0[q] = (f32x2){0.f, 0.f}; S1[q] = (f32x2){0.f, 0.f}; }
        __syncthreads();
        if (stager) { gload(0); lwrite(0); }
        __syncthreads();
        constexpr int NCH = 2304 / SC_TC;
        for (int ch = 0; ch < NCH; ++ch) {
            if (stager) {
                if (ch > 0) { const LAS float* yp = YB_ + ((ch - 1) & 1) * SC_ARR + ls_ld * 64 + c8; float* yg = Y + (size_t)row_of((ch - 1) * SC_TC + ls_ld) * ADIM + c8;
                    st16f(yg, *(const LAS f32x4*)yp); st16f(yg + 4, *(const LAS f32x4*)(yp + 4)); }
                if (ch + 1 < NCH) { gload(ch + 1); lwrite((ch + 1) & 1); }
            } else {
                const LAS float* Bf = L + (ch & 1) * SC_BUF + j * 8;
                const LAS float* Bv = L + (ch & 1) * SC_BUF + 5 * SC_ARR + 2 * rp;
                const LAS float* Bs = L + (ch & 1) * SC_BUF + 6 * SC_ARR;
                LAS float* yb = YB_ + (ch & 1) * SC_ARR + 2 * rp;
#pragma unroll 2
                for (int ls = 0; ls < SC_TC; ++ls) {
                    const LAS float* p = Bf + ls * 64;
                    const f32x4 w0 = *(const LAS f32x4*)(p), w1 = *(const LAS f32x4*)(p + 4);
                    const f32x4 d0 = *(const LAS f32x4*)(p + SC_ARR), d1 = *(const LAS f32x4*)(p + SC_ARR + 4);
                    const f32x4 b0 = *(const LAS f32x4*)(p + 2 * SC_ARR), b1 = *(const LAS f32x4*)(p + 2 * SC_ARR + 4);
                    const f32x4 k0 = *(const LAS f32x4*)(p + 3 * SC_ARR), k1 = *(const LAS f32x4*)(p + 3 * SC_ARR + 4);
                    const f32x4 r0 = *(const LAS f32x4*)(p + 4 * SC_ARR), r1 = *(const LAS f32x4*)(p + 4 * SC_ARR + 4);
                    const f32x2 vv = *(const LAS f32x2*)(Bv + ls * 64), sc = *(const LAS f32x2*)(Bs + ls * 2);
                    const f32x2 kA = {k0.x, k0.y}, kB = {k0.z, k0.w}, kC = {k1.x, k1.y}, kD = {k1.z, k1.w}, rA = {r0.x, r0.y}, rB = {r0.z, r0.w}, rC = {r1.x, r1.y}, rD = {r1.z, r1.w};
                    f32x2 a10 = S0[0] * kA; a10 += S0[1] * kB; a10 += S0[2] * kC; a10 += S0[3] * kD;
                    f32x2 a11 = S1[0] * kA; a11 += S1[1] * kB; a11 += S1[2] * kC; a11 += S1[3] * kD;
                    f32x2 a20 = S0[0] * rA; a20 += S0[1] * rB; a20 += S0[2] * rC; a20 += S0[3] * rD;
                    f32x2 a21 = S1[0] * rA; a21 += S1[1] * rB; a21 += S1[2] * rC; a21 += S1[3] * rD;
                    float q10 = a10.x + a10.y, q11 = a11.x + a11.y, q20 = a20.x + a20.y, q21 = a21.x + a21.y;
                    q10 += dpp_f<0xB1>(q10); q11 += dpp_f<0xB1>(q11); q20 += dpp_f<0xB1>(q20); q21 += dpp_f<0xB1>(q21);
                    q10 += dpp_f<0x4E>(q10); q11 += dpp_f<0x4E>(q11); q20 += dpp_f<0x4E>(q20); q21 += dpp_f<0x4E>(q21);
                    q10 += dpp_f<0x141>(q10); q11 += dpp_f<0x141>(q11); q20 += dpp_f<0x141>(q20); q21 += dpp_f<0x141>(q21);
                    const float sa0 = -q10, sa1 = -q11;
                    const f32x2 y2 = {q20 + sa0 * sc.x + vv.x * sc.y, q21 + sa1 * sc.x + vv.y * sc.y};
                    const f32x2 sA = {sa0, sa0}, sB = {sa1, sa1}, vA = {vv.x, vv.x}, vB = {vv.y, vv.y};
                    const f32x2 wA = {w0.x, w0.y}, wB = {w0.z, w0.w}, wC = {w1.x, w1.y}, wD = {w1.z, w1.w}, bA = {b0.x, b0.y}, bB = {b0.z, b0.w}, bC = {b1.x, b1.y}, bD = {b1.z, b1.w};
                    const f32x2 dA = {d0.x, d0.y}, dB = {d0.z, d0.w}, dC = {d1.x, d1.y}, dD = {d1.z, d1.w};
                    S0[0] = S0[0] * wA + sA * bA + vA * dA; S0[1] = S0[1] * wB + sA * bB + vA * dB; S0[2] = S0[2] * wC + sA * bC + vA * dC; S0[3] = S0[3] * wD + sA * bD + vA * dD;
                    S1[0] = S1[0] * wA + sB * bA + vB * dA; S1[1] = S1[1] * wB + sB * bB + vB * dB; S1[2] = S1[2] * wC + sB * bC + vB * dC; S1[3] = S1[3] * wD + sB * bD + vB * dD;
                    *(LAS f32x2*)(yb + ls * 64) = y2;
                }
            }
            __syncthreads();
        }
        if (stager) { const LAS float* yp = YB_ + ((NCH - 1) & 1) * SC_ARR + ls_ld * 64 + c8; float* yg = Y + (size_t)row_of((NCH - 1) * SC_TC + ls_ld) * ADIM + c8;
            st16f(yg, *(const LAS f32x4*)yp); st16f(yg + 4, *(const LAS f32x4*)(yp + 4)); }
    }
}

__device__ __forceinline__ void a4_mla_naive(const Ctx& C) {
    LAS float* Kt = (LAS float*)C.lds;
    LAS float* Vt = Kt + 32 * 96;
    const bf16_t* Q = WSP(const bf16_t, WS_Q); const bf16_t* KV = WSP(const bf16_t, WS_KV); const bf16_t* KR = WSP(const bf16_t, WS_KR); bf16_t* MIX = WSP(bf16_t, WS_MIX);
    const int tid = C.tid;
    for (int unit = C.bid; unit < 320; unit += C.G) {
        int b, h, qrow, nkeys; bool active = true;
        if (unit < 256) { b = unit >> 5; h = (unit >> 2) & 7; qrow = b * 2048 + (unit & 3) * 512 + tid; nkeys = 2304; }
        else { const int u = unit - 256; b = u >> 3; h = u & 7; qrow = NLAT + b * 256 + (tid & 255); nkeys = 256; active = tid < 256; }
        float q[96], acc[64], m = -1e30f, l = 0.f;
#pragma unroll
        for (int d8 = 0; d8 < 12; ++d8) { float t8[8]; ld8(Q + (size_t)qrow * 768 + h * 96 + d8 * 8, t8);
#pragma unroll
            for (int jj = 0; jj < 8; ++jj) q[d8 * 8 + jj] = t8[jj]; }
#pragma unroll
        for (int d = 0; d < 64; ++d) acc[d] = 0.f;
        for (int kt = 0; kt < nkeys; kt += 32) {
            __syncthreads();
            for (int idx = tid; idx < 32 * 48; idx += 512) { const int key = idx / 48, dp = idx % 48, kj = kt + key; const int krow = kj < 256 ? NLAT + b * 256 + kj : b * 2048 + (kj - 256);
                const unsigned w = dp < 32 ? *(const unsigned*)(KV + (size_t)krow * 1024 + h * 128 + dp * 2) : *(const unsigned*)(KR + (size_t)krow * 32 + (dp - 32) * 2);
                Kt[key * 96 + dp * 2] = __uint_as_float(w << 16); Kt[key * 96 + dp * 2 + 1] = __uint_as_float(w & 0xffff0000u); }
            for (int idx = tid; idx < 32 * 32; idx += 512) { const int key = idx >> 5, dp = idx & 31, kj = kt + key; const int krow = kj < 256 ? NLAT + b * 256 + kj : b * 2048 + (kj - 256);
                const unsigned w = *(const unsigned*)(KV + (size_t)krow * 1024 + h * 128 + 64 + dp * 2);
                Vt[key * 64 + dp * 2] = __uint_as_float(w << 16); Vt[key * 64 + dp * 2 + 1] = __uint_as_float(w & 0xffff0000u); }
            __syncthreads();
            for (int key = 0; key < 32; ++key) {
                float s = 0.f;
#pragma unroll
                for (int d4 = 0; d4 < 24; ++d4) { const f32x4 kv = *(const LAS f32x4*)(Kt + key * 96 + d4 * 4); s += q[d4 * 4] * kv.x + q[d4 * 4 + 1] * kv.y + q[d4 * 4 + 2] * kv.z + q[d4 * 4 + 3] * kv.w; }
                const float mn = fmaxf(m, s), corr = __expf(m - mn), p = __expf(s - mn); m = mn; l = l * corr + p;
#pragma unroll
                for (int d4 = 0; d4 < 16; ++d4) { const f32x4 vv = *(const LAS f32x4*)(Vt + key * 64 + d4 * 4);
                    acc[d4 * 4] = acc[d4 * 4] * corr + p * vv.x; acc[d4 * 4 + 1] = acc[d4 * 4 + 1] * corr + p * vv.y; acc[d4 * 4 + 2] = acc[d4 * 4 + 2] * corr + p * vv.z; acc[d4 * 4 + 3] = acc[d4 * 4 + 3] * corr + p * vv.w; }
            }
        }
        if (active) { const float il = 1.f / l;
#pragma unroll
            for (int d8 = 0; d8 < 8; ++d8) { float o[8];
#pragma unroll
                for (int jj = 0; jj < 8; ++jj) o[jj] = acc[d8 * 8 + jj] * il;
                st8(MIX + (size_t)qrow * DM + 512 + h * 64 + d8 * 8, o); } }
    }
    __syncthreads();
}

typedef float f32x16 __attribute__((ext_vector_type(16)));
__device__ __forceinline__ int crow(int r, int hi) { return (r & 3) + 8 * (r >> 2) + 4 * hi; }
constexpr int AT_VP = 136;
template <class Spec> __device__ __forceinline__ void attn_unit(const Ctx& C, const Spec& sp) {
    constexpr int DQ = Spec::DQ, NS = DQ / 16, KP = Spec::KPITCH, KBUF = 64 * KP, VBUF = 64 * AT_VP, BUF = KBUF + VBUF;
    static_assert(BUF % 16 == 0 && KP % 16 == 0, "alignment");
    LAS unsigned char* L = C.lds;
    const int tid = C.tid, lane = C.lane, w = C.wave, r32 = lane & 31, hi = lane >> 5;
    bf16x8 qf[NS];
    { const bf16_t* qp = sp.qptr(w * 32 + r32);
#pragma unroll
      for (int s_ = 0; s_ < NS; ++s_) qf[s_] = *(const bf16x8*)(qp + 16 * s_ + 8 * hi); }
    f32x16 o0, o1;
#pragma unroll
    for (int r = 0; r < 16; ++r) { o0[r] = 0.f; o1[r] = 0.f; }
    float m = -1e30f, lsum = 0.f;
    const int nt = sp.nt;
    const int skey = tid >> 3, sch = tid & 7, rkey = (tid >> 2) & 63, rch = 8 + (tid & 3);
    struct Stg { u32x4 gk, gk2, gv; } sa_, sb_;
    sa_.gk2 = (u32x4){0u, 0u, 0u, 0u}; sb_.gk2 = (u32x4){0u, 0u, 0u, 0u};
    auto gload = [&](int t, Stg& g_) { g_.gk = *(const u32x4*)sp.kptr(t, skey, sch); if (NS > 4 && tid < 256) g_.gk2 = *(const u32x4*)sp.kptr(t, rkey, rch); g_.gv = *(const u32x4*)sp.vptr(t, skey, sch); };
    auto lwrite = [&](int buf, const Stg& g_) { const u32x4 gk = g_.gk, gk2 = g_.gk2, gv = g_.gv; LAS unsigned char* Bk = L + buf * BUF;
        *(LAS u32x4*)(Bk + skey * KP + sch * 16) = gk; if (NS > 4 && tid < 256) *(LAS u32x4*)(Bk + rkey * KP + rch * 16) = gk2;
        LAS unsigned short* Bv = (LAS unsigned short*)(Bk + KBUF);
#pragma unroll
        for (int j = 0; j < 8; ++j) { const unsigned wv = gv[j >> 1]; Bv[(sch * 8 + j) * (AT_VP / 2) + skey] = (unsigned short)((j & 1) ? (wv >> 16) : (wv & 0xffffu)); } };
    __syncthreads();
    sp.prologue(C);
    gload(0, sa_); if (nt > 1) gload(1, sb_); lwrite(0, sa_);
    __syncthreads();
    auto compute = [&](int t) {
        if (sp.active(t, w)) {
            const LAS unsigned char* Bk = L + (t & 1) * BUF; const LAS unsigned char* Bv = Bk + KBUF;
            f32x16 p0, p1;
#pragma unroll
            for (int r = 0; r < 16; ++r) { p0[r] = 0.f; p1[r] = 0.f; }
#pragma unroll
            for (int s_ = 0; s_ < NS; ++s_) {
                const bf16x8 k0 = *(const LAS bf16x8*)(Bk + r32 * KP + 32 * s_ + 16 * hi), k1 = *(const LAS bf16x8*)(Bk + (32 + r32) * KP + 32 * s_ + 16 * hi);
                p0 = __builtin_amdgcn_mfma_f32_32x32x16_bf16(k0, qf[s_], p0, 0, 0, 0); p1 = __builtin_amdgcn_mfma_f32_32x32x16_bf16(k1, qf[s_], p1, 0, 0, 0); }
            sp.bias(C, t, w, r32, hi, p0, p1);
            float mx = fmaxf(p0[0], p1[0]);
#pragma unroll
            for (int r = 1; r < 16; ++r) mx = fmaxf(mx, fmaxf(p0[r], p1[r]));
            mx = fmaxf(mx, __shfl_xor(mx, 32));
            if (__any(mx > m + 8.0f)) {
                const float mn = fmaxf(m, mx), corr = __builtin_amdgcn_exp2f(m - mn); m = mn; lsum *= corr;
#pragma unroll
                for (int r = 0; r < 16; ++r) { o0[r] *= corr; o1[r] *= corr; }
            }
            float ps = 0.f;
#pragma unroll
            for (int r = 0; r < 16; ++r) { p0[r] = __builtin_amdgcn_exp2f(p0[r] - m); p1[r] = __builtin_amdgcn_exp2f(p1[r] - m); ps += p0[r] + p1[r]; }
            lsum += ps;
#pragma unroll
            for (int s_ = 0; s_ < 4; ++s_) {
                u32x4 pw;
                if (s_ < 2) { pw.x = pk2(p0[8 * s_ + 0], p0[8 * s_ + 1]); pw.y = pk2(p0[8 * s_ + 2], p0[8 * s_ + 3]); pw.z = pk2(p0[8 * s_ + 4], p0[8 * s_ + 5]); pw.w = pk2(p0[8 * s_ + 6], p0[8 * s_ + 7]); }
                else { const int q_ = 8 * (s_ - 2); pw.x = pk2(p1[q_ + 0], p1[q_ + 1]); pw.y = pk2(p1[q_ + 2], p1[q_ + 3]); pw.z = pk2(p1[q_ + 4], p1[q_ + 5]); pw.w = pk2(p1[q_ + 6], p1[q_ + 7]); }
                const bf16x8 pb = __builtin_bit_cast(bf16x8, pw);
#pragma unroll
                for (int dvh = 0; dvh < 2; ++dvh) {
                    const LAS unsigned char* vp = Bv + (dvh * 32 + r32) * AT_VP + 32 * s_ + 8 * hi;
                    const u32x2 a = *(const LAS u32x2*)vp, b = *(const LAS u32x2*)(vp + 16);
                    const bf16x8 vf = __builtin_bit_cast(bf16x8, (u32x4){a.x, a.y, b.x, b.y});
                    if (dvh == 0) o0 = __builtin_amdgcn_mfma_f32_32x32x16_bf16(vf, pb, o0, 0, 0, 0); else o1 = __builtin_amdgcn_mfma_f32_32x32x16_bf16(vf, pb, o1, 0, 0, 0);
                }
            }
        }
    };
    for (int t = 0; t < nt; t += 2) {
        if (t + 2 < nt) gload(t + 2, sa_);
        compute(t);
        if (t + 1 < nt) lwrite(1, sb_);
        __syncthreads();
        if (t + 1 >= nt) break;
        if (t + 3 < nt) gload(t + 3, sb_);
        compute(t + 1);
        if (t + 2 < nt) lwrite(0, sa_);
        __syncthreads();
    }
    lsum += __shfl_xor(lsum, 32);
    const float il = 1.f / lsum;
    bf16_t* op = sp.optr(w * 32 + r32);
#pragma unroll
    for (int g = 0; g < 4; ++g) { u32x2 w0, w1;
        w0.x = pk2(o0[4 * g] * il, o0[4 * g + 1] * il); w0.y = pk2(o0[4 * g + 2] * il, o0[4 * g + 3] * il);
        w1.x = pk2(o1[4 * g] * il, o1[4 * g + 1] * il); w1.y = pk2(o1[4 * g + 2] * il, o1[4 * g + 3] * il);
        st8b(op + 8 * g + 4 * hi, w0); st8b(op + 32 + 8 * g + 4 * hi, w1); }
}
struct MlaSpec { static constexpr int DQ = 96, KPITCH = 208;
    const bf16_t* Q; const bf16_t* KV; const bf16_t* KR; bf16_t* O; int b, h, q0, nt;
    __device__ __forceinline__ const bf16_t* qptr(int i) const { return Q + (size_t)(q0 + i) * 768 + h * 96; }
    __device__ __forceinline__ bf16_t* optr(int i) const { return O + (size_t)(q0 + i) * DM + 512 + h * 64; }
    __device__ __forceinline__ int krow(int t, int key) const { return t < 4 ? NLAT + b * 256 + 64 * t + key : b * 2048 + 64 * (t - 4) + key; }
    __device__ __forceinline__ const bf16_t* kptr(int t, int key, int c) const { const int kr = krow(t, key); return c < 8 ? KV + (size_t)kr * 1024 + h * 128 + c * 8 : KR + (size_t)kr * 32 + (c - 8) * 8; }
    __device__ __forceinline__ const bf16_t* vptr(int t, int key, int c) const { return KV + (size_t)krow(t, key) * 1024 + h * 128 + 64 + c * 8; }
    __device__ __forceinline__ bool active(int, int) const { return true; }
    __device__ __forceinline__ void prologue(const Ctx&) const {}
    __device__ __forceinline__ void bias(const Ctx&, int, int, int, int, f32x16&, f32x16&) const {}
};
struct NaSpec { static constexpr int DQ = 64, KPITCH = 144; static constexpr int TAB_OFF = 2 * (64 * 144 + 64 * AT_VP);
    const bf16_t* QKV; bf16_t* O; const float* rpb; int b, h, rb, kr0, ntw, nt, isctx;
    __device__ __forceinline__ const bf16_t* qptr(int i) const { return QKV + (size_t)(isctx ? NLAT + b * 256 + i : b * 2048 + rb * 256 + i) * 3072 + h * 64; }
    __device__ __forceinline__ bf16_t* optr(int i) const { return O + (size_t)(isctx ? NLAT + b * 256 + i : b * 2048 + rb * 256 + i) * DM + h * 64; }
    __device__ __forceinline__ int krow(int t, int key) const { return t < ntw ? b * 2048 + (kr0 + t) * 64 + key : NLAT + b * 256 + 64 * (t - ntw) + key; }
    __device__ __forceinline__ const bf16_t* kptr(int t, int key, int c) const { return QKV + (size_t)krow(t, key) * 3072 + 1024 + h * 64 + c * 8; }
    __device__ __forceinline__ const bf16_t* vptr(int t, int key, int c) const { return QKV + (size_t)krow(t, key) * 3072 + 2048 + h * 64 + c * 8; }
    __device__ __forceinline__ bool active(int t, int w) const { if (t >= ntw) return true; const int qr = 4 * rb + (w >> 1), rs = min(max(qr - 4, 0), 24), kr = kr0 + t; return kr >= rs && kr < rs + 8; }
    __device__ __forceinline__ void prologue(const Ctx& C) const { if (!isctx) { LAS float* tab = (LAS float*)(C.lds + TAB_OFF); for (int idx = C.tid; idx < 640; idx += 512) { const int k = idx - 64; tab[idx] = (k >= 0 && k < 465) ? rpb[h * 465 + k] * 1.4426950408889634f : 0.f; } } }
    __device__ __forceinline__ void bias(const Ctx& C, int t, int w, int r32, int hi, f32x16& p0, f32x16& p1) const {
        if (t >= ntw) return;
        const LAS float* tab = (const LAS float*)(C.lds + TAB_OFF);
        const int qr = 4 * rb + (w >> 1), qc = 32 * (w & 1) + r32, cs = min(max(qc - 8, 0), 48), ro = (kr0 + t - qr + 7) * 31 - qc + 15 + 64;
        const volatile LAS float* tb = tab + ro + 4 * hi; const int kb = 4 * hi - cs;
        float bv0[16], bv1[16];
#pragma unroll
        for (int r = 0; r < 16; ++r) { const int c = (r & 3) + 8 * (r >> 2); bv0[r] = tb[c]; bv1[r] = tb[c + 32]; }
#pragma unroll
        for (int r = 0; r < 16; ++r) { const int c = (r & 3) + 8 * (r >> 2);
            const bool v0 = (unsigned)(c + kb) < 16u, v1 = (unsigned)(c + 32 + kb) < 16u;
            p0[r] = v0 ? p0[r] + bv0[r] : -INFINITY; p1[r] = v1 ? p1[r] + bv1[r] : -INFINITY; }
    }
};
__device__ __forceinline__ void a4_mla(const Ctx& C, int layer) {
    volatile LAS int* slot = (volatile LAS int*)(C.lds + LDSCTL_OFF + 64);
    unsigned* ctr = (unsigned*)(C.ws + WS_CTL) + CW_QUEUE + 64 * layer;
    for (;;) {
        __syncthreads();
        if (C.tid == 0) slot[0] = (int)__hip_atomic_fetch_add(ctr, 1u, __ATOMIC_RELAXED, __HIP_MEMORY_SCOPE_AGENT);
        __syncthreads();
        const int unit = slot[0];
        if (unit >= 512 + 64) break;
        MlaSpec sp; sp.Q = WSP(const bf16_t, WS_Q); sp.KV = WSP(const bf16_t, WS_KV); sp.KR = WSP(const bf16_t, WS_KR); sp.O = WSP(bf16_t, WS_MIX);
        if (unit < 512) { sp.b = unit >> 6; sp.h = (unit >> 3) & 7; sp.q0 = sp.b * 2048 + (unit & 7) * 256; sp.nt = 36; }
        else { const int u = unit - 512; sp.b = u >> 3; sp.h = u & 7; sp.q0 = NLAT + sp.b * 256; sp.nt = 4; }
        attn_unit(C, sp);
    }
}
__device__ __forceinline__ void b2_na(const Ctx& C, int i, bool need_ctx) {
    for (int unit = C.bid; unit < 1024 + (need_ctx ? 128 : 0); unit += C.G) {
        NaSpec sp; sp.QKV = WSP(const bf16_t, WS_Z); sp.O = WSP(bf16_t, WS_MIX); sp.rpb = C.A.in[27] + (size_t)i * 16 * 465;
        if (unit < 1024) { sp.b = unit >> 7; sp.h = (unit >> 3) & 15; sp.rb = unit & 7; sp.isctx = 0;
            sp.kr0 = min(max(4 * sp.rb - 4, 0), 24); const int krl = min(max(4 * sp.rb + 3 - 4, 0), 24) + 7; sp.ntw = krl - sp.kr0 + 1; sp.nt = sp.ntw + 4; }
        else { const int u = unit - 1024; sp.b = u >> 4; sp.h = u & 15; sp.rb = 0; sp.isctx = 1; sp.kr0 = 0; sp.ntw = 0; sp.nt = 4; }
        attn_unit(C, sp);
    }
}

__device__ __forceinline__ void a5_output(const Ctx& C, int i) {
    const int lane = C.lane, c0 = lane * 8;
    const float* rk = C.A.in[19] + i * ADIM + c0; const float* lnw = C.A.in[20] + i * ADIM + c0; const float* lnb = C.A.in[21] + i * ADIM + c0;
    for (int row = C.gw; row < NT; row += C.ngw) {
        const float* yf = WSP(const float, WS_Y) + (size_t)row * ADIM + c0; const float* yb = yf + (size_t)NT * ADIM;
        float y[8]; { const f32x4 a0 = *(const f32x4*)yf, a1 = *(const f32x4*)(yf + 4), b0 = *(const f32x4*)yb, b1 = *(const f32x4*)(yb + 4);
            y[0] = a0.x + b0.x; y[1] = a0.y + b0.y; y[2] = a0.z + b0.z; y[3] = a0.w + b0.w; y[4] = a1.x + b1.x; y[5] = a1.y + b1.y; y[6] = a1.z + b1.z; y[7] = a1.w + b1.w; }
        float s = 0.f;
#pragma unroll
        for (int j = 0; j < 8; ++j) s += y[j];
        const float mean = sum8(s) * (1.f / 64.f); float q = 0.f;
#pragma unroll
        for (int j = 0; j < 8; ++j) { const float d = y[j] - mean; q += d * d; }
        const float rstd = rsqrtf(sum8(q) * (1.f / 64.f) + 64e-5f);
        float r[8], v[8], g[8], kd0[8], kd1[8];
        ld8(WSP(const bf16_t, WS_R) + (size_t)row * ADIM + c0, r); ld8(WSP(const bf16_t, WS_V) + (size_t)row * ADIM + c0, v); ld8(WSP(const bf16_t, WS_G) + (size_t)row * ADIM + c0, g);
        ld8(WSP(const bf16_t, WS_KD) + (size_t)row * ADIM + c0, kd0); ld8(WSP(const bf16_t, WS_KD) + ((size_t)NT + row) * ADIM + c0, kd1);
        float bs = 0.f;
#pragma unroll
        for (int j = 0; j < 8; ++j) bs += r[j] * (kd0[j] + kd1[j]) * rk[j];
        bs = sum8(bs);
        float o[8];
#pragma unroll
        for (int j = 0; j < 8; ++j) o[j] = ((y[j] - mean) * rstd * lnw[j] + lnb[j] + bs * v[j]) * g[j];
        st8(WSP(bf16_t, WS_MIX) + (size_t)row * DM + c0, o);
    }
}

__device__ __forceinline__ void b2_na_naive(const Ctx& C, int i, bool need_ctx) {
    const bf16_t* QKV = WSP(const bf16_t, WS_Z); bf16_t* MIX = WSP(bf16_t, WS_MIX);
    const float* rpb = C.A.in[27] + (size_t)i * 16 * 15 * 31;
    const int nq = need_ctx ? NT : NLAT;
    const int nblk = nq / 512;
    for (int unit = C.bid; unit < nblk * 16; unit += C.G) {
        const int h = unit & 15, qrow = (unit >> 4) * 512 + C.tid;
        float q[64], acc[64], m = -1e30f, l = 0.f;
#pragma unroll
        for (int d8 = 0; d8 < 8; ++d8) { float t8[8]; ld8(QKV + (size_t)qrow * 3072 + h * 64 + d8 * 8, t8);
#pragma unroll
            for (int jj = 0; jj < 8; ++jj) q[d8 * 8 + jj] = t8[jj]; }
#pragma unroll
        for (int d = 0; d < 64; ++d) acc[d] = 0.f;
        const bool isctx = qrow >= NLAT; const int b = isctx ? (qrow - NLAT) >> 8 : qrow >> 11;
        int qr = 0, qc = 0, rs = 0, cs = 0, nwin = 0;
        if (!isctx) { const int t = qrow & 2047; qr = t >> 6; qc = t & 63; rs = min(max(qr - 4, 0), 24); cs = min(max(qc - 8, 0), 48); nwin = 128; }
        const int nk = nwin + 256;
        for (int kj = 0; kj < nk; ++kj) {
            int krow; float bias = 0.f;
            if (kj < nwin) { const int kr = rs + (kj >> 4), kc = cs + (kj & 15); krow = b * 2048 + kr * 64 + kc; bias = rpb[(h * 15 + (kr - qr + 7)) * 31 + (kc - qc + 15)]; }
            else krow = NLAT + b * 256 + (kj - nwin);
            const bf16_t* kp = QKV + (size_t)krow * 3072 + 1024 + h * 64; const bf16_t* vp = kp + 1024;
            float s = 0.f;
#pragma unroll
            for (int d8 = 0; d8 < 8; ++d8) { float t8[8]; ld8(kp + d8 * 8, t8);
#pragma unroll
                for (int jj = 0; jj < 8; ++jj) s += q[d8 * 8 + jj] * t8[jj]; }
            s += bias;
            const float mn = fmaxf(m, s), corr = __expf(m - mn), p = __expf(s - mn); m = mn; l = l * corr + p;
#pragma unroll
            for (int d8 = 0; d8 < 8; ++d8) { float t8[8]; ld8(vp + d8 * 8, t8);
#pragma unroll
                for (int jj = 0; jj < 8; ++jj) acc[d8 * 8 + jj] = acc[d8 * 8 + jj] * corr + p * t8[jj]; }
        }
        const float il = 1.f / l;
#pragma unroll
        for (int d8 = 0; d8 < 8; ++d8) { float o[8];
#pragma unroll
            for (int jj = 0; jj < 8; ++jj) o[jj] = acc[d8 * 8 + jj] * il;
            st8(MIX + (size_t)qrow * DM + h * 64 + d8 * 8, o); }
    }
}

template <int CTRL, int N> __device__ __forceinline__ void tr_step_dpp(const float (&in)[2 * N], float (&out)[N], bool bit) {
#pragma unroll
    for (int k = 0; k < N; ++k) { const float keep = bit ? in[k + N] : in[k], give = bit ? in[k] : in[k + N]; out[k] = keep + dpp_f<CTRL>(give); } }
__device__ __forceinline__ void c2_router(const Ctx& C, int layer, int nrows) {
    const float* rw = C.A.in[29] + (size_t)layer * DM * NEXP; const int lane = C.lane;
    LAS float* scr = (LAS float*)(C.lds + C.wave * 256);
    const float* nw = C.A.in[7] + layer * DM;
    for (int grp = C.gw; grp < nrows / 4; grp += C.ngw) {
        const int row0 = grp * 4, mg = mod_group(row0);
        const float* sh = modp(C, layer, mg, 3); const float* sc = modp(C, layer, mg, 4);
        f32x4 h[4][4];
#pragma unroll
        for (int rr = 0; rr < 4; ++rr) row_load(WSP(const float, WS_X) + (size_t)(row0 + rr) * DM, lane, h[rr]);
#pragma unroll
        for (int rr = 0; rr < 4; ++rr) { const float rstd = row_rstd(h[rr]); f32x4 t[4]; row_modulate(h[rr], rstd, nw, sh, sc, lane, t);
#pragma unroll
            for (int j = 0; j < 4; ++j) h[rr][j] = t[j];
            row_store_bf16(WSP(bf16_t, WS_H) + (size_t)(row0 + rr) * DM, lane, h[rr]); }
        float lg[64];
#pragma unroll
        for (int k = 0; k < 64; ++k) lg[k] = 0.f;
#pragma unroll
        for (int j = 0; j < 4; ++j)
#pragma unroll
            for (int q = 0; q < 4; ++q) { const float* wr_ = rw + (size_t)((lane + 64 * j) * 4 + q) * NEXP;
                const f32x4 w0 = *(const f32x4*)(wr_), w1 = *(const f32x4*)(wr_ + 4), w2 = *(const f32x4*)(wr_ + 8), w3 = *(const f32x4*)(wr_ + 12);
#pragma unroll
                for (int rr = 0; rr < 4; ++rr) { const float hv = h[rr][j][q]; float* l = lg + rr * 16;
                    l[0] += hv * w0.x; l[1] += hv * w0.y; l[2] += hv * w0.z; l[3] += hv * w0.w; l[4] += hv * w1.x; l[5] += hv * w1.y; l[6] += hv * w1.z; l[7] += hv * w1.w;
                    l[8] += hv * w2.x; l[9] += hv * w2.y; l[10] += hv * w2.z; l[11] += hv * w2.w; l[12] += hv * w3.x; l[13] += hv * w3.y; l[14] += hv * w3.z; l[15] += hv * w3.w; } }
        float r1[32], r2[16], r3[8], r4[4], r5[2];
        tr_step_dpp<0x140, 32>(lg, r1, (lane >> 3) & 1); tr_step_dpp<0x141, 16>(r1, r2, (lane >> 2) & 1); tr_step_dpp<0x4E, 8>(r2, r3, (lane >> 1) & 1); tr_step_dpp<0xB1, 4>(r3, r4, lane & 1);
        { const bool bit = (lane >> 4) & 1;
#pragma unroll
          for (int k = 0; k < 2; ++k) { const float keep = bit ? r4[k + 2] : r4[k], give = bit ? r4[k] : r4[k + 2]; r5[k] = keep + __shfl_xor(give, 16); } }
        float lgt; { const bool bit = (lane >> 5) & 1; const float keep = bit ? r5[1] : r5[0], give = bit ? r5[0] : r5[1]; lgt = keep + __shfl_xor(give, 32); }
        const int idx = (((lane >> 3) & 1) << 5) | (((lane >> 2) & 1) << 4) | (((lane >> 1) & 1) << 3) | ((lane & 1) << 2) | (((lane >> 4) & 1) << 1) | ((lane >> 5) & 1);
        scr[idx] = lgt;
        asm volatile("s_waitcnt lgkmcnt(0)" ::: "memory");
        const int rr = idx >> 4, e = idx & 15;
        const f32x4 a0 = *(const LAS f32x4*)(scr + rr * 16), a1 = *(const LAS f32x4*)(scr + rr * 16 + 4), a2 = *(const LAS f32x4*)(scr + rr * 16 + 8), a3 = *(const LAS f32x4*)(scr + rr * 16 + 12);
        asm volatile("s_waitcnt lgkmcnt(0)" ::: "memory");
        const float mx = fmaxf(fmaxf(fmaxf(fmaxf(a0.x, a0.y), fmaxf(a0.z, a0.w)), fmaxf(fmaxf(a1.x, a1.y), fmaxf(a1.z, a1.w))), fmaxf(fmaxf(fmaxf(a2.x, a2.y), fmaxf(a2.z, a2.w)), fmaxf(fmaxf(a3.x, a3.y), fmaxf(a3.z, a3.w))));
        const float den = ((__expf(a0.x - mx) + __expf(a0.y - mx)) + (__expf(a0.z - mx) + __expf(a0.w - mx))) + ((__expf(a1.x - mx) + __expf(a1.y - mx)) + (__expf(a1.z - mx) + __expf(a1.w - mx)))
                        + ((__expf(a2.x - mx) + __expf(a2.y - mx)) + (__expf(a2.z - mx) + __expf(a2.w - mx))) + ((__expf(a3.x - mx) + __expf(a3.y - mx)) + (__expf(a3.z - mx) + __expf(a3.w - mx)));
        const float a = __expf(lgt - mx) / den;
        const int row = row0 + rr; float* AFF = WSP(float, WS_AFF);
        if (row < NLAT) AFF[((size_t)(row >> 11) * 16 + e) * 2048 + (row & 2047)] = a;
        else { const int r2_ = row - NLAT; AFF[(size_t)NB * 16 * 2048 + ((size_t)(r2_ >> 8) * 16 + e) * 256 + (r2_ & 255)] = a; }
    }
}

__device__ __forceinline__ void c3_topk(const Ctx& C, bool need_ctx) {
    LAS unsigned* cntw = (LAS unsigned*)C.lds;
    LAS unsigned* wtot = (LAS unsigned*)(C.lds + 256);
    LAS int* list = (LAS int*)(C.lds + 1024);
    const int nunits = 128 + (need_ctx ? 128 : 0), tid = C.tid, lane = C.lane, w = C.wave;
    const unsigned long long lt = (1ull << lane) - 1ull;
    for (int unit = C.bid; unit < nunits; unit += C.G) {
        const bool lat = unit < 128; const int u = lat ? unit : unit - 128, b = u >> 4, e = u & 15, n = lat ? 2048 : 256; const unsigned cap = lat ? 256u : 32u;
        const float* src = lat ? WSP(const float, WS_AFF) + ((size_t)b * 16 + e) * 2048 : WSP(const float, WS_AFF) + (size_t)NB * 16 * 2048 + ((size_t)b * 16 + e) * 256;
        const bool valid = 4 * tid < n;
        unsigned key[4] = {0u, 0u, 0u, 0u};
        if (valid) { const u32x4 kv = *(const u32x4*)(src + 4 * tid); key[0] = kv.x; key[1] = kv.y; key[2] = kv.z; key[3] = kv.w; }
        __syncthreads();
        if (tid < 64) cntw[tid] = 0u;
        __syncthreads();
        unsigned T = 0u;
        for (int bit = 29; bit >= 0; --bit) {
            const unsigned cand = T | (1u << bit); unsigned c = 0u;
#pragma unroll
            for (int q = 0; q < 4; ++q) c += (unsigned)__popcll(__ballot(key[q] >= cand));
            if (lane == 0 && c) atomicAdd((unsigned*)&cntw[bit], c);
            __syncthreads();
            if (cntw[bit] >= cap) T = cand;
        }
        unsigned long long bg[4], be[4]; unsigned cg = 0u, ce = 0u;
#pragma unroll
        for (int q = 0; q < 4; ++q) { bg[q] = __ballot(key[q] > T); be[q] = __ballot(valid && key[q] == T); cg += (unsigned)__popcll(bg[q]); ce += (unsigned)__popcll(be[q]); }
        if (lane == 0) { wtot[w] = cg; wtot[8 + w] = ce; }
        __syncthreads();
        unsigned tg = 0u, eoff = 0u;
#pragma unroll
        for (int k = 0; k < 8; ++k) { tg += wtot[k]; eoff += k < w ? wtot[8 + k] : 0u; }
        const unsigned need = cap - tg;
        bool selq[4]; unsigned long long bs[4]; unsigned cs_ = 0u;
#pragma unroll
        for (int q = 0; q < 4; ++q) { unsigned er = eoff;
#pragma unroll
            for (int q2 = 0; q2 < 4; ++q2) er += (unsigned)__popcll(be[q2] & lt) + ((q2 < q && ((be[q2] >> lane) & 1ull)) ? 1u : 0u);
            selq[q] = key[q] > T || (valid && key[q] == T && er < need); bs[q] = __ballot(selq[q]); cs_ += (unsigned)__popcll(bs[q]); }
        if (lane == 0) wtot[16 + w] = cs_;
        __syncthreads();
        unsigned soff = 0u;
#pragma unroll
        for (int k = 0; k < 8; ++k) soff += k < w ? wtot[16 + k] : 0u;
        if (valid) {
            int gsel[4];
#pragma unroll
            for (int q = 0; q < 4; ++q) { unsigned sl = soff;
#pragma unroll
                for (int q2 = 0; q2 < 4; ++q2) sl += (unsigned)__popcll(bs[q2] & lt) + ((q2 < q && ((bs[q2] >> lane) & 1ull)) ? 1u : 0u);
                const int i = 4 * tid + q, trow = lat ? b * 2048 + i : NLAT + b * 256 + i; int grow = -1;
                if (selq[q]) { grow = e * ROWS_E + (lat ? b * 256 + (int)sl : 2048 + b * 32 + (int)sl);
                    WSP(int, WS_IDX)[grow] = trow; WSP(float, WS_GATE)[grow] = __uint_as_float(key[q]); list[sl * 2] = trow; list[sl * 2 + 1] = grow; }
                gsel[q] = grow; }
            const int trow0 = lat ? b * 2048 + 4 * tid : NLAT + b * 256 + 4 * tid;
#pragma unroll
            for (int q = 0; q < 4; ++q) WSP(int, WS_SEL)[(size_t)(trow0 + q) * 16 + e] = gsel[q];
        }
        __syncthreads();
        for (int s_ = w; s_ < (int)cap; s_ += 8) { const int trow = list[s_ * 2], grow = list[s_ * 2 + 1];
            const u32x4* sp = (const u32x4*)(WSP(const bf16_t, WS_H) + (size_t)trow * DM); u32x4* dp = (u32x4*)(WSP(bf16_t, WS_XIN) + (size_t)grow * DM);
            st16(dp + lane, sp[lane]); st16(dp + lane + 64, sp[lane + 64]); }
    }
    __syncthreads();
}

__device__ __forceinline__ void c6_combine(const Ctx& C, int layer, int nrows) {
    const int lane = C.lane;
    for (int grp = C.gw; grp < nrows / 4; grp += C.ngw) {
        const int row0 = grp * 4, mg = mod_group(row0);
        f32x4 v[4][4], a[4][4]; int selv[4]; unsigned em[4];
#pragma unroll
        for (int rr = 0; rr < 4; ++rr) { row_load(WSP(const float, WS_X) + (size_t)(row0 + rr) * DM, lane, v[rr]); selv[rr] = WSP(const int, WS_SEL)[(size_t)(row0 + rr) * 16 + (lane & 15)]; }
#pragma unroll
        for (int rr = 0; rr < 4; ++rr) { em[rr] = (unsigned)(__ballot(selv[rr] >= 0) & 0xFFFFull);
#pragma unroll
            for (int j = 0; j < 4; ++j) a[rr][j] = (f32x4){0.f, 0.f, 0.f, 0.f}; }
        while (em[0] | em[1] | em[2] | em[3]) {
            u32x2 t[4][4];
#pragma unroll
            for (int rr = 0; rr < 4; ++rr) {
                if (em[rr]) { const int e = __builtin_ctz(em[rr]); const int g = __builtin_amdgcn_readlane(selv[rr], e); const bf16_t* y = WSP(const bf16_t, WS_YB) + (size_t)g * DM;
#pragma unroll
                    for (int j = 0; j < 4; ++j) t[rr][j] = *(const u32x2*)(y + (lane + 64 * j) * 4); }
                else {
#pragma unroll
                    for (int j = 0; j < 4; ++j) t[rr][j] = (u32x2){0u, 0u}; }
            }
#pragma unroll
            for (int rr = 0; rr < 4; ++rr) { em[rr] &= em[rr] - 1u;
#pragma unroll
                for (int j = 0; j < 4; ++j) { const u32x2 w = t[rr][j];
                    a[rr][j] += (f32x4){__uint_as_float(w.x << 16), __uint_as_float(w.x & 0xffff0000u), __uint_as_float(w.y << 16), __uint_as_float(w.y & 0xffff0000u)}; } }
        }
        const float* g2 = modp(C, layer, mg, 5);
#pragma unroll
        for (int rr = 0; rr < 4; ++rr) { const int row = row0 + rr;
#pragma unroll
            for (int j = 0; j < 4; ++j) v[rr][j] += *(const f32x4*)(g2 + (lane + 64 * j) * 4) * a[rr][j];
            const float rstd = row_rstd(v[rr]);
            if (layer < 3) { row_store(WSP(float, WS_X) + (size_t)row * DM, lane, v[rr]);
                f32x4 h[4]; row_modulate(v[rr], rstd, C.A.in[6] + (layer + 1) * DM, modp(C, layer + 1, mg, 0), modp(C, layer + 1, mg, 1), lane, h);
                row_store_bf16(WSP(bf16_t, WS_H) + (size_t)row * DM, lane, h);
            } else {
#pragma unroll
                for (int j = 0; j < 4; ++j) { const int c = (lane + 64 * j) * 4; st16f(C.out + (size_t)row * DM + c, v[rr][j] * rstd * *(const f32x4*)(C.A.in[8] + c)); }
            }
        }
    }
}

constexpr int N_PHASE_IDS = 2 + 12 * 4;
__host__ __device__ inline bool phase_exists(int p) { if (p < 2) return true; const int l = (p - 2) / 12, k = (p - 2) % 12; if (k == 11) return false; if (l & 1) return !(k >= 2 && k <= 4); return true; }

__global__ void __launch_bounds__(512, 2) fwd(Args args) {
    extern __shared__ __attribute__((aligned(16))) unsigned char lds_raw[];
    const int tid_ = threadIdx.x, wave_ = __builtin_amdgcn_readfirstlane(tid_ >> 6);
    const Ctx C0{args, args.out, args.ws, (LAS unsigned char*)lds_raw, tid_, tid_ & 63, wave_, (int)gridDim.x, (int)blockIdx.x, (int)blockIdx.x * 8 + wave_, (int)gridDim.x * 8};
    volatile LAS unsigned* MISC = (volatile LAS unsigned*)(C0.lds + LDSCTL_OFF);
    if (C0.tid < 128) MISC[C0.tid] = 0u;
    __syncthreads();
    const int lo = args.ph_lo, hi = args.ph_hi;
    XcdBarrier bar; bar.bar = (unsigned*)(C0.ws + WS_CTL) + CW_BAR; bar.x = 0; bar.st = nullptr;
    if (hi - lo > 1) bar = xcd_barrier_post((unsigned*)(C0.ws + WS_CTL) + CW_BAR, MISC + 8);
#define RUN(p) (lo <= (p) && (p) < hi)
#define SEAM(p) do { if (hi > (p) + 1) xcd_barrier(bar); } while (0)
    LAS unsigned char* ring = C0.lds;

    if (RUN(0)) { const Ctx C = relaunder(C0); PH(0, p0_convert(C)); PH(18, p0_mod(C)); SEAM(0); }
    if (RUN(1)) { const Ctx C = relaunder(C0); PH(1, p1_init(C)); SEAM(1); }

    for (int layer = 0; layer < 4; ++layer) {
        const int base = 2 + 12 * layer, i = layer >> 1;
        const bool need_ctx = layer < 3;
        if (!(layer & 1)) {
            if (RUN(base + 0)) { const Ctx C = relaunder(C0);
                pg8::Gemm g{WSP(const bf16_t, WS_H), WSP(const bf16_t, WS_WIN) + (size_t)i * ZP * 1024, 1024, 1024, 1024}; pg8::StaticOrder S; S.init(NT, ZP, C.G, C.bid);
                pg8::Epi<FStoreBf16, false> E{{WSP(bf16_t, WS_Z), ZP, 1.f, 0}};
                PH(2, pg8::gemm_phase(ring, g, S, E)); PH(19, bg_fill(C, units_missing(S.nwg, S.G, S.c))); SEAM(base + 0); }
            if (RUN(base + 1)) { const Ctx C = relaunder(C0); PH(3, a2_prepare(C, i)); SEAM(base + 1); }
            if (RUN(base + 2)) { const Ctx C = relaunder(C0); int nmiss = 0;
                { pg8::Gemm g{WSP(const bf16_t, WS_LIN), WSP(const bf16_t, WS_WLORA) + (size_t)i * 2560 * 384, 384, 384, 384}; pg8::StaticOrder S; S.init(NT, 2560, C.G, C.bid);
                  pg8::Epi<FLora, false> E{{C.A.in[12] + i * 1024, C.A.in[14] + i * 1024, C.A.in[18] + i * 512, WSP(const bf16_t, WS_KS), WSP(const bf16_t, WS_KK), WSP(float, WS_DEC), WSP(bf16_t, WS_KD), WSP(bf16_t, WS_BB), WSP(bf16_t, WS_G)}};
                  PH(4, pg8::gemm_phase(ring, g, S, E)); nmiss += units_missing(S.nwg, S.G, S.c); }
                { pg8::Gemm g{WSP(const bf16_t, WS_QN), WSP(const bf16_t, WS_WQUP) + (size_t)i * 768 * 384, 384, 384, 384}; pg8::StaticOrder S; S.init(NT, 768, C.G, C.bid);
                  pg8::Epi<FQup, false> E{{WSP(bf16_t, WS_Q), WSP(const float, WS_ROPE), ATTN_NAIVE ? 0.10206207261596577f : 0.10206207261596577f * 1.4426950408889634f}};
                  PH(16, pg8::gemm_phase(ring, g, S, E)); nmiss += units_missing(S.nwg, S.G, S.c); }
                { pg8::Gemm g{WSP(const bf16_t, WS_KVN), WSP(const bf16_t, WS_WKVUP) + (size_t)i * 1024 * 256, 256, 256, 256}; pg8::StaticOrder S; S.init(NT, 1024, C.G, C.bid);
                  pg8::Epi<FStoreBf16, false> E{{WSP(bf16_t, WS_KV), 1024, 1.f, 0}};
                  PH(17, pg8::gemm_phase(ring, g, S, E)); nmiss += units_missing(S.nwg, S.G, S.c); }
                (void)nmiss;
                SEAM(base + 2); }
            if (RUN(base + 3)) { const Ctx C = relaunder(C0); PH(5, a4_scan(C)); PH(6, if (ATTN_NAIVE) a4_mla_naive(C); else a4_mla(C, layer)); PH(19, bg_fill(C, C.bid < 128 ? 0 : BG_A4)); SEAM(base + 3); }
            if (RUN(base + 4)) { const Ctx C = relaunder(C0); PH(7, a5_output(C, i)); SEAM(base + 4); }
        } else {
            if (RUN(base + 0)) { const Ctx C = relaunder(C0);
                pg8::Gemm g{WSP(const bf16_t, WS_H), WSP(const bf16_t, WS_WQKV) + (size_t)i * 3072 * 1024, 1024, 1024, 1024}; pg8::StaticOrder S; S.init(NT, 3072, C.G, C.bid);
                pg8::Epi<FStoreBf16, false> E{{WSP(bf16_t, WS_Z), 3072, ATTN_NAIVE ? 0.125f : 0.125f * 1.4426950408889634f, 1024}};
                PH(8, pg8::gemm_phase(ring, g, S, E)); PH(19, bg_fill(C, units_missing(S.nwg, S.G, S.c))); SEAM(base + 0); }
            if (RUN(base + 1)) { const Ctx C = relaunder(C0); PH(9, if (ATTN_NAIVE) b2_na_naive(C, i, need_ctx); else b2_na(C, i, need_ctx)); SEAM(base + 1); }
        }
        if (RUN(base + 5)) { const Ctx C = relaunder(C0);
            const bf16_t* W = (layer & 1) ? WSP(const bf16_t, WS_WOUTC) + (size_t)i * 1024 * 1024 : WSP(const bf16_t, WS_WOUTA) + (size_t)i * 1024 * 1024;
            pg8::Gemm g{WSP(const bf16_t, WS_MIX), W, 1024, 1024, 1024}; pg8::StaticOrder S; S.init(need_ctx ? NT : NLAT, 1024, C.G, C.bid);
            pg8::Epi<FResid, false> E{{WSP(float, WS_X), WSP(const float, WS_MOD), layer}};
            PH(10, pg8::gemm_phase(ring, g, S, E)); PH(19, bg_fill(C, units_missing(S.nwg, S.G, S.c))); SEAM(base + 5); }
        if (RUN(base + 6)) { const Ctx C = relaunder(C0); PH(11, c2_router(C, layer, need_ctx ? NT : NLAT)); SEAM(base + 6); }
        if (RUN(base + 7)) { const Ctx C = relaunder(C0); PH(12, c3_topk(C, need_ctx)); PH(19, bg_catch_up(C, (layer + 1) * CV_NB_L)); SEAM(base + 7); }
        if (RUN(base + 8)) { const Ctx C = relaunder(C0);
            pg8::Gemm g{WSP(const bf16_t, WS_XIN), WSP(const bf16_t, WS_W13) + (size_t)layer * 16 * 4096 * 1024, 1024, 1024, 1024}; pg8::MoeOrder S; S.init(need_ctx ? 9 : 8, 16, C.G, C.bid);
            pg8::Epi<FSwiglu, true> E{{WSP(bf16_t, WS_HID)}};
            PH(13, pg8::gemm_phase(ring, g, S, E)); SEAM(base + 8); }
        if (RUN(base + 9)) { const Ctx C = relaunder(C0);
            pg8::Gemm g{WSP(const bf16_t, WS_HID), WSP(const bf16_t, WS_W2) + (size_t)layer * 16 * 1024 * 2048, 2048, 2048, 2048}; pg8::MoeOrder S; S.init(need_ctx ? 9 : 8, 4, C.G, C.bid);
            pg8::Epi<FGate, false> E{{WSP(bf16_t, WS_YB), WSP(const float, WS_GATE)}};
            PH(14, pg8::gemm_phase(ring, g, S, E)); PH(19, bg_fill(C, units_missing(S.nwg, S.G, S.c))); SEAM(base + 9); }
        if (RUN(base + 10)) { const Ctx C = relaunder(C0); PH(15, c6_combine(C, layer, need_ctx ? NT : NLAT)); if (layer < 3) SEAM(base + 10); }
    }
#undef RUN
#undef SEAM
}

extern "C" void kernel_launch(void* const* d_in, const int* in_sizes, int n_in, void* d_out, int out_size, void* d_ws, size_t ws_size, hipStream_t stream) {
    static int grid = 0;
    if (grid == 0) {
        if (n_in != 33 || out_size != NLAT * DM || ws_size < WS_END) { fprintf(stderr, "kernel_launch: unexpected shapes (n_in %d out %d ws %zu need %zu)\n", n_in, out_size, ws_size, (size_t)WS_END); grid = -1; return; }
        int dev = 0, cus = 0, per_cu = 0;
        if (hipGetDevice(&dev) != hipSuccess || hipDeviceGetAttribute(&cus, hipDeviceAttributeMultiprocessorCount, dev) != hipSuccess) { grid = -1; return; }
        if (hipFuncSetAttribute((const void*)fwd, hipFuncAttributeMaxDynamicSharedMemorySize, LDS_BYTES) != hipSuccess) { fprintf(stderr, "kernel_launch: hipFuncSetAttribute failed\n"); grid = -1; return; }
        if (hipOccupancyMaxActiveBlocksPerMultiprocessor(&per_cu, (const void*)fwd, 512, LDS_BYTES) != hipSuccess || per_cu < 1) fprintf(stderr, "kernel_launch: occupancy query says %d\n", per_cu);
        (void)hipGetLastError();
        grid = cus;
    }
    if (grid < 0) return;
    (void)hipMemsetAsync((char*)d_ws + WS_CTL, 0, CTL_BYTES, stream);
    Args a{};
    for (int i = 0; i < 33; ++i) a.in[i] = (const float*)d_in[i];
    a.out = (float*)d_out; a.ws = (unsigned char*)d_ws;
#if SINGLE_LAUNCH
    a.ph_lo = 0; a.ph_hi = N_PHASE_IDS;
    hipLaunchKernelGGL(fwd, dim3(grid), dim3(512), LDS_BYTES, stream, a);
#else
    for (int p = 0; p < N_PHASE_IDS; ++p) { if (!phase_exists(p)) continue; a.ph_lo = p; a.ph_hi = p + 1; hipLaunchKernelGGL(fwd, dim3(grid), dim3(512), LDS_BYTES, stream, a); }
#endif
}
```

```cpp
#include <hip/hip_runtime.h>
#include <cstdio>
#include <cstdint>

#ifndef PHMASK
#define PHMASK 0xFFFFFFFFu
#endif
#define PON(n) (((PHMASK) >> (n)) & 1u)
#ifndef PROBE_MASK
#define PROBE_MASK 0u
#endif
#define PH(n, ...) do { if (PON(n)) { if (((PROBE_MASK) >> (n)) & 1u) { const unsigned long long t0_ = __builtin_amdgcn_s_memrealtime(); { __VA_ARGS__; } __syncthreads(); const unsigned long long d_ = __builtin_amdgcn_s_memrealtime() - t0_; while (__builtin_amdgcn_s_memrealtime() - t0_ < 2 * d_) __builtin_amdgcn_s_sleep(8); } else { __VA_ARGS__; } } } while (0)
#ifndef EARLY_WB
#define EARLY_WB 0
#endif
#ifndef BG_A4
#define BG_A4 20
#endif
#ifndef ATTN_NAIVE
#define ATTN_NAIVE 0
#endif
#ifndef SINGLE_LAUNCH
#define SINGLE_LAUNCH 1
#endif

#define LAS __attribute__((address_space(3)))
#define GAS __attribute__((address_space(1)))
typedef unsigned short bf16_t;
typedef short bf16x8 __attribute__((ext_vector_type(8)));
typedef float f32x4 __attribute__((ext_vector_type(4)));
typedef float f32x2 __attribute__((ext_vector_type(2)));
typedef unsigned u32x4 __attribute__((ext_vector_type(4)));
typedef unsigned u32x2 __attribute__((ext_vector_type(2)));

constexpr int NB = 8, SEQ = 2048, CTXL = 256, DM = 1024;
constexpr int NLAT = NB * SEQ, NCTX = NB * CTXL, NT = NLAT + NCTX;
constexpr int ADIM = 512, ZP = 2816;
constexpr int NEXP = 16, FF = 2048, ROWS_E = 2304;
constexpr float NORM_EPS = 1e-6f;

constexpr size_t MiB = 1u << 20;
constexpr size_t WS_CTL = 0, CTL_BYTES = 1 * MiB;
constexpr size_t WS_MOD = 1 * MiB;
constexpr size_t WS_ROPE = 2 * MiB;
constexpr size_t WS_WIN = 4 * MiB;
constexpr size_t WS_WLORA = 16 * MiB;
constexpr size_t WS_WQUP = 20 * MiB;
constexpr size_t WS_WKVUP = 22 * MiB;
constexpr size_t WS_WOUTA = 24 * MiB;
constexpr size_t WS_WQKV = 28 * MiB;
constexpr size_t WS_WOUTC = 40 * MiB;
constexpr size_t WS_W13 = 48 * MiB;
constexpr size_t WS_W2 = 560 * MiB;
constexpr size_t WS_X = 816 * MiB;
constexpr size_t WS_H = 888 * MiB;
constexpr size_t WS_MIX = 924 * MiB;
constexpr size_t WS_Z = 960 * MiB;
constexpr size_t WS_R = 1068 * MiB;
constexpr size_t WS_V = 1086 * MiB;
constexpr size_t WS_KS = 1104 * MiB;
constexpr size_t WS_KK = 1122 * MiB;
constexpr size_t WS_LIN = 1140 * MiB;
constexpr size_t WS_QN = 1154 * MiB;
constexpr size_t WS_KVN = 1168 * MiB;
constexpr size_t WS_KR = 1177 * MiB;
constexpr size_t WS_DEC = 1179 * MiB;
constexpr size_t WS_KD = 1251 * MiB;
constexpr size_t WS_BB = 1287 * MiB;
constexpr size_t WS_G = 1323 * MiB;
constexpr size_t WS_Y = 1341 * MiB;
constexpr size_t WS_Q = 1413 * MiB;
constexpr size_t WS_KV = 1440 * MiB;
constexpr size_t WS_AFF = 1476 * MiB;
constexpr size_t WS_SEL = 1478 * MiB;
constexpr size_t WS_IDX = 1480 * MiB;
constexpr size_t WS_GATE = 1481 * MiB;
constexpr size_t WS_XIN = 1482 * MiB;
constexpr size_t WS_HID = 1554 * MiB;
constexpr size_t WS_YB = 1698 * MiB;
constexpr size_t WS_END = 1770 * MiB;

constexpr int CW_TMO = 0, CW_BAR = 4096, CW_QUEUE = 8192;

constexpr int RING_BYTES = 133120;
constexpr int LDSCTL_OFF = RING_BYTES;
constexpr int LDS_BYTES = 147456;

__device__ __forceinline__ float bf2f(unsigned short b) { return __uint_as_float(((unsigned)b) << 16); }
__device__ __forceinline__ unsigned f2bf(float f) { unsigned u = __float_as_uint(f); return (u + 0x7fffu + ((u >> 16) & 1u)) >> 16; }
typedef __bf16 bf16x2_t __attribute__((ext_vector_type(2)));
__device__ __forceinline__ unsigned pk2(float lo, float hi) { const f32x2 v = {lo, hi}; return __builtin_bit_cast(unsigned, __builtin_convertvector(v, bf16x2_t)); }
__device__ __forceinline__ void unpk8(const u32x4 w, float (&f)[8]) {
    f[0] = __uint_as_float(w.x << 16); f[1] = __uint_as_float(w.x & 0xffff0000u); f[2] = __uint_as_float(w.y << 16); f[3] = __uint_as_float(w.y & 0xffff0000u);
    f[4] = __uint_as_float(w.z << 16); f[5] = __uint_as_float(w.z & 0xffff0000u); f[6] = __uint_as_float(w.w << 16); f[7] = __uint_as_float(w.w & 0xffff0000u); }
__device__ __forceinline__ void ld8(const bf16_t* p, float (&f)[8]) { unpk8(*(const u32x4*)p, f); }
__device__ __forceinline__ u32x4 pack8(const float (&f)[8]) { u32x4 w; w.x = pk2(f[0], f[1]); w.y = pk2(f[2], f[3]); w.z = pk2(f[4], f[5]); w.w = pk2(f[6], f[7]); return w; }
#ifndef WT_STORES
#define WT_STORES 0
#endif
#ifndef NT_STORES
#define NT_STORES 0
#endif
__device__ __forceinline__ void st16(void* p, u32x4 v) {
#if WT_STORES
    asm volatile("global_store_dwordx4 %0, %1, off sc1\n\ts_nop 1" :: "v"(p), "v"(v) : "memory");
#elif NT_STORES
    __builtin_nontemporal_store(v, (u32x4*)p);
#else
    *(u32x4*)p = v;
#endif
}
__device__ __forceinline__ void st8b(void* p, u32x2 v) {
#if WT_STORES
    asm volatile("global_store_dwordx2 %0, %1, off sc1\n\ts_nop 0" :: "v"(p), "v"(v) : "memory");
#else
    *(u32x2*)p = v;
#endif
}
__device__ __forceinline__ void st16f(float* p, f32x4 v) { st16(p, __builtin_bit_cast(u32x4, v)); }
__device__ __forceinline__ void st8(bf16_t* p, const float (&f)[8]) { st16(p, pack8(f)); }
__device__ __forceinline__ float wave_sum_slow(float v) {
#pragma unroll
    for (int o = 1; o < 64; o <<= 1) v += __shfl_xor(v, o);
    return v; }
template <int CTRL> __device__ __forceinline__ float dpp_f(float x) { return __int_as_float(__builtin_amdgcn_update_dpp(0, __float_as_int(x), CTRL, 0xF, 0xF, true)); }
__device__ __forceinline__ float sum8(float v) { v += dpp_f<0xB1>(v); v += dpp_f<0x4E>(v); v += dpp_f<0x141>(v); return v; }
__device__ __forceinline__ float sum16(float v) { v = sum8(v); v += dpp_f<0x140>(v); return v; }
__device__ __forceinline__ float wave_sum(float v) { v = sum16(v); v += __shfl_xor(v, 16); v += __shfl_xor(v, 32); return v; }
__device__ __forceinline__ float sigmoidf_(float x) { return 1.f / (1.f + __expf(-x)); }
__device__ __forceinline__ int mod_group(int row) { return row < NLAT ? (row >> 11) : NB; }

namespace pg8 {
constexpr int BM = 256, BK = 64, HALF = 128, HTB = HALF * BK * 2, STAGE_BYTES = 8 * HTB, NXCD = 8, WGM = 8;
__host__ __device__ __forceinline__ int lds_byte(int r, int c) { const int st = (r >> 4) * 2 + (c >> 5), rr = r & 15, cc = c & 31, ob = rr * 64 + cc * 2; return st * 1024 + (ob ^ (((ob >> 9) & 1) << 5)); }
__host__ __device__ __forceinline__ void stage_rc(int b, int& R, int& C) { const int st = b / 1024, sb = b % 1024, swz = sb ^ (((sb >> 9) & 1) << 5); R = (st >> 1) * 16 + swz / 64; C = (st & 1) * 32 + (swz % 64) / 2; }
__host__ __device__ __forceinline__ int perm32(int rho) { const int n = rho >> 4, i = rho & 15; return 8 * (i >> 2) + 4 * n + (i & 3); }
struct Unit { int pm, pn; };
struct Gemm { const bf16_t* A; const bf16_t* Bt; int lda, ldb, K; };

struct StaticOrder {
    int nM, nN, nwg, G, c;
    __device__ void init(int M, int N, int G_, int c_) { nM = M / BM; nN = N / BM; nwg = nM * nN; G = G_; c = c_; }
    __device__ bool next(int i, Unit& u) const {
        const long L = (long)i * G + c; if (L >= nwg) return false;
        int wgid = (int)L; { const int q = nwg / NXCD, r = nwg % NXCD, xcd = wgid % NXCD, off = wgid / NXCD; wgid = (xcd < r ? xcd * (q + 1) : r * (q + 1) + (xcd - r) * q) + off; }
        const int nig = WGM * nN, gid = wgid / nig, fm = gid * WGM, gsz = (nM - fm) < WGM ? (nM - fm) : WGM;
        u.pm = fm + ((wgid % nig) % gsz); u.pn = (wgid % nig) / gsz; return true;
    }
};
struct MoeOrder {
    int nrt, nct, nwg, G, c;
    __device__ void init(int nrt_, int nct_, int G_, int c_) { nrt = nrt_; nct = nct_; nwg = NEXP * nrt * nct; G = G_; c = c_; }
    __device__ bool next(int i, Unit& u) const {
        const long L = (long)i * G + c; if (L >= nwg) return false;
        const int wgid = (int)(L % NXCD) * (nwg / NXCD) + (int)(L / NXCD);
        const int per = nrt * nct, e = wgid / per, rem = wgid % per, ct = rem / nrt, rt = rem % nrt;
        u.pm = e * 9 + rt; u.pn = e * nct + ct; return true;
    }
};

template <class F, bool PAIR> struct Epi {
    F f;
    __device__ __forceinline__ void operator()(const f32x4 (&acc)[2][2][4][2], const Unit& u, int wr, int wc, int fr, int fq) const {
#pragma unroll
        for (int ai = 0; ai < 2; ++ai)
#pragma unroll
            for (int m = 0; m < 4; ++m) {
                const int row = u.pm * BM + ai * HALF + wr * 64 + m * 16 + fr;
                if constexpr (PAIR) {
                    float a[8], b[8];
#pragma unroll
                    for (int j = 0; j < 4; ++j) { a[j] = acc[ai][0][m][0][j]; a[4 + j] = acc[ai][0][m][1][j]; b[j] = acc[ai][1][m][0][j]; b[4 + j] = acc[ai][1][m][1][j]; }
                    f(row, u.pn * HALF + wc * 32 + 8 * fq, a, b);
                } else if ((m & 1) == 0) {
                    typename F::Pre pre[2][2];
#pragma unroll
                    for (int mm = 0; mm < 2; ++mm)
#pragma unroll
                        for (int bj = 0; bj < 2; ++bj) f.pre(row + 16 * mm, u.pn * BM + bj * HALF + wc * 32 + 8 * fq, pre[mm][bj]);
#pragma unroll
                    for (int mm = 0; mm < 2; ++mm)
#pragma unroll
                        for (int bj = 0; bj < 2; ++bj) { float a[8];
#pragma unroll
                            for (int j = 0; j < 4; ++j) { a[j] = acc[ai][bj][m + mm][0][j]; a[4 + j] = acc[ai][bj][m + mm][1][j]; }
                            f(row + 16 * mm, u.pn * BM + bj * HALF + wc * 32 + 8 * fq, a, pre[mm][bj]); }
                }
            }
    }
};

template <class EpiT, class Sched>
__device__ __forceinline__ void gemm_phase(LAS unsigned char* lds, const Gemm g, const Sched& S, const EpiT& E) {
    int tid = threadIdx.x; asm volatile("" : "+v"(tid));
    const int wid = __builtin_amdgcn_readfirstlane(tid >> 6), lane = tid & 63, wr = wid >> 2, wc = wid & 3, fr = lane & 15, fq = lane >> 4;
    const int K = g.K, nt = K / BK;
    unsigned voffA[2], voffB[2];
#pragma unroll
    for (int i = 0; i < 2; ++i) { int R, C; stage_rc(tid * 16 + i * 8192, R, C); const int Rb = (R & ~31) + perm32(R & 31);
        voffA[i] = (unsigned)(R * g.lda + C) * 2u; voffB[i] = (unsigned)(Rb * g.ldb + C) * 2u; }
    const size_t kstep = (size_t)(BK * 2);
    const size_t hsA = (size_t)HALF * g.lda * 2, hsB = (size_t)HALF * g.ldb * 2, tsA = 2 * hsA, tsB = 2 * hsB;
    const unsigned ldsw = (unsigned)wid * 1024u;
    const int aoff = lds_byte(wr * 64 + fr, fq * 8), boff = lds_byte(wc * 32 + fr, fq * 8);
#define PG8_SA(b, h) (((b) * 2 + (h)) * HTB)
#define PG8_SB(b, h) ((4 + (b) * 2 + (h)) * HTB)
#define PG8_STAGE(bufoff, gbase, voff) do { _Pragma("unroll") for (int _i = 0; _i < 2; ++_i) \
        __builtin_amdgcn_global_load_lds((const unsigned*)((const char*)(gbase) + (voff)[_i]), (LAS unsigned*)(lds + (bufoff) + ldsw + _i * 8192), 16, 0, 0); } while (0)
#define PG8_LDA(dst, b, h) do { _Pragma("unroll") for (int m = 0; m < 4; ++m) _Pragma("unroll") for (int k = 0; k < 2; ++k) dst[m][k] = *(const LAS bf16x8*)(lds + PG8_SA(b, h) + aoff + m * 2048 + k * 1024); } while (0)
#define PG8_LDB(dst, b, h) do { _Pragma("unroll") for (int n = 0; n < 2; ++n) _Pragma("unroll") for (int k = 0; k < 2; ++k) dst[n][k] = *(const LAS bf16x8*)(lds + PG8_SB(b, h) + boff + n * 2048 + k * 1024); } while (0)
#define PG8_MMA(ai, bj, At, Bt) do { __builtin_amdgcn_s_setprio(1); _Pragma("unroll") for (int m = 0; m < 4; ++m) _Pragma("unroll") for (int n = 0; n < 2; ++n) _Pragma("unroll") for (int k = 0; k < 2; ++k) \
        acc[ai][bj][m][n] = __builtin_amdgcn_mfma_f32_16x16x32_bf16(Bt[n][k], At[m][k], acc[ai][bj][m][n], 0, 0, 0); __builtin_amdgcn_s_setprio(0); } while (0)
#define PG8_WAIT_V(n) asm volatile("s_waitcnt vmcnt(" #n ")" ::: "memory")
#define PG8_WAIT_L(n) asm volatile("s_waitcnt lgkmcnt(" #n ")" ::: "memory")
#define PG8_BAR __builtin_amdgcn_s_barrier()
#define PG8_SCHED __builtin_amdgcn_sched_barrier(0)
    Unit cur, nxt; int ui = 0;
    if (!S.next(0, cur)) return;
    f32x4 acc[2][2][4][2];
#pragma unroll
    for (int a = 0; a < 2; ++a)
#pragma unroll
        for (int b = 0; b < 2; ++b)
#pragma unroll
            for (int m = 0; m < 4; ++m)
#pragma unroll
                for (int n = 0; n < 2; ++n) acc[a][b][m][n] = (f32x4){0.f, 0.f, 0.f, 0.f};
    bf16x8 At[4][2], B0[2][2], B1[2][2];
    const char* cA = (const char*)g.A + (size_t)cur.pm * tsA; const char* cB = (const char*)g.Bt + (size_t)cur.pn * tsB;
    PG8_STAGE(PG8_SB(0, 0), cB, voffB); PG8_STAGE(PG8_SB(0, 1), cB + hsB, voffB); PG8_STAGE(PG8_SA(0, 0), cA, voffA); PG8_STAGE(PG8_SA(0, 1), cA + hsA, voffA);
    if (wr == 1) PG8_BAR;
    PG8_WAIT_V(2); PG8_BAR;
    PG8_STAGE(PG8_SB(1, 0), cB + kstep, voffB); PG8_STAGE(PG8_SA(1, 0), cA + kstep, voffA); PG8_STAGE(PG8_SB(1, 1), cB + hsB + kstep, voffB);
    PG8_WAIT_V(6); PG8_BAR;
    for (;;) {
        const bool has_next = S.next(ui + 1, nxt);
        const char* nA = has_next ? (const char*)g.A + (size_t)nxt.pm * tsA : cA; const char* nB = has_next ? (const char*)g.Bt + (size_t)nxt.pn * tsB : cB;
#pragma unroll 1
        for (int t = 0; t < nt; t += 2) {
            const bool last = (t == nt - 2);
            const char* a1 = cA + (size_t)(t + 1) * kstep;
            const char* a2 = last ? nA : cA + (size_t)(t + 2) * kstep; const char* b2 = last ? nB : cB + (size_t)(t + 2) * kstep;
            const char* a3 = a2 + kstep; const char* b3 = b2 + kstep;
            PG8_LDB(B0, 0, 0); PG8_LDB(B1, 0, 1); PG8_SCHED; PG8_LDA(At, 0, 0); PG8_STAGE(PG8_SA(1, 1), a1 + hsA, voffA);
            PG8_WAIT_V(8); PG8_WAIT_L(0); PG8_BAR; PG8_MMA(0, 0, At, B0); PG8_MMA(0, 1, At, B1); PG8_BAR; PG8_SCHED;
            PG8_LDA(At, 0, 1); PG8_STAGE(PG8_SB(0, 0), b2, voffB); PG8_STAGE(PG8_SB(0, 1), b2 + hsB, voffB); PG8_STAGE(PG8_SA(0, 0), a2, voffA);
            PG8_WAIT_V(8); PG8_WAIT_L(0); PG8_BAR; PG8_MMA(1, 0, At, B0); PG8_MMA(1, 1, At, B1); PG8_BAR; PG8_SCHED;
            PG8_LDB(B0, 1, 0); PG8_LDB(B1, 1, 1); PG8_SCHED; PG8_LDA(At, 1, 0); PG8_STAGE(PG8_SA(0, 1), a2 + hsA, voffA);
            PG8_WAIT_V(8); PG8_WAIT_L(0); PG8_BAR; PG8_MMA(0, 0, At, B0); PG8_MMA(0, 1, At, B1); PG8_BAR; PG8_SCHED;
            PG8_LDA(At, 1, 1); PG8_STAGE(PG8_SB(1, 0), b3, voffB); PG8_STAGE(PG8_SB(1, 1), b3 + hsB, voffB); PG8_STAGE(PG8_SA(1, 0), a3, voffA);
            PG8_WAIT_V(8); PG8_WAIT_L(0); PG8_BAR; PG8_MMA(1, 0, At, B0); PG8_MMA(1, 1, At, B1); PG8_BAR; PG8_SCHED;
        }
        if (wr == 0) PG8_BAR;
        E(acc, cur, wr, wc, fr, fq);
        if (!has_next) break;
#pragma unroll
        for (int a = 0; a < 2; ++a)
#pragma unroll
            for (int b = 0; b < 2; ++b)
#pragma unroll
                for (int m = 0; m < 4; ++m)
#pragma unroll
                    for (int n = 0; n < 2; ++n) acc[a][b][m][n] = (f32x4){0.f, 0.f, 0.f, 0.f};
        cur = nxt; cA = nA; cB = nB; ++ui;
        if (wr == 1) PG8_BAR;
    }
    PG8_WAIT_V(0);
    PG8_BAR;
#undef PG8_SA
#undef PG8_SB
#undef PG8_STAGE
#undef PG8_LDA
#undef PG8_LDB
#undef PG8_MMA
#undef PG8_WAIT_V
#undef PG8_WAIT_L
#undef PG8_BAR
#undef PG8_SCHED
}
}

#define XB_TMO      128
#define XB_XCNT(j)  (256  + 64 * (j))
#define XB_XSUB(j)  (1280 + 64 * (j))
#define XB_XGEN(j)  (2304 + 64 * (j))
#define XB_TOP      3328
#define XB_TOPGEN   3392
#define XCD_BAR_WORDS 3456
#define XB_SPIN_CAP (1u << 22)
__device__ __forceinline__ unsigned xb_ld(unsigned* p)              { return __hip_atomic_load(p, __ATOMIC_RELAXED, __HIP_MEMORY_SCOPE_AGENT); }
__device__ __forceinline__ unsigned xb_add(unsigned* p, unsigned v) { return __hip_atomic_fetch_add(p, v, __ATOMIC_RELAXED, __HIP_MEMORY_SCOPE_AGENT); }
__device__ __forceinline__ unsigned xb_xcc_id() { return (unsigned)__builtin_amdgcn_s_getreg((3 << 11) | 20) & 0xFu; }
#define XB_SPIN(cond, bar) do { unsigned _sp = 0; while (cond) { __builtin_amdgcn_s_sleep(1); \
    if ((++_sp & 255u) == 0u) { if (xb_ld(&(bar)[XB_TMO])) break; if (_sp > XB_SPIN_CAP) { atomicAdd(&(bar)[XB_TMO], 1u); break; } } } } while (0)
struct XcdBarrier { unsigned* bar; unsigned x; volatile LAS unsigned* st; };
__device__ __forceinline__ XcdBarrier xcd_barrier_post(unsigned* bar, volatile LAS unsigned* st) {
    XcdBarrier b; b.bar = bar; b.x = xb_xcc_id(); b.st = st;
    if (threadIdx.x == 0) (void)xb_add(&bar[XB_XCNT(b.x)], 1u);
    return b;
}
__device__ __forceinline__ void xcd_barrier_complete(unsigned* bar, unsigned x, unsigned& nloc, unsigned& nx) {
    const unsigned G = gridDim.x * gridDim.y * gridDim.z;
    unsigned sum, cnt, mine, sp = 0u;
    for (;;) {
        sum = 0u; cnt = 0u; mine = 0u;
#pragma unroll
        for (unsigned j = 0; j < 16; ++j) { const unsigned c = xb_ld(&bar[XB_XCNT(j)]); sum += c; cnt += (c > 0u) ? 1u : 0u; mine = (j == x) ? c : mine; }
        if (sum == G) break;
        __builtin_amdgcn_s_sleep(1);
        if ((++sp & 255u) == 0u) { if (xb_ld(&bar[XB_TMO])) break; if (sp > XB_SPIN_CAP) { atomicAdd(&bar[XB_TMO], 1u); break; } }
    }
    nloc = mine > 0u ? mine : 1u; nx = cnt > 0u ? cnt : 1u;
}
__device__ __forceinline__ void xcd_barrier(const XcdBarrier& b) {
    asm volatile("s_waitcnt vmcnt(0)" ::: "memory");
    __syncthreads();
    if (threadIdx.x == 0) {
        unsigned* bar = b.bar;
#if EARLY_WB
        __builtin_amdgcn_fence(__ATOMIC_RELEASE, "agent");
        asm volatile("s_waitcnt vmcnt(0)" ::: "memory");
#endif
        __builtin_amdgcn_s_waitcnt(0);
        unsigned nloc = b.st[0], nx = b.st[1];
        if (nloc == 0u) { xcd_barrier_complete(bar, b.x, nloc, nx); b.st[0] = nloc; b.st[1] = nx; }
        const unsigned old = xb_add(&bar[XB_XSUB(b.x)], 1u);
        const unsigned gen = old / nloc;
        if (old + 1u == (gen + 1u) * nloc) {
            __builtin_amdgcn_fence(__ATOMIC_RELEASE, "agent");
            asm volatile("s_waitcnt vmcnt(0)" ::: "memory");
            const unsigned og = xb_add(&bar[XB_TOP], 1u);
            const unsigned tg = og / nx;
            if (og + 1u == (tg + 1u) * nx) xb_add(&bar[XB_TOPGEN], 1u);
            else XB_SPIN(xb_ld(&bar[XB_TOPGEN]) == tg, bar);
            __builtin_amdgcn_fence(__ATOMIC_ACQUIRE, "agent");
            xb_add(&bar[XB_XGEN(b.x)], 1u);
            asm volatile("s_waitcnt vmcnt(0)" ::: "memory");
        } else {
            XB_SPIN(xb_ld(&bar[XB_XGEN(b.x)]) == gen, bar);
            __builtin_amdgcn_fence(__ATOMIC_ACQUIRE, "agent");
            asm volatile("s_waitcnt vmcnt(0)" ::: "memory");
        }
    }
    __syncthreads();
}

struct Args { const float* in[33]; float* out; unsigned char* ws; int ph_lo, ph_hi; };
struct Ctx {
    const Args& A; float* out; unsigned char* ws;
    LAS unsigned char* lds; int tid, lane, wave, G, bid, gw, ngw;
};
#define WSP(T, off) ((T*)(C.ws + (off)))
__device__ __forceinline__ Ctx relaunder(const Ctx& C0) {
    int tid = C0.tid; GAS unsigned char* wsg = (GAS unsigned char*)C0.ws; LAS unsigned char* lds = C0.lds;
    asm volatile("" : "+v"(tid), "+s"(wsg));
    unsigned char* ws = (unsigned char*)wsg;
    const int wave = __builtin_amdgcn_readfirstlane(tid >> 6);
    return Ctx{C0.A, C0.out, ws, lds, tid, tid & 63, wave, C0.G, C0.bid, C0.bid * 8 + wave, C0.G * 8};
}
__device__ __forceinline__ const float* modp(const Ctx& C, int layer, int mg, int chunk) { return WSP(const float, WS_MOD) + ((size_t)(layer * 9 + mg) * 6 + chunk) * 1024; }

__device__ __forceinline__ void tr_item(const float* src, int ld_src, int nvalid, int k0, int n0, bf16_t* dst, int ld_dst, int drow0, int dk0, LAS float* scr, int lane) {
    {
        const int n = (lane & 15) * 4; const bool ok = (n0 + n) < nvalid;
#pragma unroll 4
        for (int i = 0; i < 16; ++i) { const int k = 4 * i + (lane >> 4);
            f32x4 v = (f32x4){0.f, 0.f, 0.f, 0.f};
            if (ok) v = __builtin_nontemporal_load((const f32x4*)(src + (size_t)(k0 + k) * ld_src + n0 + n));
            LAS float* s = scr + k * 65 + n; s[0] = v.x; s[1] = v.y; s[2] = v.z; s[3] = v.w; }
    }
    asm volatile("s_waitcnt lgkmcnt(0)" ::: "memory");
    const int c = lane & 7;
#pragma unroll
    for (int jj = 0; jj < 8; ++jj) { const int nl = (lane >> 3) + 8 * jj; const LAS float* s = scr + (8 * c) * 65 + nl;
        u32x4 o; o.x = pk2(s[0 * 65], s[1 * 65]); o.y = pk2(s[2 * 65], s[3 * 65]); o.z = pk2(s[4 * 65], s[5 * 65]); o.w = pk2(s[6 * 65], s[7 * 65]);
        if (n0 + nl < nvalid) __builtin_nontemporal_store(o, (u32x4*)(dst + (size_t)(drow0 + nl) * ld_dst + dk0 + 8 * c)); }
    asm volatile("s_waitcnt lgkmcnt(0)" ::: "memory");
}
constexpr int CV_SMALL = 2120, CV_MOE_L = 16 * 3 * 512, CV_MOE = 4 * CV_MOE_L;
__device__ __forceinline__ void convert_item(const Ctx& C, int it, LAS float* scr) {
    {
        const float* src; int ld_src, nvalid, k0, n0, ld_dst, drow0, dk0; bf16_t* dst;
        if (it < 2 * CV_SMALL) {
            const int i = it / CV_SMALL; int r = it % CV_SMALL;
            if (r < 656) { src = C.A.in[9] + (size_t)i * 1024 * 2592; ld_src = 2592; nvalid = 2592; k0 = (r / 41) * 64; n0 = (r % 41) * 64; dst = WSP(bf16_t, WS_WIN) + (size_t)i * ZP * 1024; ld_dst = 1024; drow0 = n0; dk0 = k0; }
            else if ((r -= 656) < 16) { const int d = r >> 3; src = C.A.in[13] + (size_t)(i * 2 + d) * 64 * 512; ld_src = 512; nvalid = 512; k0 = 0; n0 = (r & 7) * 64; dst = WSP(bf16_t, WS_WLORA) + (size_t)i * 2560 * 384; ld_dst = 384; drow0 = d * 512 + n0; dk0 = d * 64; }
            else if ((r -= 16) < 16) { const int d = r >> 3; src = C.A.in[15] + (size_t)(i * 2 + d) * 64 * 512; ld_src = 512; nvalid = 512; k0 = 0; n0 = (r & 7) * 64; dst = WSP(bf16_t, WS_WLORA) + (size_t)i * 2560 * 384; ld_dst = 384; drow0 = 1024 + d * 512 + n0; dk0 = 128 + d * 64; }
            else if ((r -= 16) < 16) { src = C.A.in[16] + (size_t)i * 128 * 512; ld_src = 512; nvalid = 512; k0 = (r >> 3) * 64; n0 = (r & 7) * 64; dst = WSP(bf16_t, WS_WLORA) + (size_t)i * 2560 * 384; ld_dst = 384; drow0 = 2048 + n0; dk0 = 256 + k0; }
            else if ((r -= 16) < 72) { src = C.A.in[23] + (size_t)i * 384 * 768; ld_src = 768; nvalid = 768; k0 = (r / 12) * 64; n0 = (r % 12) * 64; dst = WSP(bf16_t, WS_WQUP) + (size_t)i * 768 * 384; ld_dst = 384; drow0 = n0; dk0 = k0; }
            else if ((r -= 72) < 64) { src = C.A.in[25] + (size_t)i * 256 * 1024; ld_src = 1024; nvalid = 1024; k0 = (r / 16) * 64; n0 = (r % 16) * 64; dst = WSP(bf16_t, WS_WKVUP) + (size_t)i * 1024 * 256; ld_dst = 256; drow0 = n0; dk0 = k0; }
            else if ((r -= 64) < 256) { src = C.A.in[10] + (size_t)i * 1024 * 1024; ld_src = 1024; nvalid = 1024; k0 = (r / 16) * 64; n0 = (r % 16) * 64; dst = WSP(bf16_t, WS_WOUTA) + (size_t)i * 1024 * 1024; ld_dst = 1024; drow0 = n0; dk0 = k0; }
            else if ((r -= 256) < 768) { src = C.A.in[26] + (size_t)i * 1024 * 3072; ld_src = 3072; nvalid = 3072; k0 = (r / 48) * 64; n0 = (r % 48) * 64; dst = WSP(bf16_t, WS_WQKV) + (size_t)i * 3072 * 1024; ld_dst = 1024; drow0 = n0; dk0 = k0; }
            else { r -= 768; src = C.A.in[28] + (size_t)i * 1024 * 1024; ld_src = 1024; nvalid = 1024; k0 = (r / 16) * 64; n0 = (r % 16) * 64; dst = WSP(bf16_t, WS_WOUTC) + (size_t)i * 1024 * 1024; ld_dst = 1024; drow0 = n0; dk0 = k0; }
        } else {
            const int m = it - 2 * CV_SMALL, le = m / 1536, r = m % 1536, which = r / 512, q = r % 512;
            if (which < 2) { src = C.A.in[which == 0 ? 30 : 31] + (size_t)le * 1024 * 2048; ld_src = 2048; nvalid = 2048; k0 = (q / 32) * 64; n0 = (q % 32) * 64;
                dst = WSP(bf16_t, WS_W13) + (size_t)le * 4096 * 1024; ld_dst = 1024; drow0 = (n0 >> 7) * 256 + which * 128 + (n0 & 127); dk0 = k0; }
            else { src = C.A.in[32] + (size_t)le * 2048 * 1024; ld_src = 1024; nvalid = 1024; k0 = (q / 16) * 64; n0 = (q % 16) * 64;
                dst = WSP(bf16_t, WS_W2) + (size_t)le * 1024 * 2048; ld_dst = 2048; drow0 = n0; dk0 = k0; }
        }
        tr_item(src, ld_src, nvalid, k0, n0, dst, ld_dst, drow0, dk0, scr, C.lane);
    }
}
constexpr int CV_BATCH = 16, CV_NB_L = CV_MOE_L / CV_BATCH, CV_NB = 4 * CV_NB_L;
__device__ __forceinline__ int bg_pull(const Ctx& C, unsigned* ctr, int limit) {
    volatile LAS int* slot = (volatile LAS int*)(C.lds + LDSCTL_OFF + 64);
    __syncthreads();
    if (C.tid == 0) { int b = -1; if ((int)__hip_atomic_load(ctr, __ATOMIC_RELAXED, __HIP_MEMORY_SCOPE_AGENT) < limit) { b = (int)__hip_atomic_fetch_add(ctr, 1u, __ATOMIC_RELAXED, __HIP_MEMORY_SCOPE_AGENT); if (b >= CV_NB) b = -1; } slot[0] = b; }
    __syncthreads();
    return slot[0];
}
struct MoeItem { const float* src; bf16_t* dst; int ld_src, ld_dst; };
__device__ __forceinline__ MoeItem moe_item(const Ctx& C, int m) {
    const int le = m / 1536, r = m % 1536, which = r / 512, q = r % 512; MoeItem it;
    if (which < 2) { const int k0 = (q / 32) * 64, n0 = (q % 32) * 64; it.ld_src = 2048; it.ld_dst = 1024;
        it.src = C.A.in[which == 0 ? 30 : 31] + (size_t)le * 1024 * 2048 + (size_t)k0 * 2048 + n0;
        it.dst = WSP(bf16_t, WS_W13) + (size_t)le * 4096 * 1024 + (size_t)((n0 >> 7) * 256 + which * 128 + (n0 & 127)) * 1024 + k0; }
    else { const int k0 = (q / 16) * 64, n0 = (q % 16) * 64; it.ld_src = 1024; it.ld_dst = 2048;
        it.src = C.A.in[32] + (size_t)le * 2048 * 1024 + (size_t)k0 * 1024 + n0; it.dst = WSP(bf16_t, WS_W2) + (size_t)le * 1024 * 2048 + (size_t)n0 * 2048 + k0; }
    return it;
}
__device__ __forceinline__ void tr_load(const MoeItem& it, int lane, f32x4 (&v)[16]) {
#pragma unroll
    for (int i = 0; i < 16; ++i) v[i] = __builtin_nontemporal_load((const f32x4*)(it.src + (size_t)(4 * i + (lane >> 4)) * it.ld_src + (lane & 15) * 4)); }
__device__ __forceinline__ void tr_store(const MoeItem& it, int lane, const f32x4 (&v)[16], LAS float* scr) {
#pragma unroll
    for (int i = 0; i < 16; ++i) { LAS float* s_ = scr + (4 * i + (lane >> 4)) * 65 + (lane & 15) * 4; s_[0] = v[i].x; s_[1] = v[i].y; s_[2] = v[i].z; s_[3] = v[i].w; }
    asm volatile("s_waitcnt lgkmcnt(0)" ::: "memory");
    const int c = lane & 7;
#pragma unroll
    for (int jj = 0; jj < 8; ++jj) { const int nl = (lane >> 3) + 8 * jj; const LAS float* s_ = scr + (8 * c) * 65 + nl;
        u32x4 o; o.x = pk2(s_[0 * 65], s_[1 * 65]); o.y = pk2(s_[2 * 65], s_[3 * 65]); o.z = pk2(s_[4 * 65], s_[5 * 65]); o.w = pk2(s_[6 * 65], s_[7 * 65]);
        __builtin_nontemporal_store(o, (u32x4*)(it.dst + (size_t)nl * it.ld_dst + 8 * c)); }
    asm volatile("s_waitcnt lgkmcnt(0)" ::: "memory");
}
__device__ __forceinline__ void bg_batch(const Ctx& C, int b) {
    LAS float* scr = (LAS float*)(C.lds + C.wave * 16640);
    const MoeItem ia = moe_item(C, b * CV_BATCH + C.wave), ib = moe_item(C, b * CV_BATCH + C.wave + 8);
    f32x4 va[16], vb[16]; tr_load(ia, C.lane, va); tr_load(ib, C.lane, vb);
    tr_store(ia, C.lane, va, scr); tr_store(ib, C.lane, vb, scr);
}
__device__ __forceinline__ void bg_fill(const Ctx& C, int budget) { unsigned* ctr = (unsigned*)(C.ws + WS_CTL) + CW_QUEUE + 64 * 8; for (int n = 0; n < budget; ++n) { const int b = bg_pull(C, ctr, CV_NB); if (b < 0) break; bg_batch(C, b); } }
__device__ __forceinline__ void bg_catch_up(const Ctx& C, int limit) { unsigned* ctr = (unsigned*)(C.ws + WS_CTL) + CW_QUEUE + 64 * 8; for (;;) { const int b = bg_pull(C, ctr, limit); if (b < 0) break; bg_batch(C, b); } }
__device__ __forceinline__ int units_missing(int nwg, int G, int c) { const int mx = (nwg + G - 1) / G, mine = c < nwg ? (nwg - c + G - 1) / G : 0; return mx - mine; }
__device__ __forceinline__ void p0_convert(const Ctx& C) {
    LAS float* scr = (LAS float*)(C.lds + C.wave * 16640);
    for (int it = C.gw; it < 2 * CV_SMALL; it += C.ngw) convert_item(C, it, scr);
    const u32x4 z4 = (u32x4){0u, 0u, 0u, 0u};
    const int gt = C.bid * 512 + C.tid, ngt = C.G * 512;
    for (int idx = gt; idx < 2 * 224 * 128; idx += ngt) { const int i = idx / (224 * 128), r = (idx / 128) % 224, ch = idx % 128;
        *(u32x4*)(WSP(bf16_t, WS_WIN) + ((size_t)i * ZP + 2592 + r) * 1024 + ch * 8) = z4; }
    for (int idx = gt; idx < 2 * 2560 * 48; idx += ngt) { const int i = idx / (2560 * 48), r = (idx / 48) % 2560, ch = idx % 48, seg = r >> 9;
        const int lo = seg < 4 ? seg * 8 : 32, hi = seg < 4 ? seg * 8 + 8 : 48;
        if (ch < lo || ch >= hi) *(u32x4*)(WSP(bf16_t, WS_WLORA) + ((size_t)i * 2560 + r) * 384 + ch * 8) = z4; }
    for (int idx = gt; idx < 2048 * 16; idx += ngt) { const int t = idx >> 4, i = idx & 15; const float pos = (float)(i < 8 ? (t >> 6) : (t & 63));
        const float inv = powf(10000.0f, -(float)(i & 7) / 8.0f); const float ang = pos * inv;
        WSP(float, WS_ROPE)[idx * 2] = cosf(ang); WSP(float, WS_ROPE)[idx * 2 + 1] = sinf(ang); }
}
__device__ __forceinline__ void p0_mod(const Ctx& C) {
    LAS float* sc = (LAS float*)C.lds;
    LAS float* part = (LAS float*)(C.lds + 36864);
    __syncthreads();
    for (int idx = C.tid; idx < 9 * 1024; idx += 512) { const int r = idx >> 10, k = idx & 1023; const float cv = r < 8 ? C.A.in[1][r * 1024 + k] : C.A.in[3][k]; sc[idx] = cv / (1.f + __expf(-cv)); }
    __syncthreads();
    for (int unit = C.bid; unit < 192; unit += C.G) {
        const int l = unit / 48, jb = unit % 48, jj = C.tid & 127, kc = C.tid >> 7;
        const float* w = C.A.in[4] + ((size_t)l * 1024 + kc * 256) * 6144 + jb * 128 + jj;
        float acc[9];
#pragma unroll
        for (int r = 0; r < 9; ++r) acc[r] = 0.f;
#pragma unroll 16
        for (int k = 0; k < 256; ++k) { const float wv = w[(size_t)k * 6144];
#pragma unroll
            for (int r = 0; r < 9; ++r) acc[r] += sc[r * 1024 + kc * 256 + k] * wv; }
#pragma unroll
        for (int r = 0; r < 9; ++r) part[(kc * 9 + r) * 128 + jj] = acc[r];
        __syncthreads();
        for (int idx = C.tid; idx < 9 * 128; idx += 512) { const int r = idx >> 7, j2 = idx & 127;
            const float s = part[(0 * 9 + r) * 128 + j2] + part[(1 * 9 + r) * 128 + j2] + part[(2 * 9 + r) * 128 + j2] + part[(3 * 9 + r) * 128 + j2] + C.A.in[5][l * 6144 + jb * 128 + j2];
            WSP(float, WS_MOD)[(size_t)(l * 9 + r) * 6144 + jb * 128 + j2] = s; }
        __syncthreads();
    }
}

__device__ __forceinline__ void row_load(const float* p, int lane, f32x4 (&v)[4]) {
#pragma unroll
    for (int j = 0; j < 4; ++j) v[j] = *(const f32x4*)(p + (lane + 64 * j) * 4); }
__device__ __forceinline__ void row_store(float* p, int lane, const f32x4 (&v)[4]) {
#pragma unroll
    for (int j = 0; j < 4; ++j) st16f(p + (lane + 64 * j) * 4, v[j]); }
__device__ __forceinline__ float row_rstd(const f32x4 (&v)[4]) {
    float s = 0.f;
#pragma unroll
    for (int j = 0; j < 4; ++j) s += (v[j].x * v[j].x + v[j].y * v[j].y) + (v[j].z * v[j].z + v[j].w * v[j].w);
    return rsqrtf(wave_sum(s) * (1.f / 1024.f) + NORM_EPS); }
__device__ __forceinline__ void row_modulate(const f32x4 (&v)[4], float rstd, const float* nw, const float* sh, const float* sc, int lane, f32x4 (&h)[4]) {
#pragma unroll
    for (int j = 0; j < 4; ++j) { const int c = (lane + 64 * j) * 4; const f32x4 w = *(const f32x4*)(nw + c), s1 = *(const f32x4*)(sc + c), s0 = *(const f32x4*)(sh + c);
        h[j] = (v[j] * rstd * w) * (s1 + 1.0f) + s0; } }
__device__ __forceinline__ void row_store_bf16(bf16_t* p, int lane, const f32x4 (&h)[4]) {
#pragma unroll
    for (int j = 0; j < 4; ++j) { u32x2 w; w.x = pk2(h[j].x, h[j].y); w.y = pk2(h[j].z, h[j].w); st8b(p + (lane + 64 * j) * 4, w); } }

__device__ __forceinline__ void p1_init(const Ctx& C) {
    for (int row = C.gw; row < NT; row += C.ngw) {
        const float* src = row < NLAT ? C.A.in[0] + (size_t)row * DM : C.A.in[2] + (size_t)(row - NLAT) * DM;
        f32x4 v[4], h[4]; row_load(src, C.lane, v); row_store(WSP(float, WS_X) + (size_t)row * DM, C.lane, v);
        const int mg = mod_group(row); const float rstd = row_rstd(v);
        row_modulate(v, rstd, C.A.in[6], modp(C, 0, mg, 0), modp(C, 0, mg, 1), C.lane, h);
        row_store_bf16(WSP(bf16_t, WS_H) + (size_t)row * DM, C.lane, h);
    }
}

struct PrepRaw { u32x4 zc[3], zp[3], zn[3]; unsigned lc[3], lp[3], ln[3], q[3], zr; u32x2 kv; };
__device__ __forceinline__ void prep_load(const bf16_t* Z, int row, int lane, PrepRaw& R) {
    const bool isctx = row >= NLAT; const int t = isctx ? ((row - NLAT) & 255) : (row & 2047), T = isctx ? 256 : 2048;
    const bf16_t* z = Z + (size_t)row * ZP; const bool hp = t > 0, hn = t < T - 1; const u32x4 z4 = (u32x4){0u, 0u, 0u, 0u};
#pragma unroll
    for (int seg = 0; seg < 3; ++seg) { const int c0 = seg * 512 + lane * 8;
        R.zc[seg] = *(const u32x4*)(z + c0); R.zp[seg] = hp ? *(const u32x4*)(z - ZP + c0) : z4; R.zn[seg] = hn ? *(const u32x4*)(z + ZP + c0) : z4; }
#pragma unroll
    for (int seg = 0; seg < 3; ++seg) { const int c0 = 1536 + seg * 128 + lane * 2;
        R.lc[seg] = *(const unsigned*)(z + c0); R.lp[seg] = hp ? *(const unsigned*)(z - ZP + c0) : 0u; R.ln[seg] = hn ? *(const unsigned*)(z + ZP + c0) : 0u; }
#pragma unroll
    for (int j = 0; j < 3; ++j) R.q[j] = *(const unsigned*)(z + 1920 + j * 128 + lane * 2);
    R.kv = *(const u32x2*)(z + 2304 + lane * 4);
    R.zr = *(const unsigned*)(z + 2560 + (lane & 15) * 2);
}
__device__ __forceinline__ void prep_row(const Ctx& C, int i, int row, const PrepRaw& R, const float* mu) {
    const int lane = C.lane; const bool isctx = row >= NLAT; const int t = isctx ? ((row - NLAT) & 255) : (row & 2047);
    float r8[8], k8[8], v8[8];
#pragma unroll
    for (int seg = 0; seg < 3; ++seg) {
        const int c0 = seg * 512 + lane * 8; float zc[8], zp[8], zn[8], m0[8], m1[8];
        unpk8(R.zc[seg], zc); unpk8(R.zp[seg], zp); unpk8(R.zn[seg], zn);
        *(f32x4*)&m0[0] = *(const f32x4*)(mu + c0); *(f32x4*)&m0[4] = *(const f32x4*)(mu + c0 + 4);
        *(f32x4*)&m1[0] = *(const f32x4*)(mu + 1920 + c0); *(f32x4*)&m1[4] = *(const f32x4*)(mu + 1920 + c0 + 4);
#pragma unroll
        for (int j = 0; j < 8; ++j) { const float o = zc[j] + m0[j] * (zp[j] - zc[j]) + m1[j] * (zn[j] - zc[j]); if (seg == 0) r8[j] = o; else if (seg == 1) k8[j] = o; else v8[j] = o; }
    }
    st8(WSP(bf16_t, WS_R) + (size_t)row * ADIM + lane * 8, r8);
    st8(WSP(bf16_t, WS_KS) + (size_t)row * ADIM + lane * 8, k8);
    st8(WSP(bf16_t, WS_V) + (size_t)row * ADIM + lane * 8, v8);
    { float kk[8], ss = 0.f; const float* kkw = C.A.in[17] + i * ADIM + lane * 8;
#pragma unroll
        for (int j = 0; j < 8; ++j) { kk[j] = k8[j] * kkw[j]; ss += kk[j] * kk[j]; }
        ss = sum8(ss); const float inv = 1.f / fmaxf(sqrtf(ss), 1e-12f);
#pragma unroll
        for (int j = 0; j < 8; ++j) kk[j] *= inv;
        st8(WSP(bf16_t, WS_KK) + (size_t)row * ADIM + lane * 8, kk); }
#pragma unroll
    for (int seg = 0; seg < 3; ++seg) {
        const int c0 = 1536 + seg * 128 + lane * 2; const unsigned wc_ = R.lc[seg], wp_ = R.lp[seg], wn_ = R.ln[seg];
        float o[2];
#pragma unroll
        for (int j = 0; j < 2; ++j) { const float zc = j ? __uint_as_float(wc_ & 0xffff0000u) : __uint_as_float(wc_ << 16), zp = j ? __uint_as_float(wp_ & 0xffff0000u) : __uint_as_float(wp_ << 16),
                                                  zn = j ? __uint_as_float(wn_ & 0xffff0000u) : __uint_as_float(wn_ << 16);
            const float s_ = zc + mu[c0 + j] * (zp - zc) + mu[1920 + c0 + j] * (zn - zc);
            o[j] = seg == 0 ? tanhf(s_) : (seg == 1 ? s_ : sigmoidf_(s_)); }
        *(unsigned*)(WSP(bf16_t, WS_LIN) + (size_t)row * 384 + seg * 128 + lane * 2) = pk2(o[0], o[1]);
    }
    { float q[6], ss = 0.f;
#pragma unroll
        for (int j = 0; j < 3; ++j) { const unsigned w = R.q[j]; q[2 * j] = __uint_as_float(w << 16); q[2 * j + 1] = __uint_as_float(w & 0xffff0000u); ss += q[2 * j] * q[2 * j] + q[2 * j + 1] * q[2 * j + 1]; }
        const float rstd = rsqrtf(wave_sum(ss) * (1.f / 384.f) + NORM_EPS); const float* nw = C.A.in[22] + i * 384;
#pragma unroll
        for (int j = 0; j < 3; ++j) { const int c = j * 128 + lane * 2; *(unsigned*)(WSP(bf16_t, WS_QN) + (size_t)row * 384 + c) = pk2(q[2 * j] * rstd * nw[c], q[2 * j + 1] * rstd * nw[c + 1]); } }
    { const u32x2 w = R.kv; float q[4] = {__uint_as_float(w.x << 16), __uint_as_float(w.x & 0xffff0000u), __uint_as_float(w.y << 16), __uint_as_float(w.y & 0xffff0000u)};
        const float ss = q[0] * q[0] + q[1] * q[1] + q[2] * q[2] + q[3] * q[3];
        const float rstd = rsqrtf(wave_sum(ss) * (1.f / 256.f) + NORM_EPS); const float* nw = C.A.in[24] + i * 256 + lane * 4;
        u32x2 o; o.x = pk2(q[0] * rstd * nw[0], q[1] * rstd * nw[1]); o.y = pk2(q[2] * rstd * nw[2], q[3] * rstd * nw[3]);
        *(u32x2*)(WSP(bf16_t, WS_KVN) + (size_t)row * 256 + lane * 4) = o; }
    if (lane < 16) { const unsigned w = R.zr; float x0 = __uint_as_float(w << 16), x1 = __uint_as_float(w & 0xffff0000u);
        if (!isctx) { const float cs = WSP(const float, WS_ROPE)[(t * 16 + lane) * 2], sn = WSP(const float, WS_ROPE)[(t * 16 + lane) * 2 + 1]; const float o0 = x0 * cs - x1 * sn, o1 = x0 * sn + x1 * cs; x0 = o0; x1 = o1; }
        *(unsigned*)(WSP(bf16_t, WS_KR) + (size_t)row * 32 + lane * 2) = pk2(x0, x1); }
}
__device__ __forceinline__ void a2_prepare(const Ctx& C, int i) {
    const bf16_t* Z = WSP(const bf16_t, WS_Z);
    const float* mu = C.A.in[11] + (size_t)i * 2 * 1920;
    for (int row = C.gw; row < NT; row += 2 * C.ngw) {
        const int row2 = row + C.ngw; const bool two = row2 < NT;
        PrepRaw A, B; prep_load(Z, row, C.lane, A); if (two) prep_load(Z, row2, C.lane, B);
        prep_row(C, i, row, A, mu); if (two) prep_row(C, i, row2, B, mu);
    }
}

struct FStoreBf16 { bf16_t* O; int ldo; float scale; int scale_cols;
    struct Pre {};
    __device__ __forceinline__ void pre(int, int, Pre&) const {}
    __device__ __forceinline__ void operator()(int row, int col, const float (&v)[8], const Pre&) const { float o[8]; const float s = col < scale_cols ? scale : 1.f;
#pragma unroll
        for (int j = 0; j < 8; ++j) o[j] = v[j] * s;
        st8(O + (size_t)row * ldo + col, o); } };
struct FLora { const float* w0; const float* a0; const float* ka; const bf16_t* KS; const bf16_t* KK; float* DEC; bf16_t* KD; bf16_t* BB; bf16_t* G;
    struct Pre { u32x4 k, kk; };
    __device__ __forceinline__ void pre(int row, int col, Pre& p) const { const int seg = col >> 9, c = col & 511;
        if (seg >= 2 && seg < 4) { p.k = *(const u32x4*)(KS + (size_t)row * ADIM + c); p.kk = *(const u32x4*)(KK + (size_t)row * ADIM + c); } }
    __device__ __forceinline__ void operator()(int row, int col, const float (&v)[8], const Pre& p) const {
        const int seg = col >> 9, c = col & 511;
        if (seg < 2) { float o[8]; const f32x4 t0 = *(const f32x4*)(w0 + seg * 512 + c), t1 = *(const f32x4*)(w0 + seg * 512 + c + 4); const float t[8] = {t0.x, t0.y, t0.z, t0.w, t1.x, t1.y, t1.z, t1.w};
#pragma unroll
            for (int j = 0; j < 8; ++j) { const float x = t[j] + v[j];
                o[j] = __expf(-0.6065306597126334f * sigmoidf_(x)); }
            float* d = DEC + ((size_t)seg * NT + row) * ADIM + c; st16f(d, *(const f32x4*)&o[0]); st16f(d + 4, *(const f32x4*)&o[4]);
        } else if (seg < 4) { const int d_ = seg - 2; float k[8], kk[8], kd[8], bb[8]; unpk8(p.k, k); unpk8(p.kk, kk);
            const f32x4 t0 = *(const f32x4*)(a0 + d_ * 512 + c), t1 = *(const f32x4*)(a0 + d_ * 512 + c + 4), ka0 = *(const f32x4*)(ka + c), ka1 = *(const f32x4*)(ka + c + 4);
            const float t[8] = {t0.x, t0.y, t0.z, t0.w, t1.x, t1.y, t1.z, t1.w}, kav[8] = {ka0.x, ka0.y, ka0.z, ka0.w, ka1.x, ka1.y, ka1.z, ka1.w};
#pragma unroll
            for (int j = 0; j < 8; ++j) { const float a = sigmoidf_(t[j] + v[j]); kd[j] = k[j] * (1.f + (a - 1.f) * kav[j]); bb[j] = kk[j] * a; }
            st8(KD + ((size_t)d_ * NT + row) * ADIM + c, kd); st8(BB + ((size_t)d_ * NT + row) * ADIM + c, bb);
        } else st8(G + (size_t)row * ADIM + c, v);
    } };
struct FQup { bf16_t* Q; const float* rope; float scale;
    struct Pre { f32x4 r0, r1; };
    __device__ __forceinline__ void pre(int row, int col, Pre& p) const { const int d = col % 96;
        if (d >= 64 && row < NLAT) { const float* rp = rope + ((row & 2047) * 16 + ((d - 64) >> 1)) * 2; p.r0 = *(const f32x4*)rp; p.r1 = *(const f32x4*)(rp + 4); } }
    __device__ __forceinline__ void operator()(int row, int col, const float (&v)[8], const Pre& p) const {
        const int d = col % 96; float o[8];
#pragma unroll
        for (int j = 0; j < 8; ++j) o[j] = v[j] * scale;
        if (d >= 64 && row < NLAT) { const float cs[4] = {p.r0.x, p.r0.z, p.r1.x, p.r1.z}, sn[4] = {p.r0.y, p.r0.w, p.r1.y, p.r1.w};
#pragma unroll
            for (int q = 0; q < 4; ++q) { const float x0 = o[2 * q], x1 = o[2 * q + 1]; o[2 * q] = x0 * cs[q] - x1 * sn[q]; o[2 * q + 1] = x0 * sn[q] + x1 * cs[q]; } }
        st8(Q + (size_t)row * 768 + col, o);
    } };
struct FResid { float* X; const float* mod; int layer;
    struct Pre { f32x4 x0, x1, g0, g1; };
    __device__ __forceinline__ void pre(int row, int col, Pre& p) const { const float* g = mod + ((size_t)(layer * 9 + mod_group(row)) * 6 + 2) * 1024 + col; const float* x = X + (size_t)row * DM + col;
        p.x0 = *(const f32x4*)x; p.x1 = *(const f32x4*)(x + 4); p.g0 = *(const f32x4*)g; p.g1 = *(const f32x4*)(g + 4); }
    __device__ __forceinline__ void operator()(int row, int col, const float (&v)[8], const Pre& p) const {
        float* x = X + (size_t)row * DM + col;
        st16f(x, p.x0 + p.g0 * (f32x4){v[0], v[1], v[2], v[3]}); st16f(x + 4, p.x1 + p.g1 * (f32x4){v[4], v[5], v[6], v[7]});
    } };
struct FSwiglu { bf16_t* HID;
    __device__ __forceinline__ void operator()(int row, int col, const float (&a)[8], const float (&b)[8]) const { float o[8];
#pragma unroll
        for (int j = 0; j < 8; ++j) o[j] = a[j] / (1.f + __expf(-a[j])) * b[j];
        st8(HID + (size_t)row * FF + (col & (FF - 1)), o); } };
struct FGate { bf16_t* YB; const float* gate;
    struct Pre { float g; };
    __device__ __forceinline__ void pre(int row, int, Pre& p) const { p.g = gate[row]; }
    __device__ __forceinline__ void operator()(int row, int col, const float (&v)[8], const Pre& p) const { const float g = p.g; float o[8];
#pragma unroll
        for (int j = 0; j < 8; ++j) o[j] = v[j] * g;
        st8(YB + (size_t)row * DM + (col & (DM - 1)), o); } };

constexpr int SC_TC = 32;
constexpr int SC_ARR = SC_TC * 64, SC_BUF = 6 * SC_ARR + 2 * SC_TC;
__device__ __forceinline__ void a4_scan(const Ctx& C) {
    LAS float* L = (LAS float*)C.lds;
    LAS float* YB_ = L + 2 * SC_BUF;
    const int tid = C.tid; const bool stager = tid >= 256;
    const int rp = (tid >> 3) & 31, j = tid & 7;
    const int t2 = tid & 255, ls_ld = t2 >> 3, c8 = (t2 & 7) * 8;
    for (int unit = C.bid; unit < 128; unit += C.G) {
        const int b = unit >> 4, h = (unit >> 1) & 7, dir = unit & 1;
        const float* DEC = WSP(const float, WS_DEC) + (size_t)dir * NT * ADIM + h * 64;
        const bf16_t* KD = WSP(const bf16_t, WS_KD) + (size_t)dir * NT * ADIM + h * 64;
        const bf16_t* BB = WSP(const bf16_t, WS_BB) + (size_t)dir * NT * ADIM + h * 64;
        const bf16_t* KK = WSP(const bf16_t, WS_KK) + h * 64; const bf16_t* R = WSP(const bf16_t, WS_R) + h * 64; const bf16_t* V = WSP(const bf16_t, WS_V) + h * 64;
        float* Y = WSP(float, WS_Y) + (size_t)dir * NT * ADIM + h * 64;
        auto row_of = [&](int s_) -> int { return s_ < 256 ? NLAT + b * 256 + (dir ? 255 - s_ : s_) : b * 2048 + (dir ? 2047 - (s_ - 256) : (s_ - 256)); };
        f32x4 pw0, pw1; u32x4 pkd, pbb, pkk, pr, pv;
        auto gload = [&](int chunk) { const size_t o = (size_t)row_of(chunk * SC_TC + ls_ld) * ADIM + c8;
            pw0 = *(const f32x4*)(DEC + o); pw1 = *(const f32x4*)(DEC + o + 4); pkd = *(const u32x4*)(KD + o); pbb = *(const u32x4*)(BB + o); pkk = *(const u32x4*)(KK + o); pr = *(const u32x4*)(R + o); pv = *(const u32x4*)(V + o); };
        auto lwrite = [&](int buf) { LAS float* Bf = L + buf * SC_BUF + ls_ld * 64 + c8;
            float kd[8], bb[8], kk[8], r[8], v[8]; unpk8(pkd, kd); unpk8(pbb, bb); unpk8(pkk, kk); unpk8(pr, r); unpk8(pv, v);
            *(LAS f32x4*)(Bf) = pw0; *(LAS f32x4*)(Bf + 4) = pw1;
            *(LAS f32x4*)(Bf + SC_ARR) = *(const f32x4*)&kd[0]; *(LAS f32x4*)(Bf + SC_ARR + 4) = *(const f32x4*)&kd[4];
            *(LAS f32x4*)(Bf + 2 * SC_ARR) = *(const f32x4*)&bb[0]; *(LAS f32x4*)(Bf + 2 * SC_ARR + 4) = *(const f32x4*)&bb[4];
            *(LAS f32x4*)(Bf + 3 * SC_ARR) = *(const f32x4*)&kk[0]; *(LAS f32x4*)(Bf + 3 * SC_ARR + 4) = *(const f32x4*)&kk[4];
            *(LAS f32x4*)(Bf + 4 * SC_ARR) = pw0 * *(const f32x4*)&r[0]; *(LAS f32x4*)(Bf + 4 * SC_ARR + 4) = pw1 * *(const f32x4*)&r[4];
            *(LAS f32x4*)(Bf + 5 * SC_ARR) = *(const f32x4*)&v[0]; *(LAS f32x4*)(Bf + 5 * SC_ARR + 4) = *(const f32x4*)&v[4];
            float br = 0.f, kr = 0.f;
#pragma unroll
            for (int q = 0; q < 8; ++q) { br += bb[q] * r[q]; kr += kd[q] * r[q]; }
            br = sum8(br); kr = sum8(kr);
            if ((tid & 7) == 0) *(LAS f32x2*)(L + buf * SC_BUF + 6 * SC_ARR + ls_ld * 2) = (f32x2){br, kr}; };
        f32x2 S0[4], S1[4];
#pragma unroll
        for (int q = 0; q < 4; ++q) { S0[q] = (f32x2){0.f, 0.f}; S1[q] = (f32x2){0.f, 0.f}; }
        __syncthreads();
        if (stager) { gload(0); lwrite(0); }
        __syncthreads();
        constexpr int NCH = 2304 / SC_TC;
        for (int ch = 0; ch < NCH; ++ch) {
            if (stager) {
                if (ch > 0) { const LAS float* yp = YB_ + ((ch - 1) & 1) * SC_ARR + ls_ld * 64 + c8; float* yg = Y + (size_t)row_of((ch - 1) * SC_TC + ls_ld) * ADIM + c8;
                    st16f(yg, *(const LAS f32x4*)yp); st16f(yg + 4, *(const LAS f32x4*)(yp + 4)); }
                if (ch + 1 < NCH) { gload(ch + 1); lwrite((ch + 1) & 1); }
            } else {
                const LAS float* Bf = L + (ch & 1) * SC_BUF + j * 8;
                const LAS float* Bv = L + (ch & 1) * SC_BUF + 5 * SC_ARR + 2 * rp;
                const LAS float* Bs = L + (ch & 1) * SC_BUF + 6 * SC_ARR;
                LAS float* yb = YB_ + (ch & 1) * SC_ARR + 2 * rp;
#pragma unroll 2
                for (int ls = 0; ls < SC_TC; ++ls) {
                    const LAS float* p = Bf + ls * 64;
                    const f32x4 w0 = *(const LAS f32x4*)(p), w1 = *(const LAS f32x4*)(p + 4);
                    const f32x4 d0 = *(const LAS f32x4*)(p + SC_ARR), d1 = *(const LAS f32x4*)(p + SC_ARR + 4);
                    const f32x4 b0 = *(const LAS f32x4*)(p + 2 * SC_ARR), b1 = *(const LAS f32x4*)(p + 2 * SC_ARR + 4);
                    const f32x4 k0 = *(const LAS f32x4*)(p + 3 * SC_ARR), k1 = *(const LAS f32x4*)(p + 3 * SC_ARR + 4);
                    const f32x4 r0 = *(const LAS f32x4*)(p + 4 * SC_ARR), r1 = *(const LAS f32x4*)(p + 4 * SC_ARR + 4);
                    const f32x2 vv = *(const LAS f32x2*)(Bv + ls * 64), sc = *(const LAS f32x2*)(Bs + ls * 2);
                    const f32x2 kA = {k0.x, k0.y}, kB = {k0.z, k0.w}, kC = {k1.x, k1.y}, kD = {k1.z, k1.w}, rA = {r0.x, r0.y}, rB = {r0.z, r0.w}, rC = {r1.x, r1.y}, rD = {r1.z, r1.w};
                    f32x2 a10 = S0[0] * kA; a10 += S0[1] * kB; a10 += S0[2] * kC; a10 += S0[3] * kD;
                    f32x2 a11 = S1[0] * kA; a11 += S1[1] * kB; a11 += S1[2] * kC; a11 += S1[3] * kD;
                    f32x2 a20 = S0[0] * rA; a20 += S0[1] * rB; a20 += S0[2] * rC; a20 += S0[3] * rD;
                    f32x2 a21 = S1[0] * rA; a21 += S1[1] * rB; a21 += S1[2] * rC; a21 += S1[3] * rD;
                    float q10 = a10.x + a10.y, q11 = a11.x + a11.y, q20 = a20.x + a20.y, q21 = a21.x + a21.y;
                    q10 += dpp_f<0xB1>(q10); q11 += dpp_f<0xB1>(q11); q20 += dpp_f<0xB1>(q20); q21 += dpp_f<0xB1>(q21);
                    q10 += dpp_f<0x4E>(q10); q11 += dpp_f<0x4E>(q11); q20 += dpp_f<0x4E>(q20); q21 += dpp_f<0x4E>(q21);
                    q10 += dpp_f<0x141>(q10); q11 += dpp_f<0x141>(q11); q20 += dpp_f<0x141>(q20); q21 += dpp_f<0x141>(q21);
                    const float sa0 = -q10, sa1 = -q11;
                    const f32x2 y2 = {q20 + sa0 * sc.x + vv.x * sc.y, q21 + sa1 * sc.x + vv.y * sc.y};
                    const f32x2 sA = {sa0, sa0}, sB = {sa1, sa1}, vA = {vv.x, vv.x}, vB = {vv.y, vv.y};
                    const f32x2 wA = {w0.x, w0.y}, wB = {w0.z, w0.w}, wC = {w1.x, w1.y}, wD = {w1.z, w1.w}, bA = {b0.x, b0.y}, bB = {b0.z, b0.w}, bC = {b1.x, b1.y}, bD = {b1.z, b1.w};
                    const f32x2 dA = {d0.x, d0.y}, dB = {d0.z, d0.w}, dC = {d1.x, d1.y}, dD = {d1.z, d1.w};
                    S0[0] = S0[0] * wA + sA * bA + vA * dA; S0[1] = S0[1] * wB + sA * bB + vA * dB; S0[2] = S0[2] * wC + sA * bC + vA * dC; S0[3] = S0[3] * wD + sA * bD + vA * dD;
                    S1[0] = S1[0] * wA + sB * bA + vB * dA; S1[1] = S1[1] * wB + sB * bB + vB * dB; S1[2] = S1[2] * wC + sB * bC + vB * dC; S1[3] = S1[3] * wD + sB * bD + vB * dD;
                    *(LAS f32x2*)(yb + ls * 64) = y2;
                }
            }
            __syncthreads();
        }
        if (stager) { const LAS float* yp = YB_ + ((NCH - 1) & 1) * SC_ARR + ls_ld * 64 + c8; float* yg = Y + (size_t)row_of((NCH - 1) * SC_TC + ls_ld) * ADIM + c8;
            st16f(yg, *(const LAS f32x4*)yp); st16f(yg + 4, *(const LAS f32x4*)(yp + 4)); }
    }
}

__device__ __forceinline__ void a4_mla_naive(const Ctx& C) {
    LAS float* Kt = (LAS float*)C.lds;
    LAS float* Vt = Kt + 32 * 96;
    const bf16_t* Q = WSP(const bf16_t, WS_Q); const bf16_t* KV = WSP(const bf16_t, WS_KV); const bf16_t* KR = WSP(const bf16_t, WS_KR); bf16_t* MIX = WSP(bf16_t, WS_MIX);
    const int tid = C.tid;
    for (int unit = C.bid; unit < 320; unit += C.G) {
        int b, h, qrow, nkeys; bool active = true;
        if (unit < 256) { b = unit >> 5; h = (unit >> 2) & 7; qrow = b * 2048 + (unit & 3) * 512 + tid; nkeys = 2304; }
        else { const int u = unit - 256; b = u >> 3; h = u & 7; qrow = NLAT + b * 256 + (tid & 255); nkeys = 256; active = tid < 256; }
        float q[96], acc[64], m = -1e30f, l = 0.f;
#pragma unroll
        for (int d8 = 0; d8 < 12; ++d8) { float t8[8]; ld8(Q + (size_t)qrow * 768 + h * 96 + d8 * 8, t8);
#pragma unroll
            for (int jj = 0; jj < 8; ++jj) q[d8 * 8 + jj] = t8[jj]; }
#pragma unroll
        for (int d = 0; d < 64; ++d) acc[d] = 0.f;
        for (int kt = 0; kt < nkeys; kt += 32) {
            __syncthreads();
            for (int idx = tid; idx < 32 * 48; idx += 512) { const int key = idx / 48, dp = idx % 48, kj = kt + key; const int krow = kj < 256 ? NLAT + b * 256 + kj : b * 2048 + (kj - 256);
                const unsigned w = dp < 32 ? *(const unsigned*)(KV + (size_t)krow * 1024 + h * 128 + dp * 2) : *(const unsigned*)(KR + (size_t)krow * 32 + (dp - 32) * 2);
                Kt[key * 96 + dp * 2] = __uint_as_float(w << 16); Kt[key * 96 + dp * 2 + 1] = __uint_as_float(w & 0xffff0000u); }
            for (int idx = tid; idx < 32 * 32; idx += 512) { const int key = idx >> 5, dp = idx & 31, kj = kt + key; const int krow = kj < 256 ? NLAT + b * 256 + kj : b * 2048 + (kj - 256);
                const unsigned w = *(const unsigned*)(KV + (size_t)krow * 1024 + h * 128 + 64 + dp * 2);
                Vt[key * 64 + dp * 2] = __uint_as_float(w << 16); Vt[key * 64 + dp * 2 + 1] = __uint_as_float(w & 0xffff0000u); }
            __syncthreads();
            for (int key = 0; key < 32; ++key) {
                float s = 0.f;
#pragma unroll
                for (int d4 = 0; d4 < 24; ++d4) { const f32x4 kv = *(const LAS f32x4*)(Kt + key * 96 + d4 * 4); s += q[d4 * 4] * kv.x + q[d4 * 4 + 1] * kv.y + q[d4 * 4 + 2] * kv.z + q[d4 * 4 + 3] * kv.w; }
                const float mn = fmaxf(m, s), corr = __expf(m - mn), p = __expf(s - mn); m = mn; l = l * corr + p;
#pragma unroll
                for (int d4 = 0; d4 < 16; ++d4) { const f32x4 vv = *(const LAS f32x4*)(Vt + key * 64 + d4 * 4);
                    acc[d4 * 4] = acc[d4 * 4] * corr + p * vv.x; acc[d4 * 4 + 1] = acc[d4 * 4 + 1] * corr + p * vv.y; acc[d4 * 4 + 2] = acc[d4 * 4 + 2] * corr + p * vv.z; acc[d4 * 4 + 3] = acc[d4 * 4 + 3] * corr + p * vv.w; }
            }
        }
        if (active) { const float il = 1.f / l;
#pragma unroll
            for (int d8 = 0; d8 < 8; ++d8) { float o[8];
#pragma unroll
                for (int jj = 0; jj < 8; ++jj) o[jj] = acc[d8 * 8 + jj] * il;
                st8(MIX + (size_t)qrow * DM + 512 + h * 64 + d8 * 8, o); } }
    }
    __syncthreads();
}

typedef float f32x16 __attribute__((ext_vector_type(16)));
__device__ __forceinline__ int crow(int r, int hi) { return (r & 3) + 8 * (r >> 2) + 4 * hi; }
constexpr int AT_VP = 136;
template <class Spec> __device__ __forceinline__ void attn_unit(const Ctx& C, const Spec& sp) {
    constexpr int DQ = Spec::DQ, NS = DQ / 16, KP = Spec::KPITCH, KBUF = 64 * KP, VBUF = 64 * AT_VP, BUF = KBUF + VBUF;
    static_assert(BUF % 16 == 0 && KP % 16 == 0, "alignment");
    LAS unsigned char* L = C.lds;
    const int tid = C.tid, lane = C.lane, w = C.wave, r32 = lane & 31, hi = lane >> 5;
    bf16x8 qf[NS];
    { const bf16_t* qp = sp.qptr(w * 32 + r32);
#pragma unroll
      for (int s_ = 0; s_ < NS; ++s_) qf[s_] = *(const bf16x8*)(qp + 16 * s_ + 8 * hi); }
    f32x16 o0, o1;
#pragma unroll
    for (int r = 0; r < 16; ++r) { o0[r] = 0.f; o1[r] = 0.f; }
    float m = -1e30f, lsum = 0.f;
    const int nt = sp.nt;
    const int skey = tid >> 3, sch = tid & 7, rkey = (tid >> 2) & 63, rch = 8 + (tid & 3);
    struct Stg { u32x4 gk, gk2, gv; } sa_, sb_;
    sa_.gk2 = (u32x4){0u, 0u, 0u, 0u}; sb_.gk2 = (u32x4){0u, 0u, 0u, 0u};
    auto gload = [&](int t, Stg& g_) { g_.gk = *(const u32x4*)sp.kptr(t, skey, sch); if (NS > 4 && tid < 256) g_.gk2 = *(const u32x4*)sp.kptr(t, rkey, rch); g_.gv = *(const u32x4*)sp.vptr(t, skey, sch); };
    auto lwrite = [&](int buf, const Stg& g_) { const u32x4 gk = g_.gk, gk2 = g_.gk2, gv = g_.gv; LAS unsigned char* Bk = L + buf * BUF;
        *(LAS u32x4*)(Bk + skey * KP + sch * 16) = gk; if (NS > 4 && tid < 256) *(LAS u32x4*)(Bk + rkey * KP + rch * 16) = gk2;
        LAS unsigned short* Bv = (LAS unsigned short*)(Bk + KBUF);
#pragma unroll
        for (int j = 0; j < 8; ++j) { const unsigned wv = gv[j >> 1]; Bv[(sch * 8 + j) * (AT_VP / 2) + skey] = (unsigned short)((j & 1) ? (wv >> 16) : (wv & 0xffffu)); } };
    __syncthreads();
    sp.prologue(C);
    gload(0, sa_); if (nt > 1) gload(1, sb_); lwrite(0, sa_);
    __syncthreads();
    auto compute = [&](int t) {
        if (sp.active(t, w)) {
            const LAS unsigned char* Bk = L + (t & 1) * BUF; const LAS unsigned char* Bv = Bk + KBUF;
            f32x16 p0, p1;
#pragma unroll
            for (int r = 0; r < 16; ++r) { p0[r] = 0.f; p1[r] = 0.f; }
#pragma unroll
            for (int s_ = 0; s_ < NS; ++s_) {
                const bf16x8 k0 = *(const LAS bf16x8*)(Bk + r32 * KP + 32 * s_ + 16 * hi), k1 = *(const LAS bf16x8*)(Bk + (32 + r32) * KP + 32 * s_ + 16 * hi);
                p0 = __builtin_amdgcn_mfma_f32_32x32x16_bf16(k0, qf[s_], p0, 0, 0, 0); p1 = __builtin_amdgcn_mfma_f32_32x32x16_bf16(k1, qf[s_], p1, 0, 0, 0); }
            sp.bias(C, t, w, r32, hi, p0, p1);
            float mx = fmaxf(p0[0], p1[0]);
#pragma unroll
            for (int r = 1; r < 16; ++r) mx = fmaxf(mx, fmaxf(p0[r], p1[r]));
            mx = fmaxf(mx, __shfl_xor(mx, 32));
            if (__any(mx > m + 8.0f)) {
                const float mn = fmaxf(m, mx), corr = __builtin_amdgcn_exp2f(m - mn); m = mn; lsum *= corr;
#pragma unroll
                for (int r = 0; r < 16; ++r) { o0[r] *= corr; o1[r] *= corr; }
            }
            float ps = 0.f;
#pragma unroll
            for (int r = 0; r < 16; ++r) { p0[r] = __builtin_amdgcn_exp2f(p0[r] - m); p1[r] = __builtin_amdgcn_exp2f(p1[r] - m); ps += p0[r] + p1[r]; }
            lsum += ps;
#pragma unroll
            for (int s_ = 0; s_ < 4; ++s_) {
                u32x4 pw;
                if (s_ < 2) { pw.x = pk2(p0[8 * s_ + 0], p0[8 * s_ + 1]); pw.y = pk2(p0[8 * s_ + 2], p0[8 * s_ + 3]); pw.z = pk2(p0[8 * s_ + 4], p0[8 * s_ + 5]); pw.w = pk2(p0[8 * s_ + 6], p0[8 * s_ + 7]); }
                else { const int q_ = 8 * (s_ - 2); pw.x = pk2(p1[q_ + 0], p1[q_ + 1]); pw.y = pk2(p1[q_ + 2], p1[q_ + 3]); pw.z = pk2(p1[q_ + 4], p1[q_ + 5]); pw.w = pk2(p1[q_ + 6], p1[q_ + 7]); }
                const bf16x8 pb = __builtin_bit_cast(bf16x8, pw);
#pragma unroll
                for (int dvh = 0; dvh < 2; ++dvh) {
                    const LAS unsigned char* vp = Bv + (dvh * 32 + r32) * AT_VP + 32 * s_ + 8 * hi;
                    const u32x2 a = *(const LAS u32x2*)vp, b = *(const LAS u32x2*)(vp + 16);
                    const bf16x8 vf = __builtin_bit_cast(bf16x8, (u32x4){a.x, a.y, b.x, b.y});
                    if (dvh == 0) o0 = __builtin_amdgcn_mfma_f32_32x32x16_bf16(vf, pb, o0, 0, 0, 0); else o1 = __builtin_amdgcn_mfma_f32_32x32x16_bf16(vf, pb, o1, 0, 0, 0);
                }
            }
        }
    };
    for (int t = 0; t < nt; t += 2) {
        if (t + 2 < nt) gload(t + 2, sa_);
        compute(t);
        if (t + 1 < nt) lwrite(1, sb_);
        __syncthreads();
        if (t + 1 >= nt) break;
        if (t + 3 < nt) gload(t + 3, sb_);
        compute(t + 1);
        if (t + 2 < nt) lwrite(0, sa_);
        __syncthreads();
    }
    lsum += __shfl_xor(lsum, 32);
    const float il = 1.f / lsum;
    bf16_t* op = sp.optr(w * 32 + r32);
#pragma unroll
    for (int g = 0; g < 4; ++g) { u32x2 w0, w1;
        w0.x = pk2(o0[4 * g] * il, o0[4 * g + 1] * il); w0.y = pk2(o0[4 * g + 2] * il, o0[4 * g + 3] * il);
        w1.x = pk2(o1[4 * g] * il, o1[4 * g + 1] * il); w1.y = pk2(o1[4 * g + 2] * il, o1[4 * g + 3] * il);
        st8b(op + 8 * g + 4 * hi, w0); st8b(op + 32 + 8 * g + 4 * hi, w1); }
}
struct MlaSpec { static constexpr int DQ = 96, KPITCH = 208;
    const bf16_t* Q; const bf16_t* KV; const bf16_t* KR; bf16_t* O; int b, h, q0, nt;
    __device__ __forceinline__ const bf16_t* qptr(int i) const { return Q + (size_t)(q0 + i) * 768 + h * 96; }
    __device__ __forceinline__ bf16_t* optr(int i) const { return O + (size_t)(q0 + i) * DM + 512 + h * 64; }
    __device__ __forceinline__ int krow(int t, int key) const { return t < 4 ? NLAT + b * 256 + 64 * t + key : b * 2048 + 64 * (t - 4) + key; }
    __device__ __forceinline__ const bf16_t* kptr(int t, int key, int c) const { const int kr = krow(t, key); return c < 8 ? KV + (size_t)kr * 1024 + h * 128 + c * 8 : KR + (size_t)kr * 32 + (c - 8) * 8; }
    __device__ __forceinline__ const bf16_t* vptr(int t, int key, int c) const { return KV + (size_t)krow(t, key) * 1024 + h * 128 + 64 + c * 8; }
    __device__ __forceinline__ bool active(int, int) const { return true; }
    __device__ __forceinline__ void prologue(const Ctx&) const {}
    __device__ __forceinline__ void bias(const Ctx&, int, int, int, int, f32x16&, f32x16&) const {}
};
struct NaSpec { static constexpr int DQ = 64, KPITCH = 144; static constexpr int TAB_OFF = 2 * (64 * 144 + 64 * AT_VP);
    const bf16_t* QKV; bf16_t* O; const float* rpb; int b, h, rb, kr0, ntw, nt, isctx;
    __device__ __forceinline__ const bf16_t* qptr(int i) const { return QKV + (size_t)(isctx ? NLAT + b * 256 + i : b * 2048 + rb * 256 + i) * 3072 + h * 64; }
    __device__ __forceinline__ bf16_t* optr(int i) const { return O + (size_t)(isctx ? NLAT + b * 256 + i : b * 2048 + rb * 256 + i) * DM + h * 64; }
    __device__ __forceinline__ int krow(int t, int key) const { return t < ntw ? b * 2048 + (kr0 + t) * 64 + key : NLAT + b * 256 + 64 * (t - ntw) + key; }
    __device__ __forceinline__ const bf16_t* kptr(int t, int key, int c) const { return QKV + (size_t)krow(t, key) * 3072 + 1024 + h * 64 + c * 8; }
    __device__ __forceinline__ const bf16_t* vptr(int t, int key, int c) const { return QKV + (size_t)krow(t, key) * 3072 + 2048 + h * 64 + c * 8; }
    __device__ __forceinline__ bool active(int t, int w) const { if (t >= ntw) return true; const int qr = 4 * rb + (w >> 1), rs = min(max(qr - 4, 0), 24), kr = kr0 + t; return kr >= rs && kr < rs + 8; }
    __device__ __forceinline__ void prologue(const Ctx& C) const { if (!isctx) { LAS float* tab = (LAS float*)(C.lds + TAB_OFF); for (int idx = C.tid; idx < 640; idx += 512) { const int k = idx - 64; tab[idx] = (k >= 0 && k < 465) ? rpb[h * 465 + k] * 1.4426950408889634f : 0.f; } } }
    __device__ __forceinline__ void bias(const Ctx& C, int t, int w, int r32, int hi, f32x16& p0, f32x16& p1) const {
        if (t >= ntw) return;
        const LAS float* tab = (const LAS float*)(C.lds + TAB_OFF);
        const int qr = 4 * rb + (w >> 1), qc = 32 * (w & 1) + r32, cs = min(max(qc - 8, 0), 48), ro = (kr0 + t - qr + 7) * 31 - qc + 15 + 64;
        const volatile LAS float* tb = tab + ro + 4 * hi; const int kb = 4 * hi - cs;
        float bv0[16], bv1[16];
#pragma unroll
        for (int r = 0; r < 16; ++r) { const int c = (r & 3) + 8 * (r >> 2); bv0[r] = tb[c]; bv1[r] = tb[c + 32]; }
#pragma unroll
        for (int r = 0; r < 16; ++r) { const int c = (r & 3) + 8 * (r >> 2);
            const bool v0 = (unsigned)(c + kb) < 16u, v1 = (unsigned)(c + 32 + kb) < 16u;
            p0[r] = v0 ? p0[r] + bv0[r] : -INFINITY; p1[r] = v1 ? p1[r] + bv1[r] : -INFINITY; }
    }
};
__device__ __forceinline__ void a4_mla(const Ctx& C, int layer) {
    volatile LAS int* slot = (volatile LAS int*)(C.lds + LDSCTL_OFF + 64);
    unsigned* ctr = (unsigned*)(C.ws + WS_CTL) + CW_QUEUE + 64 * layer;
    for (;;) {
        __syncthreads();
        if (C.tid == 0) slot[0] = (int)__hip_atomic_fetch_add(ctr, 1u, __ATOMIC_RELAXED, __HIP_MEMORY_SCOPE_AGENT);
        __syncthreads();
        const int unit = slot[0];
        if (unit >= 512 + 64) break;
        MlaSpec sp; sp.Q = WSP(const bf16_t, WS_Q); sp.KV = WSP(const bf16_t, WS_KV); sp.KR = WSP(const bf16_t, WS_KR); sp.O = WSP(bf16_t, WS_MIX);
        if (unit < 512) { sp.b = unit >> 6; sp.h = (unit >> 3) & 7; sp.q0 = sp.b * 2048 + (unit & 7) * 256; sp.nt = 36; }
        else { const int u = unit - 512; sp.b = u >> 3; sp.h = u & 7; sp.q0 = NLAT + sp.b * 256; sp.nt = 4; }
        attn_unit(C, sp);
    }
}
__device__ __forceinline__ void b2_na(const Ctx& C, int i, bool need_ctx) {
    for (int unit = C.bid; unit < 1024 + (need_ctx ? 128 : 0); unit += C.G) {
        NaSpec sp; sp.QKV = WSP(const bf16_t, WS_Z); sp.O = WSP(bf16_t, WS_MIX); sp.rpb = C.A.in[27] + (size_t)i * 16 * 465;
        if (unit < 1024) { sp.b = unit >> 7; sp.h = (unit >> 3) & 15; sp.rb = unit & 7; sp.isctx = 0;
            sp.kr0 = min(max(4 * sp.rb - 4, 0), 24); const int krl = min(max(4 * sp.rb + 3 - 4, 0), 24) + 7; sp.ntw = krl - sp.kr0 + 1; sp.nt = sp.ntw + 4; }
        else { const int u = unit - 1024; sp.b = u >> 4; sp.h = u & 15; sp.rb = 0; sp.isctx = 1; sp.kr0 = 0; sp.ntw = 0; sp.nt = 4; }
        attn_unit(C, sp);
    }
}

__device__ __forceinline__ void a5_output(const Ctx& C, int i) {
    const int lane = C.lane, c0 = lane * 8;
    const float* rk = C.A.in[19] + i * ADIM + c0; const float* lnw = C.A.in[20] + i * ADIM + c0; const float* lnb = C.A.in[21] + i * ADIM + c0;
    for (int row = C.gw; row < NT; row += C.ngw) {
        const float* yf = WSP(const float, WS_Y) + (size_t)row * ADIM + c0; const float* yb = yf + (size_t)NT * ADIM;
        float y[8]; { const f32x4 a0 = *(const f32x4*)yf, a1 = *(const f32x4*)(yf + 4), b0 = *(const f32x4*)yb, b1 = *(const f32x4*)(yb + 4);
            y[0] = a0.x + b0.x; y[1] = a0.y + b0.y; y[2] = a0.z + b0.z; y[3] = a0.w + b0.w; y[4] = a1.x + b1.x; y[5] = a1.y + b1.y; y[6] = a1.z + b1.z; y[7] = a1.w + b1.w; }
        float s = 0.f;
#pragma unroll
        for (int j = 0; j < 8; ++j) s += y[j];
        const float mean = sum8(s) * (1.f / 64.f); float q = 0.f;
#pragma unroll
        for (int j = 0; j < 8; ++j) { const float d = y[j] - mean; q += d * d; }
        const float rstd = rsqrtf(sum8(q) * (1.f / 64.f) + 64e-5f);
        float r[8], v[8], g[8], kd0[8], kd1[8];
        ld8(WSP(const bf16_t, WS_R) + (size_t)row * ADIM + c0, r); ld8(WSP(const bf16_t, WS_V) + (size_t)row * ADIM + c0, v); ld8(WSP(const bf16_t, WS_G) + (size_t)row * ADIM + c0, g);
        ld8(WSP(const bf16_t, WS_KD) + (size_t)row * ADIM + c0, kd0); ld8(WSP(const bf16_t, WS_KD) + ((size_t)NT + row) * ADIM + c0, kd1);
        float bs = 0.f;
#pragma unroll
        for (int j = 0; j < 8; ++j) bs += r[j] * (kd0[j] + kd1[j]) * rk[j];
        bs = sum8(bs);
        float o[8];
#pragma unroll
        for (int j = 0; j < 8; ++j) o[j] = ((y[j] - mean) * rstd * lnw[j] + lnb[j] + bs * v[j]) * g[j];
        st8(WSP(bf16_t, WS_MIX) + (size_t)row * DM + c0, o);
    }
}

__device__ __forceinline__ void b2_na_naive(const Ctx& C, int i, bool need_ctx) {
    const bf16_t* QKV = WSP(const bf16_t, WS_Z); bf16_t* MIX = WSP(bf16_t, WS_MIX);
    const float* rpb = C.A.in[27] + (size_t)i * 16 * 15 * 31;
    const int nq = need_ctx ? NT : NLAT;
    const int nblk = nq / 512;
    for (int unit = C.bid; unit < nblk * 16; unit += C.G) {
        const int h = unit & 15, qrow = (unit >> 4) * 512 + C.tid;
        float q[64], acc[64], m = -1e30f, l = 0.f;
#pragma unroll
        for (int d8 = 0; d8 < 8; ++d8) { float t8[8]; ld8(QKV + (size_t)qrow * 3072 + h * 64 + d8 * 8, t8);
#pragma unroll
            for (int jj = 0; jj < 8; ++jj) q[d8 * 8 + jj] = t8[jj]; }
#pragma unroll
        for (int d = 0; d < 64; ++d) acc[d] = 0.f;
        const bool isctx = qrow >= NLAT; const int b = isctx ? (qrow - NLAT) >> 8 : qrow >> 11;
        int qr = 0, qc = 0, rs = 0, cs = 0, nwin = 0;
        if (!isctx) { const int t = qrow & 2047; qr = t >> 6; qc = t & 63; rs = min(max(qr - 4, 0), 24); cs = min(max(qc - 8, 0), 48); nwin = 128; }
        const int nk = nwin + 256;
        for (int kj = 0; kj < nk; ++kj) {
            int krow; float bias = 0.f;
            if (kj < nwin) { const int kr = rs + (kj >> 4), kc = cs + (kj & 15); krow = b * 2048 + kr * 64 + kc; bias = rpb[(h * 15 + (kr - qr + 7)) * 31 + (kc - qc + 15)]; }
            else krow = NLAT + b * 256 + (kj - nwin);
            const bf16_t* kp = QKV + (size_t)krow * 3072 + 1024 + h * 64; const bf16_t* vp = kp + 1024;
            float s = 0.f;
#pragma unroll
            for (int d8 = 0; d8 < 8; ++d8) { float t8[8]; ld8(kp + d8 * 8, t8);
#pragma unroll
                for (int jj = 0; jj < 8; ++jj) s += q[d8 * 8 + jj] * t8[jj]; }
            s += bias;
            const float mn = fmaxf(m, s), corr = __expf(m - mn), p = __expf(s - mn); m = mn; l = l * corr + p;
#pragma unroll
            for (int d8 = 0; d8 < 8; ++d8) { float t8[8]; ld8(vp + d8 * 8, t8);
#pragma unroll
                for (int jj = 0; jj < 8; ++jj) acc[d8 * 8 + jj] = acc[d8 * 8 + jj] * corr + p * t8[jj]; }
        }
        const float il = 1.f / l;
#pragma unroll
        for (int d8 = 0; d8 < 8; ++d8) { float o[8];
#pragma unroll
            for (int jj = 0; jj < 8; ++jj) o[jj] = acc[d8 * 8 + jj] * il;
            st8(MIX + (size_t)qrow * DM + h * 64 + d8 * 8, o); }
    }
}

template <int CTRL, int N> __device__ __forceinline__ void tr_step_dpp(const float (&in)[2 * N], float (&out)[N], bool bit) {
#pragma unroll
    for (int k = 0; k < N; ++k) { const float keep = bit ? in[k + N] : in[k], give = bit ? in[k] : in[k + N]; out[k] = keep + dpp_f<CTRL>(give); } }
__device__ __forceinline__ void c2_router(const Ctx& C, int layer, int nrows) {
    const float* rw = C.A.in[29] + (size_t)layer * DM * NEXP; const int lane = C.lane;
    LAS float* scr = (LAS float*)(C.lds + C.wave * 256);
    const float* nw = C.A.in[7] + layer * DM;
    for (int grp = C.gw; grp < nrows / 4; grp += C.ngw) {
        const int row0 = grp * 4, mg = mod_group(row0);
        const float* sh = modp(C, layer, mg, 3); const float* sc = modp(C, layer, mg, 4);
        f32x4 h[4][4];
#pragma unroll
        for (int rr = 0; rr < 4; ++rr) row_load(WSP(const float, WS_X) + (size_t)(row0 + rr) * DM, lane, h[rr]);
#pragma unroll
        for (int rr = 0; rr < 4; ++rr) { const float rstd = row_rstd(h[rr]); f32x4 t[4]; row_modulate(h[rr], rstd, nw, sh, sc, lane, t);
#pragma unroll
            for (int j = 0; j < 4; ++j) h[rr][j] = t[j];
            row_store_bf16(WSP(bf16_t, WS_H) + (size_t)(row0 + rr) * DM, lane, h[rr]); }
        float lg[64];
#pragma unroll
        for (int k = 0; k < 64; ++k) lg[k] = 0.f;
#pragma unroll
        for (int j = 0; j < 4; ++j)
#pragma unroll
            for (int q = 0; q < 4; ++q) { const float* wr_ = rw + (size_t)((lane + 64 * j) * 4 + q) * NEXP;
                const f32x4 w0 = *(const f32x4*)(wr_), w1 = *(const f32x4*)(wr_ + 4), w2 = *(const f32x4*)(wr_ + 8), w3 = *(const f32x4*)(wr_ + 12);
#pragma unroll
                for (int rr = 0; rr < 4; ++rr) { const float hv = h[rr][j][q]; float* l = lg + rr * 16;
                    l[0] += hv * w0.x; l[1] += hv * w0.y; l[2] += hv * w0.z; l[3] += hv * w0.w; l[4] += hv * w1.x; l[5] += hv * w1.y; l[6] += hv * w1.z; l[7] += hv * w1.w;
                    l[8] += hv * w2.x; l[9] += hv * w2.y; l[10] += hv * w2.z; l[11] += hv * w2.w; l[12] += hv * w3.x; l[13] += hv * w3.y; l[14] += hv * w3.z; l[15] += hv * w3.w; } }
        float r1[32], r2[16], r3[8], r4[4], r5[2];
        tr_step_dpp<0x140, 32>(lg, r1, (lane >> 3) & 1); tr_step_dpp<0x141, 16>(r1, r2, (lane >> 2) & 1); tr_step_dpp<0x4E, 8>(r2, r3, (lane >> 1) & 1); tr_step_dpp<0xB1, 4>(r3, r4, lane & 1);
        { const bool bit = (lane >> 4) & 1;
#pragma unroll
          for (int k = 0; k < 2; ++k) { const float keep = bit ? r4[k + 2] : r4[k], give = bit ? r4[k] : r4[k + 2]; r5[k] = keep + __shfl_xor(give, 16); } }
        float lgt; { const bool bit = (lane >> 5) & 1; const float keep = bit ? r5[1] : r5[0], give = bit ? r5[0] : r5[1]; lgt = keep + __shfl_xor(give, 32); }
        const int idx = (((lane >> 3) & 1) << 5) | (((lane >> 2) & 1) << 4) | (((lane >> 1) & 1) << 3) | ((lane & 1) << 2) | (((lane >> 4) & 1) << 1) | ((lane >> 5) & 1);
        scr[idx] = lgt;
        asm volatile("s_waitcnt lgkmcnt(0)" ::: "memory");
        const int rr = idx >> 4, e = idx & 15;
        const f32x4 a0 = *(const LAS f32x4*)(scr + rr * 16), a1 = *(const LAS f32x4*)(scr + rr * 16 + 4), a2 = *(const LAS f32x4*)(scr + rr * 16 + 8), a3 = *(const LAS f32x4*)(scr + rr * 16 + 12);
        asm volatile("s_waitcnt lgkmcnt(0)" ::: "memory");
        const float mx = fmaxf(fmaxf(fmaxf(fmaxf(a0.x, a0.y), fmaxf(a0.z, a0.w)), fmaxf(fmaxf(a1.x, a1.y), fmaxf(a1.z, a1.w))), fmaxf(fmaxf(fmaxf(a2.x, a2.y), fmaxf(a2.z, a2.w)), fmaxf(fmaxf(a3.x, a3.y), fmaxf(a3.z, a3.w))));
        const float den = ((__expf(a0.x - mx) + __expf(a0.y - mx)) + (__expf(a0.z - mx) + __expf(a0.w - mx))) + ((__expf(a1.x - mx) + __expf(a1.y - mx)) + (__expf(a1.z - mx) + __expf(a1.w - mx)))
                        + ((__expf(a2.x - mx) + __expf(a2.y - mx)) + (__expf(a2.z - mx) + __expf(a2.w - mx))) + ((__expf(a3.x - mx) + __expf(a3.y - mx)) + (__expf(a3.z - mx) + __expf(a3.w - mx)));
        const float a = __expf(lgt - mx) / den;
        const int row = row0 + rr; float* AFF = WSP(float, WS_AFF);
        if (row < NLAT) AFF[((size_t)(row >> 11) * 16 + e) * 2048 + (row & 2047)] = a;
        else { const int r2_ = row - NLAT; AFF[(size_t)NB * 16 * 2048 + ((size_t)(r2_ >> 8) * 16 + e) * 256 + (r2_ & 255)] = a; }
    }
}

__device__ __forceinline__ void c3_topk(const Ctx& C, bool need_ctx) {
    LAS unsigned* cntw = (LAS unsigned*)C.lds;
    LAS unsigned* wtot = (LAS unsigned*)(C.lds + 256);
    LAS int* list = (LAS int*)(C.lds + 1024);
    const int nunits = 128 + (need_ctx ? 128 : 0), tid = C.tid, lane = C.lane, w = C.wave;
    const unsigned long long lt = (1ull << lane) - 1ull;
    for (int unit = C.bid; unit < nunits; unit += C.G) {
        const bool lat = unit < 128; const int u = lat ? unit : unit - 128, b = u >> 4, e = u & 15, n = lat ? 2048 : 256; const unsigned cap = lat ? 256u : 32u;
        const float* src = lat ? WSP(const float, WS_AFF) + ((size_t)b * 16 + e) * 2048 : WSP(const float, WS_AFF) + (size_t)NB * 16 * 2048 + ((size_t)b * 16 + e) * 256;
        const bool valid = 4 * tid < n;
        unsigned key[4] = {0u, 0u, 0u, 0u};
        if (valid) { const u32x4 kv = *(const u32x4*)(src + 4 * tid); key[0] = kv.x; key[1] = kv.y; key[2] = kv.z; key[3] = kv.w; }
        __syncthreads();
        if (tid < 64) cntw[tid] = 0u;
        __syncthreads();
        unsigned T = 0u;
        for (int bit = 29; bit >= 0; --bit) {
            const unsigned cand = T | (1u << bit); unsigned c = 0u;
#pragma unroll
            for (int q = 0; q < 4; ++q) c += (unsigned)__popcll(__ballot(key[q] >= cand));
            if (lane == 0 && c) atomicAdd((unsigned*)&cntw[bit], c);
            __syncthreads();
            if (cntw[bit] >= cap) T = cand;
        }
        unsigned long long bg[4], be[4]; unsigned cg = 0u, ce = 0u;
#pragma unroll
        for (int q = 0; q < 4; ++q) { bg[q] = __ballot(key[q] > T); be[q] = __ballot(valid && key[q] == T); cg += (unsigned)__popcll(bg[q]); ce += (unsigned)__popcll(be[q]); }
        if (lane == 0) { wtot[w] = cg; wtot[8 + w] = ce; }
        __syncthreads();
        unsigned tg = 0u, eoff = 0u;
#pragma unroll
        for (int k = 0; k < 8; ++k) { tg += wtot[k]; eoff += k < w ? wtot[8 + k] : 0u; }
        const unsigned need = cap - tg;
        bool selq[4]; unsigned long long bs[4]; unsigned cs_ = 0u;
#pragma unroll
        for (int q = 0; q < 4; ++q) { unsigned er = eoff;
#pragma unroll
            for (int q2 = 0; q2 < 4; ++q2) er += (unsigned)__popcll(be[q2] & lt) + ((q2 < q && ((be[q2] >> lane) & 1ull)) ? 1u : 0u);
            selq[q] = key[q] > T || (valid && key[q] == T && er < need); bs[q] = __ballot(selq[q]); cs_ += (unsigned)__popcll(bs[q]); }
        if (lane == 0) wtot[16 + w] = cs_;
        __syncthreads();
        unsigned soff = 0u;
#pragma unroll
        for (int k = 0; k < 8; ++k) soff += k < w ? wtot[16 + k] : 0u;
        if (valid) {
            int gsel[4];
#pragma unroll
            for (int q = 0; q < 4; ++q) { unsigned sl = soff;
#pragma unroll
                for (int q2 = 0; q2 < 4; ++q2) sl += (unsigned)__popcll(bs[q2] & lt) + ((q2 < q && ((bs[q2] >> lane) & 1ull)) ? 1u : 0u);
                const int i = 4 * tid + q, trow = lat ? b * 2048 + i : NLAT + b * 256 + i; int grow = -1;
                if (selq[q]) { grow = e * ROWS_E + (lat ? b * 256 + (int)sl : 2048 + b * 32 + (int)sl);
                    WSP(int, WS_IDX)[grow] = trow; WSP(float, WS_GATE)[grow] = __uint_as_float(key[q]); list[sl * 2] = trow; list[sl * 2 + 1] = grow; }
                gsel[q] = grow; }
            const int trow0 = lat ? b * 2048 + 4 * tid : NLAT + b * 256 + 4 * tid;
#pragma unroll
            for (int q = 0; q < 4; ++q) WSP(int, WS_SEL)[(size_t)(trow0 + q) * 16 + e] = gsel[q];
        }
        __syncthreads();
        for (int s_ = w; s_ < (int)cap; s_ += 8) { const int trow = list[s_ * 2], grow = list[s_ * 2 + 1];
            const u32x4* sp = (const u32x4*)(WSP(const bf16_t, WS_H) + (size_t)trow * DM); u32x4* dp = (u32x4*)(WSP(bf16_t, WS_XIN) + (size_t)grow * DM);
            st16(dp + lane, sp[lane]); st16(dp + lane + 64, sp[lane + 64]); }
    }
    __syncthreads();
}

__device__ __forceinline__ void c6_combine(const Ctx& C, int layer, int nrows) {
    const int lane = C.lane;
    for (int grp = C.gw; grp < nrows / 4; grp += C.ngw) {
        const int row0 = grp * 4, mg = mod_group(row0);
        f32x4 v[4][4], a[4][4]; int selv[4]; unsigned em[4];
#pragma unroll
        for (int rr = 0; rr < 4; ++rr) { row_load(WSP(const float, WS_X) + (size_t)(row0 + rr) * DM, lane, v[rr]); selv[rr] = WSP(const int, WS_SEL)[(size_t)(row0 + rr) * 16 + (lane & 15)]; }
#pragma unroll
        for (int rr = 0; rr < 4; ++rr) { em[rr] = (unsigned)(__ballot(selv[rr] >= 0) & 0xFFFFull);
#pragma unroll
            for (int j = 0; j < 4; ++j) a[rr][j] = (f32x4){0.f, 0.f, 0.f, 0.f}; }
        while (em[0] | em[1] | em[2] | em[3]) {
            u32x2 t[4][4];
#pragma unroll
            for (int rr = 0; rr < 4; ++rr) {
                if (em[rr]) { const int e = __builtin_ctz(em[rr]); const int g = __builtin_amdgcn_readlane(selv[rr], e); const bf16_t* y = WSP(const bf16_t, WS_YB) + (size_t)g * DM;
#pragma unroll
                    for (int j = 0; j < 4; ++j) t[rr][j] = *(const u32x2*)(y + (lane + 64 * j) * 4); }
                else {
#pragma unroll
                    for (int j = 0; j < 4; ++j) t[rr][j] = (u32x2){0u, 0u}; }
            }
#pragma unroll
            for (int rr = 0; rr < 4; ++rr) { em[rr] &= em[rr] - 1u;
#pragma unroll
                for (int j = 0; j < 4; ++j) { const u32x2 w = t[rr][j];
                    a[rr][j] += (f32x4){__uint_as_float(w.x << 16), __uint_as_float(w.x & 0xffff0000u), __uint_as_float(w.y << 16), __uint_as_float(w.y & 0xffff0000u)}; } }
        }
        const float* g2 = modp(C, layer, mg, 5);
#pragma unroll
        for (int rr = 0; rr < 4; ++rr) { const int row = row0 + rr;
#pragma unroll
            for (int j = 0; j < 4; ++j) v[rr][j] += *(const f32x4*)(g2 + (lane + 64 * j) * 4) * a[rr][j];
            const float rstd = row_rstd(v[rr]);
            if (layer < 3) { row_store(WSP(float, WS_X) + (size_t)row * DM, lane, v[rr]);
                f32x4 h[4]; row_modulate(v[rr], rstd, C.A.in[6] + (layer + 1) * DM, modp(C, layer + 1, mg, 0), modp(C, layer + 1, mg, 1), lane, h);
                row_store_bf16(WSP(bf16_t, WS_H) + (size_t)row * DM, lane, h);
            } else {
#pragma unroll
                for (int j = 0; j < 4; ++j) { const int c = (lane + 64 * j) * 4; st16f(C.out + (size_t)row * DM + c, v[rr][j] * rstd * *(const f32x4*)(C.A.in[8] + c)); }
            }
        }
    }
}

constexpr int N_PHASE_IDS = 2 + 12 * 4;
__host__ __device__ inline bool phase_exists(int p) { if (p < 2) return true; const int l = (p - 2) / 12, k = (p - 2) % 12; if (k == 11) return false; if (l & 1) return !(k >= 2 && k <= 4); return true; }

__global__ void __launch_bounds__(512, 2) fwd(Args args) {
    extern __shared__ __attribute__((aligned(16))) unsigned char lds_raw[];
    const int tid_ = threadIdx.x, wave_ = __builtin_amdgcn_readfirstlane(tid_ >> 6);
    const Ctx C0{args, args.out, args.ws, (LAS unsigned char*)lds_raw, tid_, tid_ & 63, wave_, (int)gridDim.x, (int)blockIdx.x, (int)blockIdx.x * 8 + wave_, (int)gridDim.x * 8};
    volatile LAS unsigned* MISC = (volatile LAS unsigned*)(C0.lds + LDSCTL_OFF);
    if (C0.tid < 128) MISC[C0.tid] = 0u;
    __syncthreads();
    const int lo = args.ph_lo, hi = args.ph_hi;
    XcdBarrier bar; bar.bar = (unsigned*)(C0.ws + WS_CTL) + CW_BAR; bar.x = 0; bar.st = nullptr;
    if (hi - lo > 1) bar = xcd_barrier_post((unsigned*)(C0.ws + WS_CTL) + CW_BAR, MISC + 8);
#define RUN(p) (lo <= (p) && (p) < hi)
#define SEAM(p) do { if (hi > (p) + 1) xcd_barrier(bar); } while (0)
    LAS unsigned char* ring = C0.lds;

    if (RUN(0)) { const Ctx C = relaunder(C0); PH(0, p0_convert(C)); PH(18, p0_mod(C)); SEAM(0); }
    if (RUN(1)) { const Ctx C = relaunder(C0); PH(1, p1_init(C)); SEAM(1); }

    for (int layer = 0; layer < 4; ++layer) {
        const int base = 2 + 12 * layer, i = layer >> 1;
        const bool need_ctx = layer < 3;
        if (!(layer & 1)) {
            if (RUN(base + 0)) { const Ctx C = relaunder(C0);
                pg8::Gemm g{WSP(const bf16_t, WS_H), WSP(const bf16_t, WS_WIN) + (size_t)i * ZP * 1024, 1024, 1024, 1024}; pg8::StaticOrder S; S.init(NT, ZP, C.G, C.bid);
                pg8::Epi<FStoreBf16, false> E{{WSP(bf16_t, WS_Z), ZP, 1.f, 0}};
                PH(2, pg8::gemm_phase(ring, g, S, E)); PH(19, bg_fill(C, units_missing(S.nwg, S.G, S.c))); SEAM(base + 0); }
            if (RUN(base + 1)) { const Ctx C = relaunder(C0); PH(3, a2_prepare(C, i)); SEAM(base + 1); }
            if (RUN(base + 2)) { const Ctx C = relaunder(C0); int nmiss = 0;
                { pg8::Gemm g{WSP(const bf16_t, WS_LIN), WSP(const bf16_t, WS_WLORA) + (size_t)i * 2560 * 384, 384, 384, 384}; pg8::StaticOrder S; S.init(NT, 2560, C.G, C.bid);
                  pg8::Epi<FLora, false> E{{C.A.in[12] + i * 1024, C.A.in[14] + i * 1024, C.A.in[18] + i * 512, WSP(const bf16_t, WS_KS), WSP(const bf16_t, WS_KK), WSP(float, WS_DEC), WSP(bf16_t, WS_KD), WSP(bf16_t, WS_BB), WSP(bf16_t, WS_G)}};
                  PH(4, pg8::gemm_phase(ring, g, S, E)); nmiss += units_missing(S.nwg, S.G, S.c); }
                { pg8::Gemm g{WSP(const bf16_t, WS_QN), WSP(const bf16_t, WS_WQUP) + (size_t)i * 768 * 384, 384, 384, 384}; pg8::StaticOrder S; S.init(NT, 768, C.G, C.bid);
                  pg8::Epi<FQup, false> E{{WSP(bf16_t, WS_Q), WSP(const float, WS_ROPE), ATTN_NAIVE ? 0.10206207261596577f : 0.10206207261596577f * 1.4426950408889634f}};
                  PH(16, pg8::gemm_phase(ring, g, S, E)); nmiss += units_missing(S.nwg, S.G, S.c); }
                { pg8::Gemm g{WSP(const bf16_t, WS_KVN), WSP(const bf16_t, WS_WKVUP) + (size_t)i * 1024 * 256, 256, 256, 256}; pg8::StaticOrder S; S.init(NT, 1024, C.G, C.bid);
                  pg8::Epi<FStoreBf16, false> E{{WSP(bf16_t, WS_KV), 1024, 1.f, 0}};
                  PH(17, pg8::gemm_phase(ring, g, S, E)); nmiss += units_missing(S.nwg, S.G, S.c); }
                (void)nmiss;
                SEAM(base + 2); }
            if (RUN(base + 3)) { const Ctx C = relaunder(C0); PH(5, a4_scan(C)); PH(6, if (ATTN_NAIVE) a4_mla_naive(C); else a4_mla(C, layer)); PH(19, bg_fill(C, C.bid < 128 ? 0 : BG_A4)); SEAM(base + 3); }
            if (RUN(base + 4)) { const Ctx C = relaunder(C0); PH(7, a5_output(C, i)); SEAM(base + 4); }
        } else {
            if (RUN(base + 0)) { const Ctx C = relaunder(C0);
                pg8::Gemm g{WSP(const bf16_t, WS_H), WSP(const bf16_t, WS_WQKV) + (size_t)i * 3072 * 1024, 1024, 1024, 1024}; pg8::StaticOrder S; S.init(NT, 3072, C.G, C.bid);
                pg8::Epi<FStoreBf16, false> E{{WSP(bf16_t, WS_Z), 3072, ATTN_NAIVE ? 0.125f : 0.125f * 1.4426950408889634f, 1024}};
                PH(8, pg8::gemm_phase(ring, g, S, E)); PH(19, bg_fill(C, units_missing(S.nwg, S.G, S.c))); SEAM(base + 0); }
            if (RUN(base + 1)) { const Ctx C = relaunder(C0); PH(9, if (ATTN_NAIVE) b2_na_naive(C, i, need_ctx); else b2_na(C, i, need_ctx)); SEAM(base + 1); }
        }
        if (RUN(base + 5)) { const Ctx C = relaunder(C0);
            const bf16_t* W = (layer & 1) ? WSP(const bf16_t, WS_WOUTC) + (size_t)i * 1024 * 1024 : WSP(const bf16_t, WS_WOUTA) + (size_t)i * 1024 * 1024;
            pg8::Gemm g{WSP(const bf16_t, WS_MIX), W, 1024, 1024, 1024}; pg8::StaticOrder S; S.init(need_ctx ? NT : NLAT, 1024, C.G, C.bid);
            pg8::Epi<FResid, false> E{{WSP(float, WS_X), WSP(const float, WS_MOD), layer}};
            PH(10, pg8::gemm_phase(ring, g, S, E)); PH(19, bg_fill(C, units_missing(S.nwg, S.G, S.c))); SEAM(base + 5); }
        if (RUN(base + 6)) { const Ctx C = relaunder(C0); PH(11, c2_router(C, layer, need_ctx ? NT : NLAT)); SEAM(base + 6); }
        if (RUN(base + 7)) { const Ctx C = relaunder(C0); PH(12, c3_topk(C, need_ctx)); PH(19, bg_catch_up(C, (layer + 1) * CV_NB_L)); SEAM(base + 7); }
        if (RUN(base + 8)) { const Ctx C = relaunder(C0);
            pg8::Gemm g{WSP(const bf16_t, WS_XIN), WSP(const bf16_t, WS_W13) + (size_t)layer * 16 * 4096 * 1024, 1024, 1024, 1024}; pg8::MoeOrder S; S.init(need_ctx ? 9 : 8, 16, C.G, C.bid);
            pg8::Epi<FSwiglu, true> E{{WSP(bf16_t, WS_HID)}};
            PH(13, pg8::gemm_phase(ring, g, S, E)); SEAM(base + 8); }
        if (RUN(base + 9)) { const Ctx C = relaunder(C0);
            pg8::Gemm g{WSP(const bf16_t, WS_HID), WSP(const bf16_t, WS_W2) + (size_t)layer * 16 * 1024 * 2048, 2048, 2048, 2048}; pg8::MoeOrder S; S.init(need_ctx ? 9 : 8, 4, C.G, C.bid);
            pg8::Epi<FGate, false> E{{WSP(bf16_t, WS_YB), WSP(const float, WS_GATE)}};
            PH(14, pg8::gemm_phase(ring, g, S, E)); PH(19, bg_fill(C, units_missing(S.nwg, S.G, S.c))); SEAM(base + 9); }
        if (RUN(base + 10)) { const Ctx C = relaunder(C0); PH(15, c6_combine(C, layer, need_ctx ? NT : NLAT)); if (layer < 3) SEAM(base + 10); }
    }
#undef RUN
#undef SEAM
}

extern "C" void kernel_launch(void* const* d_in, const int* in_sizes, int n_in, void* d_out, int out_size, void* d_ws, size_t ws_size, hipStream_t stream) {
    static int grid = 0;
    if (grid == 0) {
        if (n_in != 33 || out_size != NLAT * DM || ws_size < WS_END) { fprintf(stderr, "kernel_launch: unexpected shapes (n_in %d out %d ws %zu need %zu)\n", n_in, out_size, ws_size, (size_t)WS_END); grid = -1; return; }
        int dev = 0, cus = 0, per_cu = 0;
        if (hipGetDevice(&dev) != hipSuccess || hipDeviceGetAttribute(&cus, hipDeviceAttributeMultiprocessorCount, dev) != hipSuccess) { grid = -1; return; }
        if (hipFuncSetAttribute((const void*)fwd, hipFuncAttributeMaxDynamicSharedMemorySize, LDS_BYTES) != hipSuccess) { fprintf(stderr, "kernel_launch: hipFuncSetAttribute failed\n"); grid = -1; return; }
        if (hipOccupancyMaxActiveBlocksPerMultiprocessor(&per_cu, (const void*)fwd, 512, LDS_BYTES) != hipSuccess || per_cu < 1) fprintf(stderr, "kernel_launch: occupancy query says %d\n", per_cu);
        (void)hipGetLastError();
        grid = cus;
    }
    if (grid < 0) return;
    (void)hipMemsetAsync((char*)d_ws + WS_CTL, 0, CTL_BYTES, stream);
    Args a{};
    for (int i = 0; i < 33; ++i) a.in[i] = (const float*)d_in[i];
    a.out = (float*)d_out; a.ws = (unsigned char*)d_ws;
#if SINGLE_LAUNCH
    a.ph_lo = 0; a.ph_hi = N_PHASE_IDS;
    hipLaunchKernelGGL(fwd, dim3(grid), dim3(512), LDS_BYTES, stream, a);
#else
    for (int p = 0; p < N_PHASE_IDS; ++p) { if (!phase_exists(p)) continue; a.ph_lo = p; a.ph_hi = p + 1; hipLaunchKernelGGL(fwd, dim3(grid), dim3(512), LDS_BYTES, stream, a); }
#endif
}
```

```cpp
#include <hip/hip_runtime.h>
#include <cstdio>
#include <cstdint>

#ifndef PHMASK
#define PHMASK 0xFFFFFFFFu
#endif
#define PON(n) (((PHMASK) >> (n)) & 1u)
#ifndef PROBE_MASK
#define PROBE_MASK 0u
#endif
#define PH(n, ...) do { if (PON(n)) { if (((PROBE_MASK) >> (n)) & 1u) { const unsigned long long t0_ = __builtin_amdgcn_s_memrealtime(); { __VA_ARGS__; } __syncthreads(); const unsigned long long d_ = __builtin_amdgcn_s_memrealtime() - t0_; while (__builtin_amdgcn_s_memrealtime() - t0_ < 2 * d_) __builtin_amdgcn_s_sleep(8); } else { __VA_ARGS__; } } } while (0)
#ifndef EARLY_WB
#define EARLY_WB 0
#endif
#ifndef BG_A4
#define BG_A4 20
#endif
#ifndef ATTN_NAIVE
#define ATTN_NAIVE 0
#endif
#ifndef SINGLE_LAUNCH
#define SINGLE_LAUNCH 1
#endif

#define LAS __attribute__((address_space(3)))
#define GAS __attribute__((address_space(1)))
typedef unsigned short bf16_t;
typedef short bf16x8 __attribute__((ext_vector_type(8)));
typedef float f32x4 __attribute__((ext_vector_type(4)));
typedef float f32x2 __attribute__((ext_vector_type(2)));
typedef unsigned u32x4 __attribute__((ext_vector_type(4)));
typedef unsigned u32x2 __attribute__((ext_vector_type(2)));

constexpr int NB = 8, SEQ = 2048, CTXL = 256, DM = 1024;
constexpr int NLAT = NB * SEQ, NCTX = NB * CTXL, NT = NLAT + NCTX;
constexpr int ADIM = 512, ZP = 2816;
constexpr int NEXP = 16, FF = 2048, ROWS_E = 2304;
constexpr float NORM_EPS = 1e-6f;

constexpr size_t MiB = 1u << 20;
constexpr size_t WS_CTL = 0, CTL_BYTES = 1 * MiB;
constexpr size_t WS_MOD = 1 * MiB;
constexpr size_t WS_ROPE = 2 * MiB;
constexpr size_t WS_WIN = 4 * MiB;
constexpr size_t WS_WLORA = 16 * MiB;
constexpr size_t WS_WQUP = 20 * MiB;
constexpr size_t WS_WKVUP = 22 * MiB;
constexpr size_t WS_WOUTA = 24 * MiB;
constexpr size_t WS_WQKV = 28 * MiB;
constexpr size_t WS_WOUTC = 40 * MiB;
constexpr size_t WS_W13 = 48 * MiB;
constexpr size_t WS_W2 = 560 * MiB;
constexpr size_t WS_X = 816 * MiB;
constexpr size_t WS_H = 888 * MiB;
constexpr size_t WS_MIX = 924 * MiB;
constexpr size_t WS_Z = 960 * MiB;
constexpr size_t WS_R = 1068 * MiB;
constexpr size_t WS_V = 1086 * MiB;
constexpr size_t WS_KS = 1104 * MiB;
constexpr size_t WS_KK = 1122 * MiB;
constexpr size_t WS_LIN = 1140 * MiB;
constexpr size_t WS_QN = 1154 * MiB;
constexpr size_t WS_KVN = 1168 * MiB;
constexpr size_t WS_KR = 1177 * MiB;
constexpr size_t WS_DEC = 1179 * MiB;
constexpr size_t WS_KD = 1251 * MiB;
constexpr size_t WS_BB = 1287 * MiB;
constexpr size_t WS_G = 1323 * MiB;
constexpr size_t WS_Y = 1341 * MiB;
constexpr size_t WS_Q = 1413 * MiB;
constexpr size_t WS_KV = 1440 * MiB;
constexpr size_t WS_AFF = 1476 * MiB;
constexpr size_t WS_SEL = 1478 * MiB;
constexpr size_t WS_IDX = 1480 * MiB;
constexpr size_t WS_GATE = 1481 * MiB;
constexpr size_t WS_XIN = 1482 * MiB;
constexpr size_t WS_HID = 1554 * MiB;
constexpr size_t WS_YB = 1698 * MiB;
constexpr size_t WS_END = 1770 * MiB;

constexpr int CW_TMO = 0, CW_BAR = 4096, CW_QUEUE = 8192;

constexpr int RING_BYTES = 133120;
constexpr int LDSCTL_OFF = RING_BYTES;
constexpr int LDS_BYTES = 147456;

__device__ __forceinline__ float bf2f(unsigned short b) { return __uint_as_float(((unsigned)b) << 16); }
__device__ __forceinline__ unsigned f2bf(float f) { unsigned u = __float_as_uint(f); return (u + 0x7fffu + ((u >> 16) & 1u)) >> 16; }
typedef __bf16 bf16x2_t __attribute__((ext_vector_type(2)));
__device__ __forceinline__ unsigned pk2(float lo, float hi) { const f32x2 v = {lo, hi}; return __builtin_bit_cast(unsigned, __builtin_convertvector(v, bf16x2_t)); }
__device__ __forceinline__ void unpk8(const u32x4 w, float (&f)[8]) {
    f[0] = __uint_as_float(w.x << 16); f[1] = __uint_as_float(w.x & 0xffff0000u); f[2] = __uint_as_float(w.y << 16); f[3] = __uint_as_float(w.y & 0xffff0000u);
    f[4] = __uint_as_float(w.z << 16); f[5] = __uint_as_float(w.z & 0xffff0000u); f[6] = __uint_as_float(w.w << 16); f[7] = __uint_as_float(w.w & 0xffff0000u); }
__device__ __forceinline__ void ld8(const bf16_t* p, float (&f)[8]) { unpk8(*(const u32x4*)p, f); }
__device__ __forceinline__ u32x4 pack8(const float (&f)[8]) { u32x4 w; w.x = pk2(f[0], f[1]); w.y = pk2(f[2], f[3]); w.z = pk2(f[4], f[5]); w.w = pk2(f[6], f[7]); return w; }
#ifndef WT_STORES
#define WT_STORES 0
#endif
#ifndef NT_STORES
#define NT_STORES 0
#endif
__device__ __forceinline__ void st16(void* p, u32x4 v) {
#if WT_STORES
    asm volatile("global_store_dwordx4 %0, %1, off sc1\n\ts_nop 1" :: "v"(p), "v"(v) : "memory");
#elif NT_STORES
    __builtin_nontemporal_store(v, (u32x4*)p);
#else
    *(u32x4*)p = v;
#endif
}
__device__ __forceinline__ void st8b(void* p, u32x2 v) {
#if WT_STORES
    asm volatile("global_store_dwordx2 %0, %1, off sc1\n\ts_nop 0" :: "v"(p), "v"(v) : "memory");
#else
    *(u32x2*)p = v;
#endif
}
__device__ __forceinline__ void st16f(float* p, f32x4 v) { st16(p, __builtin_bit_cast(u32x4, v)); }
__device__ __forceinline__ void st8(bf16_t* p, const float (&f)[8]) { st16(p, pack8(f)); }
__device__ __forceinline__ float wave_sum_slow(float v) {
#pragma unroll
    for (int o = 1; o < 64; o <<= 1) v += __shfl_xor(v, o);
    return v; }
template <int CTRL> __device__ __forceinline__ float dpp_f(float x) { return __int_as_float(__builtin_amdgcn_update_dpp(0, __float_as_int(x), CTRL, 0xF, 0xF, true)); }
__device__ __forceinline__ float sum8(float v) { v += dpp_f<0xB1>(v); v += dpp_f<0x4E>(v); v += dpp_f<0x141>(v); return v; }
__device__ __forceinline__ float sum16(float v) { v = sum8(v); v += dpp_f<0x140>(v); return v; }
__device__ __forceinline__ float wave_sum(float v) { v = sum16(v); v += __shfl_xor(v, 16); v += __shfl_xor(v, 32); return v; }
__device__ __forceinline__ float sigmoidf_(float x) { return __builtin_amdgcn_rcpf(1.f + __expf(-x)); }
__device__ __forceinline__ int mod_group(int row) { return row < NLAT ? (row >> 11) : NB; }

namespace pg8 {
constexpr int BM = 256, BK = 64, HALF = 128, HTB = HALF * BK * 2, STAGE_BYTES = 8 * HTB, NXCD = 8, WGM = 8;
__host__ __device__ __forceinline__ int lds_byte(int r, int c) { const int st = (r >> 4) * 2 + (c >> 5), rr = r & 15, cc = c & 31, ob = rr * 64 + cc * 2; return st * 1024 + (ob ^ (((ob >> 9) & 1) << 5)); }
__host__ __device__ __forceinline__ void stage_rc(int b, int& R, int& C) { const int st = b / 1024, sb = b % 1024, swz = sb ^ (((sb >> 9) & 1) << 5); R = (st >> 1) * 16 + swz / 64; C = (st & 1) * 32 + (swz % 64) / 2; }
__host__ __device__ __forceinline__ int perm32(int rho) { const int n = rho >> 4, i = rho & 15; return 8 * (i >> 2) + 4 * n + (i & 3); }
struct Unit { int pm, pn; };
struct Gemm { const bf16_t* A; const bf16_t* Bt; int lda, ldb, K; };

struct StaticOrder {
    int nM, nN, nwg, G, c;
    __device__ void init(int M, int N, int G_, int c_) { nM = M / BM; nN = N / BM; nwg = nM * nN; G = G_; c = c_; }
    __device__ bool next(int i, Unit& u) const {
        const long L = (long)i * G + c; if (L >= nwg) return false;
        int wgid = (int)L; { const int q = nwg / NXCD, r = nwg % NXCD, xcd = wgid % NXCD, off = wgid / NXCD; wgid = (xcd < r ? xcd * (q + 1) : r * (q + 1) + (xcd - r) * q) + off; }
        const int nig = WGM * nN, gid = wgid / nig, fm = gid * WGM, gsz = (nM - fm) < WGM ? (nM - fm) : WGM;
        u.pm = fm + ((wgid % nig) % gsz); u.pn = (wgid % nig) / gsz; return true;
    }
};
struct MoeOrder {
    int nrt, nct, nwg, G, c;
    __device__ void init(int nrt_, int nct_, int G_, int c_) { nrt = nrt_; nct = nct_; nwg = NEXP * nrt * nct; G = G_; c = c_; }
    __device__ bool next(int i, Unit& u) const {
        const long L = (long)i * G + c; if (L >= nwg) return false;
        const int wgid = (int)(L % NXCD) * (nwg / NXCD) + (int)(L / NXCD);
        const int per = nrt * nct, e = wgid / per, rem = wgid % per, ct = rem / nrt, rt = rem % nrt;
        u.pm = e * 9 + rt; u.pn = e * nct + ct; return true;
    }
};

template <class F, bool PAIR> struct Epi {
    F f;
    __device__ __forceinline__ void operator()(const f32x4 (&acc)[2][2][4][2], const Unit& u, int wr, int wc, int fr, int fq) const {
#pragma unroll
        for (int ai = 0; ai < 2; ++ai)
#pragma unroll
            for (int m = 0; m < 4; ++m) {
                const int row = u.pm * BM + ai * HALF + wr * 64 + m * 16 + fr;
                if constexpr (PAIR) {
                    float a[8], b[8];
#pragma unroll
                    for (int j = 0; j < 4; ++j) { a[j] = acc[ai][0][m][0][j]; a[4 + j] = acc[ai][0][m][1][j]; b[j] = acc[ai][1][m][0][j]; b[4 + j] = acc[ai][1][m][1][j]; }
                    f(row, u.pn * HALF + wc * 32 + 8 * fq, a, b);
                } else if ((m & 1) == 0) {
                    typename F::Pre pre[2][2];
#pragma unroll
                    for (int mm = 0; mm < 2; ++mm)
#pragma unroll
                        for (int bj = 0; bj < 2; ++bj) f.pre(row + 16 * mm, u.pn * BM + bj * HALF + wc * 32 + 8 * fq, pre[mm][bj]);
#pragma unroll
                    for (int mm = 0; mm < 2; ++mm)
#pragma unroll
                        for (int bj = 0; bj < 2; ++bj) { float a[8];
#pragma unroll
                            for (int j = 0; j < 4; ++j) { a[j] = acc[ai][bj][m + mm][0][j]; a[4 + j] = acc[ai][bj][m + mm][1][j]; }
                            f(row + 16 * mm, u.pn * BM + bj * HALF + wc * 32 + 8 * fq, a, pre[mm][bj]); }
                }
            }
    }
};

template <class EpiT, class Sched>
__device__ __forceinline__ void gemm_phase(LAS unsigned char* lds, const Gemm g, const Sched& S, const EpiT& E) {
    int tid = threadIdx.x; asm volatile("" : "+v"(tid));
    const int wid = __builtin_amdgcn_readfirstlane(tid >> 6), lane = tid & 63, wr = wid >> 2, wc = wid & 3, fr = lane & 15, fq = lane >> 4;
    const int K = g.K, nt = K / BK;
    unsigned voffA[2], voffB[2];
#pragma unroll
    for (int i = 0; i < 2; ++i) { int R, C; stage_rc(tid * 16 + i * 8192, R, C); const int Rb = (R & ~31) + perm32(R & 31);
        voffA[i] = (unsigned)(R * g.lda + C) * 2u; voffB[i] = (unsigned)(Rb * g.ldb + C) * 2u; }
    const size_t kstep = (size_t)(BK * 2);
    const size_t hsA = (size_t)HALF * g.lda * 2, hsB = (size_t)HALF * g.ldb * 2, tsA = 2 * hsA, tsB = 2 * hsB;
    const unsigned ldsw = (unsigned)wid * 1024u;
    const int aoff = lds_byte(wr * 64 + fr, fq * 8), boff = lds_byte(wc * 32 + fr, fq * 8);
#define PG8_SA(b, h) (((b) * 2 + (h)) * HTB)
#define PG8_SB(b, h) ((4 + (b) * 2 + (h)) * HTB)
#define PG8_STAGE(bufoff, gbase, voff) do { _Pragma("unroll") for (int _i = 0; _i < 2; ++_i) \
        __builtin_amdgcn_global_load_lds((const unsigned*)((const char*)(gbase) + (voff)[_i]), (LAS unsigned*)(lds + (bufoff) + ldsw + _i * 8192), 16, 0, 0); } while (0)
#define PG8_LDA(dst, b, h) do { _Pragma("unroll") for (int m = 0; m < 4; ++m) _Pragma("unroll") for (int k = 0; k < 2; ++k) dst[m][k] = *(const LAS bf16x8*)(lds + PG8_SA(b, h) + aoff + m * 2048 + k * 1024); } while (0)
#define PG8_LDB(dst, b, h) do { _Pragma("unroll") for (int n = 0; n < 2; ++n) _Pragma("unroll") for (int k = 0; k < 2; ++k) dst[n][k] = *(const LAS bf16x8*)(lds + PG8_SB(b, h) + boff + n * 2048 + k * 1024); } while (0)
#define PG8_MMA(ai, bj, At, Bt) do { __builtin_amdgcn_s_setprio(1); _Pragma("unroll") for (int m = 0; m < 4; ++m) _Pragma("unroll") for (int n = 0; n < 2; ++n) _Pragma("unroll") for (int k = 0; k < 2; ++k) \
        acc[ai][bj][m][n] = __builtin_amdgcn_mfma_f32_16x16x32_bf16(Bt[n][k], At[m][k], acc[ai][bj][m][n], 0, 0, 0); __builtin_amdgcn_s_setprio(0); } while (0)
#define PG8_WAIT_V(n) asm volatile("s_waitcnt vmcnt(" #n ")" ::: "memory")
#define PG8_WAIT_L(n) asm volatile("s_waitcnt lgkmcnt(" #n ")" ::: "memory")
#define PG8_BAR __builtin_amdgcn_s_barrier()
#define PG8_SCHED __builtin_amdgcn_sched_barrier(0)
    Unit cur, nxt; int ui = 0;
    if (!S.next(0, cur)) return;
    f32x4 acc[2][2][4][2];
#pragma unroll
    for (int a = 0; a < 2; ++a)
#pragma unroll
        for (int b = 0; b < 2; ++b)
#pragma unroll
            for (int m = 0; m < 4; ++m)
#pragma unroll
                for (int n = 0; n < 2; ++n) acc[a][b][m][n] = (f32x4){0.f, 0.f, 0.f, 0.f};
    bf16x8 At[4][2], B0[2][2], B1[2][2];
    const char* cA = (const char*)g.A + (size_t)cur.pm * tsA; const char* cB = (const char*)g.Bt + (size_t)cur.pn * tsB;
    PG8_STAGE(PG8_SB(0, 0), cB, voffB); PG8_STAGE(PG8_SB(0, 1), cB + hsB, voffB); PG8_STAGE(PG8_SA(0, 0), cA, voffA); PG8_STAGE(PG8_SA(0, 1), cA + hsA, voffA);
    if (wr == 1) PG8_BAR;
    PG8_WAIT_V(2); PG8_BAR;
    PG8_STAGE(PG8_SB(1, 0), cB + kstep, voffB); PG8_STAGE(PG8_SA(1, 0), cA + kstep, voffA); PG8_STAGE(PG8_SB(1, 1), cB + hsB + kstep, voffB);
    PG8_WAIT_V(6); PG8_BAR;
    for (;;) {
        const bool has_next = S.next(ui + 1, nxt);
        const char* nA = has_next ? (const char*)g.A + (size_t)nxt.pm * tsA : cA; const char* nB = has_next ? (const char*)g.Bt + (size_t)nxt.pn * tsB : cB;
#pragma unroll 1
        for (int t = 0; t < nt; t += 2) {
            const bool last = (t == nt - 2);
            const char* a1 = cA + (size_t)(t + 1) * kstep;
            const char* a2 = last ? nA : cA + (size_t)(t + 2) * kstep; const char* b2 = last ? nB : cB + (size_t)(t + 2) * kstep;
            const char* a3 = a2 + kstep; const char* b3 = b2 + kstep;
            PG8_LDB(B0, 0, 0); PG8_LDB(B1, 0, 1); PG8_SCHED; PG8_LDA(At, 0, 0); PG8_STAGE(PG8_SA(1, 1), a1 + hsA, voffA);
            PG8_WAIT_V(8); PG8_WAIT_L(0); PG8_BAR; PG8_MMA(0, 0, At, B0); PG8_MMA(0, 1, At, B1); PG8_BAR; PG8_SCHED;
            PG8_LDA(At, 0, 1); PG8_STAGE(PG8_SB(0, 0), b2, voffB); PG8_STAGE(PG8_SB(0, 1), b2 + hsB, voffB); PG8_STAGE(PG8_SA(0, 0), a2, voffA);
            PG8_WAIT_V(8); PG8_WAIT_L(0); PG8_BAR; PG8_MMA(1, 0, At, B0); PG8_MMA(1, 1, At, B1); PG8_BAR; PG8_SCHED;
            PG8_LDB(B0, 1, 0); PG8_LDB(B1, 1, 1); PG8_SCHED; PG8_LDA(At, 1, 0); PG8_STAGE(PG8_SA(0, 1), a2 + hsA, voffA);
            PG8_WAIT_V(8); PG8_WAIT_L(0); PG8_BAR; PG8_MMA(0, 0, At, B0); PG8_MMA(0, 1, At, B1); PG8_BAR; PG8_SCHED;
            PG8_LDA(At, 1, 1); PG8_STAGE(PG8_SB(1, 0), b3, voffB); PG8_STAGE(PG8_SB(1, 1), b3 + hsB, voffB); PG8_STAGE(PG8_SA(1, 0), a3, voffA);
            PG8_WAIT_V(8); PG8_WAIT_L(0); PG8_BAR; PG8_MMA(1, 0, At, B0); PG8_MMA(1, 1, At, B1); PG8_BAR; PG8_SCHED;
        }
        if (wr == 0) PG8_BAR;
        E(acc, cur, wr, wc, fr, fq);
        if (!has_next) break;
#pragma unroll
        for (int a = 0; a < 2; ++a)
#pragma unroll
            for (int b = 0; b < 2; ++b)
#pragma unroll
                for (int m = 0; m < 4; ++m)
#pragma unroll
                    for (int n = 0; n < 2; ++n) acc[a][b][m][n] = (f32x4){0.f, 0.f, 0.f, 0.f};
        cur = nxt; cA = nA; cB = nB; ++ui;
        if (wr == 1) PG8_BAR;
    }
    PG8_WAIT_V(0);
    PG8_BAR;
#undef PG8_SA
#undef PG8_SB
#undef PG8_STAGE
#undef PG8_LDA
#undef PG8_LDB
#undef PG8_MMA
#undef PG8_WAIT_V
#undef PG8_WAIT_L
#undef PG8_BAR
#undef PG8_SCHED
}
}

#define XB_TMO      128
#define XB_XCNT(j)  (256  + 64 * (j))
#define XB_XSUB(j)  (1280 + 64 * (j))
#define XB_XGEN(j)  (2304 + 64 * (j))
#define XB_TOP      3328
#define XB_TOPGEN   3392
#define XCD_BAR_WORDS 3456
#define XB_SPIN_CAP (1u << 22)
__device__ __forceinline__ unsigned xb_ld(unsigned* p)              { return __hip_atomic_load(p, __ATOMIC_RELAXED, __HIP_MEMORY_SCOPE_AGENT); }
__device__ __forceinline__ unsigned xb_add(unsigned* p, unsigned v) { return __hip_atomic_fetch_add(p, v, __ATOMIC_RELAXED, __HIP_MEMORY_SCOPE_AGENT); }
__device__ __forceinline__ unsigned xb_xcc_id() { return (unsigned)__builtin_amdgcn_s_getreg((3 << 11) | 20) & 0xFu; }
#define XB_SPIN(cond, bar) do { unsigned _sp = 0; while (cond) { __builtin_amdgcn_s_sleep(1); \
    if ((++_sp & 255u) == 0u) { if (xb_ld(&(bar)[XB_TMO])) break; if (_sp > XB_SPIN_CAP) { atomicAdd(&(bar)[XB_TMO], 1u); break; } } } } while (0)
struct XcdBarrier { unsigned* bar; unsigned x; volatile LAS unsigned* st; };
__device__ __forceinline__ XcdBarrier xcd_barrier_post(unsigned* bar, volatile LAS unsigned* st) {
    XcdBarrier b; b.bar = bar; b.x = xb_xcc_id(); b.st = st;
    if (threadIdx.x == 0) (void)xb_add(&bar[XB_XCNT(b.x)], 1u);
    return b;
}
__device__ __forceinline__ void xcd_barrier_complete(unsigned* bar, unsigned x, unsigned& nloc, unsigned& nx) {
    const unsigned G = gridDim.x * gridDim.y * gridDim.z;
    unsigned sum, cnt, mine, sp = 0u;
    for (;;) {
        sum = 0u; cnt = 0u; mine = 0u;
#pragma unroll
        for (unsigned j = 0; j < 16; ++j) { const unsigned c = xb_ld(&bar[XB_XCNT(j)]); sum += c; cnt += (c > 0u) ? 1u : 0u; mine = (j == x) ? c : mine; }
        if (sum == G) break;
        __builtin_amdgcn_s_sleep(1);
        if ((++sp & 255u) == 0u) { if (xb_ld(&bar[XB_TMO])) break; if (sp > XB_SPIN_CAP) { atomicAdd(&bar[XB_TMO], 1u); break; } }
    }
    nloc = mine > 0u ? mine : 1u; nx = cnt > 0u ? cnt : 1u;
}
__device__ __forceinline__ void xcd_barrier(const XcdBarrier& b) {
    asm volatile("s_waitcnt vmcnt(0)" ::: "memory");
    __syncthreads();
    if (threadIdx.x == 0) {
        unsigned* bar = b.bar;
#if EARLY_WB
        __builtin_amdgcn_fence(__ATOMIC_RELEASE, "agent");
        asm volatile("s_waitcnt vmcnt(0)" ::: "memory");
#endif
        __builtin_amdgcn_s_waitcnt(0);
        unsigned nloc = b.st[0], nx = b.st[1];
        if (nloc == 0u) { xcd_barrier_complete(bar, b.x, nloc, nx); b.st[0] = nloc; b.st[1] = nx; }
        const unsigned old = xb_add(&bar[XB_XSUB(b.x)], 1u);
        const unsigned gen = old / nloc;
        if (old + 1u == (gen + 1u) * nloc) {
            __builtin_amdgcn_fence(__ATOMIC_RELEASE, "agent");
            asm volatile("s_waitcnt vmcnt(0)" ::: "memory");
            const unsigned og = xb_add(&bar[XB_TOP], 1u);
            const unsigned tg = og / nx;
            if (og + 1u == (tg + 1u) * nx) xb_add(&bar[XB_TOPGEN], 1u);
            else XB_SPIN(xb_ld(&bar[XB_TOPGEN]) == tg, bar);
            __builtin_amdgcn_fence(__ATOMIC_ACQUIRE, "agent");
            xb_add(&bar[XB_XGEN(b.x)], 1u);
            asm volatile("s_waitcnt vmcnt(0)" ::: "memory");
        } else {
            XB_SPIN(xb_ld(&bar[XB_XGEN(b.x)]) == gen, bar);
            __builtin_amdgcn_fence(__ATOMIC_ACQUIRE, "agent");
            asm volatile("s_waitcnt vmcnt(0)" ::: "memory");
        }
    }
    __syncthreads();
}

struct Args { const float* in[33]; float* out; unsigned char* ws; int ph_lo, ph_hi; };
struct Ctx {
    const Args& A; float* out; unsigned char* ws;
    LAS unsigned char* lds; int tid, lane, wave, G, bid, gw, ngw;
};
#define WSP(T, off) ((T*)(C.ws + (off)))
__device__ __forceinline__ Ctx relaunder(const Ctx& C0) {
    int tid = C0.tid; GAS unsigned char* wsg = (GAS unsigned char*)C0.ws; LAS unsigned char* lds = C0.lds;
    asm volatile("" : "+v"(tid), "+s"(wsg));
    unsigned char* ws = (unsigned char*)wsg;
    const int wave = __builtin_amdgcn_readfirstlane(tid >> 6);
    return Ctx{C0.A, C0.out, ws, lds, tid, tid & 63, wave, C0.G, C0.bid, C0.bid * 8 + wave, C0.G * 8};
}
__device__ __forceinline__ const float* modp(const Ctx& C, int layer, int mg, int chunk) { return WSP(const float, WS_MOD) + ((size_t)(layer * 9 + mg) * 6 + chunk) * 1024; }

__device__ __forceinline__ void tr_item(const float* src, int ld_src, int nvalid, int k0, int n0, bf16_t* dst, int ld_dst, int drow0, int dk0, LAS float* scr, int lane) {
    {
        const int n = (lane & 15) * 4; const bool ok = (n0 + n) < nvalid;
#pragma unroll 4
        for (int i = 0; i < 16; ++i) { const int k = 4 * i + (lane >> 4);
            f32x4 v = (f32x4){0.f, 0.f, 0.f, 0.f};
            if (ok) v = __builtin_nontemporal_load((const f32x4*)(src + (size_t)(k0 + k) * ld_src + n0 + n));
            LAS float* s = scr + k * 65 + n; s[0] = v.x; s[1] = v.y; s[2] = v.z; s[3] = v.w; }
    }
    asm volatile("s_waitcnt lgkmcnt(0)" ::: "memory");
    const int c = lane & 7;
#pragma unroll
    for (int jj = 0; jj < 8; ++jj) { const int nl = (lane >> 3) + 8 * jj; const LAS float* s = scr + (8 * c) * 65 + nl;
        u32x4 o; o.x = pk2(s[0 * 65], s[1 * 65]); o.y = pk2(s[2 * 65], s[3 * 65]); o.z = pk2(s[4 * 65], s[5 * 65]); o.w = pk2(s[6 * 65], s[7 * 65]);
        if (n0 + nl < nvalid) __builtin_nontemporal_store(o, (u32x4*)(dst + (size_t)(drow0 + nl) * ld_dst + dk0 + 8 * c)); }
    asm volatile("s_waitcnt lgkmcnt(0)" ::: "memory");
}
constexpr int CV_SMALL = 2120, CV_MOE_L = 16 * 3 * 512, CV_MOE = 4 * CV_MOE_L;
__device__ __forceinline__ void convert_item(const Ctx& C, int it, LAS float* scr) {
    {
        const float* src; int ld_src, nvalid, k0, n0, ld_dst, drow0, dk0; bf16_t* dst;
        if (it < 2 * CV_SMALL) {
            const int i = it / CV_SMALL; int r = it % CV_SMALL;
            if (r < 656) { src = C.A.in[9] + (size_t)i * 1024 * 2592; ld_src = 2592; nvalid = 2592; k0 = (r / 41) * 64; n0 = (r % 41) * 64; dst = WSP(bf16_t, WS_WIN) + (size_t)i * ZP * 1024; ld_dst = 1024; drow0 = n0; dk0 = k0; }
            else if ((r -= 656) < 16) { const int d = r >> 3; src = C.A.in[13] + (size_t)(i * 2 + d) * 64 * 512; ld_src = 512; nvalid = 512; k0 = 0; n0 = (r & 7) * 64; dst = WSP(bf16_t, WS_WLORA) + (size_t)i * 2560 * 384; ld_dst = 384; drow0 = d * 512 + n0; dk0 = d * 64; }
            else if ((r -= 16) < 16) { const int d = r >> 3; src = C.A.in[15] + (size_t)(i * 2 + d) * 64 * 512; ld_src = 512; nvalid = 512; k0 = 0; n0 = (r & 7) * 64; dst = WSP(bf16_t, WS_WLORA) + (size_t)i * 2560 * 384; ld_dst = 384; drow0 = 1024 + d * 512 + n0; dk0 = 128 + d * 64; }
            else if ((r -= 16) < 16) { src = C.A.in[16] + (size_t)i * 128 * 512; ld_src = 512; nvalid = 512; k0 = (r >> 3) * 64; n0 = (r & 7) * 64; dst = WSP(bf16_t, WS_WLORA) + (size_t)i * 2560 * 384; ld_dst = 384; drow0 = 2048 + n0; dk0 = 256 + k0; }
            else if ((r -= 16) < 72) { src = C.A.in[23] + (size_t)i * 384 * 768; ld_src = 768; nvalid = 768; k0 = (r / 12) * 64; n0 = (r % 12) * 64; dst = WSP(bf16_t, WS_WQUP) + (size_t)i * 768 * 384; ld_dst = 384; drow0 = n0; dk0 = k0; }
            else if ((r -= 72) < 64) { src = C.A.in[25] + (size_t)i * 256 * 1024; ld_src = 1024; nvalid = 1024; k0 = (r / 16) * 64; n0 = (r % 16) * 64; dst = WSP(bf16_t, WS_WKVUP) + (size_t)i * 1024 * 256; ld_dst = 256; drow0 = n0; dk0 = k0; }
            else if ((r -= 64) < 256) { src = C.A.in[10] + (size_t)i * 1024 * 1024; ld_src = 1024; nvalid = 1024; k0 = (r / 16) * 64; n0 = (r % 16) * 64; dst = WSP(bf16_t, WS_WOUTA) + (size_t)i * 1024 * 1024; ld_dst = 1024; drow0 = n0; dk0 = k0; }
            else if ((r -= 256) < 768) { src = C.A.in[26] + (size_t)i * 1024 * 3072; ld_src = 3072; nvalid = 3072; k0 = (r / 48) * 64; n0 = (r % 48) * 64; dst = WSP(bf16_t, WS_WQKV) + (size_t)i * 3072 * 1024; ld_dst = 1024; drow0 = n0; dk0 = k0; }
            else { r -= 768; src = C.A.in[28] + (size_t)i * 1024 * 1024; ld_src = 1024; nvalid = 1024; k0 = (r / 16) * 64; n0 = (r % 16) * 64; dst = WSP(bf16_t, WS_WOUTC) + (size_t)i * 1024 * 1024; ld_dst = 1024; drow0 = n0; dk0 = k0; }
        } else {
            const int m = it - 2 * CV_SMALL, le = m / 1536, r = m % 1536, which = r / 512, q = r % 512;
            if (which < 2) { src = C.A.in[which == 0 ? 30 : 31] + (size_t)le * 1024 * 2048; ld_src = 2048; nvalid = 2048; k0 = (q / 32) * 64; n0 = (q % 32) * 64;
                dst = WSP(bf16_t, WS_W13) + (size_t)le * 4096 * 1024; ld_dst = 1024; drow0 = (n0 >> 7) * 256 + which * 128 + (n0 & 127); dk0 = k0; }
            else { src = C.A.in[32] + (size_t)le * 2048 * 1024; ld_src = 1024; nvalid = 1024; k0 = (q / 16) * 64; n0 = (q % 16) * 64;
                dst = WSP(bf16_t, WS_W2) + (size_t)le * 1024 * 2048; ld_dst = 2048; drow0 = n0; dk0 = k0; }
        }
        tr_item(src, ld_src, nvalid, k0, n0, dst, ld_dst, drow0, dk0, scr, C.lane);
    }
}
constexpr int CV_BATCH = 16, CV_NB_L = CV_MOE_L / CV_BATCH, CV_NB = 4 * CV_NB_L;
__device__ __forceinline__ int bg_pull(const Ctx& C, unsigned* ctr, int limit) {
    volatile LAS int* slot = (volatile LAS int*)(C.lds + LDSCTL_OFF + 64);
    __syncthreads();
    if (C.tid == 0) { int b = -1; if ((int)__hip_atomic_load(ctr, __ATOMIC_RELAXED, __HIP_MEMORY_SCOPE_AGENT) < limit) { b = (int)__hip_atomic_fetch_add(ctr, 1u, __ATOMIC_RELAXED, __HIP_MEMORY_SCOPE_AGENT); if (b >= CV_NB) b = -1; } slot[0] = b; }
    __syncthreads();
    return slot[0];
}
struct MoeItem { const float* src; bf16_t* dst; int ld_src, ld_dst; };
__device__ __forceinline__ MoeItem moe_item(const Ctx& C, int m) {
    const int le = m / 1536, r = m % 1536, which = r / 512, q = r % 512; MoeItem it;
    if (which < 2) { const int k0 = (q / 32) * 64, n0 = (q % 32) * 64; it.ld_src = 2048; it.ld_dst = 1024;
        it.src = C.A.in[which == 0 ? 30 : 31] + (size_t)le * 1024 * 2048 + (size_t)k0 * 2048 + n0;
        it.dst = WSP(bf16_t, WS_W13) + (size_t)le * 4096 * 1024 + (size_t)((n0 >> 7) * 256 + which * 128 + (n0 & 127)) * 1024 + k0; }
    else { const int k0 = (q / 16) * 64, n0 = (q % 16) * 64; it.ld_src = 1024; it.ld_dst = 2048;
        it.src = C.A.in[32] + (size_t)le * 2048 * 1024 + (size_t)k0 * 1024 + n0; it.dst = WSP(bf16_t, WS_W2) + (size_t)le * 1024 * 2048 + (size_t)n0 * 2048 + k0; }
    return it;
}
__device__ __forceinline__ void tr_load(const MoeItem& it, int lane, f32x4 (&v)[16]) {
#pragma unroll
    for (int i = 0; i < 16; ++i) v[i] = __builtin_nontemporal_load((const f32x4*)(it.src + (size_t)(4 * i + (lane >> 4)) * it.ld_src + (lane & 15) * 4)); }
__device__ __forceinline__ void tr_store(const MoeItem& it, int lane, const f32x4 (&v)[16], LAS float* scr) {
#pragma unroll
    for (int i = 0; i < 16; ++i) { LAS float* s_ = scr + (4 * i + (lane >> 4)) * 65 + (lane & 15) * 4; s_[0] = v[i].x; s_[1] = v[i].y; s_[2] = v[i].z; s_[3] = v[i].w; }
    asm volatile("s_waitcnt lgkmcnt(0)" ::: "memory");
    const int c = lane & 7;
#pragma unroll
    for (int jj = 0; jj < 8; ++jj) { const int nl = (lane >> 3) + 8 * jj; const LAS float* s_ = scr + (8 * c) * 65 + nl;
        u32x4 o; o.x = pk2(s_[0 * 65], s_[1 * 65]); o.y = pk2(s_[2 * 65], s_[3 * 65]); o.z = pk2(s_[4 * 65], s_[5 * 65]); o.w = pk2(s_[6 * 65], s_[7 * 65]);
        __builtin_nontemporal_store(o, (u32x4*)(it.dst + (size_t)nl * it.ld_dst + 8 * c)); }
    asm volatile("s_waitcnt lgkmcnt(0)" ::: "memory");
}
__device__ __forceinline__ void bg_batch(const Ctx& C, int b) {
    LAS float* scr = (LAS float*)(C.lds + C.wave * 16640);
    const MoeItem ia = moe_item(C, b * CV_BATCH + C.wave), ib = moe_item(C, b * CV_BATCH + C.wave + 8);
    f32x4 va[16], vb[16]; tr_load(ia, C.lane, va); tr_load(ib, C.lane, vb);
    tr_store(ia, C.lane, va, scr); tr_store(ib, C.lane, vb, scr);
}
__device__ __forceinline__ void bg_fill(const Ctx& C, int budget) { unsigned* ctr = (unsigned*)(C.ws + WS_CTL) + CW_QUEUE + 64 * 8; for (int n = 0; n < budget; ++n) { const int b = bg_pull(C, ctr, CV_NB); if (b < 0) break; bg_batch(C, b); } }
__device__ __forceinline__ void bg_catch_up(const Ctx& C, int limit) { unsigned* ctr = (unsigned*)(C.ws + WS_CTL) + CW_QUEUE + 64 * 8; for (;;) { const int b = bg_pull(C, ctr, limit); if (b < 0) break; bg_batch(C, b); } }
__device__ __forceinline__ int units_missing(int nwg, int G, int c) { const int mx = (nwg + G - 1) / G, mine = c < nwg ? (nwg - c + G - 1) / G : 0; return mx - mine; }
__device__ __forceinline__ void p0_convert(const Ctx& C) {
    LAS float* scr = (LAS float*)(C.lds + C.wave * 16640);
    for (int it = C.gw; it < 2 * CV_SMALL; it += C.ngw) convert_item(C, it, scr);
    const u32x4 z4 = (u32x4){0u, 0u, 0u, 0u};
    const int gt = C.bid * 512 + C.tid, ngt = C.G * 512;
    for (int idx = gt; idx < 2 * 224 * 128; idx += ngt) { const int i = idx / (224 * 128), r = (idx / 128) % 224, ch = idx % 128;
        *(u32x4*)(WSP(bf16_t, WS_WIN) + ((size_t)i * ZP + 2592 + r) * 1024 + ch * 8) = z4; }
    for (int idx = gt; idx < 2 * 2560 * 48; idx += ngt) { const int i = idx / (2560 * 48), r = (idx / 48) % 2560, ch = idx % 48, seg = r >> 9;
        const int lo = seg < 4 ? seg * 8 : 32, hi = seg < 4 ? seg * 8 + 8 : 48;
        if (ch < lo || ch >= hi) *(u32x4*)(WSP(bf16_t, WS_WLORA) + ((size_t)i * 2560 + r) * 384 + ch * 8) = z4; }
    for (int idx = gt; idx < 2048 * 16; idx += ngt) { const int t = idx >> 4, i = idx & 15; const float pos = (float)(i < 8 ? (t >> 6) : (t & 63));
        const float inv = powf(10000.0f, -(float)(i & 7) / 8.0f); const float ang = pos * inv;
        WSP(float, WS_ROPE)[idx * 2] = cosf(ang); WSP(float, WS_ROPE)[idx * 2 + 1] = sinf(ang); }
}
__device__ __forceinline__ void p0_mod(const Ctx& C) {
    LAS float* sc = (LAS float*)C.lds;
    LAS float* part = (LAS float*)(C.lds + 36864);
    __syncthreads();
    for (int idx = C.tid; idx < 9 * 1024; idx += 512) { const int r = idx >> 10, k = idx & 1023; const float cv = r < 8 ? C.A.in[1][r * 1024 + k] : C.A.in[3][k]; sc[idx] = cv / (1.f + __expf(-cv)); }
    __syncthreads();
    for (int unit = C.bid; unit < 192; unit += C.G) {
        const int l = unit / 48, jb = unit % 48, jj = C.tid & 127, kc = C.tid >> 7;
        const float* w = C.A.in[4] + ((size_t)l * 1024 + kc * 256) * 6144 + jb * 128 + jj;
        float acc[9];
#pragma unroll
        for (int r = 0; r < 9; ++r) acc[r] = 0.f;
#pragma unroll 16
        for (int k = 0; k < 256; ++k) { const float wv = w[(size_t)k * 6144];
#pragma unroll
            for (int r = 0; r < 9; ++r) acc[r] += sc[r * 1024 + kc * 256 + k] * wv; }
#pragma unroll
        for (int r = 0; r < 9; ++r) part[(kc * 9 + r) * 128 + jj] = acc[r];
        __syncthreads();
        for (int idx = C.tid; idx < 9 * 128; idx += 512) { const int r = idx >> 7, j2 = idx & 127;
            const float s = part[(0 * 9 + r) * 128 + j2] + part[(1 * 9 + r) * 128 + j2] + part[(2 * 9 + r) * 128 + j2] + part[(3 * 9 + r) * 128 + j2] + C.A.in[5][l * 6144 + jb * 128 + j2];
            WSP(float, WS_MOD)[(size_t)(l * 9 + r) * 6144 + jb * 128 + j2] = s; }
        __syncthreads();
    }
}

__device__ __forceinline__ void row_load(const float* p, int lane, f32x4 (&v)[4]) {
#pragma unroll
    for (int j = 0; j < 4; ++j) v[j] = *(const f32x4*)(p + (lane + 64 * j) * 4); }
__device__ __forceinline__ void row_store(float* p, int lane, const f32x4 (&v)[4]) {
#pragma unroll
    for (int j = 0; j < 4; ++j) st16f(p + (lane + 64 * j) * 4, v[j]); }
__device__ __forceinline__ float row_rstd(const f32x4 (&v)[4]) {
    float s = 0.f;
#pragma unroll
    for (int j = 0; j < 4; ++j) s += (v[j].x * v[j].x + v[j].y * v[j].y) + (v[j].z * v[j].z + v[j].w * v[j].w);
    return rsqrtf(wave_sum(s) * (1.f / 1024.f) + NORM_EPS); }
__device__ __forceinline__ void row_modulate(const f32x4 (&v)[4], float rstd, const float* nw, const float* sh, const float* sc, int lane, f32x4 (&h)[4]) {
#pragma unroll
    for (int j = 0; j < 4; ++j) { const int c = (lane + 64 * j) * 4; const f32x4 w = *(const f32x4*)(nw + c), s1 = *(const f32x4*)(sc + c), s0 = *(const f32x4*)(sh + c);
        h[j] = (v[j] * rstd * w) * (s1 + 1.0f) + s0; } }
__device__ __forceinline__ void row_store_bf16(bf16_t* p, int lane, const f32x4 (&h)[4]) {
#pragma unroll
    for (int j = 0; j < 4; ++j) { u32x2 w; w.x = pk2(h[j].x, h[j].y); w.y = pk2(h[j].z, h[j].w); st8b(p + (lane + 64 * j) * 4, w); } }

__device__ __forceinline__ void p1_init(const Ctx& C) {
    for (int row = C.gw; row < NT; row += C.ngw) {
        const float* src = row < NLAT ? C.A.in[0] + (size_t)row * DM : C.A.in[2] + (size_t)(row - NLAT) * DM;
        f32x4 v[4], h[4]; row_load(src, C.lane, v);
        const int mg = mod_group(row); const float rstd = row_rstd(v);
        row_modulate(v, rstd, C.A.in[6], modp(C, 0, mg, 0), modp(C, 0, mg, 1), C.lane, h);
        row_store_bf16(WSP(bf16_t, WS_H) + (size_t)row * DM, C.lane, h);
    }
}

struct PrepRaw { u32x4 zc[3], zp[3], zn[3]; unsigned lc[3], lp[3], ln[3], q[3], zr; u32x2 kv; };
__device__ __forceinline__ void prep_load(const bf16_t* Z, int row, int lane, PrepRaw& R) {
    const bool isctx = row >= NLAT; const int t = isctx ? ((row - NLAT) & 255) : (row & 2047), T = isctx ? 256 : 2048;
    const bf16_t* z = Z + (size_t)row * ZP; const bool hp = t > 0, hn = t < T - 1; const u32x4 z4 = (u32x4){0u, 0u, 0u, 0u};
#pragma unroll
    for (int seg = 0; seg < 3; ++seg) { const int c0 = seg * 512 + lane * 8;
        R.zc[seg] = *(const u32x4*)(z + c0); R.zp[seg] = hp ? *(const u32x4*)(z - ZP + c0) : z4; R.zn[seg] = hn ? *(const u32x4*)(z + ZP + c0) : z4; }
#pragma unroll
    for (int seg = 0; seg < 3; ++seg) { const int c0 = 1536 + seg * 128 + lane * 2;
        R.lc[seg] = *(const unsigned*)(z + c0); R.lp[seg] = hp ? *(const unsigned*)(z - ZP + c0) : 0u; R.ln[seg] = hn ? *(const unsigned*)(z + ZP + c0) : 0u; }
#pragma unroll
    for (int j = 0; j < 3; ++j) R.q[j] = *(const unsigned*)(z + 1920 + j * 128 + lane * 2);
    R.kv = *(const u32x2*)(z + 2304 + lane * 4);
    R.zr = *(const unsigned*)(z + 2560 + (lane & 15) * 2);
}
__device__ __forceinline__ void prep_row(const Ctx& C, int i, int row, const PrepRaw& R, const float* mu) {
    const int lane = C.lane; const bool isctx = row >= NLAT; const int t = isctx ? ((row - NLAT) & 255) : (row & 2047);
    float r8[8], k8[8], v8[8];
#pragma unroll
    for (int seg = 0; seg < 3; ++seg) {
        const int c0 = seg * 512 + lane * 8; float zc[8], zp[8], zn[8], m0[8], m1[8];
        unpk8(R.zc[seg], zc); unpk8(R.zp[seg], zp); unpk8(R.zn[seg], zn);
        *(f32x4*)&m0[0] = *(const f32x4*)(mu + c0); *(f32x4*)&m0[4] = *(const f32x4*)(mu + c0 + 4);
        *(f32x4*)&m1[0] = *(const f32x4*)(mu + 1920 + c0); *(f32x4*)&m1[4] = *(const f32x4*)(mu + 1920 + c0 + 4);
#pragma unroll
        for (int j = 0; j < 8; ++j) { const float o = zc[j] + m0[j] * (zp[j] - zc[j]) + m1[j] * (zn[j] - zc[j]); if (seg == 0) r8[j] = o; else if (seg == 1) k8[j] = o; else v8[j] = o; }
    }
    st8(WSP(bf16_t, WS_R) + (size_t)row * ADIM + lane * 8, r8);
    st8(WSP(bf16_t, WS_KS) + (size_t)row * ADIM + lane * 8, k8);
    st8(WSP(bf16_t, WS_V) + (size_t)row * ADIM + lane * 8, v8);
    { float kk[8], ss = 0.f; const float* kkw = C.A.in[17] + i * ADIM + lane * 8;
#pragma unroll
        for (int j = 0; j < 8; ++j) { kk[j] = k8[j] * kkw[j]; ss += kk[j] * kk[j]; }
        ss = sum8(ss); const float inv = __builtin_amdgcn_rcpf(fmaxf(sqrtf(ss), 1e-12f));
#pragma unroll
        for (int j = 0; j < 8; ++j) kk[j] *= inv;
        st8(WSP(bf16_t, WS_KK) + (size_t)row * ADIM + lane * 8, kk); }
#pragma unroll
    for (int seg = 0; seg < 3; ++seg) {
        const int c0 = 1536 + seg * 128 + lane * 2; const unsigned wc_ = R.lc[seg], wp_ = R.lp[seg], wn_ = R.ln[seg];
        float o[2];
#pragma unroll
        for (int j = 0; j < 2; ++j) { const float zc = j ? __uint_as_float(wc_ & 0xffff0000u) : __uint_as_float(wc_ << 16), zp = j ? __uint_as_float(wp_ & 0xffff0000u) : __uint_as_float(wp_ << 16),
                                                  zn = j ? __uint_as_float(wn_ & 0xffff0000u) : __uint_as_float(wn_ << 16);
            const float s_ = zc + mu[c0 + j] * (zp - zc) + mu[1920 + c0 + j] * (zn - zc);
            o[j] = seg == 0 ? 2.f * sigmoidf_(2.f * s_) - 1.f : (seg == 1 ? s_ : sigmoidf_(s_)); }
        *(unsigned*)(WSP(bf16_t, WS_LIN) + (size_t)row * 384 + seg * 128 + lane * 2) = pk2(o[0], o[1]);
    }
    { float q[6], ss = 0.f;
#pragma unroll
        for (int j = 0; j < 3; ++j) { const unsigned w = R.q[j]; q[2 * j] = __uint_as_float(w << 16); q[2 * j + 1] = __uint_as_float(w & 0xffff0000u); ss += q[2 * j] * q[2 * j] + q[2 * j + 1] * q[2 * j + 1]; }
        const float rstd = rsqrtf(wave_sum(ss) * (1.f / 384.f) + NORM_EPS); const float* nw = C.A.in[22] + i * 384;
#pragma unroll
        for (int j = 0; j < 3; ++j) { const int c = j * 128 + lane * 2; *(unsigned*)(WSP(bf16_t, WS_QN) + (size_t)row * 384 + c) = pk2(q[2 * j] * rstd * nw[c], q[2 * j + 1] * rstd * nw[c + 1]); } }
    { const u32x2 w = R.kv; float q[4] = {__uint_as_float(w.x << 16), __uint_as_float(w.x & 0xffff0000u), __uint_as_float(w.y << 16), __uint_as_float(w.y & 0xffff0000u)};
        const float ss = q[0] * q[0] + q[1] * q[1] + q[2] * q[2] + q[3] * q[3];
        const float rstd = rsqrtf(wave_sum(ss) * (1.f / 256.f) + NORM_EPS); const float* nw = C.A.in[24] + i * 256 + lane * 4;
        u32x2 o; o.x = pk2(q[0] * rstd * nw[0], q[1] * rstd * nw[1]); o.y = pk2(q[2] * rstd * nw[2], q[3] * rstd * nw[3]);
        *(u32x2*)(WSP(bf16_t, WS_KVN) + (size_t)row * 256 + lane * 4) = o; }
    if (lane < 16) { const unsigned w = R.zr; float x0 = __uint_as_float(w << 16), x1 = __uint_as_float(w & 0xffff0000u);
        if (!isctx) { const float cs = WSP(const float, WS_ROPE)[(t * 16 + lane) * 2], sn = WSP(const float, WS_ROPE)[(t * 16 + lane) * 2 + 1]; const float o0 = x0 * cs - x1 * sn, o1 = x0 * sn + x1 * cs; x0 = o0; x1 = o1; }
        *(unsigned*)(WSP(bf16_t, WS_KR) + (size_t)row * 32 + lane * 2) = pk2(x0, x1); }
}
__device__ __forceinline__ void a2_prepare(const Ctx& C, int i) {
    const bf16_t* Z = WSP(const bf16_t, WS_Z);
    const float* mu = C.A.in[11] + (size_t)i * 2 * 1920;
    for (int row = C.gw; row < NT; row += 2 * C.ngw) {
        const int row2 = row + C.ngw; const bool two = row2 < NT;
        PrepRaw A, B; prep_load(Z, row, C.lane, A); if (two) prep_load(Z, row2, C.lane, B);
        prep_row(C, i, row, A, mu); if (two) prep_row(C, i, row2, B, mu);
    }
}

struct FStoreBf16 { bf16_t* O; int ldo; float scale; int scale_cols;
    struct Pre {};
    __device__ __forceinline__ void pre(int, int, Pre&) const {}
    __device__ __forceinline__ void operator()(int row, int col, const float (&v)[8], const Pre&) const { float o[8]; const float s = col < scale_cols ? scale : 1.f;
#pragma unroll
        for (int j = 0; j < 8; ++j) o[j] = v[j] * s;
        st8(O + (size_t)row * ldo + col, o); } };
struct FLora { const float* w0; const float* a0; const float* ka; const bf16_t* KS; const bf16_t* KK; float* DEC; bf16_t* KD; bf16_t* BB; bf16_t* G;
    struct Pre { u32x4 k, kk; };
    __device__ __forceinline__ void pre(int row, int col, Pre& p) const { const int seg = col >> 9, c = col & 511;
        if (seg >= 2 && seg < 4) { p.k = *(const u32x4*)(KS + (size_t)row * ADIM + c); p.kk = *(const u32x4*)(KK + (size_t)row * ADIM + c); } }
    __device__ __forceinline__ void operator()(int row, int col, const float (&v)[8], const Pre& p) const {
        const int seg = col >> 9, c = col & 511;
        if (seg < 2) { float o[8]; const f32x4 t0 = *(const f32x4*)(w0 + seg * 512 + c), t1 = *(const f32x4*)(w0 + seg * 512 + c + 4); const float t[8] = {t0.x, t0.y, t0.z, t0.w, t1.x, t1.y, t1.z, t1.w};
#pragma unroll
            for (int j = 0; j < 8; ++j) { const float x = t[j] + v[j];
                o[j] = __expf(-0.6065306597126334f * sigmoidf_(x)); }
            float* d = DEC + ((size_t)seg * NT + row) * ADIM + c; st16f(d, *(const f32x4*)&o[0]); st16f(d + 4, *(const f32x4*)&o[4]);
        } else if (seg < 4) { const int d_ = seg - 2; float k[8], kk[8], kd[8], bb[8]; unpk8(p.k, k); unpk8(p.kk, kk);
            const f32x4 t0 = *(const f32x4*)(a0 + d_ * 512 + c), t1 = *(const f32x4*)(a0 + d_ * 512 + c + 4), ka0 = *(const f32x4*)(ka + c), ka1 = *(const f32x4*)(ka + c + 4);
            const float t[8] = {t0.x, t0.y, t0.z, t0.w, t1.x, t1.y, t1.z, t1.w}, kav[8] = {ka0.x, ka0.y, ka0.z, ka0.w, ka1.x, ka1.y, ka1.z, ka1.w};
#pragma unroll
            for (int j = 0; j < 8; ++j) { const float a = sigmoidf_(t[j] + v[j]); kd[j] = k[j] * (1.f + (a - 1.f) * kav[j]); bb[j] = kk[j] * a; }
            st8(KD + ((size_t)d_ * NT + row) * ADIM + c, kd); st8(BB + ((size_t)d_ * NT + row) * ADIM + c, bb);
        } else st8(G + (size_t)row * ADIM + c, v);
    } };
struct FQup { bf16_t* Q; const float* rope; float scale;
    struct Pre { f32x4 r0, r1; };
    __device__ __forceinline__ void pre(int row, int col, Pre& p) const { const int d = col % 96;
        if (d >= 64 && row < NLAT) { const float* rp = rope + ((row & 2047) * 16 + ((d - 64) >> 1)) * 2; p.r0 = *(const f32x4*)rp; p.r1 = *(const f32x4*)(rp + 4); } }
    __device__ __forceinline__ void operator()(int row, int col, const float (&v)[8], const Pre& p) const {
        const int d = col % 96; float o[8];
#pragma unroll
        for (int j = 0; j < 8; ++j) o[j] = v[j] * scale;
        if (d >= 64 && row < NLAT) { const float cs[4] = {p.r0.x, p.r0.z, p.r1.x, p.r1.z}, sn[4] = {p.r0.y, p.r0.w, p.r1.y, p.r1.w};
#pragma unroll
            for (int q = 0; q < 4; ++q) { const float x0 = o[2 * q], x1 = o[2 * q + 1]; o[2 * q] = x0 * cs[q] - x1 * sn[q]; o[2 * q + 1] = x0 * sn[q] + x1 * cs[q]; } }
        st8(Q + (size_t)row * 768 + col, o);
    } };
struct FResid { float* X; const float* rl; const float* rc; const float* mod; int layer;
    struct Pre { f32x4 x0, x1, g0, g1; };
    __device__ __forceinline__ void pre(int row, int col, Pre& p) const { const float* g = mod + ((size_t)(layer * 9 + mod_group(row)) * 6 + 2) * 1024 + col;
        const float* x = (row < NLAT ? rl + (size_t)row * DM : rc + (size_t)(row - NLAT) * DM) + col;
        p.x0 = *(const f32x4*)x; p.x1 = *(const f32x4*)(x + 4); p.g0 = *(const f32x4*)g; p.g1 = *(const f32x4*)(g + 4); }
    __device__ __forceinline__ void operator()(int row, int col, const float (&v)[8], const Pre& p) const {
        float* x = X + (size_t)row * DM + col;
        st16f(x, p.x0 + p.g0 * (f32x4){v[0], v[1], v[2], v[3]}); st16f(x + 4, p.x1 + p.g1 * (f32x4){v[4], v[5], v[6], v[7]});
    } };
struct FSwiglu { bf16_t* HID;
    __device__ __forceinline__ void operator()(int row, int col, const float (&a)[8], const float (&b)[8]) const { float o[8];
#pragma unroll
        for (int j = 0; j < 8; ++j) o[j] = a[j] * __builtin_amdgcn_rcpf(1.f + __expf(-a[j])) * b[j];
        st8(HID + (size_t)row * FF + (col & (FF - 1)), o); } };
struct FGate { bf16_t* YB; const float* gate;
    struct Pre { float g; };
    __device__ __forceinline__ void pre(int row, int, Pre& p) const { p.g = gate[row]; }
    __device__ __forceinline__ void operator()(int row, int col, const float (&v)[8], const Pre& p) const { const float g = p.g; float o[8];
#pragma unroll
        for (int j = 0; j < 8; ++j) o[j] = v[j] * g;
        st8(YB + (size_t)row * DM + (col & (DM - 1)), o); } };

constexpr int SC_TC = 32;
constexpr int SC_ARR = SC_TC * 64, SC_BUF = 6 * SC_ARR + 2 * SC_TC;
__device__ __forceinline__ void a4_scan(const Ctx& C) {
    LAS float* L = (LAS float*)C.lds;
    LAS float* YB_ = L + 2 * SC_BUF;
    const int tid = C.tid; const bool stager = tid >= 256;
    const int rp = (tid >> 3) & 31, j = tid & 7;
    const int t2 = tid & 255, ls_ld = t2 >> 3, c8 = (t2 & 7) * 8;
    for (int unit = C.bid; unit < 128; unit += C.G) {
        const int b = unit >> 4, h = (unit >> 1) & 7, dir = unit & 1;
        const float* DEC = WSP(const float, WS_DEC) + (size_t)dir * NT * ADIM + h * 64;
        const bf16_t* KD = WSP(const bf16_t, WS_KD) + (size_t)dir * NT * ADIM + h * 64;
        const bf16_t* BB = WSP(const bf16_t, WS_BB) + (size_t)dir * NT * ADIM + h * 64;
        const bf16_t* KK = WSP(const bf16_t, WS_KK) + h * 64; const bf16_t* R = WSP(const bf16_t, WS_R) + h * 64; const bf16_t* V = WSP(const bf16_t, WS_V) + h * 64;
        float* Y = WSP(float, WS_Y) + (size_t)dir * NT * ADIM + h * 64;
        auto row_of = [&](int s_) -> int { return s_ < 256 ? NLAT + b * 256 + (dir ? 255 - s_ : s_) : b * 2048 + (dir ? 2047 - (s_ - 256) : (s_ - 256)); };
        f32x4 pw0, pw1; u32x4 pkd, pbb, pkk, pr, pv;
        auto gload = [&](int chunk) { const size_t o = (size_t)row_of(chunk * SC_TC + ls_ld) * ADIM + c8;
            pw0 = *(const f32x4*)(DEC + o); pw1 = *(const f32x4*)(DEC + o + 4); pkd = *(const u32x4*)(KD + o); pbb = *(const u32x4*)(BB + o); pkk = *(const u32x4*)(KK + o); pr = *(const u32x4*)(R + o); pv = *(const u32x4*)(V + o); };
        auto lwrite = [&](int buf) { LAS float* Bf = L + buf * SC_BUF + ls_ld * 64 + c8;
            float kd[8], bb[8], kk[8], r[8], v[8]; unpk8(pkd, kd); unpk8(pbb, bb); unpk8(pkk, kk); unpk8(pr, r); unpk8(pv, v);
            *(LAS f32x4*)(Bf) = pw0; *(LAS f32x4*)(Bf + 4) = pw1;
            *(LAS f32x4*)(Bf + SC_ARR) = *(const f32x4*)&kd[0]; *(LAS f32x4*)(Bf + SC_ARR + 4) = *(const f32x4*)&kd[4];
            *(LAS f32x4*)(Bf + 2 * SC_ARR) = *(const f32x4*)&bb[0]; *(LAS f32x4*)(Bf + 2 * SC_ARR + 4) = *(const f32x4*)&bb[4];
            *(LAS f32x4*)(Bf + 3 * SC_ARR) = *(const f32x4*)&kk[0]; *(LAS f32x4*)(Bf + 3 * SC_ARR + 4) = *(const f32x4*)&kk[4];
            *(LAS f32x4*)(Bf + 4 * SC_ARR) = pw0 * *(const f32x4*)&r[0]; *(LAS f32x4*)(Bf + 4 * SC_ARR + 4) = pw1 * *(const f32x4*)&r[4];
            *(LAS f32x4*)(Bf + 5 * SC_ARR) = *(const f32x4*)&v[0]; *(LAS f32x4*)(Bf + 5 * SC_ARR + 4) = *(const f32x4*)&v[4];
            float br = 0.f, kr = 0.f;
#pragma unroll
            for (int q = 0; q < 8; ++q) { br += bb[q] * r[q]; kr += kd[q] * r[q]; }
            br = sum8(br); kr = sum8(kr);
            if ((tid & 7) == 0) *(LAS f32x2*)(L + buf * SC_BUF + 6 * SC_ARR + ls_ld * 2) = (f32x2){br, kr}; };
        f32x2 S0[4], S1[4];
#pragma unroll
        for (int q = 0; q < 4; ++q) { S0[q] = (f32x2){0.f, 0.f}; S1[q] = (f32x2){0.f, 0.f}; }
        __syncthreads();
        if (stager) { gload(0); lwrite(0); }
        __syncthreads();
        constexpr int NCH = 2304 / SC_TC;
        for (int ch = 0; ch < NCH; ++ch) {
            if (stager) {
                if (ch > 0) { const LAS float* yp = YB_ + ((ch - 1) & 1) * SC_ARR + ls_ld * 64 + c8; float* yg = Y + (size_t)row_of((ch - 1) * SC_TC + ls_ld) * ADIM + c8;
                    st16f(yg, *(const LAS f32x4*)yp); st16f(yg + 4, *(const LAS f32x4*)(yp + 4)); }
                if (ch + 1 < NCH) { gload(ch + 1); lwrite((ch + 1) & 1); }
            } else {
                const LAS float* Bf = L + (ch & 1) * SC_BUF + j * 8;
                const LAS float* Bv = L + (ch & 1) * SC_BUF + 5 * SC_ARR + 2 * rp;
                const LAS float* Bs = L + (ch & 1) * SC_BUF + 6 * SC_ARR;
                LAS float* yb = YB_ + (ch & 1) * SC_ARR + 2 * rp;
#pragma unroll 2
                for (int ls = 0; ls < SC_TC; ++ls) {
                    const LAS float* p = Bf + ls * 64;
                    const f32x4 w0 = *(const LAS f32x4*)(p), w1 = *(const LAS f32x4*)(p + 4);
                    const f32x4 d0 = *(const LAS f32x4*)(p + SC_ARR), d1 = *(const LAS f32x4*)(p + SC_ARR + 4);
                    const f32x4 b0 = *(const LAS f32x4*)(p + 2 * SC_ARR), b1 = *(const LAS f32x4*)(p + 2 * SC_ARR + 4);
                    const f32x4 k0 = *(const LAS f32x4*)(p + 3 * SC_ARR), k1 = *(const LAS f32x4*)(p + 3 * SC_ARR + 4);
                    const f32x4 r0 = *(const LAS f32x4*)(p + 4 * SC_ARR), r1 = *(const LAS f32x4*)(p + 4 * SC_ARR + 4);
                    const f32x2 vv = *(const LAS f32x2*)(Bv + ls * 64), sc = *(const LAS f32x2*)(Bs + ls * 2);
                    const f32x2 kA = {k0.x, k0.y}, kB = {k0.z, k0.w}, kC = {k1.x, k1.y}, kD = {k1.z, k1.w}, rA = {r0.x, r0.y}, rB = {r0.z, r0.w}, rC = {r1.x, r1.y}, rD = {r1.z, r1.w};
                    f32x2 a10 = S0[0] * kA; a10 += S0[1] * kB; a10 += S0[2] * kC; a10 += S0[3] * kD;
                    f32x2 a11 = S1[0] * kA; a11 += S1[1] * kB; a11 += S1[2] * kC; a11 += S1[3] * kD;
                    f32x2 a20 = S0[0] * rA; a20 += S0[1] * rB; a20 += S0[2] * rC; a20 += S0[3] * rD;
                    f32x2 a21 = S1[0] * rA; a21 += S1[1] * rB; a21 += S1[2] * rC; a21 += S1[3] * rD;
                    float q10 = a10.x + a10.y, q11 = a11.x + a11.y, q20 = a20.x + a20.y, q21 = a21.x + a21.y;
                    q10 += dpp_f<0xB1>(q10); q11 += dpp_f<0xB1>(q11); q20 += dpp_f<0xB1>(q20); q21 += dpp_f<0xB1>(q21);
                    q10 += dpp_f<0x4E>(q10); q11 += dpp_f<0x4E>(q11); q20 += dpp_f<0x4E>(q20); q21 += dpp_f<0x4E>(q21);
                    q10 += dpp_f<0x141>(q10); q11 += dpp_f<0x141>(q11); q20 += dpp_f<0x141>(q20); q21 += dpp_f<0x141>(q21);
                    const float sa0 = -q10, sa1 = -q11;
                    const f32x2 y2 = {q20 + sa0 * sc.x + vv.x * sc.y, q21 + sa1 * sc.x + vv.y * sc.y};
                    const f32x2 sA = {sa0, sa0}, sB = {sa1, sa1}, vA = {vv.x, vv.x}, vB = {vv.y, vv.y};
                    const f32x2 wA = {w0.x, w0.y}, wB = {w0.z, w0.w}, wC = {w1.x, w1.y}, wD = {w1.z, w1.w}, bA = {b0.x, b0.y}, bB = {b0.z, b0.w}, bC = {b1.x, b1.y}, bD = {b1.z, b1.w};
                    const f32x2 dA = {d0.x, d0.y}, dB = {d0.z, d0.w}, dC = {d1.x, d1.y}, dD = {d1.z, d1.w};
                    S0[0] = S0[0] * wA + sA * bA + vA * dA; S0[1] = S0[1] * wB + sA * bB + vA * dB; S0[2] = S0[2] * wC + sA * bC + vA * dC; S0[3] = S0[3] * wD + sA * bD + vA * dD;
                    S1[0] = S1[0] * wA + sB * bA + vB * dA; S1[1] = S1[1] * wB + sB * bB + vB * dB; S1[2] = S1[2] * wC + sB * bC + vB * dC; S1[3] = S1[3] * wD + sB * bD + vB * dD;
                    *(LAS f32x2*)(yb + ls * 64) = y2;
                }
            }
            __syncthreads();
        }
        if (stager) { const LAS float* yp = YB_ + ((NCH - 1) & 1) * SC_ARR + ls_ld * 64 + c8; float* yg = Y + (size_t)row_of((NCH - 1) * SC_TC + ls_ld) * ADIM + c8;
            st16f(yg, *(const LAS f32x4*)yp); st16f(yg + 4, *(const LAS f32x4*)(yp + 4)); }
    }
}

__device__ __forceinline__ void a4_mla_naive(const Ctx& C) {
    LAS float* Kt = (LAS float*)C.lds;
    LAS float* Vt = Kt + 32 * 96;
    const bf16_t* Q = WSP(const bf16_t, WS_Q); const bf16_t* KV = WSP(const bf16_t, WS_KV); const bf16_t* KR = WSP(const bf16_t, WS_KR); bf16_t* MIX = WSP(bf16_t, WS_MIX);
    const int tid = C.tid;
    for (int unit = C.bid; unit < 320; unit += C.G) {
        int b, h, qrow, nkeys; bool active = true;
        if (unit < 256) { b = unit >> 5; h = (unit >> 2) & 7; qrow = b * 2048 + (unit & 3) * 512 + tid; nkeys = 2304; }
        else { const int u = unit - 256; b = u >> 3; h = u & 7; qrow = NLAT + b * 256 + (tid & 255); nkeys = 256; active = tid < 256; }
        float q[96], acc[64], m = -1e30f, l = 0.f;
#pragma unroll
        for (int d8 = 0; d8 < 12; ++d8) { float t8[8]; ld8(Q + (size_t)qrow * 768 + h * 96 + d8 * 8, t8);
#pragma unroll
            for (int jj = 0; jj < 8; ++jj) q[d8 * 8 + jj] = t8[jj]; }
#pragma unroll
        for (int d = 0; d < 64; ++d) acc[d] = 0.f;
        for (int kt = 0; kt < nkeys; kt += 32) {
            __syncthreads();
            for (int idx = tid; idx < 32 * 48; idx += 512) { const int key = idx / 48, dp = idx % 48, kj = kt + key; const int krow = kj < 256 ? NLAT + b * 256 + kj : b * 2048 + (kj - 256);
                const unsigned w = dp < 32 ? *(const unsigned*)(KV + (size_t)krow * 1024 + h * 128 + dp * 2) : *(const unsigned*)(KR + (size_t)krow * 32 + (dp - 32) * 2);
                Kt[key * 96 + dp * 2] = __uint_as_float(w << 16); Kt[key * 96 + dp * 2 + 1] = __uint_as_float(w & 0xffff0000u); }
            for (int idx = tid; idx < 32 * 32; idx += 512) { const int key = idx >> 5, dp = idx & 31, kj = kt + key; const int krow = kj < 256 ? NLAT + b * 256 + kj : b * 2048 + (kj - 256);
                const unsigned w = *(const unsigned*)(KV + (size_t)krow * 1024 + h * 128 + 64 + dp * 2);
                Vt[key * 64 + dp * 2] = __uint_as_float(w << 16); Vt[key * 64 + dp * 2 + 1] = __uint_as_float(w & 0xffff0000u); }
            __syncthreads();
            for (int key = 0; key < 32; ++key) {
                float s = 0.f;
#pragma unroll
                for (int d4 = 0; d4 < 24; ++d4) { const f32x4 kv = *(const LAS f32x4*)(Kt + key * 96 + d4 * 4); s += q[d4 * 4] * kv.x + q[d4 * 4 + 1] * kv.y + q[d4 * 4 + 2] * kv.z + q[d4 * 4 + 3] * kv.w; }
                const float mn = fmaxf(m, s), corr = __expf(m - mn), p = __expf(s - mn); m = mn; l = l * corr + p;
#pragma unroll
                for (int d4 = 0; d4 < 16; ++d4) { const f32x4 vv = *(const LAS f32x4*)(Vt + key * 64 + d4 * 4);
                    acc[d4 * 4] = acc[d4 * 4] * corr + p * vv.x; acc[d4 * 4 + 1] = acc[d4 * 4 + 1] * corr + p * vv.y; acc[d4 * 4 + 2] = acc[d4 * 4 + 2] * corr + p * vv.z; acc[d4 * 4 + 3] = acc[d4 * 4 + 3] * corr + p * vv.w; }
            }
        }
        if (active) { const float il = 1.f / l;
#pragma unroll
            for (int d8 = 0; d8 < 8; ++d8) { float o[8];
#pragma unroll
                for (int jj = 0; jj < 8; ++jj) o[jj] = acc[d8 * 8 + jj] * il;
                st8(MIX + (size_t)qrow * DM + 512 + h * 64 + d8 * 8, o); } }
    }
    __syncthreads();
}

typedef float f32x16 __attribute__((ext_vector_type(16)));
__device__ __forceinline__ int crow(int r, int hi) { return (r & 3) + 8 * (r >> 2) + 4 * hi; }
constexpr int AT_VP = 136;
template <class Spec> __device__ __forceinline__ void attn_unit(const Ctx& C, const Spec& sp) {
    constexpr int DQ = Spec::DQ, NS = DQ / 16, KP = Spec::KPITCH, KBUF = 64 * KP, VBUF = 64 * AT_VP, BUF = KBUF + VBUF;
    static_assert(BUF % 16 == 0 && KP % 16 == 0, "alignment");
    LAS unsigned char* L = C.lds;
    const int tid = C.tid, lane = C.lane, w = C.wave, r32 = lane & 31, hi = lane >> 5;
    bf16x8 qf[NS];
    { const bf16_t* qp = sp.qptr(w * 32 + r32);
#pragma unroll
      for (int s_ = 0; s_ < NS; ++s_) qf[s_] = *(const bf16x8*)(qp + 16 * s_ + 8 * hi); }
    f32x16 o0, o1;
#pragma unroll
    for (int r = 0; r < 16; ++r) { o0[r] = 0.f; o1[r] = 0.f; }
    float m = -1e30f, lsum = 0.f;
    const int nt = sp.nt;
    const int skey = tid >> 3, sch = tid & 7, rkey = (tid >> 2) & 63, rch = 8 + (tid & 3);
    struct Stg { u32x4 gk, gk2, gv; } sa_, sb_;
    sa_.gk2 = (u32x4){0u, 0u, 0u, 0u}; sb_.gk2 = (u32x4){0u, 0u, 0u, 0u};
    auto gload = [&](int t, Stg& g_) { g_.gk = *(const u32x4*)sp.kptr(t, skey, sch); if (NS > 4 && tid < 256) g_.gk2 = *(const u32x4*)sp.kptr(t, rkey, rch); g_.gv = *(const u32x4*)sp.vptr(t, skey, sch); };
    auto lwrite = [&](int buf, const Stg& g_) { const u32x4 gk = g_.gk, gk2 = g_.gk2, gv = g_.gv; LAS unsigned char* Bk = L + buf * BUF;
        *(LAS u32x4*)(Bk + skey * KP + sch * 16) = gk; if (NS > 4 && tid < 256) *(LAS u32x4*)(Bk + rkey * KP + rch * 16) = gk2;
        LAS unsigned short* Bv = (LAS unsigned short*)(Bk + KBUF);
#pragma unroll
        for (int j = 0; j < 8; ++j) { const unsigned wv = gv[j >> 1]; Bv[(sch * 8 + j) * (AT_VP / 2) + skey] = (unsigned short)((j & 1) ? (wv >> 16) : (wv & 0xffffu)); } };
    __syncthreads();
    sp.prologue(C);
    gload(0, sa_); if (nt > 1) gload(1, sb_); lwrite(0, sa_);
    __syncthreads();
    auto compute = [&](int t) {
        if (sp.active(t, w)) {
            const LAS unsigned char* Bk = L + (t & 1) * BUF; const LAS unsigned char* Bv = Bk + KBUF;
            f32x16 p0, p1;
#pragma unroll
            for (int r = 0; r < 16; ++r) { p0[r] = 0.f; p1[r] = 0.f; }
#pragma unroll
            for (int s_ = 0; s_ < NS; ++s_) {
                const bf16x8 k0 = *(const LAS bf16x8*)(Bk + r32 * KP + 32 * s_ + 16 * hi), k1 = *(const LAS bf16x8*)(Bk + (32 + r32) * KP + 32 * s_ + 16 * hi);
                p0 = __builtin_amdgcn_mfma_f32_32x32x16_bf16(k0, qf[s_], p0, 0, 0, 0); p1 = __builtin_amdgcn_mfma_f32_32x32x16_bf16(k1, qf[s_], p1, 0, 0, 0); }
            sp.bias(C, t, w, r32, hi, p0, p1);
            float mx = fmaxf(p0[0], p1[0]);
#pragma unroll
            for (int r = 1; r < 16; ++r) mx = fmaxf(mx, fmaxf(p0[r], p1[r]));
            mx = fmaxf(mx, __shfl_xor(mx, 32));
            if (__any(mx > m + 8.0f)) {
                const float mn = fmaxf(m, mx), corr = __builtin_amdgcn_exp2f(m - mn); m = mn; lsum *= corr;
#pragma unroll
                for (int r = 0; r < 16; ++r) { o0[r] *= corr; o1[r] *= corr; }
            }
            float ps = 0.f;
#pragma unroll
            for (int r = 0; r < 16; ++r) { p0[r] = __builtin_amdgcn_exp2f(p0[r] - m); p1[r] = __builtin_amdgcn_exp2f(p1[r] - m); ps += p0[r] + p1[r]; }
            lsum += ps;
#pragma unroll
            for (int s_ = 0; s_ < 4; ++s_) {
                u32x4 pw;
                if (s_ < 2) { pw.x = pk2(p0[8 * s_ + 0], p0[8 * s_ + 1]); pw.y = pk2(p0[8 * s_ + 2], p0[8 * s_ + 3]); pw.z = pk2(p0[8 * s_ + 4], p0[8 * s_ + 5]); pw.w = pk2(p0[8 * s_ + 6], p0[8 * s_ + 7]); }
                else { const int q_ = 8 * (s_ - 2); pw.x = pk2(p1[q_ + 0], p1[q_ + 1]); pw.y = pk2(p1[q_ + 2], p1[q_ + 3]); pw.z = pk2(p1[q_ + 4], p1[q_ + 5]); pw.w = pk2(p1[q_ + 6], p1[q_ + 7]); }
                const bf16x8 pb = __builtin_bit_cast(bf16x8, pw);
#pragma unroll
                for (int dvh = 0; dvh < 2; ++dvh) {
                    const LAS unsigned char* vp = Bv + (dvh * 32 + r32) * AT_VP + 32 * s_ + 8 * hi;
                    const u32x2 a = *(const LAS u32x2*)vp, b = *(const LAS u32x2*)(vp + 16);
                    const bf16x8 vf = __builtin_bit_cast(bf16x8, (u32x4){a.x, a.y, b.x, b.y});
                    if (dvh == 0) o0 = __builtin_amdgcn_mfma_f32_32x32x16_bf16(vf, pb, o0, 0, 0, 0); else o1 = __builtin_amdgcn_mfma_f32_32x32x16_bf16(vf, pb, o1, 0, 0, 0);
                }
            }
        }
    };
    for (int t = 0; t < nt; t += 2) {
        if (t + 2 < nt) gload(t + 2, sa_);
        compute(t);
        if (t + 1 < nt) lwrite(1, sb_);
        __syncthreads();
        if (t + 1 >= nt) break;
        if (t + 3 < nt) gload(t + 3, sb_);
        compute(t + 1);
        if (t + 2 < nt) lwrite(0, sa_);
        __syncthreads();
    }
    lsum += __shfl_xor(lsum, 32);
    const float il = 1.f / lsum;
    bf16_t* op = sp.optr(w * 32 + r32);
#pragma unroll
    for (int g = 0; g < 4; ++g) { u32x2 w0, w1;
        w0.x = pk2(o0[4 * g] * il, o0[4 * g + 1] * il); w0.y = pk2(o0[4 * g + 2] * il, o0[4 * g + 3] * il);
        w1.x = pk2(o1[4 * g] * il, o1[4 * g + 1] * il); w1.y = pk2(o1[4 * g + 2] * il, o1[4 * g + 3] * il);
        st8b(op + 8 * g + 4 * hi, w0); st8b(op + 32 + 8 * g + 4 * hi, w1); }
}
struct MlaSpec { static constexpr int DQ = 96, KPITCH = 208;
    const bf16_t* Q; const bf16_t* KV; const bf16_t* KR; bf16_t* O; int b, h, q0, nt;
    __device__ __forceinline__ const bf16_t* qptr(int i) const { return Q + (size_t)(q0 + i) * 768 + h * 96; }
    __device__ __forceinline__ bf16_t* optr(int i) const { return O + (size_t)(q0 + i) * DM + 512 + h * 64; }
    __device__ __forceinline__ int krow(int t, int key) const { return t < 4 ? NLAT + b * 256 + 64 * t + key : b * 2048 + 64 * (t - 4) + key; }
    __device__ __forceinline__ const bf16_t* kptr(int t, int key, int c) const { const int kr = krow(t, key); return c < 8 ? KV + (size_t)kr * 1024 + h * 128 + c * 8 : KR + (size_t)kr * 32 + (c - 8) * 8; }
    __device__ __forceinline__ const bf16_t* vptr(int t, int key, int c) const { return KV + (size_t)krow(t, key) * 1024 + h * 128 + 64 + c * 8; }
    __device__ __forceinline__ bool active(int, int) const { return true; }
    __device__ __forceinline__ void prologue(const Ctx&) const {}
    __device__ __forceinline__ void bias(const Ctx&, int, int, int, int, f32x16&, f32x16&) const {}
};
struct NaSpec { static constexpr int DQ = 64, KPITCH = 144; static constexpr int TAB_OFF = 2 * (64 * 144 + 64 * AT_VP);
    const bf16_t* QKV; bf16_t* O; const float* rpb; int b, h, rb, kr0, ntw, nt, isctx;
    __device__ __forceinline__ const bf16_t* qptr(int i) const { return QKV + (size_t)(isctx ? NLAT + b * 256 + i : b * 2048 + rb * 256 + i) * 3072 + h * 64; }
    __device__ __forceinline__ bf16_t* optr(int i) const { return O + (size_t)(isctx ? NLAT + b * 256 + i : b * 2048 + rb * 256 + i) * DM + h * 64; }
    __device__ __forceinline__ int krow(int t, int key) const { return t < ntw ? b * 2048 + (kr0 + t) * 64 + key : NLAT + b * 256 + 64 * (t - ntw) + key; }
    __device__ __forceinline__ const bf16_t* kptr(int t, int key, int c) const { return QKV + (size_t)krow(t, key) * 3072 + 1024 + h * 64 + c * 8; }
    __device__ __forceinline__ const bf16_t* vptr(int t, int key, int c) const { return QKV + (size_t)krow(t, key) * 3072 + 2048 + h * 64 + c * 8; }
    __device__ __forceinline__ bool active(int t, int w) const { if (t >= ntw) return true; const int qr = 4 * rb + (w >> 1), rs = min(max(qr - 4, 0), 24), kr = kr0 + t; return kr >= rs && kr < rs + 8; }
    __device__ __forceinline__ void prologue(const Ctx& C) const { if (!isctx) { LAS float* tab = (LAS float*)(C.lds + TAB_OFF); for (int idx = C.tid; idx < 640; idx += 512) { const int k = idx - 64; tab[idx] = (k >= 0 && k < 465) ? rpb[h * 465 + k] * 1.4426950408889634f : 0.f; } } }
    __device__ __forceinline__ void bias(const Ctx& C, int t, int w, int r32, int hi, f32x16& p0, f32x16& p1) const {
        if (t >= ntw) return;
        const LAS float* tab = (const LAS float*)(C.lds + TAB_OFF);
        const int qr = 4 * rb + (w >> 1), qc = 32 * (w & 1) + r32, cs = min(max(qc - 8, 0), 48), ro = (kr0 + t - qr + 7) * 31 - qc + 15 + 64;
        const volatile LAS float* tb = tab + ro + 4 * hi; const int kb = 4 * hi - cs;
        float bv0[16], bv1[16];
#pragma unroll
        for (int r = 0; r < 16; ++r) { const int c = (r & 3) + 8 * (r >> 2); bv0[r] = tb[c]; bv1[r] = tb[c + 32]; }
#pragma unroll
        for (int r = 0; r < 16; ++r) { const int c = (r & 3) + 8 * (r >> 2);
            const bool v0 = (unsigned)(c + kb) < 16u, v1 = (unsigned)(c + 32 + kb) < 16u;
            p0[r] = v0 ? p0[r] + bv0[r] : -INFINITY; p1[r] = v1 ? p1[r] + bv1[r] : -INFINITY; }
    }
};
__device__ __forceinline__ void a4_mla(const Ctx& C, int layer) {
    volatile LAS int* slot = (volatile LAS int*)(C.lds + LDSCTL_OFF + 64);
    unsigned* ctr = (unsigned*)(C.ws + WS_CTL) + CW_QUEUE + 64 * layer;
    for (;;) {
        __syncthreads();
        if (C.tid == 0) slot[0] = (int)__hip_atomic_fetch_add(ctr, 1u, __ATOMIC_RELAXED, __HIP_MEMORY_SCOPE_AGENT);
        __syncthreads();
        const int unit = slot[0];
        if (unit >= 512 + 64) break;
        MlaSpec sp; sp.Q = WSP(const bf16_t, WS_Q); sp.KV = WSP(const bf16_t, WS_KV); sp.KR = WSP(const bf16_t, WS_KR); sp.O = WSP(bf16_t, WS_MIX);
        if (unit < 512) { sp.b = unit >> 6; sp.h = (unit >> 3) & 7; sp.q0 = sp.b * 2048 + (unit & 7) * 256; sp.nt = 36; }
        else { const int u = unit - 512; sp.b = u >> 3; sp.h = u & 7; sp.q0 = NLAT + sp.b * 256; sp.nt = 4; }
        attn_unit(C, sp);
    }
}
__device__ __forceinline__ void b2_na(const Ctx& C, int i, bool need_ctx) {
    for (int unit = C.bid; unit < 1024 + (need_ctx ? 128 : 0); unit += C.G) {
        NaSpec sp; sp.QKV = WSP(const bf16_t, WS_Z); sp.O = WSP(bf16_t, WS_MIX); sp.rpb = C.A.in[27] + (size_t)i * 16 * 465;
        if (unit < 1024) { sp.b = unit >> 7; sp.h = (unit >> 3) & 15; sp.rb = unit & 7; sp.isctx = 0;
            sp.kr0 = min(max(4 * sp.rb - 4, 0), 24); const int krl = min(max(4 * sp.rb + 3 - 4, 0), 24) + 7; sp.ntw = krl - sp.kr0 + 1; sp.nt = sp.ntw + 4; }
        else { const int u = unit - 1024; sp.b = u >> 4; sp.h = u & 15; sp.rb = 0; sp.isctx = 1; sp.kr0 = 0; sp.ntw = 0; sp.nt = 4; }
        attn_unit(C, sp);
    }
}

__device__ __forceinline__ void a5_output(const Ctx& C, int i) {
    const int lane = C.lane, c0 = lane * 8;
    const float* rk = C.A.in[19] + i * ADIM + c0; const float* lnw = C.A.in[20] + i * ADIM + c0; const float* lnb = C.A.in[21] + i * ADIM + c0;
    for (int row = C.gw; row < NT; row += C.ngw) {
        const float* yf = WSP(const float, WS_Y) + (size_t)row * ADIM + c0; const float* yb = yf + (size_t)NT * ADIM;
        float y[8]; { const f32x4 a0 = *(const f32x4*)yf, a1 = *(const f32x4*)(yf + 4), b0 = *(const f32x4*)yb, b1 = *(const f32x4*)(yb + 4);
            y[0] = a0.x + b0.x; y[1] = a0.y + b0.y; y[2] = a0.z + b0.z; y[3] = a0.w + b0.w; y[4] = a1.x + b1.x; y[5] = a1.y + b1.y; y[6] = a1.z + b1.z; y[7] = a1.w + b1.w; }
        float s = 0.f;
#pragma unroll
        for (int j = 0; j < 8; ++j) s += y[j];
        const float mean = sum8(s) * (1.f / 64.f); float q = 0.f;
#pragma unroll
        for (int j = 0; j < 8; ++j) { const float d = y[j] - mean; q += d * d; }
        const float rstd = rsqrtf(sum8(q) * (1.f / 64.f) + 64e-5f);
        float r[8], v[8], g[8], kd0[8], kd1[8];
        ld8(WSP(const bf16_t, WS_R) + (size_t)row * ADIM + c0, r); ld8(WSP(const bf16_t, WS_V) + (size_t)row * ADIM + c0, v); ld8(WSP(const bf16_t, WS_G) + (size_t)row * ADIM + c0, g);
        ld8(WSP(const bf16_t, WS_KD) + (size_t)row * ADIM + c0, kd0); ld8(WSP(const bf16_t, WS_KD) + ((size_t)NT + row) * ADIM + c0, kd1);
        float bs = 0.f;
#pragma unroll
        for (int j = 0; j < 8; ++j) bs += r[j] * (kd0[j] + kd1[j]) * rk[j];
        bs = sum8(bs);
        float o[8];
#pragma unroll
        for (int j = 0; j < 8; ++j) o[j] = ((y[j] - mean) * rstd * lnw[j] + lnb[j] + bs * v[j]) * g[j];
        st8(WSP(bf16_t, WS_MIX) + (size_t)row * DM + c0, o);
    }
}

__device__ __forceinline__ void b2_na_naive(const Ctx& C, int i, bool need_ctx) {
    const bf16_t* QKV = WSP(const bf16_t, WS_Z); bf16_t* MIX = WSP(bf16_t, WS_MIX);
    const float* rpb = C.A.in[27] + (size_t)i * 16 * 15 * 31;
    const int nq = need_ctx ? NT : NLAT;
    const int nblk = nq / 512;
    for (int unit = C.bid; unit < nblk * 16; unit += C.G) {
        const int h = unit & 15, qrow = (unit >> 4) * 512 + C.tid;
        float q[64], acc[64], m = -1e30f, l = 0.f;
#pragma unroll
        for (int d8 = 0; d8 < 8; ++d8) { float t8[8]; ld8(QKV + (size_t)qrow * 3072 + h * 64 + d8 * 8, t8);
#pragma unroll
            for (int jj = 0; jj < 8; ++jj) q[d8 * 8 + jj] = t8[jj]; }
#pragma unroll
        for (int d = 0; d < 64; ++d) acc[d] = 0.f;
        const bool isctx = qrow >= NLAT; const int b = isctx ? (qrow - NLAT) >> 8 : qrow >> 11;
        int qr = 0, qc = 0, rs = 0, cs = 0, nwin = 0;
        if (!isctx) { const int t = qrow & 2047; qr = t >> 6; qc = t & 63; rs = min(max(qr - 4, 0), 24); cs = min(max(qc - 8, 0), 48); nwin = 128; }
        const int nk = nwin + 256;
        for (int kj = 0; kj < nk; ++kj) {
            int krow; float bias = 0.f;
            if (kj < nwin) { const int kr = rs + (kj >> 4), kc = cs + (kj & 15); krow = b * 2048 + kr * 64 + kc; bias = rpb[(h * 15 + (kr - qr + 7)) * 31 + (kc - qc + 15)]; }
            else krow = NLAT + b * 256 + (kj - nwin);
            const bf16_t* kp = QKV + (size_t)krow * 3072 + 1024 + h * 64; const bf16_t* vp = kp + 1024;
            float s = 0.f;
#pragma unroll
            for (int d8 = 0; d8 < 8; ++d8) { float t8[8]; ld8(kp + d8 * 8, t8);
#pragma unroll
                for (int jj = 0; jj < 8; ++jj) s += q[d8 * 8 + jj] * t8[jj]; }
            s += bias;
            const float mn = fmaxf(m, s), corr = __expf(m - mn), p = __expf(s - mn); m = mn; l = l * corr + p;
#pragma unroll
            for (int d8 = 0; d8 < 8; ++d8) { float t8[8]; ld8(vp + d8 * 8, t8);
#pragma unroll
                for (int jj = 0; jj < 8; ++jj) acc[d8 * 8 + jj] = acc[d8 * 8 + jj] * corr + p * t8[jj]; }
        }
        const float il = 1.f / l;
#pragma unroll
        for (int d8 = 0; d8 < 8; ++d8) { float o[8];
#pragma unroll
            for (int jj = 0; jj < 8; ++jj) o[jj] = acc[d8 * 8 + jj] * il;
            st8(MIX + (size_t)qrow * DM + h * 64 + d8 * 8, o); }
    }
}

template <int CTRL, int N> __device__ __forceinline__ void tr_step_dpp(const float (&in)[2 * N], float (&out)[N], bool bit) {
#pragma unroll
    for (int k = 0; k < N; ++k) { const float keep = bit ? in[k + N] : in[k], give = bit ? in[k] : in[k + N]; out[k] = keep + dpp_f<CTRL>(give); } }
__device__ __forceinline__ void c2_router(const Ctx& C, int layer, int nrows) {
    const float* rw = C.A.in[29] + (size_t)layer * DM * NEXP; const int lane = C.lane;
    LAS float* scr = (LAS float*)(C.lds + C.wave * 256);
    const float* nw = C.A.in[7] + layer * DM;
    for (int grp = C.gw; grp < nrows / 4; grp += C.ngw) {
        const int row0 = grp * 4, mg = mod_group(row0);
        const float* sh = modp(C, layer, mg, 3); const float* sc = modp(C, layer, mg, 4);
        f32x4 h[4][4];
#pragma unroll
        for (int rr = 0; rr < 4; ++rr) row_load(WSP(const float, WS_X) + (size_t)(row0 + rr) * DM, lane, h[rr]);
#pragma unroll
        for (int rr = 0; rr < 4; ++rr) { const float rstd = row_rstd(h[rr]); f32x4 t[4]; row_modulate(h[rr], rstd, nw, sh, sc, lane, t);
#pragma unroll
            for (int j = 0; j < 4; ++j) h[rr][j] = t[j];
            row_store_bf16(WSP(bf16_t, WS_H) + (size_t)(row0 + rr) * DM, lane, h[rr]); }
        float lg[64];
#pragma unroll
        for (int k = 0; k < 64; ++k) lg[k] = 0.f;
#pragma unroll
        for (int j = 0; j < 4; ++j)
#pragma unroll
            for (int q = 0; q < 4; ++q) { const float* wr_ = rw + (size_t)((lane + 64 * j) * 4 + q) * NEXP;
                const f32x4 w0 = *(const f32x4*)(wr_), w1 = *(const f32x4*)(wr_ + 4), w2 = *(const f32x4*)(wr_ + 8), w3 = *(const f32x4*)(wr_ + 12);
#pragma unroll
                for (int rr = 0; rr < 4; ++rr) { const float hv = h[rr][j][q]; float* l = lg + rr * 16;
                    l[0] += hv * w0.x; l[1] += hv * w0.y; l[2] += hv * w0.z; l[3] += hv * w0.w; l[4] += hv * w1.x; l[5] += hv * w1.y; l[6] += hv * w1.z; l[7] += hv * w1.w;
                    l[8] += hv * w2.x; l[9] += hv * w2.y; l[10] += hv * w2.z; l[11] += hv * w2.w; l[12] += hv * w3.x; l[13] += hv * w3.y; l[14] += hv * w3.z; l[15] += hv * w3.w; } }
        float r1[32], r2[16], r3[8], r4[4], r5[2];
        tr_step_dpp<0x140, 32>(lg, r1, (lane >> 3) & 1); tr_step_dpp<0x141, 16>(r1, r2, (lane >> 2) & 1); tr_step_dpp<0x4E, 8>(r2, r3, (lane >> 1) & 1); tr_step_dpp<0xB1, 4>(r3, r4, lane & 1);
        { const bool bit = (lane >> 4) & 1;
#pragma unroll
          for (int k = 0; k < 2; ++k) { const float keep = bit ? r4[k + 2] : r4[k], give = bit ? r4[k] : r4[k + 2]; r5[k] = keep + __shfl_xor(give, 16); } }
        float lgt; { const bool bit = (lane >> 5) & 1; const float keep = bit ? r5[1] : r5[0], give = bit ? r5[0] : r5[1]; lgt = keep + __shfl_xor(give, 32); }
        const int idx = (((lane >> 3) & 1) << 5) | (((lane >> 2) & 1) << 4) | (((lane >> 1) & 1) << 3) | ((lane & 1) << 2) | (((lane >> 4) & 1) << 1) | ((lane >> 5) & 1);
        scr[idx] = lgt;
        asm volatile("s_waitcnt lgkmcnt(0)" ::: "memory");
        const int rr = idx >> 4, e = idx & 15;
        const f32x4 a0 = *(const LAS f32x4*)(scr + rr * 16), a1 = *(const LAS f32x4*)(scr + rr * 16 + 4), a2 = *(const LAS f32x4*)(scr + rr * 16 + 8), a3 = *(const LAS f32x4*)(scr + rr * 16 + 12);
        asm volatile("s_waitcnt lgkmcnt(0)" ::: "memory");
        const float mx = fmaxf(fmaxf(fmaxf(fmaxf(a0.x, a0.y), fmaxf(a0.z, a0.w)), fmaxf(fmaxf(a1.x, a1.y), fmaxf(a1.z, a1.w))), fmaxf(fmaxf(fmaxf(a2.x, a2.y), fmaxf(a2.z, a2.w)), fmaxf(fmaxf(a3.x, a3.y), fmaxf(a3.z, a3.w))));
        const float den = ((__expf(a0.x - mx) + __expf(a0.y - mx)) + (__expf(a0.z - mx) + __expf(a0.w - mx))) + ((__expf(a1.x - mx) + __expf(a1.y - mx)) + (__expf(a1.z - mx) + __expf(a1.w - mx)))
                        + ((__expf(a2.x - mx) + __expf(a2.y - mx)) + (__expf(a2.z - mx) + __expf(a2.w - mx))) + ((__expf(a3.x - mx) + __expf(a3.y - mx)) + (__expf(a3.z - mx) + __expf(a3.w - mx)));
        const float a = __expf(lgt - mx) * __builtin_amdgcn_rcpf(den);
        const int row = row0 + rr; float* AFF = WSP(float, WS_AFF);
        if (row < NLAT) AFF[((size_t)(row >> 11) * 16 + e) * 2048 + (row & 2047)] = a;
        else { const int r2_ = row - NLAT; AFF[(size_t)NB * 16 * 2048 + ((size_t)(r2_ >> 8) * 16 + e) * 256 + (r2_ & 255)] = a; }
    }
}

__device__ __forceinline__ void c3_topk(const Ctx& C, bool need_ctx) {
    LAS unsigned* cntw = (LAS unsigned*)C.lds;
    LAS unsigned* wtot = (LAS unsigned*)(C.lds + 256);
    LAS int* list = (LAS int*)(C.lds + 1024);
    const int nunits = 128 + (need_ctx ? 128 : 0), tid = C.tid, lane = C.lane, w = C.wave;
    const unsigned long long lt = (1ull << lane) - 1ull;
    for (int unit = C.bid; unit < nunits; unit += C.G) {
        const bool lat = unit < 128; const int u = lat ? unit : unit - 128, b = u >> 4, e = u & 15, n = lat ? 2048 : 256; const unsigned cap = lat ? 256u : 32u;
        const float* src = lat ? WSP(const float, WS_AFF) + ((size_t)b * 16 + e) * 2048 : WSP(const float, WS_AFF) + (size_t)NB * 16 * 2048 + ((size_t)b * 16 + e) * 256;
        const bool valid = 4 * tid < n;
        unsigned key[4] = {0u, 0u, 0u, 0u};
        if (valid) { const u32x4 kv = *(const u32x4*)(src + 4 * tid); key[0] = kv.x; key[1] = kv.y; key[2] = kv.z; key[3] = kv.w; }
        __syncthreads();
        if (tid < 64) cntw[tid] = 0u;
        __syncthreads();
        unsigned T = 0u;
        for (int bit = 29; bit >= 0; --bit) {
            const unsigned cand = T | (1u << bit); unsigned c = 0u;
#pragma unroll
            for (int q = 0; q < 4; ++q) c += (unsigned)__popcll(__ballot(key[q] >= cand));
            if (lane == 0 && c) atomicAdd((unsigned*)&cntw[bit], c);
            __syncthreads();
            if (cntw[bit] >= cap) T = cand;
        }
        unsigned long long bg[4], be[4]; unsigned cg = 0u, ce = 0u;
#pragma unroll
        for (int q = 0; q < 4; ++q) { bg[q] = __ballot(key[q] > T); be[q] = __ballot(valid && key[q] == T); cg += (unsigned)__popcll(bg[q]); ce += (unsigned)__popcll(be[q]); }
        if (lane == 0) { wtot[w] = cg; wtot[8 + w] = ce; }
        __syncthreads();
        unsigned tg = 0u, eoff = 0u;
#pragma unroll
        for (int k = 0; k < 8; ++k) { tg += wtot[k]; eoff += k < w ? wtot[8 + k] : 0u; }
        const unsigned need = cap - tg;
        bool selq[4]; unsigned long long bs[4]; unsigned cs_ = 0u;
#pragma unroll
        for (int q = 0; q < 4; ++q) { unsigned er = eoff;
#pragma unroll
            for (int q2 = 0; q2 < 4; ++q2) er += (unsigned)__popcll(be[q2] & lt) + ((q2 < q && ((be[q2] >> lane) & 1ull)) ? 1u : 0u);
            selq[q] = key[q] > T || (valid && key[q] == T && er < need); bs[q] = __ballot(selq[q]); cs_ += (unsigned)__popcll(bs[q]); }
        if (lane == 0) wtot[16 + w] = cs_;
        __syncthreads();
        unsigned soff = 0u;
#pragma unroll
        for (int k = 0; k < 8; ++k) soff += k < w ? wtot[16 + k] : 0u;
        if (valid) {
            int gsel[4];
#pragma unroll
            for (int q = 0; q < 4; ++q) { unsigned sl = soff;
#pragma unroll
                for (int q2 = 0; q2 < 4; ++q2) sl += (unsigned)__popcll(bs[q2] & lt) + ((q2 < q && ((bs[q2] >> lane) & 1ull)) ? 1u : 0u);
                const int i = 4 * tid + q, trow = lat ? b * 2048 + i : NLAT + b * 256 + i; int grow = -1;
                if (selq[q]) { grow = e * ROWS_E + (lat ? b * 256 + (int)sl : 2048 + b * 32 + (int)sl);
                    WSP(int, WS_IDX)[grow] = trow; WSP(float, WS_GATE)[grow] = __uint_as_float(key[q]); list[sl * 2] = trow; list[sl * 2 + 1] = grow; }
                gsel[q] = grow; }
            const int trow0 = lat ? b * 2048 + 4 * tid : NLAT + b * 256 + 4 * tid;
#pragma unroll
            for (int q = 0; q < 4; ++q) WSP(int, WS_SEL)[(size_t)(trow0 + q) * 16 + e] = gsel[q];
        }
        __syncthreads();
        for (int s_ = w; s_ < (int)cap; s_ += 8) { const int trow = list[s_ * 2], grow = list[s_ * 2 + 1];
            const u32x4* sp = (const u32x4*)(WSP(const bf16_t, WS_H) + (size_t)trow * DM); u32x4* dp = (u32x4*)(WSP(bf16_t, WS_XIN) + (size_t)grow * DM);
            st16(dp + lane, sp[lane]); st16(dp + lane + 64, sp[lane + 64]); }
    }
    __syncthreads();
}

__device__ __forceinline__ void c6_combine(const Ctx& C, int layer, int nrows) {
    const int lane = C.lane;
    for (int grp = C.gw; grp < nrows / 4; grp += C.ngw) {
        const int row0 = grp * 4, mg = mod_group(row0);
        f32x4 v[4][4], a[4][4]; int selv[4]; unsigned em[4];
#pragma unroll
        for (int rr = 0; rr < 4; ++rr) { row_load(WSP(const float, WS_X) + (size_t)(row0 + rr) * DM, lane, v[rr]); selv[rr] = WSP(const int, WS_SEL)[(size_t)(row0 + rr) * 16 + (lane & 15)]; }
#pragma unroll
        for (int rr = 0; rr < 4; ++rr) { em[rr] = (unsigned)(__ballot(selv[rr] >= 0) & 0xFFFFull);
#pragma unroll
            for (int j = 0; j < 4; ++j) a[rr][j] = (f32x4){0.f, 0.f, 0.f, 0.f}; }
        while (em[0] | em[1] | em[2] | em[3]) {
            u32x2 t[4][4];
#pragma unroll
            for (int rr = 0; rr < 4; ++rr) {
                if (em[rr]) { const int e = __builtin_ctz(em[rr]); const int g = __builtin_amdgcn_readlane(selv[rr], e); const bf16_t* y = WSP(const bf16_t, WS_YB) + (size_t)g * DM;
#pragma unroll
                    for (int j = 0; j < 4; ++j) t[rr][j] = *(const u32x2*)(y + (lane + 64 * j) * 4); }
                else {
#pragma unroll
                    for (int j = 0; j < 4; ++j) t[rr][j] = (u32x2){0u, 0u}; }
            }
#pragma unroll
            for (int rr = 0; rr < 4; ++rr) { em[rr] &= em[rr] - 1u;
#pragma unroll
                for (int j = 0; j < 4; ++j) { const u32x2 w = t[rr][j];
                    a[rr][j] += (f32x4){__uint_as_float(w.x << 16), __uint_as_float(w.x & 0xffff0000u), __uint_as_float(w.y << 16), __uint_as_float(w.y & 0xffff0000u)}; } }
        }
        const float* g2 = modp(C, layer, mg, 5);
#pragma unroll
        for (int rr = 0; rr < 4; ++rr) { const int row = row0 + rr;
#pragma unroll
            for (int j = 0; j < 4; ++j) v[rr][j] += *(const f32x4*)(g2 + (lane + 64 * j) * 4) * a[rr][j];
            const float rstd = row_rstd(v[rr]);
            if (layer < 3) { row_store(WSP(float, WS_X) + (size_t)row * DM, lane, v[rr]);
                f32x4 h[4]; row_modulate(v[rr], rstd, C.A.in[6] + (layer + 1) * DM, modp(C, layer + 1, mg, 0), modp(C, layer + 1, mg, 1), lane, h);
                row_store_bf16(WSP(bf16_t, WS_H) + (size_t)row * DM, lane, h);
            } else {
#pragma unroll
                for (int j = 0; j < 4; ++j) { const int c = (lane + 64 * j) * 4; st16f(C.out + (size_t)row * DM + c, v[rr][j] * rstd * *(const f32x4*)(C.A.in[8] + c)); }
            }
        }
    }
}

constexpr int N_PHASE_IDS = 2 + 12 * 4;
__host__ __device__ inline bool phase_exists(int p) { if (p < 2) return true; const int l = (p - 2) / 12, k = (p - 2) % 12; if (k == 11) return false; if (l & 1) return !(k >= 2 && k <= 4); return true; }

__global__ void __launch_bounds__(512, 2) fwd(Args args) {
    extern __shared__ __attribute__((aligned(16))) unsigned char lds_raw[];
    const int tid_ = threadIdx.x, wave_ = __builtin_amdgcn_readfirstlane(tid_ >> 6);
    const Ctx C0{args, args.out, args.ws, (LAS unsigned char*)lds_raw, tid_, tid_ & 63, wave_, (int)gridDim.x, (int)blockIdx.x, (int)blockIdx.x * 8 + wave_, (int)gridDim.x * 8};
    volatile LAS unsigned* MISC = (volatile LAS unsigned*)(C0.lds + LDSCTL_OFF);
    if (C0.tid < 128) MISC[C0.tid] = 0u;
    __syncthreads();
    const int lo = args.ph_lo, hi = args.ph_hi;
    XcdBarrier bar; bar.bar = (unsigned*)(C0.ws + WS_CTL) + CW_BAR; bar.x = 0; bar.st = nullptr;
    if (hi - lo > 1) bar = xcd_barrier_post((unsigned*)(C0.ws + WS_CTL) + CW_BAR, MISC + 8);
#define RUN(p) (lo <= (p) && (p) < hi)
#define SEAM(p) do { if (hi > (p) + 1) xcd_barrier(bar); } while (0)
    LAS unsigned char* ring = C0.lds;

    if (RUN(0)) { const Ctx C = relaunder(C0); PH(0, p0_convert(C)); PH(18, p0_mod(C)); SEAM(0); }
    if (RUN(1)) { const Ctx C = relaunder(C0); PH(1, p1_init(C)); SEAM(1); }

    for (int layer = 0; layer < 4; ++layer) {
        const int base = 2 + 12 * layer, i = layer >> 1;
        const bool need_ctx = layer < 3;
        if (!(layer & 1)) {
            if (RUN(base + 0)) { const Ctx C = relaunder(C0);
                pg8::Gemm g{WSP(const bf16_t, WS_H), WSP(const bf16_t, WS_WIN) + (size_t)i * ZP * 1024, 1024, 1024, 1024}; pg8::StaticOrder S; S.init(NT, ZP, C.G, C.bid);
                pg8::Epi<FStoreBf16, false> E{{WSP(bf16_t, WS_Z), ZP, 1.f, 0}};
                PH(2, pg8::gemm_phase(ring, g, S, E)); PH(19, bg_fill(C, units_missing(S.nwg, S.G, S.c))); SEAM(base + 0); }
            if (RUN(base + 1)) { const Ctx C = relaunder(C0); PH(3, a2_prepare(C, i)); SEAM(base + 1); }
            if (RUN(base + 2)) { const Ctx C = relaunder(C0); int nmiss = 0;
                { pg8::Gemm g{WSP(const bf16_t, WS_LIN), WSP(const bf16_t, WS_WLORA) + (size_t)i * 2560 * 384, 384, 384, 384}; pg8::StaticOrder S; S.init(NT, 2560, C.G, C.bid);
                  pg8::Epi<FLora, false> E{{C.A.in[12] + i * 1024, C.A.in[14] + i * 1024, C.A.in[18] + i * 512, WSP(const bf16_t, WS_KS), WSP(const bf16_t, WS_KK), WSP(float, WS_DEC), WSP(bf16_t, WS_KD), WSP(bf16_t, WS_BB), WSP(bf16_t, WS_G)}};
                  PH(4, pg8::gemm_phase(ring, g, S, E)); nmiss += units_missing(S.nwg, S.G, S.c); }
                { pg8::Gemm g{WSP(const bf16_t, WS_QN), WSP(const bf16_t, WS_WQUP) + (size_t)i * 768 * 384, 384, 384, 384}; pg8::StaticOrder S; S.init(NT, 768, C.G, C.bid);
                  pg8::Epi<FQup, false> E{{WSP(bf16_t, WS_Q), WSP(const float, WS_ROPE), ATTN_NAIVE ? 0.10206207261596577f : 0.10206207261596577f * 1.4426950408889634f}};
                  PH(16, pg8::gemm_phase(ring, g, S, E)); nmiss += units_missing(S.nwg, S.G, S.c); }
                { pg8::Gemm g{WSP(const bf16_t, WS_KVN), WSP(const bf16_t, WS_WKVUP) + (size_t)i * 1024 * 256, 256, 256, 256}; pg8::StaticOrder S; S.init(NT, 1024, C.G, C.bid);
                  pg8::Epi<FStoreBf16, false> E{{WSP(bf16_t, WS_KV), 1024, 1.f, 0}};
                  PH(17, pg8::gemm_phase(ring, g, S, E)); nmiss += units_missing(S.nwg, S.G, S.c); }
                (void)nmiss;
                SEAM(base + 2); }
            if (RUN(base + 3)) { const Ctx C = relaunder(C0); PH(5, a4_scan(C)); PH(6, if (ATTN_NAIVE) a4_mla_naive(C); else a4_mla(C, layer)); PH(19, bg_fill(C, C.bid < 128 ? 0 : BG_A4)); SEAM(base + 3); }
            if (RUN(base + 4)) { const Ctx C = relaunder(C0); PH(7, a5_output(C, i)); SEAM(base + 4); }
        } else {
            if (RUN(base + 0)) { const Ctx C = relaunder(C0);
                pg8::Gemm g{WSP(const bf16_t, WS_H), WSP(const bf16_t, WS_WQKV) + (size_t)i * 3072 * 1024, 1024, 1024, 1024}; pg8::StaticOrder S; S.init(NT, 3072, C.G, C.bid);
                pg8::Epi<FStoreBf16, false> E{{WSP(bf16_t, WS_Z), 3072, ATTN_NAIVE ? 0.125f : 0.125f * 1.4426950408889634f, 1024}};
                PH(8, pg8::gemm_phase(ring, g, S, E)); PH(19, bg_fill(C, units_missing(S.nwg, S.G, S.c))); SEAM(base + 0); }
            if (RUN(base + 1)) { const Ctx C = relaunder(C0); PH(9, if (ATTN_NAIVE) b2_na_naive(C, i, need_ctx); else b2_na(C, i, need_ctx)); SEAM(base + 1); }
        }
        if (RUN(base + 5)) { const Ctx C = relaunder(C0);
            const bf16_t* W = (layer & 1) ? WSP(const bf16_t, WS_WOUTC) + (size_t)i * 1024 * 1024 : WSP(const bf16_t, WS_WOUTA) + (size_t)i * 1024 * 1024;
            pg8::Gemm g{WSP(const bf16_t, WS_MIX), W, 1024, 1024, 1024}; pg8::StaticOrder S; S.init(need_ctx ? NT : NLAT, 1024, C.G, C.bid);
            pg8::Epi<FResid, false> E{{WSP(float, WS_X), layer == 0 ? C.A.in[0] : WSP(const float, WS_X), layer == 0 ? C.A.in[2] : WSP(const float, WS_X) + (size_t)NLAT * DM, WSP(const float, WS_MOD), layer}};
            PH(10, pg8::gemm_phase(ring, g, S, E)); PH(19, bg_fill(C, units_missing(S.nwg, S.G, S.c))); SEAM(base + 5); }
        if (RUN(base + 6)) { const Ctx C = relaunder(C0); PH(11, c2_router(C, layer, need_ctx ? NT : NLAT)); SEAM(base + 6); }
        if (RUN(base + 7)) { const Ctx C = relaunder(C0); PH(12, c3_topk(C, need_ctx)); PH(19, bg_catch_up(C, (layer + 1) * CV_NB_L)); SEAM(base + 7); }
        if (RUN(base + 8)) { const Ctx C = relaunder(C0);
            pg8::Gemm g{WSP(const bf16_t, WS_XIN), WSP(const bf16_t, WS_W13) + (size_t)layer * 16 * 4096 * 1024, 1024, 1024, 1024}; pg8::MoeOrder S; S.init(need_ctx ? 9 : 8, 16, C.G, C.bid);
            pg8::Epi<FSwiglu, true> E{{WSP(bf16_t, WS_HID)}};
            PH(13, pg8::gemm_phase(ring, g, S, E)); SEAM(base + 8); }
        if (RUN(base + 9)) { const Ctx C = relaunder(C0);
            pg8::Gemm g{WSP(const bf16_t, WS_HID), WSP(const bf16_t, WS_W2) + (size_t)layer * 16 * 1024 * 2048, 2048, 2048, 2048}; pg8::MoeOrder S; S.init(need_ctx ? 9 : 8, 4, C.G, C.bid);
            pg8::Epi<FGate, false> E{{WSP(bf16_t, WS_YB), WSP(const float, WS_GATE)}};
            PH(14, pg8::gemm_phase(ring, g, S, E)); PH(19, bg_fill(C, units_missing(S.nwg, S.G, S.c))); SEAM(base + 9); }
        if (RUN(base + 10)) { const Ctx C = relaunder(C0); PH(15, c6_combine(C, layer, need_ctx ? NT : NLAT)); if (layer < 3) SEAM(base + 10); }
    }
#undef RUN
#undef SEAM
}

extern "C" void kernel_launch(void* const* d_in, const int* in_sizes, int n_in, void* d_out, int out_size, void* d_ws, size_t ws_size, hipStream_t stream) {
    static int grid = 0;
    if (grid == 0) {
        if (n_in != 33 || out_size != NLAT * DM || ws_size < WS_END) { fprintf(stderr, "kernel_launch: unexpected shapes (n_in %d out %d ws %zu need %zu)\n", n_in, out_size, ws_size, (size_t)WS_END); grid = -1; return; }
        int dev = 0, cus = 0, per_cu = 0;
        if (hipGetDevice(&dev) != hipSuccess || hipDeviceGetAttribute(&cus, hipDeviceAttributeMultiprocessorCount, dev) != hipSuccess) { grid = -1; return; }
        if (hipFuncSetAttribute((const void*)fwd, hipFuncAttributeMaxDynamicSharedMemorySize, LDS_BYTES) != hipSuccess) { fprintf(stderr, "kernel_launch: hipFuncSetAttribute failed\n"); grid = -1; return; }
        if (hipOccupancyMaxActiveBlocksPerMultiprocessor(&per_cu, (const void*)fwd, 512, LDS_BYTES) != hipSuccess || per_cu < 1) fprintf(stderr, "kernel_launch: occupancy query says %d\n", per_cu);
        (void)hipGetLastError();
        grid = cus;
    }
    if (grid < 0) return;
    (void)hipMemsetAsync((char*)d_ws + WS_CTL, 0, CTL_BYTES, stream);
    Args a{};
    for (int i = 0; i < 33; ++i) a.in[i] = (const float*)d_in[i];
    a.out = (float*)d_out; a.ws = (unsigned char*)d_ws;
#if SINGLE_LAUNCH
    a.ph_lo = 0; a.ph_hi = N_PHASE_IDS;
    hipLaunchKernelGGL(fwd, dim3(grid), dim3(512), LDS_BYTES, stream, a);
#else
    for (int p = 0; p < N_PHASE_IDS; ++p) { if (!phase_exists(p)) continue; a.ph_lo = p; a.ph_hi = p + 1; hipLaunchKernelGGL(fwd, dim3(grid), dim3(512), LDS_BYTES, stream, a); }
#endif
}
```
